# Optimizing an MI355X kernel written in HIP

```python
import jax, jax.numpy as jnp
from jax import lax
import numpy as np

D_MODEL = 1024
BATCH = 16
SEQ = 2048
DEPTH = 1

N_META = 16
BLOCK = 128
WINDOW = 128
PREFIX = BLOCK
N_PAD = PREFIX - N_META
HEAD_DIM = 64
A_HEADS = D_MODEL // 128
A_KV_HEADS = A_HEADS // 4
A_GROUP = A_HEADS // A_KV_HEADS
B_HEADS = D_MODEL // 128
A_WIDTH = A_HEADS * HEAD_DIM
A_KV_WIDTH = A_KV_HEADS * HEAD_DIM
B_WIDTH = B_HEADS * HEAD_DIM
W_IN_COLS = A_WIDTH + 2 * A_KV_WIDTH + 3 * B_WIDTH + B_HEADS + 2 * D_MODEL
D_FF = ((8 * D_MODEL // 3 + 127) // 128) * 128
EPS = 1e-6
NEG = -1e30

kernel_name = "hybrid_swa_sink_fox_macaron_block"


def rms_norm(x, g):
    xf = x.astype(jnp.float32)
    y = xf * lax.rsqrt(jnp.mean(xf * xf, axis=-1, keepdims=True) + EPS)
    return (y * g.astype(jnp.float32)).astype(x.dtype)


def swiglu(x, w_in, w_out):
    gu = x @ w_in
    g, u = jnp.split(gu, 2, axis=-1)
    return (jax.nn.silu(g) * u) @ w_out


def alibi_slopes(n_heads):
    return jnp.exp2(-8.0 * jnp.arange(1, n_heads + 1, dtype=jnp.float32) / n_heads)


def sliding_window_sink_attention(q, k, v, sinks):
    b, l, _, dh = q.shape
    nb = l // BLOCK
    qb = q.reshape(b, nb, BLOCK, A_KV_HEADS, A_GROUP, dh)
    kb = k.reshape(b, nb, BLOCK, A_KV_HEADS, dh)
    vb = v.reshape(b, nb, BLOCK, A_KV_HEADS, dh)
    pad_blk = ((0, 0), (1, 0), (0, 0), (0, 0), (0, 0))
    band_k = jnp.concatenate([jnp.pad(kb[:, :-1], pad_blk), kb], axis=2)
    band_v = jnp.concatenate([jnp.pad(vb[:, :-1], pad_blk), vb], axis=2)
    meta_k = jnp.broadcast_to(k[:, None, N_PAD:PREFIX], (b, nb, N_META, A_KV_HEADS, dh))
    meta_v = jnp.broadcast_to(v[:, None, N_PAD:PREFIX], (b, nb, N_META, A_KV_HEADS, dh))
    keys = jnp.concatenate([meta_k, band_k], axis=2)
    vals = jnp.concatenate([meta_v, band_v], axis=2)

    q_pos = jnp.arange(l).reshape(nb, BLOCK)
    band_pos = (jnp.arange(nb)[:, None] - 1) * BLOCK + jnp.arange(2 * BLOCK)[None, :]
    meta_pos = jnp.broadcast_to(N_PAD + jnp.arange(N_META)[None, :], (nb, N_META))
    k_pos = jnp.concatenate([meta_pos, band_pos], axis=1)
    is_band = jnp.concatenate([jnp.zeros((N_META,), bool), jnp.ones((2 * BLOCK,), bool)])
    dist = q_pos[:, :, None] - k_pos[:, None, :]
    band_ok = (dist < WINDOW) & (k_pos[:, None, :] >= PREFIX)
    allowed = (dist >= 0) & jnp.where(is_band[None, None, :], band_ok, True)

    slopes = alibi_slopes(A_HEADS).reshape(A_KV_HEADS, A_GROUP)
    s = jnp.einsum('bnqkgd,bnskd->bnkgqs', qb, keys).astype(jnp.float32) * (dh ** -0.5)
    s = s - slopes[None, None, :, :, None, None] * dist.astype(jnp.float32)[None, :, None, None, :, :]
    s = jnp.where(allowed[None, :, None, None, :, :], s, NEG)
    sink = jnp.broadcast_to(
        sinks.astype(jnp.float32).reshape(A_KV_HEADS, A_GROUP)[None, None, :, :, None, None],
        s.shape[:-1] + (1,))
    p = jax.nn.softmax(jnp.concatenate([s, sink], axis=-1), axis=-1)[..., :-1]
    o = jnp.einsum('bnkgqs,bnskd->bnqkgd', p.astype(v.dtype), vals)
    return o.reshape(b, l, A_HEADS * dh)


def forgetting_attention(q, k, v, log_f):
    b, l, h, dh = q.shape
    nb = l // BLOCK
    c = jnp.cumsum(log_f, axis=1).transpose(0, 2, 1)
    outs = []
    for i in range(nb):
        q_lo, k_hi = i * BLOCK, (i + 1) * BLOCK
        s = jnp.einsum('bqhd,bshd->bhqs', q[:, q_lo:k_hi], k[:, :k_hi]).astype(jnp.float32) * (dh ** -0.5)
        s = s + c[:, :, q_lo:k_hi, None] - c[:, :, None, :k_hi]
        q_pos = q_lo + jnp.arange(BLOCK)
        k_pos = jnp.arange(k_hi)
        allowed = (k_pos[None, :] <= q_pos[:, None]) & (k_pos[None, :] >= N_PAD)
        s = jnp.where(allowed[None, None], s, NEG)
        p = jax.nn.softmax(s, axis=-1)
        outs.append(jnp.einsum('bhqs,bshd->bqhd', p.astype(v.dtype), v[:, :k_hi]))
    return jnp.concatenate(outs, axis=1).reshape(b, l, h * dh)


def setup_inputs(seed: int = 0) -> dict:
    key = jax.random.key(seed)
    ks = jax.random.split(key, 20)
    f32 = jnp.float32
    n = lambda k, shape, scale: jax.random.normal(k, shape, f32) * scale
    return {
        "x": n(ks[0], (BATCH, SEQ, D_MODEL), 1.0),
        "meta_tokens": n(ks[1], (N_META, D_MODEL), 1.0),
        "ffn1_norm": 1.0 + n(ks[2], (DEPTH, D_MODEL), 0.02),
        "ffn1_w_in": n(ks[3], (DEPTH, D_MODEL, 2 * D_FF), D_MODEL ** -0.5),
        "ffn1_w_out": n(ks[4], (DEPTH, D_FF, D_MODEL), D_FF ** -0.5),
        "mix_norm": 1.0 + n(ks[5], (DEPTH, D_MODEL), 0.02),
        "w_in": n(ks[6], (DEPTH, D_MODEL, W_IN_COLS), D_MODEL ** -0.5),
        "b_forget": 2.0 + n(ks[7], (DEPTH, B_HEADS), 0.1),
        "attn_sinks": n(ks[8], (DEPTH, A_HEADS), 0.5),
        "w_branch_a": n(ks[9], (DEPTH, A_WIDTH, D_MODEL), A_WIDTH ** -0.5),
        "w_branch_b": n(ks[10], (DEPTH, B_WIDTH, D_MODEL), B_WIDTH ** -0.5),
        "w_out": n(ks[11], (DEPTH, D_MODEL, D_MODEL), D_MODEL ** -0.5),
        "ffn2_norm": 1.0 + n(ks[12], (DEPTH, D_MODEL), 0.02),
        "ffn2_w_in": n(ks[13], (DEPTH, D_MODEL, 2 * D_FF), D_MODEL ** -0.5),
        "ffn2_w_out": n(ks[14], (DEPTH, D_FF, D_MODEL), D_FF ** -0.5),
        "final_norm": 1.0 + n(ks[15], (D_MODEL,), 0.02),
    }


def reference(x, meta_tokens, ffn1_norm, ffn1_w_in, ffn1_w_out, mix_norm, w_in, b_forget,
              attn_sinks, w_branch_a, w_branch_b, w_out, ffn2_norm, ffn2_w_in, ffn2_w_out,
              final_norm):
    b = x.shape[0]
    pads = jnp.zeros((b, N_PAD, D_MODEL), x.dtype)
    meta = jnp.broadcast_to(meta_tokens.astype(x.dtype)[None], (b, N_META, D_MODEL))
    h = jnp.concatenate([pads, meta, x], axis=1)
    l = h.shape[1]

    sizes = [A_WIDTH, A_KV_WIDTH, A_KV_WIDTH, B_WIDTH, B_WIDTH, B_WIDTH, B_HEADS, D_MODEL, D_MODEL]
    offsets = []
    acc = 0
    for sz in sizes[:-1]:
        acc += sz
        offsets.append(acc)

    for i in range(DEPTH):
        h = h + 0.5 * swiglu(rms_norm(h, ffn1_norm[i]), ffn1_w_in[i], ffn1_w_out[i])

        u = rms_norm(h, mix_norm[i])
        proj = u @ w_in[i]
        qa, ka, va, qb, kb, vb, f_logit, g_a, g_b = jnp.split(proj, offsets, axis=-1)
        qa = qa.reshape(b, l, A_HEADS, HEAD_DIM)
        ka = ka.reshape(b, l, A_KV_HEADS, HEAD_DIM)
        va = va.reshape(b, l, A_KV_HEADS, HEAD_DIM)
        qb = qb.reshape(b, l, B_HEADS, HEAD_DIM)
        kb = kb.reshape(b, l, B_HEADS, HEAD_DIM)
        vb = vb.reshape(b, l, B_HEADS, HEAD_DIM)
        log_f = jax.nn.log_sigmoid((f_logit + b_forget[i]).astype(jnp.float32))

        y_a = sliding_window_sink_attention(qa, ka, va, attn_sinks[i]) @ w_branch_a[i]
        y_b = forgetting_attention(qb, kb, vb, log_f) @ w_branch_b[i]
        mixed = jax.nn.sigmoid(g_a) * y_a + jax.nn.sigmoid(g_b) * y_b
        h = h + mixed @ w_out[i]

        h = h + 0.5 * swiglu(rms_norm(h, ffn2_norm[i]), ffn2_w_in[i], ffn2_w_out[i])

    return rms_norm(h, final_norm)[:, PREFIX:]
```

```cpp
#include <hip/hip_runtime.h>
#include <hip/hip_bf16.h>
#include <cstdio>
#include <cstdint>

#define LAS __attribute__((address_space(3)))
#define GAS __attribute__((address_space(1)))
typedef unsigned short bf16_t;
typedef short bf16x8 __attribute__((ext_vector_type(8)));
typedef float f32x4 __attribute__((ext_vector_type(4)));
typedef float f32x16 __attribute__((ext_vector_type(16)));
typedef unsigned u32x4 __attribute__((ext_vector_type(4)));
typedef unsigned u32x2 __attribute__((ext_vector_type(2)));
typedef short s16x4 __attribute__((ext_vector_type(4)));

constexpr int DM = 1024, NBATCH = 16, SEQ = 2048, MROWS = NBATCH * SEQ;
constexpr int DFF = 2816, NPROJ = 4608;
constexpr int LPOS = 2176, NKR = NBATCH * LPOS;
constexpr int NMETA = 16, KR_META = 112, KR_REAL = 128;
constexpr float EPS = 1e-6f, LOG2E = 1.4426950408889634f, QSCALE = 0.125f * 1.4426950408889634f;

__device__ __forceinline__ unsigned cvt_pk_bf16(float lo, float hi) { unsigned r; asm volatile("v_cvt_pk_bf16_f32 %0, %1, %2" : "=v"(r) : "v"(lo), "v"(hi)); return r; }
__device__ __forceinline__ float bf_lo(unsigned w) { return __uint_as_float(w << 16); }
__device__ __forceinline__ float bf_hi(unsigned w) { return __uint_as_float(w & 0xffff0000u); }

namespace pg8 {
#define PG8_LAS __attribute__((address_space(3)))
constexpr int BM = 256, BK = 64, HALF = 128, HTB = HALF * BK * 2  , STAGE_BYTES = 8 * HTB, NXCD = 8, WGM = 8;

__host__ __device__ __forceinline__ int lds_byte(int r, int c) { const int st = (r >> 4) * 2 + (c >> 5), rr = r & 15, cc = c & 31, ob = rr * 64 + cc * 2; return st * 1024 + (ob ^ (((ob >> 9) & 1) << 5)); }
__host__ __device__ __forceinline__ void stage_rc(int b, int& R, int& C) { const int st = b / 1024, sb = b % 1024, swz = sb ^ (((sb >> 9) & 1) << 5); R = (st >> 1) * 16 + swz / 64; C = (st & 1) * 32 + (swz % 64) / 2; }
__host__ __device__ __forceinline__ int perm32(int rho) { const int n = rho >> 4, i = rho & 15; return 8 * (i >> 2) + 4 * n + (i & 3); }

struct Unit { int pm, pn, koff, br; };
struct Gemm { const bf16_t* A; const bf16_t* Bt; int lda, ldb, K; };

struct StaticOrder {
    int nM, nN, nwg, G, c;
    __host__ __device__ void init(int M, int N, int G_, int c_) { nM = M / BM; nN = N / BM; nwg = nM * nN; G = G_; c = c_; }
    __host__ __device__ bool next(int i, Unit& u) const {
        const long L = (long)i * G + c; if (L >= nwg) return false;
        int wgid = (int)L; { const int q = nwg / NXCD, r = nwg % NXCD, xcd = wgid % NXCD, off = wgid / NXCD; wgid = (xcd < r ? xcd * (q + 1) : r * (q + 1) + (xcd - r) * q) + off; }
        const int nig = WGM * nN, gid = wgid / nig, fm = gid * WGM, gsz = (nM - fm) < WGM ? (nM - fm) : WGM;
        u.pm = fm + ((wgid % nig) % gsz); u.pn = (wgid % nig) / gsz; u.koff = 0; u.br = 0; return true;
    }
    __device__ __forceinline__ void a_ready(const Unit&) const {}
    __device__ __forceinline__ void done(const Unit&) const {}
};
struct DualOrder {
    StaticOrder S;
    __host__ __device__ bool next(int i, Unit& u) const { if (!S.next(i >> 1, u)) return false; u.br = i & 1; u.koff = 512 * (i & 1); return true; }
    __device__ __forceinline__ void a_ready(const Unit&) const {}
    __device__ __forceinline__ void done(const Unit&) const {}
};

__device__ __forceinline__ float row_rs(const float* ssq, int row, int fq) {
    const f32x4 p = *(const f32x4*)(ssq + (size_t)row * 16 + 4 * fq);
    float s = (p[0] + p[1]) + (p[2] + p[3]);
    s += __shfl_xor(s, 16); s += __shfl_xor(s, 32);
    return __builtin_amdgcn_rsqf(s * (1.0f / 1024.0f) + EPS);
}
__device__ __forceinline__ float fast_sigmoid(float x) { return __builtin_amdgcn_rcpf(1.0f + __builtin_amdgcn_exp2f(-x * LOG2E)); }
__device__ __forceinline__ u32x4 pack8(const f32x4 a, const f32x4 b) { u32x4 w; w.x = cvt_pk_bf16(a[0], a[1]); w.y = cvt_pk_bf16(a[2], a[3]); w.z = cvt_pk_bf16(b[0], b[1]); w.w = cvt_pk_bf16(b[2], b[3]); return w; }

struct EpiSwiGLU {
    static constexpr bool PERM = true, AFTER_DRAIN = false, MID = false;
    bf16_t* O; const float* ssq;
    __device__ __forceinline__ void operator()(const f32x4 (&acc)[2][2][4][2], const Unit& u, int wr, int wc, int fr, int fq) const {
        const int row0 = u.pm * BM + wr * 64 + fr, col0 = u.pn * HALF + wc * 32 + 8 * fq;
#pragma unroll
        for (int ai = 0; ai < 2; ++ai)
#pragma unroll
            for (int m = 0; m < 4; ++m) {
                const int row = row0 + ai * HALF + m * 16; const float rs = row_rs(ssq, row, fq);
                f32x4 o[2];
#pragma unroll
                for (int n = 0; n < 2; ++n)
#pragma unroll
                    for (int e = 0; e < 4; ++e) { const float g = acc[ai][0][m][n][e] * rs, uu = acc[ai][1][m][n][e] * rs; o[n][e] = g * fast_sigmoid(g) * uu; }
                *(u32x4*)(O + (size_t)row * DFF + col0) = pack8(o[0], o[1]);
            }
    }
};
template <bool BASE_F32> struct EpiResB {
    static constexpr bool PERM = true, AFTER_DRAIN = false, MID = false;
    const void* base; bf16_t* xb; float* ssq; float scale;
    __device__ __forceinline__ void operator()(const f32x4 (&acc)[2][2][4][2], const Unit& u, int wr, int wc, int fr, int fq) const {
        const int row0 = u.pm * BM + wr * 64 + fr, col0 = u.pn * BM + wc * 32 + 8 * fq;
#pragma unroll
        for (int ai = 0; ai < 2; ++ai)
#pragma unroll
            for (int m = 0; m < 4; ++m) {
                const int row = row0 + ai * HALF + m * 16; const size_t off = (size_t)row * DM + col0; float sq = 0.f;
#pragma unroll
                for (int bj = 0; bj < 2; ++bj) {
                    const size_t c = off + bj * HALF; f32x4 b0, b1;
                    if (BASE_F32) { b0 = *(const f32x4*)((const float*)base + c); b1 = *(const f32x4*)((const float*)base + c + 4); }
                    else { const u32x4 w = *(const u32x4*)((const bf16_t*)base + c); b0 = (f32x4){bf_lo(w.x), bf_hi(w.x), bf_lo(w.y), bf_hi(w.y)}; b1 = (f32x4){bf_lo(w.z), bf_hi(w.z), bf_lo(w.w), bf_hi(w.w)}; }
                    const f32x4 v0 = b0 + acc[ai][bj][m][0] * scale, v1 = b1 + acc[ai][bj][m][1] * scale;
                    *(u32x4*)(xb + c) = pack8(v0, v1);
                    sq += (v0[0] * v0[0] + v0[1] * v0[1]) + (v0[2] * v0[2] + v0[3] * v0[3]) + (v1[0] * v1[0] + v1[1] * v1[1]) + (v1[2] * v1[2] + v1[3] * v1[3]);
                }
                sq += __shfl_xor(sq, 16); sq += __shfl_xor(sq, 32);
                if (fq == 0) ssq[(size_t)row * 16 + u.pn * 4 + wc] = sq;
                if (m & 1) asm volatile("" ::: "memory");
            }
    }
};
struct EpiFinal {
    static constexpr bool PERM = true, AFTER_DRAIN = false, MID = false;
    const bf16_t* base; float* out; const float* gf; float* part; unsigned* cnt; float scale;
    __device__ __forceinline__ void operator()(f32x4 (&acc)[2][2][4][2], const Unit& u, int wr, int wc, int fr, int fq) const {
        const int row0 = u.pm * BM + wr * 64 + fr, col0 = u.pn * BM + wc * 32 + 8 * fq;
#pragma unroll
        for (int ai = 0; ai < 2; ++ai)
#pragma unroll
            for (int m = 0; m < 4; ++m) {
                const int row = row0 + ai * HALF + m * 16; const size_t off = (size_t)row * DM + col0; float sq = 0.f;
#pragma unroll
                for (int bj = 0; bj < 2; ++bj) {
                    const u32x4 w = *(const u32x4*)(base + off + bj * HALF);
                    const f32x4 b0 = (f32x4){bf_lo(w.x), bf_hi(w.x), bf_lo(w.y), bf_hi(w.y)}, b1 = (f32x4){bf_lo(w.z), bf_hi(w.z), bf_lo(w.w), bf_hi(w.w)};
                    const f32x4 v0 = b0 + acc[ai][bj][m][0] * scale, v1 = b1 + acc[ai][bj][m][1] * scale;
                    acc[ai][bj][m][0] = v0; acc[ai][bj][m][1] = v1;
                    sq += (v0[0] * v0[0] + v0[1] * v0[1]) + (v0[2] * v0[2] + v0[3] * v0[3]) + (v1[0] * v1[0] + v1[1] * v1[1]) + (v1[2] * v1[2] + v1[3] * v1[3]);
                }
                sq += __shfl_xor(sq, 16); sq += __shfl_xor(sq, 32);
                if (fq == 0) __hip_atomic_store(part + (size_t)row * 16 + u.pn * 4 + wc, sq, __ATOMIC_RELAXED, __HIP_MEMORY_SCOPE_AGENT);
                if (m & 1) asm volatile("" ::: "memory");
            }
        asm volatile("s_waitcnt vmcnt(0)" ::: "memory");
        unsigned* pc = cnt + 64 * u.pm;
        if ((threadIdx.x & 63) == 0) __hip_atomic_fetch_add(pc, 1u, __ATOMIC_RELAXED, __HIP_MEMORY_SCOPE_AGENT);
        for (unsigned spins = 0; spins < (1u << 22); ++spins) {
            if ((unsigned)__builtin_amdgcn_readfirstlane(__hip_atomic_load(pc, __ATOMIC_RELAXED, __HIP_MEMORY_SCOPE_AGENT)) >= 32u) break;
            __builtin_amdgcn_s_sleep(2);
        }
        asm volatile("" ::: "memory");
        const int gc0 = u.pn * BM + wc * 32 + 8 * fq;
#pragma unroll
        for (int ai = 0; ai < 2; ++ai)
#pragma unroll
            for (int m = 0; m < 4; ++m) {
                const int row = row0 + ai * HALF + m * 16; const size_t off = (size_t)row * DM + col0;
                const unsigned long long* pp = (const unsigned long long*)(part + (size_t)row * 16 + 4 * fq);
                const unsigned long long q0 = __hip_atomic_load(pp, __ATOMIC_RELAXED, __HIP_MEMORY_SCOPE_AGENT), q1 = __hip_atomic_load(pp + 1, __ATOMIC_RELAXED, __HIP_MEMORY_SCOPE_AGENT);
                float s = (__uint_as_float((unsigned)q0) + __uint_as_float((unsigned)(q0 >> 32))) + (__uint_as_float((unsigned)q1) + __uint_as_float((unsigned)(q1 >> 32)));
                s += __shfl_xor(s, 16); s += __shfl_xor(s, 32);
                const float rs = 1.0f / sqrtf(s * (1.0f / 1024.0f) + EPS);
#pragma unroll
                for (int bj = 0; bj < 2; ++bj) {
                    const f32x4 g0 = *(const f32x4*)(gf + gc0 + bj * HALF), g1 = *(const f32x4*)(gf + gc0 + bj * HALF + 4);
                    *(f32x4*)(out + off + bj * HALF) = acc[ai][bj][m][0] * rs * g0; *(f32x4*)(out + off + bj * HALF + 4) = acc[ai][bj][m][1] * rs * g1;
                }
            }
    }
};
struct EpiProj {
    static constexpr bool PERM = true, AFTER_DRAIN = false, MID = false;
    const float* ssq; bf16_t *QO, *KA, *VA, *KB, *VB, *RAB, *SGB; float* LOGF; const float* bfg;
    __device__ __forceinline__ void operator()(const f32x4 (&acc)[2][2][4][2], const Unit& u, int wr, int wc, int fr, int fq) const {
        const int pn = u.pn, row0 = u.pm * BM + wr * 64 + fr, kadd = KR_REAL * (u.pm / 8 + 1);
        if (pn == 17) {
            f32x4 bb0 = *(const f32x4*)(bfg), bb1 = *(const f32x4*)(bfg + 4);
#pragma unroll
            for (int ai = 0; ai < 2; ++ai)
#pragma unroll
                for (int m = 0; m < 4; ++m) {
                    const int row = row0 + ai * HALF + m * 16; const float rs = row_rs(ssq, row, fq);
                    if (wc == 0 && fq == 0) {
                        f32x4 lf[2];
#pragma unroll
                        for (int n = 0; n < 2; ++n)
#pragma unroll
                            for (int e = 0; e < 4; ++e) { const float x = acc[ai][0][m][n][e] * rs + (n ? bb1[e] : bb0[e]); lf[n][e] = fminf(x, 0.f) - log1pf(expf(-fabsf(x))); }
                        float* d = LOGF + (size_t)(row + kadd) * 8; *(f32x4*)d = lf[0]; *(f32x4*)(d + 4) = lf[1];
                    }
                }
            return;
        }
        if (pn >= 9) {
            const int cg = (pn - 9) * HALF + wc * 32 + 8 * fq;
#pragma unroll
            for (int ai = 0; ai < 2; ++ai)
#pragma unroll
                for (int m = 0; m < 4; ++m) {
                    const int row = row0 + ai * HALF + m * 16; const float rs = row_rs(ssq, row, fq); f32x4 r[2], sb[2];
#pragma unroll
                    for (int n = 0; n < 2; ++n)
#pragma unroll
                        for (int e = 0; e < 4; ++e) {
                            const float ga = __builtin_amdgcn_fmed3f(acc[ai][0][m][n][e] * rs, -80.f, 80.f), gb = __builtin_amdgcn_fmed3f(acc[ai][1][m][n][e] * rs, -80.f, 80.f);
                            const float ea = __builtin_amdgcn_exp2f(-ga * LOG2E), eb = __builtin_amdgcn_exp2f(-gb * LOG2E);
                            r[n][e] = (1.0f + eb) * __builtin_amdgcn_rcpf(1.0f + ea); sb[n][e] = __builtin_amdgcn_rcpf(1.0f + eb);
                        }
                    *(u32x4*)(RAB + (size_t)row * DM + cg) = pack8(r[0], r[1]); *(u32x4*)(SGB + (size_t)row * DM + cg) = pack8(sb[0], sb[1]);
                }
            return;
        }
        bf16_t* d0; bf16_t* d1; int pitch, radd = 0; float mul = 1.f;
        if (pn < 2)       { d0 = QO + pn * 256; d1 = d0 + HALF; pitch = DM; mul = QSCALE; }
        else if (pn == 2) { d0 = KA; d1 = VA; pitch = 128; radd = kadd; }
        else if (pn < 5)  { d0 = QO + 512 + (pn - 3) * 256; d1 = d0 + HALF; pitch = DM; mul = QSCALE; }
        else if (pn < 7)  { d0 = KB + (pn - 5) * 256; d1 = d0 + HALF; pitch = 512; radd = kadd; }
        else              { d0 = VB + (pn - 7) * 256; d1 = d0 + HALF; pitch = 512; radd = kadd; }
        const int cw = wc * 32 + 8 * fq;
#pragma unroll
        for (int ai = 0; ai < 2; ++ai)
#pragma unroll
            for (int m = 0; m < 4; ++m) {
                const int row = row0 + ai * HALF + m * 16; const float rs = row_rs(ssq, row, fq) * mul; const size_t ro = (size_t)(row + radd) * pitch + cw;
#pragma unroll
                for (int bj = 0; bj < 2; ++bj) {
                    const f32x4 v0 = acc[ai][bj][m][0] * rs, v1 = acc[ai][bj][m][1] * rs;
                    *(u32x4*)((bj ? d1 : d0) + ro) = pack8(v0, v1);
                }
            }
    }
};
struct EpiMix {
    static constexpr bool PERM = true, AFTER_DRAIN = false, MID = true;
    const bf16_t *RAB, *SGB; bf16_t* MIX;
    __device__ __forceinline__ void mid(f32x4 (&acc)[2][2][4][2], const Unit& u, int wr, int wc, int fr, int fq) const {
        int row0 = u.pm * BM + wr * 64 + fr; const int col0 = u.pn * BM + wc * 32 + 8 * fq;
        asm volatile("" : "+v"(row0));
#pragma unroll
        for (int ai = 0; ai < 2; ++ai)
#pragma unroll
            for (int m = 0; m < 4; ++m) {
                const int row = row0 + ai * HALF + m * 16;
#pragma unroll
                for (int bj = 0; bj < 2; ++bj) {
                    const u32x4 gw = *(const u32x4*)(RAB + (size_t)row * DM + col0 + bj * HALF);
                    acc[ai][bj][m][0] *= (f32x4){bf_lo(gw.x), bf_hi(gw.x), bf_lo(gw.y), bf_hi(gw.y)}; acc[ai][bj][m][1] *= (f32x4){bf_lo(gw.z), bf_hi(gw.z), bf_lo(gw.w), bf_hi(gw.w)};
                }
                if (m & 1) asm volatile("" ::: "memory");
            }
    }
    __device__ __forceinline__ void operator()(const f32x4 (&acc)[2][2][4][2], const Unit& u, int wr, int wc, int fr, int fq) const {
        int row0 = u.pm * BM + wr * 64 + fr; const int col0 = u.pn * BM + wc * 32 + 8 * fq;
        asm volatile("" : "+v"(row0));
#pragma unroll
        for (int ai = 0; ai < 2; ++ai)
#pragma unroll
            for (int m = 0; m < 4; ++m) {
                const int row = row0 + ai * HALF + m * 16;
#pragma unroll
                for (int bj = 0; bj < 2; ++bj) {
                    const size_t c = (size_t)row * DM + col0 + bj * HALF;
                    const u32x4 gw = *(const u32x4*)(SGB + c);
                    const f32x4 v0 = acc[ai][bj][m][0] * (f32x4){bf_lo(gw.x), bf_hi(gw.x), bf_lo(gw.y), bf_hi(gw.y)}, v1 = acc[ai][bj][m][1] * (f32x4){bf_lo(gw.z), bf_hi(gw.z), bf_lo(gw.w), bf_hi(gw.w)};
                    *(u32x4*)(MIX + c) = pack8(v0, v1);
                }
                if (m & 1) asm volatile("" ::: "memory");
            }
    }
};
struct EpiNull {
    static constexpr bool PERM = true, AFTER_DRAIN = false, MID = false;
    __device__ __forceinline__ void operator()(const f32x4 (&acc)[2][2][4][2], const Unit& u, int wr, int wc, int fr, int fq) const {
#pragma unroll
        for (int ai = 0; ai < 2; ++ai)
#pragma unroll
            for (int bj = 0; bj < 2; ++bj)
#pragma unroll
                for (int m = 0; m < 4; ++m)
#pragma unroll
                    for (int n = 0; n < 2; ++n) asm volatile("" :: "v"(acc[ai][bj][m][n]));
    }
};

template <int MODE> struct EpiProjX {
    static constexpr bool PERM = true, AFTER_DRAIN = false, MID = false;
    const float* ssq; bf16_t* D;
    __device__ __forceinline__ void operator()(const f32x4 (&acc)[2][2][4][2], const Unit& u, int wr, int wc, int fr, int fq) const {
        int row0 = u.pm * BM + wr * 64 + fr; const int cw = (u.pn % 4) * 256 + wc * 32 + 8 * fq;
        asm volatile("" : "+v"(row0));
#pragma unroll
        for (int ai = 0; ai < 2; ++ai)
#pragma unroll
            for (int m = 0; m < 4; ++m) {
                const int row = row0 + ai * HALF + m * 16;
                if (MODE == 0) {
                    const float rs = row_rs(ssq, row, fq); f32x4 r[2], sb[2];
#pragma unroll
                    for (int n = 0; n < 2; ++n)
#pragma unroll
                        for (int e = 0; e < 4; ++e) {
                            const float ga = __builtin_amdgcn_fmed3f(acc[ai][0][m][n][e] * rs, -80.f, 80.f), gb = __builtin_amdgcn_fmed3f(acc[ai][1][m][n][e] * rs, -80.f, 80.f);
                            const float ea = __builtin_amdgcn_exp2f(-ga * LOG2E), eb = __builtin_amdgcn_exp2f(-gb * LOG2E);
                            r[n][e] = (1.0f + eb) * __builtin_amdgcn_rcpf(1.0f + ea); sb[n][e] = __builtin_amdgcn_rcpf(1.0f + eb);
                        }
                    u32x4 a = pack8(r[0], r[1]), b = pack8(sb[0], sb[1]); asm volatile("" :: "v"(a), "v"(b));
                } else if (MODE == 1) {
#pragma unroll
                    for (int bj = 0; bj < 2; ++bj) *(u32x4*)(D + (size_t)row * DM + cw + bj * HALF) = pack8(acc[ai][bj][m][0], acc[ai][bj][m][1]);
                } else {
                    const int lrow = (int)blockIdx.x * BM + (row & 255); const int cw2 = wc * 32 + 8 * fq;
#pragma unroll
                    for (int bj = 0; bj < 2; ++bj) *(u32x4*)(D + (size_t)lrow * DM + cw2 + bj * HALF) = pack8(acc[ai][bj][m][0], acc[ai][bj][m][1]);
                }
            }
    }
};
template <class Epi, class Sched, bool ALIGN_EPI = false, bool SP2 = false>
__device__ __forceinline__ void gemm_phase(PG8_LAS unsigned char* lds, const Gemm g, const Sched& S, const Epi& E) {
    const int tid = threadIdx.x, wid = __builtin_amdgcn_readfirstlane(tid >> 6), lane = tid & 63, wr = wid >> 2, wc = wid & 3, fr = lane & 15, fq = lane >> 4;
    const int K = g.K, nt = K / BK;
    unsigned voffA[2], voffB[2];
#pragma unroll
    for (int i = 0; i < 2; ++i) { int R, C; stage_rc(tid * 16 + i * 8192, R, C); const int Rb = Epi::PERM ? ((R & ~31) + perm32(R & 31)) : R;
        voffA[i] = (unsigned)(R * g.lda + C) * 2u; voffB[i] = (unsigned)(Rb * g.ldb + C) * 2u; }
    const size_t kstep = (size_t)(BK * 2);
    const size_t hstepA = (size_t)HALF * g.lda * 2, hstepB = (size_t)HALF * g.ldb * 2;
    const size_t tstepA = 2 * hstepA, tstepB = 2 * hstepB;
    const unsigned ldsw = (unsigned)wid * 1024u;
    const int aoff = lds_byte(wr * 64 + fr, fq * 8), boff = lds_byte(wc * 32 + fr, fq * 8);
#define PG8_SA(b, h) (((b) * 2 + (h)) * HTB)
#define PG8_SB(b, h) ((4 + (b) * 2 + (h)) * HTB)
#define PG8_STAGE(bufoff, gbase, voff) do { _Pragma("unroll") for (int _i = 0; _i < 2; ++_i) \
        __builtin_amdgcn_global_load_lds((const unsigned*)((const char*)(gbase) + (voff)[_i]), (PG8_LAS unsigned*)(lds + (bufoff) + ldsw + _i * 8192), 16, 0, 0); } while (0)
#define PG8_LDA(dst, b, h) do { _Pragma("unroll") for (int m = 0; m < 4; ++m) _Pragma("unroll") for (int k = 0; k < 2; ++k) dst[m][k] = *(const PG8_LAS bf16x8*)(lds + PG8_SA(b, h) + aoff + m * 2048 + k * 1024); } while (0)
#define PG8_LDB(dst, b, h) do { _Pragma("unroll") for (int n = 0; n < 2; ++n) _Pragma("unroll") for (int k = 0; k < 2; ++k) dst[n][k] = *(const PG8_LAS bf16x8*)(lds + PG8_SB(b, h) + boff + n * 2048 + k * 1024); } while (0)
#define PG8_MMA(ai, bj, At, Bt) do { __builtin_amdgcn_s_setprio(1); _Pragma("unroll") for (int m = 0; m < 4; ++m) _Pragma("unroll") for (int n = 0; n < 2; ++n) _Pragma("unroll") for (int k = 0; k < 2; ++k) \
        acc[ai][bj][m][n] = __builtin_amdgcn_mfma_f32_16x16x32_bf16(Bt[n][k], At[m][k], acc[ai][bj][m][n], 0, 0, 0); __builtin_amdgcn_s_setprio(0); } while (0)
#define PG8_WAIT_V(n) asm volatile("s_waitcnt vmcnt(" #n ")" ::: "memory")
#define PG8_WAIT_L(n) asm volatile("s_waitcnt lgkmcnt(" #n ")" ::: "memory")
#define PG8_BAR __builtin_amdgcn_s_barrier()
#define PG8_SCHED __builtin_amdgcn_sched_barrier(0)
    Unit cur, nxt; int ui = 0;
    if (!S.next(0, cur)) return;
    f32x4 acc[2][2][4][2];
#pragma unroll
    for (int a = 0; a < 2; ++a)
#pragma unroll
        for (int b = 0; b < 2; ++b)
#pragma unroll
            for (int m = 0; m < 4; ++m)
#pragma unroll
                for (int n = 0; n < 2; ++n) acc[a][b][m][n] = (f32x4){0.f, 0.f, 0.f, 0.f};
    bf16x8 At[4][2], B0[2][2], B1[2][2];
    const char* cA = (const char*)g.A + (size_t)cur.pm * tstepA + (size_t)cur.koff * 2; const char* cB = (const char*)g.Bt + (size_t)cur.pn * tstepB + (size_t)cur.koff * 2;
    S.a_ready(cur);
    if constexpr (SP2) {
        PG8_STAGE(PG8_SB(0, 0), cB, voffB); PG8_STAGE(PG8_SB(0, 1), cB + hstepB, voffB); PG8_STAGE(PG8_SA(0, 0), cA, voffA); PG8_STAGE(PG8_SA(0, 1), cA + hstepA, voffA);
        if (wr == 1) PG8_BAR;
        PG8_WAIT_V(2); PG8_BAR;
        PG8_STAGE(PG8_SB(1, 0), cB + kstep, voffB); PG8_STAGE(PG8_SA(1, 0), cA + kstep, voffA); PG8_STAGE(PG8_SB(1, 1), cB + hstepB + kstep, voffB);
        PG8_WAIT_V(6); PG8_BAR;
    } else {
        PG8_STAGE(PG8_SB(0, 0), cB, voffB); PG8_STAGE(PG8_SA(0, 0), cA, voffA); PG8_STAGE(PG8_SB(0, 1), cB + hstepB, voffB); PG8_STAGE(PG8_SA(0, 1), cA + hstepA, voffA);
        if (wr == 1) PG8_BAR;
        PG8_WAIT_V(4); PG8_BAR;
        PG8_STAGE(PG8_SB(1, 0), cB + kstep, voffB); PG8_STAGE(PG8_SA(1, 0), cA + kstep, voffA); PG8_STAGE(PG8_SB(1, 1), cB + hstepB + kstep, voffB);
        PG8_WAIT_V(6); PG8_BAR;
    }
    for (;;) {
        const bool has_next = S.next(ui + 1, nxt);
        const char* nA = has_next ? (const char*)g.A + (size_t)nxt.pm * tstepA + (size_t)nxt.koff * 2 : cA; const char* nB = has_next ? (const char*)g.Bt + (size_t)nxt.pn * tstepB + (size_t)nxt.koff * 2 : cB;
        for (int t = 0; t < nt; t += 2) {
            const bool last = (t == nt - 2);
            if constexpr (Epi::MID) { if (t == (nt >> 1)) E.mid(acc, cur, wr, wc, fr, fq); }
            const char* a1 = cA + (size_t)(t + 1) * kstep;
            const char* a2 = last ? nA : cA + (size_t)(t + 2) * kstep; const char* b2 = last ? nB : cB + (size_t)(t + 2) * kstep;
            const char* a3 = a2 + kstep; const char* b3 = b2 + kstep;
            if (last && has_next) S.a_ready(nxt);
            if constexpr (SP2) {
            PG8_LDB(B0, 0, 0); PG8_LDB(B1, 0, 1); PG8_SCHED; PG8_LDA(At, 0, 0); PG8_STAGE(PG8_SA(1, 1), a1 + hstepA, voffA);
            PG8_WAIT_V(8); PG8_WAIT_L(0); PG8_BAR; PG8_MMA(0, 0, At, B0); PG8_MMA(0, 1, At, B1); PG8_BAR; PG8_SCHED;
            PG8_LDA(At, 0, 1); PG8_STAGE(PG8_SB(0, 0), b2, voffB); PG8_STAGE(PG8_SB(0, 1), b2 + hstepB, voffB); PG8_STAGE(PG8_SA(0, 0), a2, voffA);
            PG8_WAIT_V(8); PG8_WAIT_L(0); PG8_BAR; PG8_MMA(1, 0, At, B0); PG8_MMA(1, 1, At, B1); PG8_BAR; PG8_SCHED;
            PG8_LDB(B0, 1, 0); PG8_LDB(B1, 1, 1); PG8_SCHED; PG8_LDA(At, 1, 0); PG8_STAGE(PG8_SA(0, 1), a2 + hstepA, voffA);
            PG8_WAIT_V(8); PG8_WAIT_L(0); PG8_BAR; PG8_MMA(0, 0, At, B0); PG8_MMA(0, 1, At, B1); PG8_BAR; PG8_SCHED;
            PG8_LDA(At, 1, 1); PG8_STAGE(PG8_SB(1, 0), b3, voffB); PG8_STAGE(PG8_SB(1, 1), b3 + hstepB, voffB); PG8_STAGE(PG8_SA(1, 0), a3, voffA);
            PG8_WAIT_V(8); PG8_WAIT_L(0); PG8_BAR; PG8_MMA(1, 0, At, B0); PG8_MMA(1, 1, At, B1); PG8_BAR; PG8_SCHED;
            } else {
            PG8_LDB(B0, 0, 0); PG8_SCHED; PG8_LDA(At, 0, 0); PG8_STAGE(PG8_SA(1, 1), a1 + hstepA, voffA);
            PG8_WAIT_L(8); PG8_BAR; PG8_WAIT_L(0); PG8_MMA(0, 0, At, B0); PG8_BAR; PG8_SCHED;
            PG8_LDB(B1, 0, 1); PG8_STAGE(PG8_SB(0, 0), b2, voffB);
            PG8_BAR; PG8_WAIT_L(0); PG8_MMA(0, 1, At, B1); PG8_BAR;
            PG8_LDA(At, 0, 1); PG8_STAGE(PG8_SA(0, 0), a2, voffA);
            PG8_BAR; PG8_WAIT_L(0); PG8_MMA(1, 0, At, B0); PG8_BAR; PG8_SCHED;
            PG8_STAGE(PG8_SB(0, 1), b2 + hstepB, voffB);
            PG8_WAIT_V(6); PG8_BAR; PG8_MMA(1, 1, At, B1); PG8_BAR;
            PG8_LDB(B0, 1, 0); PG8_SCHED; PG8_LDA(At, 1, 0); PG8_STAGE(PG8_SA(0, 1), a2 + hstepA, voffA);
            PG8_WAIT_L(8); PG8_BAR; PG8_WAIT_L(0); PG8_MMA(0, 0, At, B0); PG8_BAR; PG8_SCHED;
            PG8_LDB(B1, 1, 1); PG8_STAGE(PG8_SB(1, 0), b3, voffB);
            PG8_BAR; PG8_WAIT_L(0); PG8_MMA(0, 1, At, B1); PG8_BAR;
            PG8_LDA(At, 1, 1); PG8_STAGE(PG8_SA(1, 0), a3, voffA);
            PG8_BAR; PG8_WAIT_L(0); PG8_MMA(1, 0, At, B0); PG8_BAR; PG8_SCHED;
            PG8_STAGE(PG8_SB(1, 1), b3 + hstepB, voffB);
            PG8_WAIT_V(6); PG8_BAR; PG8_MMA(1, 1, At, B1); PG8_BAR;
            }
        }
        if constexpr (ALIGN_EPI) { if (wr == 0) PG8_BAR; }
        if constexpr (!Epi::AFTER_DRAIN) { E(acc, cur, wr, wc, fr, fq); S.done(cur); }
        if (!has_next) break;
#pragma unroll
        for (int a = 0; a < 2; ++a)
#pragma unroll
            for (int b = 0; b < 2; ++b)
#pragma unroll
                for (int m = 0; m < 4; ++m)
#pragma unroll
                    for (int n = 0; n < 2; ++n) acc[a][b][m][n] = (f32x4){0.f, 0.f, 0.f, 0.f};
        cur = nxt; cA = nA; cB = nB; ++ui;
        if constexpr (ALIGN_EPI) { if (wr == 1) PG8_BAR; }
    }
    PG8_WAIT_V(0);
    if constexpr (!ALIGN_EPI) { if (wr == 0) PG8_BAR; }
    PG8_BAR;
    if constexpr (Epi::AFTER_DRAIN) { E.fused(acc, cur, wr, wc, fr, fq, lds, wid, lane); S.done(cur); }
#undef PG8_SA
#undef PG8_SB
#undef PG8_STAGE
#undef PG8_LDA
#undef PG8_LDB
#undef PG8_MMA
#undef PG8_WAIT_V
#undef PG8_WAIT_L
#undef PG8_BAR
#undef PG8_SCHED
}
}

namespace attn {
constexpr int SLOTB = 8192;
constexpr int LDS_K = 0, LDS_V = 2 * SLOTB, LDS_WS = 4 * SLOTB, LDS_OST = LDS_WS + 8 * 256, LDS_CL = LDS_OST + 8 * 4096, LDS_SCAN = LDS_CL + 2064 * 4 + 64, LDS_END = LDS_SCAN + 64;
#define SBAR() __builtin_amdgcn_sched_barrier(0)
__device__ __forceinline__ int crow(int r, int hi) { return (r & 3) + 8 * (r >> 2) + 4 * hi; }
__device__ __forceinline__ void glds16(const void* gsrc, unsigned lds_dst) { unsigned keep;
    asm volatile("s_mov_b32 %0, m0\n\ts_mov_b32 m0, %2\n\ts_nop 0\n\tglobal_load_lds_dwordx4 %1, off\n\ts_mov_b32 m0, %0" : "=&s"(keep) : "v"(gsrc), "s"(lds_dst) : "memory"); }
typedef float f32x2_t __attribute__((ext_vector_type(2))); typedef __bf16 bf16x2_t __attribute__((ext_vector_type(2)));
__device__ __forceinline__ unsigned cvtpk_s(float lo, float hi) { f32x2_t v = {lo, hi}; bf16x2_t b = __builtin_convertvector(v, bf16x2_t); return __builtin_bit_cast(unsigned, b); }
#define MX3(a, b, c) __builtin_fmaxf(__builtin_fmaxf((a), (b)), (c))
__device__ __forceinline__ void qkt(f32x16& p0, f32x16& p1, const char* Kslot, const bf16x8* qr, const f32x16& negm, int r32, int hi) {
    const char* kb = Kslot + hi * 1024 + r32 * 16;
#pragma unroll
    for (int d0 = 0; d0 < 4; ++d0) {
        const bf16x8 b0 = *reinterpret_cast<const bf16x8*>(kb + d0 * 2048);
        const bf16x8 b1 = *reinterpret_cast<const bf16x8*>(kb + d0 * 2048 + 512);
        if (d0 == 0) { p0 = __builtin_amdgcn_mfma_f32_32x32x16_bf16(b0, qr[0], negm, 0, 0, 0); p1 = __builtin_amdgcn_mfma_f32_32x32x16_bf16(b1, qr[0], negm, 0, 0, 0); }
        else { p0 = __builtin_amdgcn_mfma_f32_32x32x16_bf16(b0, qr[d0], p0, 0, 0, 0); p1 = __builtin_amdgcn_mfma_f32_32x32x16_bf16(b1, qr[d0], p1, 0, 0, 0); }
    }
}
__device__ __forceinline__ float rowmax(const f32x16& p0, const f32x16& p1) {
    float a = MX3(p0[0], p0[1], p1[0]), b = MX3(p0[2], p0[3], p1[1]); a = MX3(a, p1[2], p1[3]);
#pragma unroll
    for (int r = 4; r < 16; r += 4) { a = MX3(a, p0[r], p0[r + 1]); b = MX3(b, p0[r + 2], p0[r + 3]); a = MX3(a, p1[r], p1[r + 1]); b = MX3(b, p1[r + 2], p1[r + 3]); }
    const float m = __builtin_fmaxf(a, b);
    auto rr = __builtin_amdgcn_permlane32_swap(__float_as_uint(m), __float_as_uint(m), false, false);
    return __builtin_fmaxf(__uint_as_float(rr[0]), __uint_as_float(rr[1]));
}
__device__ __forceinline__ void pv(f32x16* o, int vb, bf16x8 pa0, bf16x8 pa1, bf16x8 pa2, bf16x8 pa3) {
#pragma unroll
    for (int d0 = 0; d0 < 2; ++d0) { s16x4 lo[4], hi[4];
#pragma unroll
        for (int ks = 0; ks < 4; ++ks) {
            asm volatile("ds_read_b64_tr_b16 %0,%1 offset:%c2" : "=&v"(lo[ks]) : "v"(vb), "i"(d0 * 4096 + ks * 1024) : "memory");
            asm volatile("ds_read_b64_tr_b16 %0,%1 offset:%c2" : "=&v"(hi[ks]) : "v"(vb), "i"(d0 * 4096 + ks * 1024 + 512) : "memory"); }
        asm volatile("s_waitcnt lgkmcnt(0)" ::: "memory"); SBAR();
#define PK(k) (bf16x8){lo[k][0], lo[k][1], lo[k][2], lo[k][3], hi[k][0], hi[k][1], hi[k][2], hi[k][3]}
        o[d0] = __builtin_amdgcn_mfma_f32_32x32x16_bf16(pa0, PK(0), o[d0], 0, 0, 0);
        o[d0] = __builtin_amdgcn_mfma_f32_32x32x16_bf16(pa1, PK(1), o[d0], 0, 0, 0);
        o[d0] = __builtin_amdgcn_mfma_f32_32x32x16_bf16(pa2, PK(2), o[d0], 0, 0, 0);
        o[d0] = __builtin_amdgcn_mfma_f32_32x32x16_bf16(pa3, PK(3), o[d0], 0, 0, 0);
#undef PK
    }
}
#define WAIT_BAR0() asm volatile("s_waitcnt vmcnt(0) lgkmcnt(0)\n\ts_barrier" ::: "memory")

template <int MODE>
__device__ __forceinline__ void unit(const bf16_t* Qw, bf16_t* Ow, const bf16_t* Kh, const bf16_t* Vh, int kp, int NT, int kbase, int qpos0,
                                     float slope2, float sink2, const float* cl, char* shm) {
    const int tid = threadIdx.x, lane = tid & 63, r32 = lane & 31, hi = lane >> 5; const int wid = __builtin_amdgcn_readfirstlane(tid >> 6);
    const unsigned lds0 = (unsigned)(uintptr_t)shm;
    float* wsf = (float*)(shm + LDS_WS) + wid * 64;
    const bf16_t* ksrc = Kh + (size_t)lane * kp + wid * 8;
    const bf16_t* vsrc = Vh + (size_t)(16 * (wid & 3) + (lane >> 2)) * kp + (wid >> 2) * 32 + (lane & 3) * 8;
    const unsigned kdst = lds0 + LDS_K + wid * 1024, vdst = lds0 + LDS_V + wid * 1024;
#define TILE_KR0(t) ((t) == 0 ? 64 : kbase + 64 * ((t) - 1))
#define DMA_KV(t, slot) do { const size_t ro_ = (size_t)TILE_KR0(t) * kp; \
        glds16(ksrc + ro_, (unsigned)__builtin_amdgcn_readfirstlane(kdst + (slot) * SLOTB)); glds16(vsrc + ro_, (unsigned)__builtin_amdgcn_readfirstlane(vdst + (slot) * SLOTB)); } while (0)
    const int vb0 = (int)(lds0 + LDS_V) + ((lane >> 4) & 1) * 32 + (lane & 3) * 8 + (4 * hi + ((lane & 15) >> 2)) * 64;
    DMA_KV(0, 0);
    bf16x8 qr[4];
#pragma unroll
    for (int d0 = 0; d0 < 4; ++d0) qr[d0] = *reinterpret_cast<const bf16x8*>(Qw + (size_t)r32 * DM + d0 * 16 + hi * 8);
    const int qp = qpos0 + r32;
    const float rowterm = (MODE == 0) ? cl[qp - KR_META] : -slope2 * (float)qp;
    float mhat = (MODE == 0) ? 0.f : sink2, l_reg = (MODE == 1 && hi == 0) ? 1.f : 0.f;
    f32x16 o[2]; o[0] = f32x16{}; o[1] = f32x16{};
    for (int t = 0; t < NT; ++t) {
        WAIT_BAR0();
        if (t + 1 < NT) DMA_KV(t + 1, (t + 1) & 1);
        const int slot = t & 1, kr0 = TILE_KR0(t);
        f32x16 negm; { const float nm = rowterm - mhat;
#pragma unroll
            for (int r = 0; r < 16; ++r) negm[r] = nm; }
        f32x16 p0, p1;
        qkt(p0, p1, shm + LDS_K + slot * SLOTB, qr, negm, r32, hi);
        const bool need_mask = (MODE == 1) || (kr0 < KR_META) || (kr0 + 63 > qpos0);
        if (need_mask) {
#pragma unroll
            for (int r = 0; r < 16; ++r) {
                const int k0 = kr0 + crow(r, hi), k1 = k0 + 32;
                bool ok0, ok1; float c0, c1;
                if (MODE == 0) { ok0 = (k0 >= KR_META) && (k0 <= qp); ok1 = (k1 >= KR_META) && (k1 <= qp);
                    c0 = -cl[k0 >= KR_META ? k0 - KR_META : 0]; c1 = -cl[k1 >= KR_META ? k1 - KR_META : 0]; }
                else { ok0 = (t == 0) ? (k0 >= KR_META) : (k0 >= KR_REAL && k0 <= qp && qp - k0 < 128); ok1 = (t == 0) ? (k1 >= KR_META) : (k1 >= KR_REAL && k1 <= qp && qp - k1 < 128);
                    c0 = slope2 * (float)k0; c1 = slope2 * (float)k1; }
                p0[r] = ok0 ? p0[r] + c0 : -INFINITY; p1[r] = ok1 ? p1[r] + c1 : -INFINITY;
            }
        } else {
#pragma unroll
            for (int r = 0; r < 16; ++r) { const int k0 = kr0 + crow(r, hi) - KR_META; p0[r] -= cl[k0]; p1[r] -= cl[k0 + 32]; }
        }
        const float rm = rowmax(p0, p1);
        if (MODE == 0 && t == 0) {
            mhat = rm;
#pragma unroll
            for (int r = 0; r < 16; ++r) { p0[r] -= rm; p1[r] -= rm; }
        } else if (__any(rm > 0.f)) {
            const float dl = __builtin_fmaxf(rm, 0.f); mhat += dl;
#pragma unroll
            for (int r = 0; r < 16; ++r) { p0[r] -= dl; p1[r] -= dl; }
            const float f = __builtin_amdgcn_exp2f(-dl); l_reg *= f;
            if (hi == 0) wsf[r32] = f;
            asm volatile("s_waitcnt lgkmcnt(0)" ::: "memory");
#pragma unroll
            for (int d = 0; d < 2; ++d)
#pragma unroll
                for (int r = 0; r < 16; ++r) o[d][r] *= wsf[crow(r, hi)];
        }
        float sacc = 0.f;
#pragma unroll
        for (int r = 0; r < 16; ++r) { p0[r] = __builtin_amdgcn_exp2f(p0[r]); p1[r] = __builtin_amdgcn_exp2f(p1[r]); sacc += p0[r] + p1[r]; }
        l_reg += sacc;
        u32x4 pw0, pw1, pw2, pw3;
        pw0 = (u32x4){cvtpk_s(p0[0], p0[1]), cvtpk_s(p0[2], p0[3]), cvtpk_s(p0[4], p0[5]), cvtpk_s(p0[6], p0[7])};
        pw1 = (u32x4){cvtpk_s(p0[8], p0[9]), cvtpk_s(p0[10], p0[11]), cvtpk_s(p0[12], p0[13]), cvtpk_s(p0[14], p0[15])};
        pw2 = (u32x4){cvtpk_s(p1[0], p1[1]), cvtpk_s(p1[2], p1[3]), cvtpk_s(p1[4], p1[5]), cvtpk_s(p1[6], p1[7])};
        pw3 = (u32x4){cvtpk_s(p1[8], p1[9]), cvtpk_s(p1[10], p1[11]), cvtpk_s(p1[12], p1[13]), cvtpk_s(p1[14], p1[15])};
        SBAR();
        pv(o, vb0 + slot * SLOTB, __builtin_bit_cast(bf16x8, pw0), __builtin_bit_cast(bf16x8, pw1), __builtin_bit_cast(bf16x8, pw2), __builtin_bit_cast(bf16x8, pw3));
    }
    { auto rr = __builtin_amdgcn_permlane32_swap(__float_as_uint(l_reg), __float_as_uint(l_reg), false, false); l_reg = __uint_as_float(rr[0]) + __uint_as_float(rr[1]); }
    if (hi == 0) wsf[32 + r32] = l_reg;
    asm volatile("s_waitcnt lgkmcnt(0)" ::: "memory");
    float rli[16];
#pragma unroll
    for (int r = 0; r < 16; ++r) rli[r] = 1.0f / wsf[32 + crow(r, hi)];
    { __hip_bfloat16* stg = (__hip_bfloat16*)(shm + LDS_OST) + wid * 2048;
#pragma unroll
        for (int r = 0; r < 16; ++r) { const int orow = crow(r, hi);
#pragma unroll
            for (int d0 = 0; d0 < 2; ++d0) stg[orow * 64 + d0 * 32 + r32] = __float2bfloat16(o[d0][r] * rli[r]); }
        asm volatile("s_waitcnt lgkmcnt(0)" ::: "memory");
#pragma unroll
        for (int i = 0; i < 4; ++i) { const int row = i * 8 + (lane >> 3), ch = lane & 7; const u32x4 v = *(const u32x4*)(stg + row * 64 + ch * 8); *(u32x4*)(Ow + (size_t)row * DM + ch * 8) = v; } }
    asm volatile("s_waitcnt lgkmcnt(0)\n\ts_barrier" ::: "memory");
#undef DMA_KV
#undef TILE_KR0
}
#undef WAIT_BAR0
#undef SBAR
#undef MX3
}

namespace attn2 {
using bf16=__hip_bfloat16;
__device__ __forceinline__ int crow(int r,int hi){return (r&3)+8*(r>>2)+4*hi;}
#define SBAR() __builtin_amdgcn_sched_barrier(0)
__device__ __forceinline__ void cmask(f32x16&p0,f32x16&p1,int jb,int qrel,int hi){
  const float NEG=-INFINITY; int kb=64*jb+4*hi;
  #pragma unroll
  for(int r=0;r<16;++r){int kv=kb+(r&3)+8*(r>>2); if(kv>qrel)p0[r]=NEG; if(kv+32>qrel)p1[r]=NEG;}
}

constexpr int NSLOT=3, SLOTB=8192;
constexpr int NW=8;
constexpr int LDS_K=0, LDS_V=NSLOT*SLOTB, LDS_WS=2*NSLOT*SLOTB, LDS_OST=LDS_WS+NW*64*4, LDS_CL=LDS_OST+NW*4096, LDS_SCAN=LDS_CL+2064*4+64, LDS_END=LDS_SCAN+64;
__device__ __forceinline__ void glds16(const void*gsrc,unsigned lds_dst){unsigned keep;
  asm volatile("s_mov_b32 %0, m0\n\ts_mov_b32 m0, %2\n\ts_nop 0\n\tglobal_load_lds_dwordx4 %1, off\n\ts_mov_b32 m0, %0":"=&s"(keep):"v"(gsrc),"s"(lds_dst):"memory");}
__device__ __forceinline__ float max3f(float a,float b,float c){float r;asm("v_max3_f32 %0, %1, %2, %3":"=v"(r):"v"(a),"v"(b),"v"(c));return r;}
__device__ __forceinline__ float max2f(float a,float b){float r;asm("v_max_f32_e32 %0, %1, %2":"=v"(r):"v"(a),"v"(b));return r;}
__device__ __forceinline__ float fadd_s(float a,float b){float r;asm("v_add_f32_e32 %0, %1, %2":"=v"(r):"v"(a),"v"(b));return r;}
__device__ __forceinline__ float fsub_s(float a,float b){float r;asm("v_sub_f32_e32 %0, %1, %2":"=v"(r):"v"(a),"v"(b));return r;}
typedef float f32x2_t __attribute__((ext_vector_type(2))); typedef __bf16 bf16x2_t __attribute__((ext_vector_type(2)));
__device__ __forceinline__ unsigned cvtpk_s(float lo,float hi){f32x2_t v={lo,hi};bf16x2_t b=__builtin_convertvector(v,bf16x2_t);return __builtin_bit_cast(unsigned,b);}
#define WAIT_BAR(N) asm volatile("s_waitcnt vmcnt(" #N ") lgkmcnt(0)\n\ts_barrier":::"memory")

__device__ __forceinline__ void qkt(f32x16&p0,f32x16&p1,const char*Kslot,const bf16x8*qr,const f32x16&negm,int r32,int hi){
  const char*kb=Kslot+hi*1024+r32*16;
  #pragma unroll
  for(int d0=0;d0<4;++d0){
    const bf16x8 b0=*reinterpret_cast<const bf16x8*>(kb+d0*2048);
    const bf16x8 b1=*reinterpret_cast<const bf16x8*>(kb+d0*2048+512);
    if(d0==0){p0=__builtin_amdgcn_mfma_f32_32x32x16_bf16(b0,qr[0],negm,0,0,0);p1=__builtin_amdgcn_mfma_f32_32x32x16_bf16(b1,qr[0],negm,0,0,0);}
    else{p0=__builtin_amdgcn_mfma_f32_32x32x16_bf16(b0,qr[d0],p0,0,0,0);p1=__builtin_amdgcn_mfma_f32_32x32x16_bf16(b1,qr[d0],p1,0,0,0);}}
}
typedef __attribute__((address_space(3))) const char* lds_cptr;
typedef short v4i16_t __attribute__((ext_vector_type(4)));
__device__ __forceinline__ void kload8(bf16x8*kf,lds_cptr kp){
  kf[0]=*(const __attribute__((address_space(3))) bf16x8*)(kp);      kf[1]=*(const __attribute__((address_space(3))) bf16x8*)(kp+512);
  kf[2]=*(const __attribute__((address_space(3))) bf16x8*)(kp+2048); kf[3]=*(const __attribute__((address_space(3))) bf16x8*)(kp+2560);
  kf[4]=*(const __attribute__((address_space(3))) bf16x8*)(kp+4096); kf[5]=*(const __attribute__((address_space(3))) bf16x8*)(kp+4608);
  kf[6]=*(const __attribute__((address_space(3))) bf16x8*)(kp+6144); kf[7]=*(const __attribute__((address_space(3))) bf16x8*)(kp+6656);
}
__device__ __forceinline__ void kload2(bf16x8*kf,lds_cptr kp,int j){ kf[2*j]=*(const __attribute__((address_space(3))) bf16x8*)(kp+j*2048); kf[2*j+1]=*(const __attribute__((address_space(3))) bf16x8*)(kp+j*2048+512); }
__device__ __forceinline__ s16x4 vtr(lds_cptr p){ return __builtin_bit_cast(s16x4,__builtin_amdgcn_ds_read_tr16_b64_v4i16((__attribute__((address_space(3))) v4i16_t*)p)); }
__device__ __forceinline__ float rowmax(const f32x16&p0,const f32x16&p1){
  float a=max3f(p0[0],p0[1],p1[0]),b=max3f(p0[2],p0[3],p1[1]);a=max3f(a,p1[2],p1[3]);
  #pragma unroll
  for(int r=4;r<16;r+=4){a=max3f(a,p0[r],p0[r+1]);b=max3f(b,p0[r+2],p0[r+3]);a=max3f(a,p1[r],p1[r+1]);b=max3f(b,p1[r+2],p1[r+3]);}
  const float m=max2f(a,b);
  auto rr=__builtin_amdgcn_permlane32_swap(__float_as_uint(m),__float_as_uint(m),false,false);
  return max2f(__uint_as_float(rr[0]),__uint_as_float(rr[1]));
}
__device__ __forceinline__ void pv(f32x16*o,int vb,bf16x8 pa0,bf16x8 pa1,bf16x8 pa2,bf16x8 pa3){
  #pragma unroll
  for(int d0=0;d0<2;++d0){s16x4 lo[4],hi[4];
    #pragma unroll
    for(int ks=0;ks<4;++ks){
      asm volatile("ds_read_b64_tr_b16 %0,%1 offset:%c2":"=&v"(lo[ks]):"v"(vb),"i"(d0*4096+ks*1024):"memory");
      asm volatile("ds_read_b64_tr_b16 %0,%1 offset:%c2":"=&v"(hi[ks]):"v"(vb),"i"(d0*4096+ks*1024+512):"memory");}
    asm volatile("s_waitcnt lgkmcnt(0)":::"memory");SBAR();
    #define PK(k) (bf16x8){lo[k][0],lo[k][1],lo[k][2],lo[k][3],hi[k][0],hi[k][1],hi[k][2],hi[k][3]}
    o[d0]=__builtin_amdgcn_mfma_f32_32x32x16_bf16(pa0,PK(0),o[d0],0,0,0);
    o[d0]=__builtin_amdgcn_mfma_f32_32x32x16_bf16(pa1,PK(1),o[d0],0,0,0);
    o[d0]=__builtin_amdgcn_mfma_f32_32x32x16_bf16(pa2,PK(2),o[d0],0,0,0);
    o[d0]=__builtin_amdgcn_mfma_f32_32x32x16_bf16(pa3,PK(3),o[d0],0,0,0);
    #undef PK
  }
}


__device__ __forceinline__ void amask(f32x16&p0,f32x16&p1,int kr0,int qp,float slope2,int hi){
  asm volatile("":"+v"(slope2));
  const float base=slope2*(float)(kr0+4*hi); const int d0=qp-kr0-4*hi;
  #pragma unroll
  for(int r=0;r<16;++r){ const int cr=(r&3)+8*(r>>2); const int da=d0-cr, db=da-32;
    const bool ok0=((unsigned)da<128u)&&(qp-da>=KR_REAL), ok1=((unsigned)db<128u)&&(qp-db>=KR_REAL);
    p0[r]=ok0?p0[r]+__builtin_fmaf(slope2,(float)cr,base):-INFINITY; p1[r]=ok1?p1[r]+__builtin_fmaf(slope2,(float)(cr+32),base):-INFINITY; }
}
template<int MODE,int THRL> __device__ __forceinline__ void unit2(const bf16*Qw,bf16*Ow,const bf16*__restrict__ Kh,const bf16*__restrict__ Vh,int kp,int NT,int kbase,int qpos0,int qrel0,float slope2,float sink2,const float*cl,char*shm){
  const int tid=threadIdx.x; int lane_=tid&63; asm volatile("":"+v"(lane_));
  const int lane=lane_,r32=lane&31,hi=lane>>5; const int wid=__builtin_amdgcn_readfirstlane(tid>>6);
  const unsigned lds0=(unsigned)(uintptr_t)shm;
  float*wsf=(float*)(shm+LDS_WS)+wid*64;
  const bf16*ksrc=Kh+(long)lane*kp+wid*8;
  const bf16*vsrc=Vh+(long)(16*(wid&3)+(lane>>2))*kp+(wid>>2)*32+(lane&3)*8;
  const unsigned kdst=lds0+LDS_K+wid*1024, vdst=lds0+LDS_V+wid*1024;
  #define TROW(t) ((t)==0?64:kbase+64*((t)-1))
  #define DMA_K(t,slot) glds16(ksrc+(long)TROW(t)*kp,(unsigned)__builtin_amdgcn_readfirstlane(kdst+(slot)))
  #define DMA_V(t,slot) glds16(vsrc+(long)TROW(t)*kp,(unsigned)__builtin_amdgcn_readfirstlane(vdst+(slot)))
  const int vb0=(int)(lds0+LDS_V)+((lane>>4)&1)*32+(lane&3)*8+(4*hi+((lane&15)>>2))*64;
  const char*Kbase=shm+LDS_K; bf16x8 kf[8];
  const lds_cptr shm3=(lds_cptr)shm; const lds_cptr kp0=shm3+LDS_K+hi*1024+r32*16; const lds_cptr vp0=shm3+LDS_V+((lane>>4)&1)*32+(lane&3)*8+(4*hi+((lane&15)>>2))*64;
  DMA_K(0,0);DMA_V(0,0);DMA_K(1,SLOTB);
  bf16x8 qr[4];
  #pragma unroll
  for(int d0=0;d0<4;++d0)qr[d0]=*reinterpret_cast<const bf16x8*>(&Qw[(long)r32*DM+d0*16+hi*8]);
  const int qrel=qrel0+r32, qp=qpos0+r32;
  const float rowterm=(MODE==0)?cl[qp-KR_META]:-slope2*(float)qp;
  float mhat=(MODE==0)?0.f:sink2,l_reg=(MODE==1&&hi==0)?1.f:0.f;f32x16 o[2];o[0]=f32x16{};o[1]=f32x16{};f32x16 negm;
  { const float nm_=rowterm-mhat; _Pragma("unroll") for(int r=0;r<16;++r)negm[r]=nm_; } asm volatile("":"+v"(negm));
  #define POST(C0,C1,t,MK) do{ if(MODE==0){ const float*clt_=cl+(TROW(t)-KR_META)+4*hi; \
      _Pragma("unroll") for(int g_=0;g_<4;++g_){ const f32x4 a_=*(const f32x4*)(clt_+8*g_), b_=*(const f32x4*)(clt_+32+8*g_); \
        _Pragma("unroll") for(int e_=0;e_<4;++e_){ C0[4*g_+e_]-=a_[e_]; C1[4*g_+e_]-=b_[e_]; } SBAR(); } \
      if(MK) cmask(C0,C1,(t)-(NT-4),qrel,hi); } \
    else { amask(C0,C1,TROW(t),qp,slope2,hi); } }while(0)
  #define POST0(P0,P1) do{ _Pragma("unroll") for(int r=0;r<16;++r)P0[r]=-INFINITY; _Pragma("unroll") for(int r=0;r<8;++r)P1[r]=-INFINITY; \
    if(MODE==0){ const f32x4 a_=*(const f32x4*)(cl+4*hi), b_=*(const f32x4*)(cl+8+4*hi); _Pragma("unroll") for(int e_=0;e_<4;++e_){ P1[8+e_]-=a_[e_]; P1[12+e_]-=b_[e_]; } } \
    else { _Pragma("unroll") for(int r=8;r<16;++r)P1[r]+=slope2*(float)(96+crow(r,hi)); } }while(0)
  bool resc=false;
  #define START(P0,P1) do{ const float rm=rowmax(P0,P1); resc=false; \
    { const float dl=(MODE==0)?rm:__builtin_fmaxf(rm,0.f); mhat=fadd_s(mhat,dl); \
      _Pragma("unroll") for(int r=0;r<16;++r){P0[r]=fsub_s(P0[r],dl);P1[r]=fsub_s(P1[r],dl);} \
      { const float nm_=rowterm-mhat; _Pragma("unroll") for(int r=0;r<16;++r)negm[r]=nm_; } asm volatile("":"+v"(negm)); \
      if(MODE==1) l_reg*=__builtin_amdgcn_exp2f(-dl); } \
    _Pragma("unroll") for(int r=0;r<16;++r)P0[r]=__builtin_amdgcn_exp2f(P0[r]); }while(0)
  #define RESC() do{ if(resc){ asm volatile("s_waitcnt lgkmcnt(0)":::"memory"); \
      _Pragma("unroll") for(int d_=0;d_<2;++d_) _Pragma("unroll") for(int r=0;r<16;++r)o[d_][r]*=wsf[crow(r,hi)]; } }while(0)
  f32x16 pA0,pA1,pB0,pB1;
  int sl_prev=0,sl_cur=0,sl_next=SLOTB;
  #define ROT() do{sl_prev=sl_cur;sl_cur=sl_next;sl_next=(sl_next==(NSLOT-1)*SLOTB)?0:sl_next+SLOTB;}while(0)
  DMA_K(2,2*SLOTB);
  WAIT_BAR(3);
  qkt(pA0,pA1,Kbase,qr,negm,r32,hi);asm volatile("s_nop 15\n\ts_nop 7":"+v"(pA0),"+v"(pA1));POST0(pA0,pA1);
  START(pA0,pA1);
  _Pragma("unroll") for(int r=0;r<16;++r)pA1[r]=__builtin_amdgcn_exp2f(pA1[r]);
  WAIT_BAR(0);
  DMA_K(3,0);DMA_V(1,SLOTB);
  ROT();
  kload8(kf,kp0+sl_cur);
  WAIT_BAR(2);
  s16x4 vlo[8],vhi[8]; u32x4 pw0,pw1,pw2,pw3;
  #define PKW(P,B) cvtpk_s(P[B],P[B+1])
  #define PAF(k) __builtin_bit_cast(bf16x8,pw##k)
  #define VFR(i) (bf16x8){vlo[i][0],vlo[i][1],vlo[i][2],vlo[i][3],vhi[i][0],vhi[i][1],vhi[i][2],vhi[i][3]}
  #define PIN(x) asm volatile("":"+v"(x))
  #define MX3(a,b,c) __builtin_fmaxf(__builtin_fmaxf((a),(b)),(c))
  #define GAPA(MF,A0,A1,A2,A3,W0,W1,PW) do{ MF; sacc+=A0; sacc+=A1; sacc+=A2; sacc+=A3; PIN(sacc); W0; W1; PIN(PW); SBAR(); }while(0)
  #define EX(v) __builtin_amdgcn_exp2f(v)
  #define GAPB(MF,X,B) do{ MF; X[B]=EX(X[B]); X[B+1]=EX(X[B+1]); X[B+2]=EX(X[B+2]); X[B+3]=EX(X[B+3]); PIN(X); SBAR(); }while(0)
  #define VRD(i) do{ vlo[i]=vtr(vp_+(((i)>>2)*4096+((i)&3)*1024)); vhi[i]=vtr(vp_+(((i)>>2)*4096+((i)&3)*1024+512)); }while(0)
  #define KRD(G,j) do{ if(G){ kload2(kf,kp0+sl_next,j); SBAR(); } }while(0)
  #define STEP(C0,C1,P0,P1,t,GK,GV,GL,MK) do{ SBAR(); \
    const lds_cptr vp_=vp0+sl_prev; \
    VRD(0); SBAR(); float sacc=(P0[0]+P0[1]); \
    GAPA(C0=__builtin_amdgcn_mfma_f32_32x32x16_bf16(kf[0],qr[0],negm,0,0,0), P0[2],P0[3],P0[4],P0[5],     pw0[0]=PKW(P0,0), pw0[1]=PKW(P0,2), pw0); \
    VRD(4); SBAR(); GAPA(C1=__builtin_amdgcn_mfma_f32_32x32x16_bf16(kf[1],qr[0],negm,0,0,0), P0[6],P0[7],P0[8],P0[9],     pw0[2]=PKW(P0,4), pw0[3]=PKW(P0,6), pw0); \
    VRD(1); SBAR(); GAPA(C0=__builtin_amdgcn_mfma_f32_32x32x16_bf16(kf[2],qr[1],C0,0,0,0),   P0[10],P0[11],P0[12],P0[13], pw1[0]=PKW(P0,8), pw1[1]=PKW(P0,10), pw1); \
    VRD(5); SBAR(); GAPA(C1=__builtin_amdgcn_mfma_f32_32x32x16_bf16(kf[3],qr[1],C1,0,0,0),   P0[14],P0[15],P1[0],P1[1],   pw1[2]=PKW(P0,12),pw1[3]=PKW(P0,14), pw1); \
    VRD(2); SBAR(); GAPA(C0=__builtin_amdgcn_mfma_f32_32x32x16_bf16(kf[4],qr[2],C0,0,0,0),   P1[2],P1[3],P1[4],P1[5],     pw2[0]=PKW(P1,0), pw2[1]=PKW(P1,2), pw2); \
    VRD(6); SBAR(); GAPA(C1=__builtin_amdgcn_mfma_f32_32x32x16_bf16(kf[5],qr[2],C1,0,0,0),   P1[6],P1[7],P1[8],P1[9],     pw2[2]=PKW(P1,4), pw2[3]=PKW(P1,6), pw2); \
    VRD(3); SBAR(); GAPA(C0=__builtin_amdgcn_mfma_f32_32x32x16_bf16(kf[6],qr[3],C0,0,0,0),   P1[10],P1[11],P1[12],P1[13], pw3[0]=PKW(P1,8), pw3[1]=PKW(P1,10), pw3); \
    VRD(7); SBAR(); GAPA(C1=__builtin_amdgcn_mfma_f32_32x32x16_bf16(kf[7],qr[3],C1,0,0,0),   P1[14],P1[15],0.f,0.f,       pw3[2]=PKW(P1,12),pw3[3]=PKW(P1,14), pw3); \
    l_reg+=sacc; \
    if(GK){DMA_K((t)+3,sl_cur);} if(GV){DMA_V((t)+1,sl_next);} \
    POST(C0,C1,t,MK); \
    { float a=MX3(C0[0],C0[1],C1[0]),b=MX3(C0[2],C0[3],C1[1]); a=MX3(a,C1[2],C1[3]); \
      _Pragma("unroll") for(int r=4;r<16;r+=4){a=MX3(a,C0[r],C0[r+1]);b=MX3(b,C0[r+2],C0[r+3]);a=MX3(a,C1[r],C1[r+1]);b=MX3(b,C1[r+2],C1[r+3]);} \
      float rm=__builtin_fmaxf(a,b); { auto rr=__builtin_amdgcn_permlane32_swap(__float_as_uint(rm),__float_as_uint(rm),false,false); rm=__builtin_fmaxf(__uint_as_float(rr[0]),__uint_as_float(rr[1])); } \
      resc=false; \
      if(__builtin_expect(__any(rm>(float)THRL),0)){ const float dl=__builtin_fmaxf(rm,0.f); mhat+=dl; \
        _Pragma("unroll") for(int r=0;r<16;++r){C0[r]-=dl;C1[r]-=dl;} \
        { const float nm_=rowterm-mhat; _Pragma("unroll") for(int r=0;r<16;++r)negm[r]=nm_; } asm volatile("":"+v"(negm)); \
        const float f=__builtin_amdgcn_exp2f(-dl); l_reg*=f; if(hi==0)wsf[r32]=f; resc=true; } } \
    SBAR(); \
    GAPB(o[0]=__builtin_amdgcn_mfma_f32_32x32x16_bf16(PAF(0),VFR(0),o[0],0,0,0), C0,0); \
    GAPB(o[1]=__builtin_amdgcn_mfma_f32_32x32x16_bf16(PAF(0),VFR(4),o[1],0,0,0), C0,4); \
    KRD(GL,0); GAPB(o[0]=__builtin_amdgcn_mfma_f32_32x32x16_bf16(PAF(1),VFR(1),o[0],0,0,0), C0,8); \
    KRD(GL,1); GAPB(o[1]=__builtin_amdgcn_mfma_f32_32x32x16_bf16(PAF(1),VFR(5),o[1],0,0,0), C0,12); \
    KRD(GL,2); GAPB(o[0]=__builtin_amdgcn_mfma_f32_32x32x16_bf16(PAF(2),VFR(2),o[0],0,0,0), C1,0); \
    KRD(GL,3); GAPB(o[1]=__builtin_amdgcn_mfma_f32_32x32x16_bf16(PAF(2),VFR(6),o[1],0,0,0), C1,4); \
    GAPB(o[0]=__builtin_amdgcn_mfma_f32_32x32x16_bf16(PAF(3),VFR(3),o[0],0,0,0), C1,8); \
    GAPB(o[1]=__builtin_amdgcn_mfma_f32_32x32x16_bf16(PAF(3),VFR(7),o[1],0,0,0), C1,12); \
    }while(0)
  int t=1;
  for(;t<NT-4;t+=2){
    STEP(pB0,pB1,pA0,pA1,t,true,true,true,false);     WAIT_BAR(2); RESC(); ROT();
    STEP(pA0,pA1,pB0,pB1,t+1,true,true,true,false);   WAIT_BAR(2); RESC(); ROT();
  }
  STEP(pB0,pB1,pA0,pA1,NT-4,true,true,true,true);     WAIT_BAR(2); RESC(); ROT();
  STEP(pA0,pA1,pB0,pB1,NT-3,false,true,true,true);    WAIT_BAR(1); RESC(); ROT();
  STEP(pB0,pB1,pA0,pA1,NT-2,false,true,true,true);    WAIT_BAR(0); RESC(); ROT();
  STEP(pA0,pA1,pB0,pB1,NT-1,false,false,false,true);  RESC();
  { float sacc=pA0[0]+pA0[1]; _Pragma("unroll") for(int r=2;r<16;++r)sacc+=pA0[r]; _Pragma("unroll") for(int r=0;r<16;++r)sacc+=pA1[r]; l_reg+=sacc;
    pw0=(u32x4){PKW(pA0,0),PKW(pA0,2),PKW(pA0,4),PKW(pA0,6)};pw1=(u32x4){PKW(pA0,8),PKW(pA0,10),PKW(pA0,12),PKW(pA0,14)};pw2=(u32x4){PKW(pA1,0),PKW(pA1,2),PKW(pA1,4),PKW(pA1,6)};pw3=(u32x4){PKW(pA1,8),PKW(pA1,10),PKW(pA1,12),PKW(pA1,14)};
    SBAR(); pv(o,vb0+sl_cur,PAF(0),PAF(1),PAF(2),PAF(3)); }
  #undef PKW
  #undef PAF
  #undef VFR
  #undef PIN
  #undef MX3
  #undef GAPA
  #undef GAPB
  #undef EX
  #undef VRD
  #undef KRD
  #undef STEP
  {auto rr=__builtin_amdgcn_permlane32_swap(__float_as_uint(l_reg),__float_as_uint(l_reg),false,false);l_reg=__uint_as_float(rr[0])+__uint_as_float(rr[1]);}
  if(hi==0)wsf[32+r32]=l_reg;asm volatile("s_waitcnt lgkmcnt(0)":::"memory");
  float rli[16];
  #pragma unroll
  for(int r=0;r<16;++r)rli[r]=__builtin_amdgcn_rcpf(wsf[32+crow(r,hi)]);
  { bf16*stg=(bf16*)(shm+LDS_OST)+wid*2048;
    #pragma unroll
    for(int r=0;r<16;++r){const int orow=crow(r,hi);
      #pragma unroll
      for(int d0=0;d0<2;++d0)stg[orow*64+d0*32+r32]=__float2bfloat16(o[d0][r]*rli[r]);}
    asm volatile("s_waitcnt lgkmcnt(0)":::"memory");
    #pragma unroll
    for(int i=0;i<4;++i){const int row=i*8+(lane>>3),ch=lane&7; const u32x4 v=*(const u32x4*)(stg+row*64+ch*8); *(u32x4*)(Ow+(long)row*DM+ch*8)=v;} }
  asm volatile("s_waitcnt lgkmcnt(0)\n\ts_barrier":::"memory");
  #undef DMA_K
  #undef DMA_V
  #undef POST
  #undef POST0
  #undef TROW
  #undef START
  #undef RESC
  #undef ROT
}

#undef SBAR
#undef WAIT_BAR
}

constexpr int NWAVES = 8;
#ifndef MK_N_LAUNCHES
#define MK_N_LAUNCHES 1
#endif
constexpr int N_PHASES = 9;
constexpr int N_LAUNCHES = MK_N_LAUNCHES;

constexpr size_t MiB = 1u << 20;
constexpr size_t WS_CTL = 0, CTL_ZERO_BYTES = 64 * 1024;
constexpr size_t WS_SSQ = 2 * MiB;
constexpr size_t WS_META = 10 * MiB;
constexpr size_t WS_LOGF = 11 * MiB;
constexpr size_t WS_W1 = 16 * MiB, WS_W2 = 27 * MiB, WS_WP = 33 * MiB, WS_WAB = 42 * MiB, WS_WO = 44 * MiB, WS_W3 = 46 * MiB, WS_W4 = 57 * MiB;
constexpr size_t WS_XB = 64 * MiB;
constexpr size_t WS_R = 128 * MiB;
constexpr size_t WS_ACT = WS_R;
constexpr size_t WS_QO = WS_R, WS_KA = WS_R + 64 * MiB, WS_VA = WS_KA + 9 * MiB, WS_KB = WS_VA + 9 * MiB, WS_VB = WS_KB + 34 * MiB,
                 WS_SGA = WS_VB + 34 * MiB, WS_SGB = WS_SGA + 64 * MiB, WS_MIX = WS_SGB + 64 * MiB, WS_END = WS_MIX + 64 * MiB;
static_assert(WS_W1 + (size_t)2 * DFF * DM * 2 <= WS_W2 && WS_W2 + (size_t)DM * DFF * 2 <= WS_WP && WS_WP + (size_t)NPROJ * DM * 2 <= WS_WAB && WS_W3 + (size_t)2 * DFF * DM * 2 <= WS_W4 && WS_W4 + (size_t)DM * DFF * 2 <= WS_XB, "weights map");
static_assert((size_t)NKR * 128 * 2 <= 9 * MiB && (size_t)NKR * 512 * 2 <= 34 * MiB && (size_t)NKR * 8 * 4 <= 2 * MiB && WS_END <= 512 * MiB && WS_ACT + (size_t)MROWS * DFF * 2 <= WS_END, "activation map");
constexpr size_t MT_XB = 0, MT_SSQ0 = 32768, MT_ACT = 65536, MT_H1B = 163840, MT_SSQ1 = 196608;
constexpr int CW_BAR = 4096;
constexpr int CW_PANEL = 8192;
static_assert((CW_PANEL + 64 * 128) * 4 <= (int)CTL_ZERO_BYTES, "control words inside the per-call memset");

constexpr int RING_OFF = 0, RING_BYTES = 131072;
constexpr int LDSCTL_OFF = RING_BYTES, MISC_OFF = LDSCTL_OFF + 320;
constexpr int LDS_BYTES = 147456;
static_assert(MISC_OFF + 128 <= LDS_BYTES && attn::LDS_END <= RING_BYTES && attn2::LDS_END <= RING_BYTES, "LDS map");

typedef GAS unsigned gu32;
#define RLX_AGENT __ATOMIC_RELAXED, __HIP_MEMORY_SCOPE_AGENT
#define LDS_WAIT() asm volatile("s_waitcnt lgkmcnt(0)" ::: "memory")
#define VM_WAIT() asm volatile("s_waitcnt vmcnt(0)" ::: "memory")
#define XB_TMO      128
#define XB_XCNT(j)  (256  + 64 * (j))
#define XB_XSUB(j)  (1280 + 64 * (j))
#define XB_XGEN(j)  (2304 + 64 * (j))
#define XB_TOP      3328
#define XB_TOPGEN   3392
#define XCD_BAR_WORDS 3456
#define XB_SPIN_CAP (1u << 18)

__device__ __forceinline__ unsigned xb_ld(unsigned* p)              { return __hip_atomic_load(p, __ATOMIC_RELAXED, __HIP_MEMORY_SCOPE_AGENT); }
__device__ __forceinline__ unsigned xb_add(unsigned* p, unsigned v) { return __hip_atomic_fetch_add(p, v, __ATOMIC_RELAXED, __HIP_MEMORY_SCOPE_AGENT); }
__device__ __forceinline__ unsigned xb_xcc_id() { return (unsigned)__builtin_amdgcn_s_getreg((3 << 11) | 20) & 0xFu; }
#define XB_SPIN(cond, bar) do { unsigned _sp = 0; while (cond) { __builtin_amdgcn_s_sleep(1); \
    if ((++_sp & 255u) == 0u) { if (xb_ld(&(bar)[XB_TMO])) break; if (_sp > XB_SPIN_CAP) { atomicAdd(&(bar)[XB_TMO], 1u); break; } } } } while (0)

struct XcdBarrier {
    unsigned* bar; unsigned x;
    volatile LAS unsigned* st;
};

__device__ __forceinline__ XcdBarrier xcd_barrier_post(unsigned* bar, volatile LAS unsigned* st) {
    XcdBarrier b; b.bar = bar; b.x = xb_xcc_id(); b.st = st;
    if (threadIdx.x == 0) (void)xb_add(&bar[XB_XCNT(b.x)], 1u);
    return b;
}
__device__ __forceinline__ void xcd_barrier_complete(unsigned* bar, unsigned x, unsigned& nloc, unsigned& nx) {
    const unsigned G = gridDim.x * gridDim.y * gridDim.z;
    unsigned sum, cnt, mine, sp = 0u;
    for (;;) {
        sum = 0u; cnt = 0u; mine = 0u;
#pragma unroll
        for (unsigned j = 0; j < 16; ++j) { const unsigned c = xb_ld(&bar[XB_XCNT(j)]); sum += c; cnt += (c > 0u) ? 1u : 0u; mine = (j == x) ? c : mine; }
        if (sum == G) break;
        __builtin_amdgcn_s_sleep(1);
        if ((++sp & 255u) == 0u) { if (xb_ld(&bar[XB_TMO])) break; if (sp > XB_SPIN_CAP) { atomicAdd(&bar[XB_TMO], 1u); break; } }
    }
    nloc = mine > 0u ? mine : 1u; nx = cnt > 0u ? cnt : 1u;
}

__device__ __forceinline__ void xcd_barrier(const XcdBarrier& b) {
    asm volatile("s_waitcnt vmcnt(0)" ::: "memory");
    __syncthreads();
    if (threadIdx.x == 0) {
        unsigned* bar = b.bar;
        __builtin_amdgcn_s_waitcnt(0);
        unsigned nloc = b.st[0], nx = b.st[1];
        if (nloc == 0u) { xcd_barrier_complete(bar, b.x, nloc, nx); b.st[0] = nloc; b.st[1] = nx; }
        const unsigned old = xb_add(&bar[XB_XSUB(b.x)], 1u);
        const unsigned gen = old / nloc;
        if (old + 1u == (gen + 1u) * nloc) {
            __builtin_amdgcn_fence(__ATOMIC_RELEASE, "agent");
            asm volatile("s_waitcnt vmcnt(0)" ::: "memory");
            const unsigned og = xb_add(&bar[XB_TOP], 1u);
            const unsigned tg = og / nx;
            if (og + 1u == (tg + 1u) * nx) xb_add(&bar[XB_TOPGEN], 1u);
            else XB_SPIN(xb_ld(&bar[XB_TOPGEN]) == tg, bar);
            __builtin_amdgcn_fence(__ATOMIC_ACQUIRE, "agent");
            xb_add(&bar[XB_XGEN(b.x)], 1u);
            asm volatile("s_waitcnt vmcnt(0)" ::: "memory");
        } else {
            XB_SPIN(xb_ld(&bar[XB_XGEN(b.x)]) == gen, bar);
            __builtin_amdgcn_fence(__ATOMIC_ACQUIRE, "agent");
            asm volatile("s_waitcnt vmcnt(0)" ::: "memory");
        }
    }
    __syncthreads();
}

struct Frame {
    LAS unsigned char* lds;
    volatile LAS unsigned* MISC;
    gu32* ctl;
    int tid, lane, wave;
    int vcu, G;
    unsigned char* ws;
    const float* in[16]; float* out;
};
__device__ __forceinline__ float wave_sum(float v) {
#pragma unroll
    for (int o = 1; o < 64; o <<= 1) v += __shfl_xor(v, o);
    return v;
}
__device__ __forceinline__ void tr_item(const float* W, int ldw, int k0, int c0, int ncols, const float* gain, bf16_t* WT, int ldt, int drow0, int dk0, LAS float* scr, int lane) {
    float v[32]; const int col = lane & 31, kh = lane >> 5;
    const float* wp = W + (size_t)(k0 + kh) * ldw + c0 + (col < ncols ? col : 0);
#pragma unroll
    for (int i = 0; i < 32; ++i) v[i] = wp[(size_t)(2 * i) * ldw];
    if (gain) {
#pragma unroll
        for (int i = 0; i < 32; ++i) v[i] *= gain[k0 + 2 * i + kh];
    }
#pragma unroll
    for (int i = 0; i < 32; ++i) scr[(2 * i + kh) * 33 + col] = v[i];
    LDS_WAIT(); asm volatile("" ::: "memory");
    const int c = lane & 7;
#pragma unroll
    for (int j = 0; j < 4; ++j) { const int n = (lane >> 3) + 8 * j; const LAS float* s = scr + (8 * c) * 33 + n;
        u32x4 o; o.x = cvt_pk_bf16(s[0 * 33], s[1 * 33]); o.y = cvt_pk_bf16(s[2 * 33], s[3 * 33]); o.z = cvt_pk_bf16(s[4 * 33], s[5 * 33]); o.w = cvt_pk_bf16(s[6 * 33], s[7 * 33]);
        if (n < ncols) *(GAS u32x4*)(WT + (size_t)(drow0 + n) * ldt + dk0 + k0 + 8 * c) = o; }
    LDS_WAIT(); asm volatile("" ::: "memory");
}
__device__ __forceinline__ int swiglu_row(int c0) { const int up = c0 >= DFF, c = up ? c0 - DFF : c0; return 256 * (c / 128) + (up ? 128 : 0) + (c % 128); }
__device__ __forceinline__ void row_to_bf16(const float* xrow, bf16_t* orow, float* ssq16, int lane) {
    const GAS f32x4* xr = (const GAS f32x4*)xrow + lane;
    f32x4 v[4]; float s = 0.f;
#pragma unroll
    for (int j = 0; j < 4; ++j) { v[j] = xr[64 * j]; s += (v[j].x * v[j].x + v[j].y * v[j].y) + (v[j].z * v[j].z + v[j].w * v[j].w); }
    s = wave_sum(s);
    GAS u32x2* o8 = (GAS u32x2*)orow + lane;
#pragma unroll
    for (int j = 0; j < 4; ++j) { u32x2 w; w.x = cvt_pk_bf16(v[j].x, v[j].y); w.y = cvt_pk_bf16(v[j].z, v[j].w); o8[64 * j] = w; }
    if (ssq16 && lane < 16) ssq16[lane] = lane == 0 ? s : 0.f;
}
__device__ __forceinline__ void zero_bytes(Frame& F, void* p, size_t nbytes) {
    const size_t n16 = nbytes / 16; GAS u32x4* q = (GAS u32x4*)p;
    for (size_t i = (size_t)F.vcu * 512 + F.tid; i < n16; i += (size_t)F.G * 512) q[i] = (u32x4){0u, 0u, 0u, 0u};
}
__device__ __forceinline__ void p0_prologue(Frame& F) {
    LAS float* scr = (LAS float*)(F.lds + RING_OFF + F.wave * 16384);
    const int gw = F.vcu * NWAVES + F.wave, NGW = F.G * NWAVES;
    unsigned char* ws = F.ws;
    bf16_t *W1t = (bf16_t*)(ws + WS_W1), *W2t = (bf16_t*)(ws + WS_W2), *Wpt = (bf16_t*)(ws + WS_WP), *Wabt = (bf16_t*)(ws + WS_WAB), *Wot = (bf16_t*)(ws + WS_WO), *W3t = (bf16_t*)(ws + WS_W3), *W4t = (bf16_t*)(ws + WS_W4);
    constexpr int I0 = 16 * 176, I1 = 44 * 32, I2 = 16 * 72, I3 = 16 * 64, I4 = 16, I5 = 8 * 32, I6 = 8 * 32, I7 = 16 * 32, I8 = I0, I9 = I1;
    constexpr int NITEMS = I0 + I1 + I2 + I3 + I4 + I5 + I6 + I7 + I8 + I9;
    for (int it = gw; it < NITEMS; it += NGW) {
        int r = it;
        if (r < I0) { const int kb = r / 176, nb = r % 176; tr_item(F.in[3], 2 * DFF, 64 * kb, 32 * nb, 32, F.in[2], W1t, DM, swiglu_row(32 * nb), 0, scr, F.lane); continue; } r -= I0;
        if (r < I1) { const int kb = r / 32, nb = r % 32; tr_item(F.in[4], DM, 64 * kb, 32 * nb, 32, nullptr, W2t, DFF, 32 * nb, 0, scr, F.lane); continue; } r -= I1;
        if (r < I2) { const int kb = r / 72, nb = r % 72; tr_item(F.in[6], 4360, 64 * kb, 32 * nb, 32, F.in[5], Wpt, DM, 32 * nb, 0, scr, F.lane); continue; } r -= I2;
        if (r < I3) { const int kb = r / 64, nb = r % 64, gb = nb >= 32, cb = gb ? nb - 32 : nb;
            tr_item(F.in[6], 4360, 64 * kb, 2312 + 32 * nb, 32, F.in[5], Wpt, DM, 2304 + 256 * (cb / 4) + (gb ? 128 : 0) + 32 * (cb % 4), 0, scr, F.lane); continue; } r -= I3;
        if (r < I4) { tr_item(F.in[6], 4360, 64 * r, 2304, 8, F.in[5], Wpt, DM, 4352, 0, scr, F.lane); continue; } r -= I4;
        if (r < I5) { const int kb = r / 32, nb = r % 32; tr_item(F.in[9], DM, 64 * kb, 32 * nb, 32, nullptr, Wabt, DM, 32 * nb, 0, scr, F.lane); continue; } r -= I5;
        if (r < I6) { const int kb = r / 32, nb = r % 32; tr_item(F.in[10], DM, 64 * kb, 32 * nb, 32, nullptr, Wabt, DM, 32 * nb, 512, scr, F.lane); continue; } r -= I6;
        if (r < I7) { const int kb = r / 32, nb = r % 32; tr_item(F.in[11], DM, 64 * kb, 32 * nb, 32, nullptr, Wot, DM, 32 * nb, 0, scr, F.lane); continue; } r -= I7;
        if (r < I8) { const int kb = r / 176, nb = r % 176; tr_item(F.in[13], 2 * DFF, 64 * kb, 32 * nb, 32, F.in[12], W3t, DM, swiglu_row(32 * nb), 0, scr, F.lane); continue; } r -= I8;
        { const int kb = r / 32, nb = r % 32; tr_item(F.in[14], DM, 64 * kb, 32 * nb, 32, nullptr, W4t, DFF, 32 * nb, 0, scr, F.lane); }
    }
    bf16_t* XB = (bf16_t*)(ws + WS_XB); float* SSQ = (float*)(ws + WS_SSQ);
    for (int m0 = gw * 4; m0 < MROWS; m0 += NGW * 4) {
        f32x4 v[4][4]; float sq[4];
#pragma unroll
        for (int r = 0; r < 4; ++r)
#pragma unroll
            for (int j = 0; j < 4; ++j) v[r][j] = ((const GAS f32x4*)(F.in[0] + (size_t)(m0 + r) * DM))[64 * j + F.lane];
#pragma unroll
        for (int r = 0; r < 4; ++r) { float s_ = 0.f;
#pragma unroll
            for (int j = 0; j < 4; ++j) s_ += (v[r][j].x * v[r][j].x + v[r][j].y * v[r][j].y) + (v[r][j].z * v[r][j].z + v[r][j].w * v[r][j].w);
            sq[r] = wave_sum(s_); }
#pragma unroll
        for (int r = 0; r < 4; ++r) { GAS u32x2* o8 = (GAS u32x2*)(XB + (size_t)(m0 + r) * DM) + F.lane;
#pragma unroll
            for (int j = 0; j < 4; ++j) { u32x2 w; w.x = cvt_pk_bf16(v[r][j].x, v[r][j].y); w.y = cvt_pk_bf16(v[r][j].z, v[r][j].w); o8[64 * j] = w; } }
        if (F.lane < 16) {
#pragma unroll
            for (int r = 0; r < 4; ++r) SSQ[(size_t)(m0 + r) * 16 + F.lane] = F.lane == 0 ? sq[r] : 0.f; }
    }
    if (gw < NMETA) row_to_bf16(F.in[1] + (size_t)gw * DM, (bf16_t*)(ws + WS_META + MT_XB) + (size_t)gw * DM, (float*)(ws + WS_META + MT_SSQ0) + gw * 16, F.lane);
    zero_bytes(F, Wpt + (size_t)4360 * DM, (size_t)(NPROJ - 4360) * DM * 2);
    for (int b = 0; b < NBATCH; ++b) {
        zero_bytes(F, (bf16_t*)(ws + WS_KA) + (size_t)b * LPOS * 128, (size_t)KR_META * 128 * 2);
        zero_bytes(F, (bf16_t*)(ws + WS_VA) + (size_t)b * LPOS * 128, (size_t)KR_META * 128 * 2);
        zero_bytes(F, (bf16_t*)(ws + WS_KB) + (size_t)b * LPOS * 512, (size_t)KR_META * 512 * 2);
        zero_bytes(F, (bf16_t*)(ws + WS_VB) + (size_t)b * LPOS * 512, (size_t)KR_META * 512 * 2);
    }
}
__device__ __forceinline__ f32x4 meta_partial(const bf16_t* Wr, int ldw, const bf16_t* X, int ldx, int K, int wid, int lane) {
    const int i = lane & 15, q = lane >> 4; f32x4 acc = (f32x4){0.f, 0.f, 0.f, 0.f};
    for (int s = wid; s < K / 32; s += NWAVES) {
        const bf16x8 a = *(const bf16x8*)(Wr + (size_t)i * ldw + s * 32 + q * 8), b = *(const bf16x8*)(X + (size_t)i * ldx + s * 32 + q * 8);
        acc = __builtin_amdgcn_mfma_f32_16x16x32_bf16(a, b, acc, 0, 0, 0);
    }
    return acc;
}
__device__ __forceinline__ f32x4 meta_reduce(Frame& F, f32x4 part, int blk) {
    LAS f32x4* scr = (LAS f32x4*)(F.lds + RING_OFF + blk * 8192);
    scr[F.wave * 64 + F.lane] = part;
    __syncthreads();
    f32x4 s = scr[F.lane];
#pragma unroll
    for (int w = 1; w < NWAVES; ++w) s += scr[w * 64 + F.lane];
    __syncthreads();
    return s;
}
__device__ __forceinline__ void meta_up(Frame& F) {
    if (F.vcu >= DFF / 16) return;
    unsigned char* ws = F.ws; const int c = F.vcu, j = F.lane & 15, q = F.lane >> 4;
    const bf16_t* W1t = (const bf16_t*)(ws + WS_W1); const bf16_t* X = (const bf16_t*)(ws + WS_META + MT_XB);
    const int grow = 256 * (c / 8) + 16 * (c % 8);
    f32x4 g = meta_partial(W1t + (size_t)grow * DM, DM, X, DM, DM, F.wave, F.lane);
    f32x4 u = meta_partial(W1t + (size_t)(grow + 128) * DM, DM, X, DM, DM, F.wave, F.lane);
    g = meta_reduce(F, g, 0); u = meta_reduce(F, u, 1);
    if (F.wave == 0) {
        const float rs = 1.0f / sqrtf(((const float*)(ws + WS_META + MT_SSQ0))[j * 16] * (1.0f / 1024.0f) + EPS);
        float o[4];
#pragma unroll
        for (int e = 0; e < 4; ++e) { const float gg = g[e] * rs, uu = u[e] * rs; o[e] = gg * pg8::fast_sigmoid(gg) * uu; }
        u32x2 w; w.x = cvt_pk_bf16(o[0], o[1]); w.y = cvt_pk_bf16(o[2], o[3]);
        *(u32x2*)((bf16_t*)(ws + WS_META + MT_ACT) + (size_t)j * DFF + 16 * c + 4 * q) = w;
    }
}
__device__ __forceinline__ void meta_down(Frame& F) {
    if (F.vcu >= DM / 16) return;
    unsigned char* ws = F.ws; const int c = F.vcu, j = F.lane & 15, q = F.lane >> 4;
    const bf16_t* W2t = (const bf16_t*)(ws + WS_W2); const bf16_t* X = (const bf16_t*)(ws + WS_META + MT_ACT);
    f32x4 d = meta_partial(W2t + (size_t)(16 * c) * DFF, DFF, X, DFF, DFF, F.wave, F.lane);
    d = meta_reduce(F, d, 0);
    if (F.wave == 0) {
        const f32x4 base = *(const f32x4*)(F.in[1] + (size_t)j * DM + 16 * c + 4 * q);
        const f32x4 v = base + d * 0.5f;
        u32x2 w; w.x = cvt_pk_bf16(v[0], v[1]); w.y = cvt_pk_bf16(v[2], v[3]);
        *(u32x2*)((bf16_t*)(ws + WS_META + MT_H1B) + (size_t)j * DM + 16 * c + 4 * q) = w;
        float sq = (v[0] * v[0] + v[1] * v[1]) + (v[2] * v[2] + v[3] * v[3]);
        sq += __shfl_xor(sq, 16); sq += __shfl_xor(sq, 32);
        if (q == 0) ((float*)(ws + WS_META + MT_SSQ1))[j * 64 + c] = sq;
    }
}
__device__ __forceinline__ void meta_proj(Frame& F) {
    if (F.vcu >= 81) return;
    unsigned char* ws = F.ws; const int g = F.vcu, j = F.lane & 15, q = F.lane >> 4;
    const bf16_t* Wpt = (const bf16_t*)(ws + WS_WP); const bf16_t* X = (const bf16_t*)(ws + WS_META + MT_H1B);
    int prow; bf16_t* dst; int pitch, col;
    if (g < 8)       { prow = 512 + 16 * g;         dst = (bf16_t*)(ws + WS_KA); pitch = 128; col = 16 * g; }
    else if (g < 16) { prow = 640 + 16 * (g - 8);   dst = (bf16_t*)(ws + WS_VA); pitch = 128; col = 16 * (g - 8); }
    else if (g < 48) { prow = 1280 + 16 * (g - 16); dst = (bf16_t*)(ws + WS_KB); pitch = 512; col = 16 * (g - 16); }
    else if (g < 80) { prow = 1792 + 16 * (g - 48); dst = (bf16_t*)(ws + WS_VB); pitch = 512; col = 16 * (g - 48); }
    else             { prow = 4352;                 dst = nullptr; pitch = 0; col = 0; }
    f32x4 d = meta_partial(Wpt + (size_t)prow * DM, DM, X, DM, DM, F.wave, F.lane);
    d = meta_reduce(F, d, 0);
    if (F.wave == 0) {
        const float* s1 = (const float*)(ws + WS_META + MT_SSQ1) + j * 64 + 16 * q;
        const f32x4 a0 = *(const f32x4*)s1, a1 = *(const f32x4*)(s1 + 4), a2 = *(const f32x4*)(s1 + 8), a3 = *(const f32x4*)(s1 + 12);
        float s = ((a0[0] + a0[1]) + (a0[2] + a0[3])) + ((a1[0] + a1[1]) + (a1[2] + a1[3])) + ((a2[0] + a2[1]) + (a2[2] + a2[3])) + ((a3[0] + a3[1]) + (a3[2] + a3[3]));
        s += __shfl_xor(s, 16); s += __shfl_xor(s, 32);
        const float rs = 1.0f / sqrtf(s * (1.0f / 1024.0f) + EPS);
        const f32x4 v = d * rs;
        if (dst) {
            u32x2 w; w.x = cvt_pk_bf16(v[0], v[1]); w.y = cvt_pk_bf16(v[2], v[3]);
            for (int b = 0; b < NBATCH; ++b) *(u32x2*)(dst + (size_t)(b * LPOS + KR_META + j) * pitch + col + 4 * q) = w;
        } else if (q < 2) {
            const f32x4 bb = *(const f32x4*)(F.in[7] + 4 * q); f32x4 lf;
#pragma unroll
            for (int e = 0; e < 4; ++e) { const float x = v[e] + bb[e]; lf[e] = fminf(x, 0.f) - log1pf(expf(-fabsf(x))); }
            float* L = (float*)(ws + WS_LOGF);
            for (int b = 0; b < NBATCH; ++b) *(f32x4*)(L + (size_t)(b * LPOS + KR_META + j) * 8 + 4 * q) = lf;
        }
    }
}
__device__ __forceinline__ void attn_phase(Frame& F, char* shm, bf16_t* OB) {
    unsigned char* ws = F.ws;
    bf16_t* QO = (bf16_t*)(ws + WS_QO);
    const bf16_t *KA = (const bf16_t*)(ws + WS_KA), *VA = (const bf16_t*)(ws + WS_VA), *KB = (const bf16_t*)(ws + WS_KB), *VB = (const bf16_t*)(ws + WS_VB);
    const float* LOGF = (const float*)(ws + WS_LOGF);
    float* cl = (float*)(shm + attn2::LDS_CL); float* wtot = (float*)(shm + attn2::LDS_SCAN);
    for (int s = F.vcu; s < NBATCH * 8 * 2; s += F.G) {
        const int bh = s >> 1, half = s & 1, b = bh >> 3, h = bh & 7;
        { float v[5]; float run = 0.f; int ln = F.lane; asm volatile("" : "+v"(ln));
#pragma unroll
          for (int k = 0; k < 5; ++k) { const int e = F.tid * 5 + k; const float x = (e < 2064) ? LOGF[(size_t)(b * LPOS + KR_META + e) * 8 + h] : 0.f; run += x; v[k] = run; }
          float inc = run;
#pragma unroll
          for (int o = 1; o < 64; o <<= 1) { const float y = __shfl_up(inc, o); if (ln >= o) inc += y; }
          if (ln == 63) wtot[F.wave] = inc;
          __syncthreads();
          float woff = 0.f;
          for (int w = 0; w < F.wave; ++w) woff += wtot[w];
          const float ex = inc - run + woff;
#pragma unroll
          for (int k = 0; k < 5; ++k) { const int e = F.tid * 5 + k; if (e < 2064) cl[e] = (v[k] + ex) * LOG2E; }
          __syncthreads(); }
        for (int i = 0; i < 4; ++i) {
            const int jj = half == 0 ? (i == 0 ? 0 : i == 1 ? 7 : i == 2 ? 3 : 4) : (i == 0 ? 1 : i == 1 ? 6 : i == 2 ? 2 : 5);
            const int t0 = 256 * jj + 32 * F.wave;
            bf16_t* qw = QO + (size_t)(b * SEQ + t0) * DM + 512 + h * 64;
            attn2::unit2<0, 8>((const attn2::bf16*)qw, (attn2::bf16*)(OB + (qw - QO)), (const attn2::bf16*)(KB + (size_t)b * LPOS * 512 + h * 64), (const attn2::bf16*)(VB + (size_t)b * LPOS * 512 + h * 64), 512, 4 * jj + 5, KR_REAL, KR_REAL + t0, 32 * F.wave, 0.f, 0.f, cl, shm);
        }
        __syncthreads();
    }
    for (int s = F.vcu; s < 256; s += F.G) {
        for (int i = 0; i < 4; ++i) {
            const int a = s * 4 + i, b = a >> 6, rem = a & 63, n = rem >> 2, kvh = (rem >> 1) & 1, pair = rem & 1;
            const int head = kvh * 4 + pair * 2 + (F.wave >> 2), t0 = 128 * n + 32 * (F.wave & 3);
            bf16_t* qw = QO + (size_t)(b * SEQ + t0) * DM + head * 64;
            const float slope2 = exp2f(-(float)(head + 1)) * LOG2E, sink2 = F.in[8][head] * LOG2E;
            attn::unit<1>(qw, OB + (qw - QO), KA + (size_t)b * LPOS * 128 + kvh * 64, VA + (size_t)b * LPOS * 128 + kvh * 64, 128, 5, 128 * n, KR_REAL + t0, slope2, sink2, nullptr, shm);
        }
    }
}
__device__ __forceinline__ void final_norm(Frame& F) {
    const int gw = F.vcu * NWAVES + F.wave, NGW = F.G * NWAVES;
    const float* SSQ = (const float*)(F.ws + WS_SSQ);
    f32x4 gf[4];
#pragma unroll
    for (int j = 0; j < 4; ++j) gf[j] = ((const f32x4*)F.in[15])[64 * j + F.lane];
    for (int m = gw; m < MROWS; m += NGW) {
        const f32x4 p = *(const f32x4*)(SSQ + (size_t)m * 16 + 4 * (F.lane & 3));
        float s = (p[0] + p[1]) + (p[2] + p[3]); s += __shfl_xor(s, 1); s += __shfl_xor(s, 2);
        const float rs = 1.0f / sqrtf(s * (1.0f / 1024.0f) + EPS);
        GAS f32x4* xr = (GAS f32x4*)(F.out + (size_t)m * DM) + F.lane;
#pragma unroll
        for (int j = 0; j < 4; ++j) { const f32x4 v = xr[64 * j]; xr[64 * j] = v * rs * gf[j]; }
    }
}

struct Args { const float* in[16]; float* out; unsigned char* ws; int ph_lo, ph_hi, alt, pad; };
__global__ void __launch_bounds__(NWAVES * 64, 2) fwd_kernel(Args args) {
    extern __shared__ __attribute__((aligned(16))) unsigned char lds[];
    Frame F;
    F.lds = (LAS unsigned char*)lds;
    F.MISC = (volatile LAS unsigned*)(F.lds + MISC_OFF);
    F.tid = threadIdx.x; F.lane = F.tid & 63; F.wave = __builtin_amdgcn_readfirstlane(F.tid >> 6);
    F.G = gridDim.x; { const int bx = blockIdx.x; F.vcu = (F.G % 8 == 0) ? (bx % 8) * (F.G / 8) + bx / 8 : bx; }
    F.ws = args.ws; F.out = args.out;
#pragma unroll
    for (int i = 0; i < 16; ++i) F.in[i] = args.in[i];
    F.ctl = (gu32*)(F.ws + WS_CTL);
    for (int u = F.tid; u < (LDS_BYTES - LDSCTL_OFF) / 4; u += NWAVES * 64) ((LAS unsigned*)(F.lds + LDSCTL_OFF))[u] = 0u;
    __syncthreads();
    XcdBarrier bar; bar.bar = (unsigned*)(F.ctl + CW_BAR); bar.x = 0; bar.st = nullptr;
    if (N_LAUNCHES == 1) bar = xcd_barrier_post((unsigned*)(F.ctl + CW_BAR), F.MISC + 8);
#define GRID_BAR() do { if (N_LAUNCHES == 1) xcd_barrier(bar); } while (0)
    const int lo = args.ph_lo, hi = args.ph_hi;
#define IN(k) (lo <= (k) && (k) < hi)
#define BOTH(k) (IN(k) && IN((k) + 1))
#define ENDBAR(k) do { if (BOTH(k)) GRID_BAR(); } while (0)
    unsigned char* ws = F.ws;
    bf16_t* XB = (bf16_t*)(ws + WS_XB); bf16_t* ACT = (bf16_t*)(ws + WS_ACT); float* SSQ = (float*)(ws + WS_SSQ);
    const int bx = (int)blockIdx.x;

    if (IN(0)) { p0_prologue(F); ENDBAR(0); }

    if (IN(1)) {
        meta_up(F);
        pg8::Gemm g{XB, (const bf16_t*)(ws + WS_W1), DM, DM, DM}; pg8::StaticOrder S; S.init(MROWS, 2 * DFF, F.G, bx);
        pg8::EpiSwiGLU E{ACT, SSQ};
#if defined(EXP_NULL_EPI)
        if (args.alt) { pg8::EpiNull EN; pg8::gemm_phase<pg8::EpiNull, pg8::StaticOrder, true, true>(F.lds + RING_OFF, g, S, EN); } else
#endif
        pg8::gemm_phase<pg8::EpiSwiGLU, pg8::StaticOrder, true, true>(F.lds + RING_OFF, g, S, E);
        ENDBAR(1);
    }
    if (IN(2)) {
        meta_down(F);
        pg8::Gemm g{ACT, (const bf16_t*)(ws + WS_W2), DFF, DFF, DFF}; pg8::StaticOrder S; S.init(MROWS, DM, F.G, bx);
        pg8::EpiResB<true> E{F.in[0], XB, SSQ, 0.5f};
#if defined(EXP_NULL_EPI)
        if (args.alt) { pg8::EpiNull EN; pg8::gemm_phase<pg8::EpiNull, pg8::StaticOrder, true, true>(F.lds + RING_OFF, g, S, EN); } else
#endif
        pg8::gemm_phase<pg8::EpiResB<true>, pg8::StaticOrder, true, true>(F.lds + RING_OFF, g, S, E);
        ENDBAR(2);
    }
    if (IN(3)) {
        meta_proj(F);
        pg8::Gemm g{XB, (const bf16_t*)(ws + WS_WP), DM, DM, DM}; pg8::StaticOrder S; S.init(MROWS, NPROJ, F.G, bx);
        pg8::EpiProj E{SSQ, (bf16_t*)(ws + WS_QO), (bf16_t*)(ws + WS_KA), (bf16_t*)(ws + WS_VA), (bf16_t*)(ws + WS_KB), (bf16_t*)(ws + WS_VB), (bf16_t*)(ws + WS_SGA), (bf16_t*)(ws + WS_SGB), (float*)(ws + WS_LOGF), F.in[7]};
#if defined(EXP_NULL_EPI)
        if (args.alt) { pg8::EpiNull EN; pg8::gemm_phase<pg8::EpiNull, pg8::StaticOrder, true, true>(F.lds + RING_OFF, g, S, EN); } else
#elif defined(EXP_PROJX)
        if (args.alt) { pg8::EpiProjX<EXP_PROJX> EX{SSQ, (bf16_t*)(ws + WS_QO)}; pg8::gemm_phase<pg8::EpiProjX<EXP_PROJX>, pg8::StaticOrder, true, true>(F.lds + RING_OFF, g, S, EX); } else
#endif
        pg8::gemm_phase<pg8::EpiProj, pg8::StaticOrder, true, true>(F.lds + RING_OFF, g, S, E);
        ENDBAR(3);
    }
    if (IN(4)) { attn_phase(F, (char*)lds + RING_OFF, args.alt ? (bf16_t*)(ws + WS_MIX) : (bf16_t*)(ws + WS_QO)); ENDBAR(4); }

    if (IN(5)) {
        pg8::Gemm g{(const bf16_t*)(ws + WS_QO), (const bf16_t*)(ws + WS_WAB), DM, DM, DM}; pg8::StaticOrder S; S.init(MROWS, DM, F.G, bx);
        pg8::EpiMix E{(const bf16_t*)(ws + WS_SGA), (const bf16_t*)(ws + WS_SGB), (bf16_t*)(ws + WS_MIX)};
        pg8::gemm_phase<pg8::EpiMix, pg8::StaticOrder, true, true>(F.lds + RING_OFF, g, S, E);
        ENDBAR(5);
    }
    if (IN(6)) {
        pg8::Gemm g{(const bf16_t*)(ws + WS_MIX), (const bf16_t*)(ws + WS_WO), DM, DM, DM}; pg8::StaticOrder S; S.init(MROWS, DM, F.G, bx);
        pg8::EpiResB<false> E{XB, XB, SSQ, 1.0f};
        pg8::gemm_phase<pg8::EpiResB<false>, pg8::StaticOrder, true, true>(F.lds + RING_OFF, g, S, E);
        ENDBAR(6);
    }
    if (IN(7)) {
        pg8::Gemm g{XB, (const bf16_t*)(ws + WS_W3), DM, DM, DM}; pg8::StaticOrder S; S.init(MROWS, 2 * DFF, F.G, bx);
        pg8::EpiSwiGLU E{ACT, SSQ};
        pg8::gemm_phase<pg8::EpiSwiGLU, pg8::StaticOrder, true, true>(F.lds + RING_OFF, g, S, E);
        ENDBAR(7);
    }
    if (IN(8)) {
        pg8::Gemm g{ACT, (const bf16_t*)(ws + WS_W4), DFF, DFF, DFF}; pg8::StaticOrder S; S.init(MROWS, DM, F.G, bx);
        pg8::EpiFinal E{XB, F.out, F.in[15], SSQ, (unsigned*)(F.ctl + CW_PANEL), 0.5f};
        pg8::gemm_phase<pg8::EpiFinal, pg8::StaticOrder, true, true>(F.lds + RING_OFF, g, S, E);
    }
#undef IN
#undef BOTH
#undef GRID_BAR
}

extern "C" void kernel_launch(void* const* d_in, const int* in_sizes, int n_in, void* d_out, int out_size, void* d_ws, size_t ws_size, hipStream_t stream) {
    static int grid = 0;
    if (grid == 0) {
        if (n_in != 16 || in_sizes[0] != MROWS * DM || out_size != MROWS * DM || ws_size < WS_END) {
            fprintf(stderr, "kernel_launch: built for 16 inputs, x/out of %d floats, >= %zu bytes of workspace; got n_in %d, in0 %d, out %d, ws %zu; nothing launched\n", MROWS * DM, (size_t)WS_END, n_in, n_in > 0 ? in_sizes[0] : -1, out_size, ws_size); grid = -1; return; }
        int dev = 0, cus = 0, per_cu = 0;
        if (hipGetDevice(&dev) != hipSuccess || hipDeviceGetAttribute(&cus, hipDeviceAttributeMultiprocessorCount, dev) != hipSuccess) { fprintf(stderr, "kernel_launch: device query failed\n"); grid = -1; return; }
        if (hipFuncSetAttribute((const void*)fwd_kernel, hipFuncAttributeMaxDynamicSharedMemorySize, LDS_BYTES) != hipSuccess) { fprintf(stderr, "kernel_launch: hipFuncSetAttribute failed\n"); grid = -1; return; }
        if (hipOccupancyMaxActiveBlocksPerMultiprocessor(&per_cu, (const void*)fwd_kernel, NWAVES * 64, LDS_BYTES) != hipSuccess || per_cu < 1) { fprintf(stderr, "kernel_launch: occupancy query reports %d workgroups per CU\n", per_cu); per_cu = 1; }
        (void)hipGetLastError();
        grid = cus * (per_cu < 1 ? 1 : 1);
    }
    if (grid < 0) return;
    if (hipMemsetAsync((char*)d_ws + WS_CTL, 0, CTL_ZERO_BYTES, stream) != hipSuccess) { fprintf(stderr, "kernel_launch: hipMemsetAsync failed\n"); return; }
    Args a{};
    for (int i = 0; i < 16; ++i) a.in[i] = (const float*)d_in[i];
    a.out = (float*)d_out; a.ws = (unsigned char*)d_ws;
#ifndef EXP_REP
#define EXP_REP -1
#endif
    for (int li = 0; li < N_LAUNCHES; ++li) {
        if (N_LAUNCHES == 1) { a.ph_lo = 0; a.ph_hi = N_PHASES; } else { a.ph_lo = li; a.ph_hi = li + 1; }
        if (N_LAUNCHES != 1 && li == EXP_REP) { a.alt = 1; hipLaunchKernelGGL(fwd_kernel, dim3(grid), dim3(NWAVES * 64), LDS_BYTES, stream, a); a.alt = 0; }
        hipLaunchKernelGGL(fwd_kernel, dim3(grid), dim3(NWAVES * 64), LDS_BYTES, stream, a);
        const hipError_t le = hipPeekAtLastError();
        if (le != hipSuccess) { fprintf(stderr, "kernel_launch: launch %d failed: %s\n", li, hipGetErrorName(le)); break; }
    }
}
```

```cpp
#include <hip/hip_runtime.h>
#include <hip/hip_bf16.h>
#include <cstdio>
#include <cstdint>

#define LAS __attribute__((address_space(3)))
#define GAS __attribute__((address_space(1)))
typedef unsigned short bf16_t;
typedef short bf16x8 __attribute__((ext_vector_type(8)));
typedef float f32x4 __attribute__((ext_vector_type(4)));
typedef float f32x16 __attribute__((ext_vector_type(16)));
typedef unsigned u32x4 __attribute__((ext_vector_type(4)));
typedef unsigned u32x2 __attribute__((ext_vector_type(2)));
typedef short s16x4 __attribute__((ext_vector_type(4)));

constexpr int DM = 1024, NBATCH = 16, SEQ = 2048, MROWS = NBATCH * SEQ;
constexpr int DFF = 2816, NPROJ = 4608;
constexpr int LPOS = 2176, NKR = NBATCH * LPOS;
constexpr int NMETA = 16, KR_META = 112, KR_REAL = 128;
constexpr float EPS = 1e-6f, LOG2E = 1.4426950408889634f, QSCALE = 0.125f * 1.4426950408889634f;

__device__ __forceinline__ unsigned cvt_pk_bf16(float lo, float hi) { unsigned r; asm volatile("v_cvt_pk_bf16_f32 %0, %1, %2" : "=v"(r) : "v"(lo), "v"(hi)); return r; }
__device__ __forceinline__ void st16_wt(void* p, u32x4 v) { asm volatile("global_store_dwordx4 %0, %1, off sc1\n\ts_nop 1" :: "v"(p), "v"(v) : "memory"); }
__device__ __forceinline__ float bf_lo(unsigned w) { return __uint_as_float(w << 16); }
__device__ __forceinline__ float bf_hi(unsigned w) { return __uint_as_float(w & 0xffff0000u); }

namespace pg8 {
#define PG8_LAS __attribute__((address_space(3)))
constexpr int BM = 256, BK = 64, HALF = 128, HTB = HALF * BK * 2  , STAGE_BYTES = 8 * HTB, NXCD = 8, WGM = 8;

__host__ __device__ __forceinline__ int lds_byte(int r, int c) { const int st = (r >> 4) * 2 + (c >> 5), rr = r & 15, cc = c & 31, ob = rr * 64 + cc * 2; return st * 1024 + (ob ^ (((ob >> 9) & 1) << 5)); }
__host__ __device__ __forceinline__ void stage_rc(int b, int& R, int& C) { const int st = b / 1024, sb = b % 1024, swz = sb ^ (((sb >> 9) & 1) << 5); R = (st >> 1) * 16 + swz / 64; C = (st & 1) * 32 + (swz % 64) / 2; }
__host__ __device__ __forceinline__ int perm32(int rho) { const int n = rho >> 4, i = rho & 15; return 8 * (i >> 2) + 4 * n + (i & 3); }

struct Unit { int pm, pn, koff, br; };
struct Gemm { const bf16_t* A; const bf16_t* Bt; int lda, ldb, K; };

struct StaticOrder {
    int nM, nN, nwg, G, c;
    __host__ __device__ void init(int M, int N, int G_, int c_) { nM = M / BM; nN = N / BM; nwg = nM * nN; G = G_; c = c_; }
    __host__ __device__ bool next(int i, Unit& u) const {
        const long L = (long)i * G + c; if (L >= nwg) return false;
        int wgid = (int)L; { const int q = nwg / NXCD, r = nwg % NXCD, xcd = wgid % NXCD, off = wgid / NXCD; wgid = (xcd < r ? xcd * (q + 1) : r * (q + 1) + (xcd - r) * q) + off; }
        const int nig = WGM * nN, gid = wgid / nig, fm = gid * WGM, gsz = (nM - fm) < WGM ? (nM - fm) : WGM;
        u.pm = fm + ((wgid % nig) % gsz); u.pn = (wgid % nig) / gsz; u.koff = 0; u.br = 0; return true;
    }
    __device__ __forceinline__ void a_ready(const Unit&) const {}
    __device__ __forceinline__ void done(const Unit&) const {}
};
struct DualOrder {
    StaticOrder S;
    __host__ __device__ bool next(int i, Unit& u) const { if (!S.next(i >> 1, u)) return false; u.br = i & 1; u.koff = 512 * (i & 1); return true; }
    __device__ __forceinline__ void a_ready(const Unit&) const {}
    __device__ __forceinline__ void done(const Unit&) const {}
};

__device__ __forceinline__ float row_rs(const float* ssq, int row, int fq) {
    const f32x4 p = *(const f32x4*)(ssq + (size_t)row * 16 + 4 * fq);
    float s = (p[0] + p[1]) + (p[2] + p[3]);
    s += __shfl_xor(s, 16); s += __shfl_xor(s, 32);
    return __builtin_amdgcn_rsqf(s * (1.0f / 1024.0f) + EPS);
}
typedef float f32x2 __attribute__((ext_vector_type(2)));
__device__ __forceinline__ void row_rs8(const float* ssq, int row0, int fq, float (&rs)[8]) {
    f32x4 p[8];
#pragma unroll
    for (int i = 0; i < 8; ++i) p[i] = *(const f32x4*)(ssq + (size_t)(row0 + (i >> 2) * HALF + (i & 3) * 16) * 16 + 4 * fq);
#pragma unroll
    for (int i = 0; i < 8; ++i) { float s = (p[i][0] + p[i][1]) + (p[i][2] + p[i][3]); s += __shfl_xor(s, 16); s += __shfl_xor(s, 32); rs[i] = __builtin_amdgcn_rsqf(s * (1.0f / 1024.0f) + EPS); }
}
__device__ __forceinline__ float fast_sigmoid(float x) { return __builtin_amdgcn_rcpf(1.0f + __builtin_amdgcn_exp2f(-x * LOG2E)); }
__device__ __forceinline__ u32x4 pack8(const f32x4 a, const f32x4 b) { u32x4 w; w.x = cvt_pk_bf16(a[0], a[1]); w.y = cvt_pk_bf16(a[2], a[3]); w.z = cvt_pk_bf16(b[0], b[1]); w.w = cvt_pk_bf16(b[2], b[3]); return w; }

__device__ __forceinline__ void pf_tile(const void* base, int esz, const Unit& u, int part, int nparts, int tid, float& junk) {
    const int lpr = esz * 2, per = 256 * lpr / nparts, L = part * per + tid;
    if (tid < per) { const char* p = (const char*)base + ((size_t)(u.pm * BM + L / lpr) * DM + (size_t)u.pn * BM) * esz + (L % lpr) * 128;
        asm volatile("global_load_dword %0, %1, off" : "+v"(junk) : "v"(p) : "memory"); }
}
__device__ __forceinline__ void row_rs8_cached(const float* ssq, int pm, int row0, int fr, int fq, PG8_LAS float* rc, float (&rs)[8]) {
    const int wid = __builtin_amdgcn_readfirstlane((int)threadIdx.x >> 6);
    PG8_LAS float* mine = rc + wid * 128; PG8_LAS int* tag = (PG8_LAS int*)(rc + 1024) + wid;
    const int have = __builtin_amdgcn_readfirstlane(*tag);
    if (have != pm + 1) {
        row_rs8(ssq, row0, fq, rs);
        if (fq == 0) { *(PG8_LAS f32x4*)(mine + fr * 8) = (f32x4){rs[0], rs[1], rs[2], rs[3]}; *(PG8_LAS f32x4*)(mine + fr * 8 + 4) = (f32x4){rs[4], rs[5], rs[6], rs[7]}; }
        if ((threadIdx.x & 63) == 0) *tag = pm + 1;
    } else {
        const f32x4 a = *(const PG8_LAS f32x4*)(mine + fr * 8), b = *(const PG8_LAS f32x4*)(mine + fr * 8 + 4);
        rs[0] = a[0]; rs[1] = a[1]; rs[2] = a[2]; rs[3] = a[3]; rs[4] = b[0]; rs[5] = b[1]; rs[6] = b[2]; rs[7] = b[3];
    }
}
struct EpiSwiGLU {
    static constexpr bool PERM = true, AFTER_DRAIN = false, MID = false, PF = false;
    bf16_t* O; const float* ssq; PG8_LAS float* rsc;
    __device__ __forceinline__ int issued(const Unit&, int) const { return 8; }
    __device__ __forceinline__ void operator()(const f32x4 (&acc)[2][2][4][2], const Unit& u, int wr, int wc, int fr, int fq) const {
        const int row0 = u.pm * BM + wr * 64 + fr, col0 = u.pn * HALF + wc * 32 + 8 * fq;
        float rsv[8]; row_rs8_cached(ssq, u.pm, row0, fr, fq, rsc, rsv);
#pragma unroll
        for (int ai = 0; ai < 2; ++ai)
#pragma unroll
            for (int m = 0; m < 4; ++m) {
                const int row = row0 + ai * HALF + m * 16; const float rs = rsv[ai * 4 + m];
                f32x4 o[2]; const float c1 = -LOG2E * rs, rs2 = rs * rs;
#pragma unroll
                for (int n = 0; n < 2; ++n)
#pragma unroll
                    for (int e = 0; e < 4; e += 2) {
                        const f32x2 g = (f32x2){acc[ai][0][m][n][e], acc[ai][0][m][n][e + 1]}, uu = (f32x2){acc[ai][1][m][n][e], acc[ai][1][m][n][e + 1]};
                        const f32x2 t = g * c1; f32x2 d; d.x = __builtin_amdgcn_exp2f(t.x); d.y = __builtin_amdgcn_exp2f(t.y); d = d + 1.0f;
                        f32x2 r; r.x = __builtin_amdgcn_rcpf(d.x); r.y = __builtin_amdgcn_rcpf(d.y);
                        const f32x2 w = (g * uu) * (r * rs2); o[n][e] = w.x; o[n][e + 1] = w.y;
                    }
                *(u32x4*)(O + (size_t)row * DFF + col0) = pack8(o[0], o[1]);
            }
    }
};
template <bool BASE_F32> struct EpiResB {
    static constexpr bool PERM = true, AFTER_DRAIN = false, MID = false, PF = false;
    const void* base; bf16_t* xb; float* ssq; float scale;
    __device__ __forceinline__ int issued(const Unit&, int) const { return 16; }
    __device__ __forceinline__ void prefetch(const Unit& u, int t, int nt, int tid, float& junk) const { const int q = t - (nt - 8); if (q >= 0) pf_tile(base, BASE_F32 ? 4 : 2, u, q >> 1, 4, tid, junk); }
    __device__ __forceinline__ void operator()(const f32x4 (&acc)[2][2][4][2], const Unit& u, int wr, int wc, int fr, int fq) const {
        const int row0 = u.pm * BM + wr * 64 + fr, col0 = u.pn * BM + wc * 32 + 8 * fq;
        u32x4 wv[2][4][2];
        if (!BASE_F32) {
#pragma unroll
            for (int ai = 0; ai < 2; ++ai)
#pragma unroll
                for (int m = 0; m < 4; ++m)
#pragma unroll
                    for (int bj = 0; bj < 2; ++bj) wv[ai][m][bj] = *(const u32x4*)((const bf16_t*)base + (size_t)(row0 + ai * HALF + m * 16) * DM + col0 + bj * HALF);
        }
#pragma unroll
        for (int ai = 0; ai < 2; ++ai) {
            f32x4 fv[4][2][2];
            if (BASE_F32) {
#pragma unroll
                for (int m = 0; m < 4; ++m)
#pragma unroll
                    for (int bj = 0; bj < 2; ++bj) { const float* bp = (const float*)base + (size_t)(row0 + ai * HALF + m * 16) * DM + col0 + bj * HALF; fv[m][bj][0] = *(const f32x4*)bp; fv[m][bj][1] = *(const f32x4*)(bp + 4); }
            }
#pragma unroll
            for (int m = 0; m < 4; ++m) {
                const int row = row0 + ai * HALF + m * 16; const size_t off = (size_t)row * DM + col0; float sq = 0.f;
#pragma unroll
                for (int bj = 0; bj < 2; ++bj) {
                    const size_t c = off + bj * HALF; f32x4 b0, b1;
                    if (BASE_F32) { b0 = fv[m][bj][0]; b1 = fv[m][bj][1]; }
                    else { const u32x4 w = wv[ai][m][bj]; b0 = (f32x4){bf_lo(w.x), bf_hi(w.x), bf_lo(w.y), bf_hi(w.y)}; b1 = (f32x4){bf_lo(w.z), bf_hi(w.z), bf_lo(w.w), bf_hi(w.w)}; }
                    const f32x4 v0 = b0 + acc[ai][bj][m][0] * scale, v1 = b1 + acc[ai][bj][m][1] * scale;
                    *(u32x4*)(xb + c) = pack8(v0, v1);
                    sq += (v0[0] * v0[0] + v0[1] * v0[1]) + (v0[2] * v0[2] + v0[3] * v0[3]) + (v1[0] * v1[0] + v1[1] * v1[1]) + (v1[2] * v1[2] + v1[3] * v1[3]);
                }
                sq += __shfl_xor(sq, 16); sq += __shfl_xor(sq, 32);
                if (fq == 0) ssq[(size_t)row * 16 + u.pn * 4 + wc] = sq;
            }
            if (BASE_F32) asm volatile("" ::: "memory");
        }
    }
};
struct EpiFinal {
    static constexpr bool PERM = true, AFTER_DRAIN = false, MID = false, PF = false;
    const bf16_t* base; float* out; const float* gf; float* part; unsigned* cnt; float scale;
    __device__ __forceinline__ int issued(const Unit&, int) const { return 16; }
    __device__ __forceinline__ void prefetch(const Unit& u, int t, int nt, int tid, float& junk) const { const int q = t - (nt - 8); if (q >= 0) pf_tile(base, 2, u, q >> 1, 4, tid, junk); }
    __device__ __forceinline__ void operator()(f32x4 (&acc)[2][2][4][2], const Unit& u, int wr, int wc, int fr, int fq) const {
        const int row0 = u.pm * BM + wr * 64 + fr, col0 = u.pn * BM + wc * 32 + 8 * fq;
        u32x4 wv[2][4][2];
#pragma unroll
        for (int ai = 0; ai < 2; ++ai)
#pragma unroll
            for (int m = 0; m < 4; ++m)
#pragma unroll
                for (int bj = 0; bj < 2; ++bj) wv[ai][m][bj] = *(const u32x4*)(base + (size_t)(row0 + ai * HALF + m * 16) * DM + col0 + bj * HALF);
#pragma unroll
        for (int ai = 0; ai < 2; ++ai)
#pragma unroll
            for (int m = 0; m < 4; ++m) {
                const int row = row0 + ai * HALF + m * 16; float sq = 0.f;
#pragma unroll
                for (int bj = 0; bj < 2; ++bj) {
                    const u32x4 w = wv[ai][m][bj];
                    const f32x4 b0 = (f32x4){bf_lo(w.x), bf_hi(w.x), bf_lo(w.y), bf_hi(w.y)}, b1 = (f32x4){bf_lo(w.z), bf_hi(w.z), bf_lo(w.w), bf_hi(w.w)};
                    const f32x4 v0 = b0 + acc[ai][bj][m][0] * scale, v1 = b1 + acc[ai][bj][m][1] * scale;
                    acc[ai][bj][m][0] = v0; acc[ai][bj][m][1] = v1;
                    sq += (v0[0] * v0[0] + v0[1] * v0[1]) + (v0[2] * v0[2] + v0[3] * v0[3]) + (v1[0] * v1[0] + v1[1] * v1[1]) + (v1[2] * v1[2] + v1[3] * v1[3]);
                }
                sq += __shfl_xor(sq, 16); sq += __shfl_xor(sq, 32);
                if (fq == 0) __hip_atomic_store(part + (size_t)row * 16 + u.pn * 4 + wc, sq, __ATOMIC_RELAXED, __HIP_MEMORY_SCOPE_AGENT);
            }
        asm volatile("s_waitcnt vmcnt(0)" ::: "memory");
        unsigned* pc = cnt + 64 * u.pm;
        if ((threadIdx.x & 63) == 0) __hip_atomic_fetch_add(pc, 1u, __ATOMIC_RELAXED, __HIP_MEMORY_SCOPE_AGENT);
        for (unsigned spins = 0; spins < (1u << 22); ++spins) {
            if ((unsigned)__builtin_amdgcn_readfirstlane(__hip_atomic_load(pc, __ATOMIC_RELAXED, __HIP_MEMORY_SCOPE_AGENT)) >= 32u) break;
            __builtin_amdgcn_s_sleep(2);
        }
        asm volatile("" ::: "memory");
        const int gc0 = u.pn * BM + wc * 32 + 8 * fq;
        unsigned long long qq[8][2];
#pragma unroll
        for (int i = 0; i < 8; ++i) { const unsigned long long* pp = (const unsigned long long*)(part + (size_t)(row0 + (i >> 2) * HALF + (i & 3) * 16) * 16 + 4 * fq);
            qq[i][0] = __hip_atomic_load(pp, __ATOMIC_RELAXED, __HIP_MEMORY_SCOPE_AGENT); qq[i][1] = __hip_atomic_load(pp + 1, __ATOMIC_RELAXED, __HIP_MEMORY_SCOPE_AGENT); }
#pragma unroll
        for (int ai = 0; ai < 2; ++ai)
#pragma unroll
            for (int m = 0; m < 4; ++m) {
                const int row = row0 + ai * HALF + m * 16; const size_t off = (size_t)row * DM + col0;
                const unsigned long long q0 = qq[ai * 4 + m][0], q1 = qq[ai * 4 + m][1];
                float s = (__uint_as_float((unsigned)q0) + __uint_as_float((unsigned)(q0 >> 32))) + (__uint_as_float((unsigned)q1) + __uint_as_float((unsigned)(q1 >> 32)));
                s += __shfl_xor(s, 16); s += __shfl_xor(s, 32);
                const float rs = 1.0f / sqrtf(s * (1.0f / 1024.0f) + EPS);
#pragma unroll
                for (int bj = 0; bj < 2; ++bj) {
                    const f32x4 g0 = *(const f32x4*)(gf + gc0 + bj * HALF), g1 = *(const f32x4*)(gf + gc0 + bj * HALF + 4);
                    *(f32x4*)(out + off + bj * HALF) = acc[ai][bj][m][0] * rs * g0; *(f32x4*)(out + off + bj * HALF + 4) = acc[ai][bj][m][1] * rs * g1;
                }
            }
    }
};
struct EpiProj {
    static constexpr bool PERM = true, AFTER_DRAIN = false, MID = false, PF = false;
    const float* ssq; bf16_t *QO, *KA, *VA, *KB, *VB, *RAB, *SGB; float* LOGF; const float* bfg; float *QN2, *KN2; PG8_LAS float* rsc;
    __device__ __forceinline__ int issued(const Unit& u, int wc) const { return u.pn == 17 ? (wc == 0 ? 16 : 0) : 16; }
    __device__ __forceinline__ void operator()(const f32x4 (&acc)[2][2][4][2], const Unit& u, int wr, int wc, int fr, int fq) const {
        const int pn = u.pn, row0 = u.pm * BM + wr * 64 + fr, kadd = KR_REAL * (u.pm / 8 + 1);
        float rsv[8]; row_rs8_cached(ssq, u.pm, row0, fr, fq, rsc, rsv);
        if (pn == 17) {
            f32x4 bb0 = *(const f32x4*)(bfg), bb1 = *(const f32x4*)(bfg + 4);
#pragma unroll
            for (int ai = 0; ai < 2; ++ai)
#pragma unroll
                for (int m = 0; m < 4; ++m) {
                    const int row = row0 + ai * HALF + m * 16; const float rs = rsv[ai * 4 + m];
                    if (wc == 0 && fq == 0) {
                        f32x4 lf[2];
#pragma unroll
                        for (int n = 0; n < 2; ++n)
#pragma unroll
                            for (int e = 0; e < 4; ++e) { const float x = acc[ai][0][m][n][e] * rs + (n ? bb1[e] : bb0[e]); lf[n][e] = fminf(x, 0.f) - log1pf(expf(-fabsf(x))); }
                        float* d = LOGF + (size_t)(row + kadd) * 8; *(f32x4*)d = lf[0]; *(f32x4*)(d + 4) = lf[1];
                    }
                }
            return;
        }
        if (pn >= 9) {
            const int cg = (pn - 9) * HALF + wc * 32 + 8 * fq;
#pragma unroll
            for (int ai = 0; ai < 2; ++ai)
#pragma unroll
                for (int m = 0; m < 4; ++m) {
                    const int row = row0 + ai * HALF + m * 16; const float rs = rsv[ai * 4 + m]; f32x4 r[2], sb[2];
                    const float c1 = -LOG2E * rs;
#pragma unroll
                    for (int n = 0; n < 2; ++n)
#pragma unroll
                        for (int e = 0; e < 4; e += 2) {
                            f32x2 ta = (f32x2){acc[ai][0][m][n][e], acc[ai][0][m][n][e + 1]} * c1, tb = (f32x2){acc[ai][1][m][n][e], acc[ai][1][m][n][e + 1]} * c1;
                            ta.x = __builtin_amdgcn_fmed3f(ta.x, -115.4f, 115.4f); ta.y = __builtin_amdgcn_fmed3f(ta.y, -115.4f, 115.4f); tb.x = __builtin_amdgcn_fmed3f(tb.x, -115.4f, 115.4f); tb.y = __builtin_amdgcn_fmed3f(tb.y, -115.4f, 115.4f);
                            f32x2 da, db; da.x = __builtin_amdgcn_exp2f(ta.x); da.y = __builtin_amdgcn_exp2f(ta.y); db.x = __builtin_amdgcn_exp2f(tb.x); db.y = __builtin_amdgcn_exp2f(tb.y);
                            da = da + 1.0f; db = db + 1.0f;
                            f32x2 ra, rb; ra.x = __builtin_amdgcn_rcpf(da.x); ra.y = __builtin_amdgcn_rcpf(da.y); rb.x = __builtin_amdgcn_rcpf(db.x); rb.y = __builtin_amdgcn_rcpf(db.y);
                            const f32x2 q = db * ra; r[n][e] = q.x; r[n][e + 1] = q.y; sb[n][e] = rb.x; sb[n][e + 1] = rb.y;
                        }
                    *(u32x4*)(RAB + (size_t)row * DM + cg) = pack8(r[0], r[1]); *(u32x4*)(SGB + (size_t)row * DM + cg) = pack8(sb[0], sb[1]);
                }
            return;
        }
        bf16_t* d0; bf16_t* d1; int pitch, radd = 0; float mul = 1.f;
        if (pn < 2)       { d0 = QO + pn * 256; d1 = d0 + HALF; pitch = DM; mul = QSCALE; }
        else if (pn == 2) { d0 = KA; d1 = VA; pitch = 128; radd = kadd; }
        else if (pn < 5)  { d0 = QO + 512 + (pn - 3) * 256; d1 = d0 + HALF; pitch = DM; mul = QSCALE; }
        else if (pn < 7)  { d0 = KB + (pn - 5) * 256; d1 = d0 + HALF; pitch = 512; radd = kadd; }
        else              { d0 = VB + (pn - 7) * 256; d1 = d0 + HALF; pitch = 512; radd = kadd; }
        const int cw = wc * 32 + 8 * fq;
#pragma unroll
        for (int ai = 0; ai < 2; ++ai)
#pragma unroll
            for (int m = 0; m < 4; ++m) {
                const int row = row0 + ai * HALF + m * 16; const float rs = rsv[ai * 4 + m] * mul; const size_t ro = (size_t)(row + radd) * pitch + cw;
#pragma unroll
                for (int bj = 0; bj < 2; ++bj) {
                    const f32x4 v0 = acc[ai][bj][m][0] * rs, v1 = acc[ai][bj][m][1] * rs;
                    *(u32x4*)((bj ? d1 : d0) + ro) = pack8(v0, v1);
                    if (pn >= 3 && pn < 7) {
                        float s2 = (v0[0] * v0[0] + v0[1] * v0[1]) + (v0[2] * v0[2] + v0[3] * v0[3]) + (v1[0] * v1[0] + v1[1] * v1[1]) + (v1[2] * v1[2] + v1[3] * v1[3]);
                        s2 += __shfl_xor(s2, 16); s2 += __shfl_xor(s2, 32);
                        if (fq == 0) ((pn < 5 ? QN2 : KN2) + (size_t)(row + radd) * 16)[2 * (4 * ((pn - 3) & 1) + 2 * bj + (wc >> 1)) + (wc & 1)] = s2;
                    }
                }
            }
    }
};
struct EpiMix {
    static constexpr bool PERM = true, AFTER_DRAIN = false, MID = true, PF = false;
    const bf16_t *RAB, *SGB; bf16_t* MIX;
    __device__ __forceinline__ int issued(const Unit&, int) const { return 16; }
    __device__ __forceinline__ void prefetch(const Unit& u, int t, int nt, int tid, float& junk) const { const int h = nt >> 1; if (t < h) pf_tile(RAB, 2, u, t >> 1, h >> 1, tid, junk); else pf_tile(SGB, 2, u, (t - h) >> 1, h >> 1, tid, junk); }
    __device__ __forceinline__ void mid(f32x4 (&acc)[2][2][4][2], const Unit& u, int wr, int wc, int fr, int fq) const {
        int row0 = u.pm * BM + wr * 64 + fr; const int col0 = u.pn * BM + wc * 32 + 8 * fq;
        asm volatile("" : "+v"(row0));
        u32x4 gv[2][4][2];
#pragma unroll
        for (int ai = 0; ai < 2; ++ai)
#pragma unroll
            for (int m = 0; m < 4; ++m)
#pragma unroll
                for (int bj = 0; bj < 2; ++bj) gv[ai][m][bj] = *(const u32x4*)(RAB + (size_t)(row0 + ai * HALF + m * 16) * DM + col0 + bj * HALF);
#pragma unroll
        for (int ai = 0; ai < 2; ++ai)
#pragma unroll
            for (int m = 0; m < 4; ++m) {
#pragma unroll
                for (int bj = 0; bj < 2; ++bj) {
                    const u32x4 gw = gv[ai][m][bj];
                    acc[ai][bj][m][0] *= (f32x4){bf_lo(gw.x), bf_hi(gw.x), bf_lo(gw.y), bf_hi(gw.y)}; acc[ai][bj][m][1] *= (f32x4){bf_lo(gw.z), bf_hi(gw.z), bf_lo(gw.w), bf_hi(gw.w)};
                }
            }
    }
    __device__ __forceinline__ void operator()(const f32x4 (&acc)[2][2][4][2], const Unit& u, int wr, int wc, int fr, int fq) const {
        int row0 = u.pm * BM + wr * 64 + fr; const int col0 = u.pn * BM + wc * 32 + 8 * fq;
        asm volatile("" : "+v"(row0));
        u32x4 gv[2][4][2];
#pragma unroll
        for (int ai = 0; ai < 2; ++ai)
#pragma unroll
            for (int m = 0; m < 4; ++m)
#pragma unroll
                for (int bj = 0; bj < 2; ++bj) gv[ai][m][bj] = *(const u32x4*)(SGB + (size_t)(row0 + ai * HALF + m * 16) * DM + col0 + bj * HALF);
#pragma unroll
        for (int ai = 0; ai < 2; ++ai)
#pragma unroll
            for (int m = 0; m < 4; ++m) {
                const int row = row0 + ai * HALF + m * 16;
#pragma unroll
                for (int bj = 0; bj < 2; ++bj) {
                    const size_t c = (size_t)row * DM + col0 + bj * HALF;
                    const u32x4 gw = gv[ai][m][bj];
                    const f32x4 v0 = acc[ai][bj][m][0] * (f32x4){bf_lo(gw.x), bf_hi(gw.x), bf_lo(gw.y), bf_hi(gw.y)}, v1 = acc[ai][bj][m][1] * (f32x4){bf_lo(gw.z), bf_hi(gw.z), bf_lo(gw.w), bf_hi(gw.w)};
                    *(u32x4*)(MIX + c) = pack8(v0, v1);
                }
            }
    }
};
struct EpiNull {
    static constexpr bool PERM = true, AFTER_DRAIN = false, MID = false, PF = false;
    __device__ __forceinline__ int issued(const Unit&, int) const { return 0; }
    __device__ __forceinline__ void operator()(const f32x4 (&acc)[2][2][4][2], const Unit& u, int wr, int wc, int fr, int fq) const {
#pragma unroll
        for (int ai = 0; ai < 2; ++ai)
#pragma unroll
            for (int bj = 0; bj < 2; ++bj)
#pragma unroll
                for (int m = 0; m < 4; ++m)
#pragma unroll
                    for (int n = 0; n < 2; ++n) asm volatile("" :: "v"(acc[ai][bj][m][n]));
    }
};

template <int MODE> struct EpiProjX {
    static constexpr bool PERM = true, AFTER_DRAIN = false, MID = false, PF = false;
    const float* ssq; bf16_t* D;
    __device__ __forceinline__ int issued(const Unit&, int) const { return 0; }
    __device__ __forceinline__ void operator()(const f32x4 (&acc)[2][2][4][2], const Unit& u, int wr, int wc, int fr, int fq) const {
        int row0 = u.pm * BM + wr * 64 + fr; const int cw = (u.pn % 4) * 256 + wc * 32 + 8 * fq;
        asm volatile("" : "+v"(row0));
#pragma unroll
        for (int ai = 0; ai < 2; ++ai)
#pragma unroll
            for (int m = 0; m < 4; ++m) {
                const int row = row0 + ai * HALF + m * 16;
                if (MODE == 0) {
                    const float rs = row_rs(ssq, row, fq); f32x4 r[2], sb[2];
#pragma unroll
                    for (int n = 0; n < 2; ++n)
#pragma unroll
                        for (int e = 0; e < 4; ++e) {
                            const float ga = __builtin_amdgcn_fmed3f(acc[ai][0][m][n][e] * rs, -80.f, 80.f), gb = __builtin_amdgcn_fmed3f(acc[ai][1][m][n][e] * rs, -80.f, 80.f);
                            const float ea = __builtin_amdgcn_exp2f(-ga * LOG2E), eb = __builtin_amdgcn_exp2f(-gb * LOG2E);
                            r[n][e] = (1.0f + eb) * __builtin_amdgcn_rcpf(1.0f + ea); sb[n][e] = __builtin_amdgcn_rcpf(1.0f + eb);
                        }
                    u32x4 a = pack8(r[0], r[1]), b = pack8(sb[0], sb[1]); asm volatile("" :: "v"(a), "v"(b));
                } else if (MODE == 1) {
#pragma unroll
                    for (int bj = 0; bj < 2; ++bj) *(u32x4*)(D + (size_t)row * DM + cw + bj * HALF) = pack8(acc[ai][bj][m][0], acc[ai][bj][m][1]);
                } else {
                    const int lrow = (int)blockIdx.x * BM + (row & 255); const int cw2 = wc * 32 + 8 * fq;
#pragma unroll
                    for (int bj = 0; bj < 2; ++bj) *(u32x4*)(D + (size_t)lrow * DM + cw2 + bj * HALF) = pack8(acc[ai][bj][m][0], acc[ai][bj][m][1]);
                }
            }
    }
};
template <class Epi, class Sched, bool ALIGN_EPI = false, bool SP2 = false>
__device__ __forceinline__ void gemm_phase(PG8_LAS unsigned char* lds, const Gemm g, const Sched& S, const Epi& E) {
    const int tid = threadIdx.x, wid = __builtin_amdgcn_readfirstlane(tid >> 6), lane = tid & 63, wr = wid >> 2, wc = wid & 3, fr = lane & 15, fq = lane >> 4;
    const int K = g.K, nt = K / BK;
    unsigned voffA[2], voffB[2];
#pragma unroll
    for (int i = 0; i < 2; ++i) { int R, C; stage_rc(tid * 16 + i * 8192, R, C); const int Rb = Epi::PERM ? ((R & ~31) + perm32(R & 31)) : R;
        voffA[i] = (unsigned)(R * g.lda + C) * 2u; voffB[i] = (unsigned)(Rb * g.ldb + C) * 2u; }
    const size_t kstep = (size_t)(BK * 2);
    const size_t hstepA = (size_t)HALF * g.lda * 2, hstepB = (size_t)HALF * g.ldb * 2;
    const size_t tstepA = 2 * hstepA, tstepB = 2 * hstepB;
    const unsigned ldsw = (unsigned)wid * 1024u;
    const int aoff = lds_byte(wr * 64 + fr, fq * 8), boff = lds_byte(wc * 32 + fr, fq * 8);
#define PG8_SA(b, h) (((b) * 2 + (h)) * HTB)
#define PG8_SB(b, h) ((4 + (b) * 2 + (h)) * HTB)
#define PG8_STAGE(bufoff, gbase, voff) do { _Pragma("unroll") for (int _i = 0; _i < 2; ++_i) \
        __builtin_amdgcn_global_load_lds((const unsigned*)((const char*)(gbase) + (voff)[_i]), (PG8_LAS unsigned*)(lds + (bufoff) + ldsw + _i * 8192), 16, 0, 0); } while (0)
#define PG8_LDA(dst, b, h) do { _Pragma("unroll") for (int m = 0; m < 4; ++m) _Pragma("unroll") for (int k = 0; k < 2; ++k) dst[m][k] = *(const PG8_LAS bf16x8*)(lds + PG8_SA(b, h) + aoff + m * 2048 + k * 1024); } while (0)
#define PG8_LDB(dst, b, h) do { _Pragma("unroll") for (int n = 0; n < 2; ++n) _Pragma("unroll") for (int k = 0; k < 2; ++k) dst[n][k] = *(const PG8_LAS bf16x8*)(lds + PG8_SB(b, h) + boff + n * 2048 + k * 1024); } while (0)
#define PG8_MMA(ai, bj, At, Bt) do { __builtin_amdgcn_s_setprio(1); _Pragma("unroll") for (int m = 0; m < 4; ++m) _Pragma("unroll") for (int n = 0; n < 2; ++n) _Pragma("unroll") for (int k = 0; k < 2; ++k) \
        acc[ai][bj][m][n] = __builtin_amdgcn_mfma_f32_16x16x32_bf16(Bt[n][k], At[m][k], acc[ai][bj][m][n], 0, 0, 0); __builtin_amdgcn_s_setprio(0); } while (0)
#define PG8_WAIT_V(n) asm volatile("s_waitcnt vmcnt(" #n ")" ::: "memory")
#define PG8_WAIT_L(n) asm volatile("s_waitcnt lgkmcnt(" #n ")" ::: "memory")
#define PG8_WAIT_VX(xs_) asm volatile("s_waitcnt vmcnt(24)\n\ts_cmp_ge_u32 %0, 16\n\ts_cbranch_scc1 1f\n\ts_waitcnt vmcnt(16)\n\ts_cmp_ge_u32 %0, 8\n\ts_cbranch_scc1 1f\n\ts_waitcnt vmcnt(8)\n1:" :: "s"(xs_) : "memory", "scc")
#define PG8_BAR __builtin_amdgcn_s_barrier()
#define PG8_SCHED __builtin_amdgcn_sched_barrier(0)
    Unit cur, nxt; int ui = 0; int xs = 0;
    if (!S.next(0, cur)) return;
    f32x4 acc[2][2][4][2];
#pragma unroll
    for (int a = 0; a < 2; ++a)
#pragma unroll
        for (int b = 0; b < 2; ++b)
#pragma unroll
            for (int m = 0; m < 4; ++m)
#pragma unroll
                for (int n = 0; n < 2; ++n) acc[a][b][m][n] = (f32x4){0.f, 0.f, 0.f, 0.f};
    bf16x8 At[4][2], B0[2][2], B1[2][2];
    const char* cA = (const char*)g.A + (size_t)cur.pm * tstepA + (size_t)cur.koff * 2; const char* cB = (const char*)g.Bt + (size_t)cur.pn * tstepB + (size_t)cur.koff * 2;
    S.a_ready(cur);
    if constexpr (SP2) {
        PG8_STAGE(PG8_SB(0, 0), cB, voffB); PG8_STAGE(PG8_SB(0, 1), cB + hstepB, voffB); PG8_STAGE(PG8_SA(0, 0), cA, voffA); PG8_STAGE(PG8_SA(0, 1), cA + hstepA, voffA);
        if (wr == 1) PG8_BAR;
        PG8_WAIT_V(2); PG8_BAR;
        PG8_STAGE(PG8_SB(1, 0), cB + kstep, voffB); PG8_STAGE(PG8_SA(1, 0), cA + kstep, voffA); PG8_STAGE(PG8_SB(1, 1), cB + hstepB + kstep, voffB);
        PG8_WAIT_V(6); PG8_BAR;
    } else {
        PG8_STAGE(PG8_SB(0, 0), cB, voffB); PG8_STAGE(PG8_SA(0, 0), cA, voffA); PG8_STAGE(PG8_SB(0, 1), cB + hstepB, voffB); PG8_STAGE(PG8_SA(0, 1), cA + hstepA, voffA);
        if (wr == 1) PG8_BAR;
        PG8_WAIT_V(4); PG8_BAR;
        PG8_STAGE(PG8_SB(1, 0), cB + kstep, voffB); PG8_STAGE(PG8_SA(1, 0), cA + kstep, voffA); PG8_STAGE(PG8_SB(1, 1), cB + hstepB + kstep, voffB);
        PG8_WAIT_V(6); PG8_BAR;
    }
    for (;;) {
        const bool has_next = S.next(ui + 1, nxt);
        const char* nA = has_next ? (const char*)g.A + (size_t)nxt.pm * tstepA + (size_t)nxt.koff * 2 : cA; const char* nB = has_next ? (const char*)g.Bt + (size_t)nxt.pn * tstepB + (size_t)nxt.koff * 2 : cB;
        for (int t = 0; t < nt; t += 2) {
            const bool last = (t == nt - 2);
            if constexpr (Epi::MID) { if (t == (nt >> 1)) E.mid(acc, cur, wr, wc, fr, fq); }
            const char* a1 = cA + (size_t)(t + 1) * kstep;
            const char* a2 = last ? nA : cA + (size_t)(t + 2) * kstep; const char* b2 = last ? nB : cB + (size_t)(t + 2) * kstep;
            const char* a3 = a2 + kstep; const char* b3 = b2 + kstep;
            if (last && has_next) S.a_ready(nxt);
            if constexpr (SP2) {
            PG8_LDB(B0, 0, 0); PG8_LDB(B1, 0, 1); PG8_SCHED; PG8_LDA(At, 0, 0); PG8_STAGE(PG8_SA(1, 1), a1 + hstepA, voffA);
            PG8_WAIT_VX(xs); PG8_WAIT_L(0); PG8_BAR; PG8_MMA(0, 0, At, B0); PG8_MMA(0, 1, At, B1); PG8_BAR; PG8_SCHED;
            PG8_LDA(At, 0, 1); PG8_STAGE(PG8_SB(0, 0), b2, voffB); PG8_STAGE(PG8_SB(0, 1), b2 + hstepB, voffB); PG8_STAGE(PG8_SA(0, 0), a2, voffA);
            PG8_WAIT_VX(xs); asm volatile("s_mov_b32 %0, 0" : "=s"(xs)); PG8_WAIT_L(0); PG8_BAR; PG8_MMA(1, 0, At, B0); PG8_MMA(1, 1, At, B1); PG8_BAR; PG8_SCHED;
            PG8_LDB(B0, 1, 0); PG8_LDB(B1, 1, 1); PG8_SCHED; PG8_LDA(At, 1, 0); PG8_STAGE(PG8_SA(0, 1), a2 + hstepA, voffA);
            PG8_WAIT_V(8); PG8_WAIT_L(0); PG8_BAR; PG8_MMA(0, 0, At, B0); PG8_MMA(0, 1, At, B1); PG8_BAR; PG8_SCHED;
            PG8_LDA(At, 1, 1); PG8_STAGE(PG8_SB(1, 0), b3, voffB); PG8_STAGE(PG8_SB(1, 1), b3 + hstepB, voffB); PG8_STAGE(PG8_SA(1, 0), a3, voffA);
            PG8_WAIT_V(8); PG8_WAIT_L(0); PG8_BAR; PG8_MMA(1, 0, At, B0); PG8_MMA(1, 1, At, B1); PG8_BAR; PG8_SCHED;
            } else {
            PG8_LDB(B0, 0, 0); PG8_SCHED; PG8_LDA(At, 0, 0); PG8_STAGE(PG8_SA(1, 1), a1 + hstepA, voffA);
            PG8_WAIT_L(8); PG8_BAR; PG8_WAIT_L(0); PG8_MMA(0, 0, At, B0); PG8_BAR; PG8_SCHED;
            PG8_LDB(B1, 0, 1); PG8_STAGE(PG8_SB(0, 0), b2, voffB);
            PG8_BAR; PG8_WAIT_L(0); PG8_MMA(0, 1, At, B1); PG8_BAR;
            PG8_LDA(At, 0, 1); PG8_STAGE(PG8_SA(0, 0), a2, voffA);
            PG8_BAR; PG8_WAIT_L(0); PG8_MMA(1, 0, At, B0); PG8_BAR; PG8_SCHED;
            PG8_STAGE(PG8_SB(0, 1), b2 + hstepB, voffB);
            PG8_WAIT_V(6); PG8_BAR; PG8_MMA(1, 1, At, B1); PG8_BAR;
            PG8_LDB(B0, 1, 0); PG8_SCHED; PG8_LDA(At, 1, 0); PG8_STAGE(PG8_SA(0, 1), a2 + hstepA, voffA);
            PG8_WAIT_L(8); PG8_BAR; PG8_WAIT_L(0); PG8_MMA(0, 0, At, B0); PG8_BAR; PG8_SCHED;
            PG8_LDB(B1, 1, 1); PG8_STAGE(PG8_SB(1, 0), b3, voffB);
            PG8_BAR; PG8_WAIT_L(0); PG8_MMA(0, 1, At, B1); PG8_BAR;
            PG8_LDA(At, 1, 1); PG8_STAGE(PG8_SA(1, 0), a3, voffA);
            PG8_BAR; PG8_WAIT_L(0); PG8_MMA(1, 0, At, B0); PG8_BAR; PG8_SCHED;
            PG8_STAGE(PG8_SB(1, 1), b3 + hstepB, voffB);
            PG8_WAIT_V(6); PG8_BAR; PG8_MMA(1, 1, At, B1); PG8_BAR;
            }
        }
        if constexpr (ALIGN_EPI) { if (wr == 0) PG8_BAR; }
        if constexpr (!Epi::AFTER_DRAIN) { E(acc, cur, wr, wc, fr, fq); S.done(cur); xs = __builtin_amdgcn_readfirstlane(E.issued(cur, wc)); }
        if (!has_next) break;
#pragma unroll
        for (int a = 0; a < 2; ++a)
#pragma unroll
            for (int b = 0; b < 2; ++b)
#pragma unroll
                for (int m = 0; m < 4; ++m)
#pragma unroll
                    for (int n = 0; n < 2; ++n) acc[a][b][m][n] = (f32x4){0.f, 0.f, 0.f, 0.f};
        cur = nxt; cA = nA; cB = nB; ++ui;
        if constexpr (ALIGN_EPI) { if (wr == 1) PG8_BAR; }
    }
    PG8_WAIT_V(0);
    if constexpr (!ALIGN_EPI) { if (wr == 0) PG8_BAR; }
    PG8_BAR;
    if constexpr (Epi::AFTER_DRAIN) { E.fused(acc, cur, wr, wc, fr, fq, lds, wid, lane); S.done(cur); }
#undef PG8_SA
#undef PG8_SB
#undef PG8_STAGE
#undef PG8_LDA
#undef PG8_LDB
#undef PG8_MMA
#undef PG8_WAIT_V
#undef PG8_WAIT_L
#undef PG8_WAIT_VX
#undef PG8_BAR
#undef PG8_SCHED
}
}

namespace attn {
constexpr int SLOTB = 8192;
constexpr int NSLOT = 5;
constexpr int LDS_K = 0, LDS_V = NSLOT * SLOTB, LDS_WS = 2 * NSLOT * SLOTB, LDS_OST = LDS_WS + 8 * 256, LDS_CL = LDS_OST + 8 * 4096, LDS_SCAN = LDS_CL + 2064 * 4 + 64, LDS_END = LDS_SCAN + 64;
#define SBAR() __builtin_amdgcn_sched_barrier(0)
__device__ __forceinline__ int crow(int r, int hi) { return (r & 3) + 8 * (r >> 2) + 4 * hi; }
__device__ __forceinline__ void glds16(const void* gsrc, unsigned lds_dst) { unsigned keep;
    asm volatile("s_mov_b32 %0, m0\n\ts_mov_b32 m0, %2\n\ts_nop 0\n\tglobal_load_lds_dwordx4 %1, off\n\ts_mov_b32 m0, %0" : "=&s"(keep) : "v"(gsrc), "s"(lds_dst) : "memory"); }
typedef float f32x2_t __attribute__((ext_vector_type(2))); typedef __bf16 bf16x2_t __attribute__((ext_vector_type(2)));
__device__ __forceinline__ unsigned cvtpk_s(float lo, float hi) { f32x2_t v = {lo, hi}; bf16x2_t b = __builtin_convertvector(v, bf16x2_t); return __builtin_bit_cast(unsigned, b); }
#define MX3(a, b, c) __builtin_fmaxf(__builtin_fmaxf((a), (b)), (c))
__device__ __forceinline__ void qkt(f32x16& p0, f32x16& p1, const char* Kslot, const bf16x8* qr, const f32x16& negm, int r32, int hi) {
    const char* kb = Kslot + hi * 1024 + r32 * 16;
#pragma unroll
    for (int d0 = 0; d0 < 4; ++d0) {
        const bf16x8 b0 = *reinterpret_cast<const bf16x8*>(kb + d0 * 2048);
        const bf16x8 b1 = *reinterpret_cast<const bf16x8*>(kb + d0 * 2048 + 512);
        if (d0 == 0) { p0 = __builtin_amdgcn_mfma_f32_32x32x16_bf16(b0, qr[0], negm, 0, 0, 0); p1 = __builtin_amdgcn_mfma_f32_32x32x16_bf16(b1, qr[0], negm, 0, 0, 0); }
        else { p0 = __builtin_amdgcn_mfma_f32_32x32x16_bf16(b0, qr[d0], p0, 0, 0, 0); p1 = __builtin_amdgcn_mfma_f32_32x32x16_bf16(b1, qr[d0], p1, 0, 0, 0); }
    }
}
__device__ __forceinline__ float rowmax(const f32x16& p0, const f32x16& p1) {
    float a = MX3(p0[0], p0[1], p1[0]), b = MX3(p0[2], p0[3], p1[1]); a = MX3(a, p1[2], p1[3]);
#pragma unroll
    for (int r = 4; r < 16; r += 4) { a = MX3(a, p0[r], p0[r + 1]); b = MX3(b, p0[r + 2], p0[r + 3]); a = MX3(a, p1[r], p1[r + 1]); b = MX3(b, p1[r + 2], p1[r + 3]); }
    const float m = __builtin_fmaxf(a, b);
    auto rr = __builtin_amdgcn_permlane32_swap(__float_as_uint(m), __float_as_uint(m), false, false);
    return __builtin_fmaxf(__uint_as_float(rr[0]), __uint_as_float(rr[1]));
}
__device__ __forceinline__ void pv(f32x16* o, int vb, bf16x8 pa0, bf16x8 pa1, bf16x8 pa2, bf16x8 pa3) {
#pragma unroll
    for (int d0 = 0; d0 < 2; ++d0) { s16x4 lo[4], hi[4];
#pragma unroll
        for (int ks = 0; ks < 4; ++ks) {
            asm volatile("ds_read_b64_tr_b16 %0,%1 offset:%c2" : "=&v"(lo[ks]) : "v"(vb), "i"(d0 * 4096 + ks * 1024) : "memory");
            asm volatile("ds_read_b64_tr_b16 %0,%1 offset:%c2" : "=&v"(hi[ks]) : "v"(vb), "i"(d0 * 4096 + ks * 1024 + 512) : "memory"); }
        asm volatile("s_waitcnt lgkmcnt(0)" ::: "memory"); SBAR();
#define PK(k) (bf16x8){lo[k][0], lo[k][1], lo[k][2], lo[k][3], hi[k][0], hi[k][1], hi[k][2], hi[k][3]}
        o[d0] = __builtin_amdgcn_mfma_f32_32x32x16_bf16(pa0, PK(0), o[d0], 0, 0, 0);
        o[d0] = __builtin_amdgcn_mfma_f32_32x32x16_bf16(pa1, PK(1), o[d0], 0, 0, 0);
        o[d0] = __builtin_amdgcn_mfma_f32_32x32x16_bf16(pa2, PK(2), o[d0], 0, 0, 0);
        o[d0] = __builtin_amdgcn_mfma_f32_32x32x16_bf16(pa3, PK(3), o[d0], 0, 0, 0);
#undef PK
    }
}
#define WAIT_BAR0() asm volatile("s_waitcnt vmcnt(0) lgkmcnt(0)\n\ts_barrier" ::: "memory")

template <int MODE>
__device__ __forceinline__ void unit(const bf16_t* Qw, bf16_t* Ow, const bf16_t* Kh, const bf16_t* Vh, int kp, int NT, int kbase, int qpos0,
                                     float slope2, float sink2, const float* cl, char* shm) {
    const int tid = threadIdx.x, lane = tid & 63, r32 = lane & 31, hi = lane >> 5; const int wid = __builtin_amdgcn_readfirstlane(tid >> 6);
    const unsigned lds0 = (unsigned)(uintptr_t)shm;
    float* wsf = (float*)(shm + LDS_WS) + wid * 64;
    const bf16_t* ksrc = Kh + (size_t)lane * kp + wid * 8;
    const bf16_t* vsrc = Vh + (size_t)(16 * (wid & 3) + (lane >> 2)) * kp + (wid >> 2) * 32 + (lane & 3) * 8;
    const unsigned kdst = lds0 + LDS_K + wid * 1024, vdst = lds0 + LDS_V + wid * 1024;
#define TILE_KR0(t) ((t) == 0 ? 64 : kbase + 64 * ((t) - 1))
#define DMA_KV(t, slot) do { const size_t ro_ = (size_t)TILE_KR0(t) * kp; \
        glds16(ksrc + ro_, (unsigned)__builtin_amdgcn_readfirstlane(kdst + (slot) * SLOTB)); glds16(vsrc + ro_, (unsigned)__builtin_amdgcn_readfirstlane(vdst + (slot) * SLOTB)); } while (0)
    const int vb0 = (int)(lds0 + LDS_V) + ((lane >> 4) & 1) * 32 + (lane & 3) * 8 + (4 * hi + ((lane & 15) >> 2)) * 64;
    DMA_KV(0, 0);
    bf16x8 qr[4];
#pragma unroll
    for (int d0 = 0; d0 < 4; ++d0) qr[d0] = *reinterpret_cast<const bf16x8*>(Qw + (size_t)r32 * DM + d0 * 16 + hi * 8);
    const int qp = qpos0 + r32;
    const float rowterm = (MODE == 0) ? cl[qp - KR_META] : -slope2 * (float)qp;
    float mhat = (MODE == 0) ? 0.f : sink2, l_reg = (MODE == 1 && hi == 0) ? 1.f : 0.f;
    f32x16 o[2]; o[0] = f32x16{}; o[1] = f32x16{};
    for (int t = 0; t < NT; ++t) {
        WAIT_BAR0();
        if (t + 1 < NT) DMA_KV(t + 1, (t + 1) & 1);
        const int slot = t & 1, kr0 = TILE_KR0(t);
        bool empty = false, full = false;
        if (MODE == 1 && t > 0) { empty = (kr0 > qpos0 + 31) || (kr0 + 63 <= qpos0 - 128) || (kr0 + 63 < KR_REAL);
            full = (kr0 >= KR_REAL) && (kr0 + 63 <= qpos0) && (qpos0 + 31 - kr0 < 128); }
        if (empty) continue;
        f32x16 negm; { const float nm = rowterm - mhat;
#pragma unroll
            for (int r = 0; r < 16; ++r) negm[r] = nm; }
        f32x16 p0, p1;
        qkt(p0, p1, shm + LDS_K + slot * SLOTB, qr, negm, r32, hi);
        const bool need_mask = (MODE == 1 && !full) || (MODE == 0 && ((kr0 < KR_META) || (kr0 + 63 > qpos0)));
        if (need_mask) {
#pragma unroll
            for (int r = 0; r < 16; ++r) {
                const int k0 = kr0 + crow(r, hi), k1 = k0 + 32;
                bool ok0, ok1; float c0, c1;
                if (MODE == 0) { ok0 = (k0 >= KR_META) && (k0 <= qp); ok1 = (k1 >= KR_META) && (k1 <= qp);
                    c0 = -cl[k0 >= KR_META ? k0 - KR_META : 0]; c1 = -cl[k1 >= KR_META ? k1 - KR_META : 0]; }
                else { ok0 = (t == 0) ? (k0 >= KR_META) : (k0 >= KR_REAL && k0 <= qp && qp - k0 < 128); ok1 = (t == 0) ? (k1 >= KR_META) : (k1 >= KR_REAL && k1 <= qp && qp - k1 < 128);
                    c0 = slope2 * (float)k0; c1 = slope2 * (float)k1; }
                p0[r] = ok0 ? p0[r] + c0 : -INFINITY; p1[r] = ok1 ? p1[r] + c1 : -INFINITY;
            }
        } else {
#pragma unroll
            for (int r = 0; r < 16; ++r) { const int k0 = kr0 + crow(r, hi);
                if (MODE == 0) { p0[r] -= cl[k0 - KR_META]; p1[r] -= cl[k0 - KR_META + 32]; }
                else { p0[r] += slope2 * (float)k0; p1[r] += slope2 * (float)(k0 + 32); } }
        }
        const float rm = rowmax(p0, p1);
        if (MODE == 0 && t == 0) {
            mhat = rm;
#pragma unroll
            for (int r = 0; r < 16; ++r) { p0[r] -= rm; p1[r] -= rm; }
        } else if (__any(rm > 0.f)) {
            const float dl = __builtin_fmaxf(rm, 0.f); mhat += dl;
#pragma unroll
            for (int r = 0; r < 16; ++r) { p0[r] -= dl; p1[r] -= dl; }
            const float f = __builtin_amdgcn_exp2f(-dl); l_reg *= f;
            if (hi == 0) wsf[r32] = f;
            asm volatile("s_waitcnt lgkmcnt(0)" ::: "memory");
#pragma unroll
            for (int d = 0; d < 2; ++d)
#pragma unroll
                for (int r = 0; r < 16; ++r) o[d][r] *= wsf[crow(r, hi)];
        }
        float sacc = 0.f;
#pragma unroll
        for (int r = 0; r < 16; ++r) { p0[r] = __builtin_amdgcn_exp2f(p0[r]); p1[r] = __builtin_amdgcn_exp2f(p1[r]); sacc += p0[r] + p1[r]; }
        l_reg += sacc;
        u32x4 pw0, pw1, pw2, pw3;
        pw0 = (u32x4){cvtpk_s(p0[0], p0[1]), cvtpk_s(p0[2], p0[3]), cvtpk_s(p0[4], p0[5]), cvtpk_s(p0[6], p0[7])};
        pw1 = (u32x4){cvtpk_s(p0[8], p0[9]), cvtpk_s(p0[10], p0[11]), cvtpk_s(p0[12], p0[13]), cvtpk_s(p0[14], p0[15])};
        pw2 = (u32x4){cvtpk_s(p1[0], p1[1]), cvtpk_s(p1[2], p1[3]), cvtpk_s(p1[4], p1[5]), cvtpk_s(p1[6], p1[7])};
        pw3 = (u32x4){cvtpk_s(p1[8], p1[9]), cvtpk_s(p1[10], p1[11]), cvtpk_s(p1[12], p1[13]), cvtpk_s(p1[14], p1[15])};
        SBAR();
        pv(o, vb0 + slot * SLOTB, __builtin_bit_cast(bf16x8, pw0), __builtin_bit_cast(bf16x8, pw1), __builtin_bit_cast(bf16x8, pw2), __builtin_bit_cast(bf16x8, pw3));
    }
    { auto rr = __builtin_amdgcn_permlane32_swap(__float_as_uint(l_reg), __float_as_uint(l_reg), false, false); l_reg = __uint_as_float(rr[0]) + __uint_as_float(rr[1]); }
    if (hi == 0) wsf[32 + r32] = l_reg;
    asm volatile("s_waitcnt lgkmcnt(0)" ::: "memory");
    float rli[16];
#pragma unroll
    for (int r = 0; r < 16; ++r) rli[r] = 1.0f / wsf[32 + crow(r, hi)];
    { __hip_bfloat16* stg = (__hip_bfloat16*)(shm + LDS_OST) + wid * 2048;
#pragma unroll
        for (int r = 0; r < 16; ++r) { const int orow = crow(r, hi);
#pragma unroll
            for (int d0 = 0; d0 < 2; ++d0) stg[orow * 64 + d0 * 32 + r32] = __float2bfloat16(o[d0][r] * rli[r]); }
        asm volatile("s_waitcnt lgkmcnt(0)" ::: "memory");
#pragma unroll
        for (int i = 0; i < 4; ++i) { const int row = i * 8 + (lane >> 3), ch = lane & 7; const u32x4 v = *(const u32x4*)(stg + row * 64 + ch * 8); *(u32x4*)(Ow + (size_t)row * DM + ch * 8) = v; } }
    asm volatile("s_waitcnt lgkmcnt(0)\n\ts_barrier" ::: "memory");
#undef DMA_KV
#undef TILE_KR0
}

__device__ __forceinline__ void unit_swa(const bf16_t* Qw, bf16_t* Ow, const bf16_t* Kh, const bf16_t* Vh, int kp, int kbase, int qpos0, float slope2, float sink2, char* shm, int dbg_nocompute = 0) {
    const int tid = threadIdx.x; int lane_ = tid & 63; asm volatile("" : "+v"(lane_));
    const int lane = lane_, r32 = lane & 31, hi = lane >> 5; const int wid = __builtin_amdgcn_readfirstlane(tid >> 6);
    const unsigned lds0 = (unsigned)(uintptr_t)shm;
    float* wsf = (float*)(shm + LDS_WS) + wid * 64;
    const bf16_t* ksrc = Kh + (size_t)lane * kp + wid * 8;
    const bf16_t* vsrc = Vh + (size_t)(16 * (wid & 3) + (lane >> 2)) * kp + (wid >> 2) * 32 + (lane & 3) * 8;
    const unsigned kdst = lds0 + LDS_K + wid * 1024, vdst = lds0 + LDS_V + wid * 1024;
#define TILE_KR0(t) ((t) == 0 ? 64 : kbase + 64 * ((t) - 1))
#define DMA_KV(t, slot) do { const size_t ro_ = (size_t)TILE_KR0(t) * kp; \
        glds16(ksrc + ro_, (unsigned)__builtin_amdgcn_readfirstlane(kdst + (slot) * SLOTB)); glds16(vsrc + ro_, (unsigned)__builtin_amdgcn_readfirstlane(vdst + (slot) * SLOTB)); } while (0)
    const int vb0 = (int)(lds0 + LDS_V) + ((lane >> 4) & 1) * 32 + (lane & 3) * 8 + (4 * hi + ((lane & 15) >> 2)) * 64;
#pragma unroll
    for (int t = 0; t < 5; ++t) DMA_KV(t, t);
    bf16x8 qr[4];
#pragma unroll
    for (int d0 = 0; d0 < 4; ++d0) qr[d0] = *reinterpret_cast<const bf16x8*>(Qw + (size_t)r32 * DM + d0 * 16 + hi * 8);
    const int qp = qpos0 + r32;
    const float rowterm = -slope2 * (float)qp;
    float mhat = sink2, l_reg = (hi == 0) ? 1.f : 0.f;
    f32x16 o[2]; o[0] = f32x16{}; o[1] = f32x16{};
#define SWA_RESCALE(RM, SUBS) do { if (__any((RM) > 8.f)) { const float dl = __builtin_fmaxf((RM), 0.f); mhat += dl; SUBS; \
        const float f = __builtin_amdgcn_exp2f(-dl); l_reg *= f; if (hi == 0) wsf[r32] = f; asm volatile("s_waitcnt lgkmcnt(0)" ::: "memory"); \
        _Pragma("unroll") for (int d = 0; d < 2; ++d) _Pragma("unroll") for (int r = 0; r < 16; ++r) o[d][r] *= wsf[crow(r, hi)]; } } while (0)
    WAIT_BAR0();
    for (int t = 0; t < 5; ++t) {
        if (dbg_nocompute) continue;
        const int slot = t, kr0 = TILE_KR0(t);
        const char* Kslot = shm + LDS_K + slot * SLOTB;
        if (t == 0) {
            f32x16 p1; { const float nm = rowterm - mhat;
#pragma unroll
                for (int r = 0; r < 16; ++r) p1[r] = nm; }
            const char* kb = Kslot + hi * 1024 + r32 * 16 + 512;
#pragma unroll
            for (int d0 = 0; d0 < 4; ++d0) p1 = __builtin_amdgcn_mfma_f32_32x32x16_bf16(*reinterpret_cast<const bf16x8*>(kb + d0 * 2048), qr[d0], p1, 0, 0, 0);
            const float base = slope2 * (float)(96 + 4 * hi);
            float x[8];
#pragma unroll
            for (int r = 0; r < 8; ++r) x[r] = p1[8 + r] + __builtin_fmaf(slope2, (float)(((8 + r) & 3) + 8 * ((8 + r) >> 2)), base);
            float rm = MX3(MX3(x[0], x[1], x[2]), MX3(x[3], x[4], x[5]), __builtin_fmaxf(x[6], x[7]));
            { auto rr = __builtin_amdgcn_permlane32_swap(__float_as_uint(rm), __float_as_uint(rm), false, false); rm = __builtin_fmaxf(__uint_as_float(rr[0]), __uint_as_float(rr[1])); }
            SWA_RESCALE(rm, _Pragma("unroll") for (int r = 0; r < 8; ++r) x[r] -= dl);
            float sacc = 0.f;
#pragma unroll
            for (int r = 0; r < 8; ++r) { x[r] = __builtin_amdgcn_exp2f(x[r]); sacc += x[r]; }
            l_reg += sacc;
            const u32x4 pw3 = (u32x4){cvtpk_s(x[0], x[1]), cvtpk_s(x[2], x[3]), cvtpk_s(x[4], x[5]), cvtpk_s(x[6], x[7])};
            const int vb = vb0 + slot * SLOTB;
#pragma unroll
            for (int d0 = 0; d0 < 2; ++d0) { s16x4 lo, hh;
                asm volatile("ds_read_b64_tr_b16 %0,%1 offset:%c2" : "=&v"(lo) : "v"(vb), "i"(d0 * 4096 + 3 * 1024) : "memory");
                asm volatile("ds_read_b64_tr_b16 %0,%1 offset:%c2" : "=&v"(hh) : "v"(vb), "i"(d0 * 4096 + 3 * 1024 + 512) : "memory");
                asm volatile("s_waitcnt lgkmcnt(0)" ::: "memory"); SBAR();
                o[d0] = __builtin_amdgcn_mfma_f32_32x32x16_bf16(__builtin_bit_cast(bf16x8, pw3), (bf16x8){lo[0], lo[1], lo[2], lo[3], hh[0], hh[1], hh[2], hh[3]}, o[d0], 0, 0, 0); }
            continue;
        }
        const int dmin = qpos0 - (kr0 + 63), dmax = qpos0 + 31 - kr0;
        if (dmax < 0 || dmin >= 128 || kr0 + 63 < KR_REAL) continue;
        f32x16 negm; { const float nm = rowterm - mhat;
#pragma unroll
            for (int r = 0; r < 16; ++r) negm[r] = nm; }
        f32x16 p0, p1;
        qkt(p0, p1, Kslot, qr, negm, r32, hi);
        const float base = slope2 * (float)(kr0 + 4 * hi);
        const int lim = qp - kr0 - 4 * hi;
        if (dmin < 0) {
#pragma unroll
            for (int r = 0; r < 16; ++r) { const int cr = (r & 3) + 8 * (r >> 2);
                p0[r] = (cr <= lim) ? p0[r] + __builtin_fmaf(slope2, (float)cr, base) : -INFINITY; p1[r] = (cr + 32 <= lim) ? p1[r] + __builtin_fmaf(slope2, (float)(cr + 32), base) : -INFINITY; }
        } else if (dmax >= 128) {
#pragma unroll
            for (int r = 0; r < 16; ++r) { const int cr = (r & 3) + 8 * (r >> 2);
                p0[r] = (cr > lim - 128) ? p0[r] + __builtin_fmaf(slope2, (float)cr, base) : -INFINITY; p1[r] = (cr + 32 > lim - 128) ? p1[r] + __builtin_fmaf(slope2, (float)(cr + 32), base) : -INFINITY; }
        } else {
#pragma unroll
            for (int r = 0; r < 16; ++r) { const int cr = (r & 3) + 8 * (r >> 2); p0[r] += __builtin_fmaf(slope2, (float)cr, base); p1[r] += __builtin_fmaf(slope2, (float)(cr + 32), base); }
        }
        const float rm = rowmax(p0, p1);
        SWA_RESCALE(rm, _Pragma("unroll") for (int r = 0; r < 16; ++r) { p0[r] -= dl; p1[r] -= dl; });
        float sacc = 0.f;
#pragma unroll
        for (int r = 0; r < 16; ++r) { p0[r] = __builtin_amdgcn_exp2f(p0[r]); p1[r] = __builtin_amdgcn_exp2f(p1[r]); sacc += p0[r] + p1[r]; }
        l_reg += sacc;
        u32x4 pw0, pw1, pw2, pw3;
        pw0 = (u32x4){cvtpk_s(p0[0], p0[1]), cvtpk_s(p0[2], p0[3]), cvtpk_s(p0[4], p0[5]), cvtpk_s(p0[6], p0[7])};
        pw1 = (u32x4){cvtpk_s(p0[8], p0[9]), cvtpk_s(p0[10], p0[11]), cvtpk_s(p0[12], p0[13]), cvtpk_s(p0[14], p0[15])};
        pw2 = (u32x4){cvtpk_s(p1[0], p1[1]), cvtpk_s(p1[2], p1[3]), cvtpk_s(p1[4], p1[5]), cvtpk_s(p1[6], p1[7])};
        pw3 = (u32x4){cvtpk_s(p1[8], p1[9]), cvtpk_s(p1[10], p1[11]), cvtpk_s(p1[12], p1[13]), cvtpk_s(p1[14], p1[15])};
        SBAR();
        pv(o, vb0 + slot * SLOTB, __builtin_bit_cast(bf16x8, pw0), __builtin_bit_cast(bf16x8, pw1), __builtin_bit_cast(bf16x8, pw2), __builtin_bit_cast(bf16x8, pw3));
    }
    { auto rr = __builtin_amdgcn_permlane32_swap(__float_as_uint(l_reg), __float_as_uint(l_reg), false, false); l_reg = __uint_as_float(rr[0]) + __uint_as_float(rr[1]); }
    if (hi == 0) wsf[32 + r32] = l_reg;
    asm volatile("s_waitcnt lgkmcnt(0)" ::: "memory");
    float rli[16];
#pragma unroll
    for (int r = 0; r < 16; ++r) rli[r] = 1.0f / wsf[32 + crow(r, hi)];
    { __hip_bfloat16* stg = (__hip_bfloat16*)(shm + LDS_OST) + wid * 2048;
#pragma unroll
        for (int r = 0; r < 16; ++r) { const int orow = crow(r, hi);
#pragma unroll
            for (int d0 = 0; d0 < 2; ++d0) stg[orow * 64 + d0 * 32 + r32] = __float2bfloat16(o[d0][r] * rli[r]); }
        asm volatile("s_waitcnt lgkmcnt(0)" ::: "memory");
#pragma unroll
        for (int i = 0; i < 4; ++i) { const int row = i * 8 + (lane >> 3), ch = lane & 7; const u32x4 v = *(const u32x4*)(stg + row * 64 + ch * 8); *(u32x4*)(Ow + (size_t)row * DM + ch * 8) = v; } }
    asm volatile("s_waitcnt lgkmcnt(0)\n\ts_barrier" ::: "memory");
#undef SWA_RESCALE
#undef DMA_KV
#undef TILE_KR0
}

__device__ __forceinline__ void unit_swa2(const bf16_t* Qw, bf16_t* Ow, const bf16_t* Kh, const bf16_t* Vh, int kp, int kbase, int qpos0, float slope2, float sink2, char* shm) {
    const int tid = threadIdx.x; int lane_ = tid & 63; asm volatile("" : "+v"(lane_));
    const int lane = lane_, r32 = lane & 31, hi = lane >> 5; const int wid = __builtin_amdgcn_readfirstlane(tid >> 6);
    const unsigned lds0 = (unsigned)(uintptr_t)shm;
    float* wsf = (float*)(shm + LDS_WS) + wid * 64;
    const bf16_t* ksrc = Kh + (size_t)lane * kp + wid * 8;
    const bf16_t* vsrc = Vh + (size_t)(16 * (wid & 3) + (lane >> 2)) * kp + (wid >> 2) * 32 + (lane & 3) * 8;
    const unsigned kdst = lds0 + LDS_K + wid * 1024, vdst = lds0 + LDS_V + wid * 1024;
#define TILE_KR0(t) ((t) == 0 ? 64 : kbase + 64 * ((t) - 1))
#define DMA_KV(t, slot) do { const size_t ro_ = (size_t)TILE_KR0(t) * kp; \
        glds16(ksrc + ro_, (unsigned)__builtin_amdgcn_readfirstlane(kdst + (slot) * SLOTB)); glds16(vsrc + ro_, (unsigned)__builtin_amdgcn_readfirstlane(vdst + (slot) * SLOTB)); } while (0)
    const int vb0 = (int)(lds0 + LDS_V) + ((lane >> 4) & 1) * 32 + (lane & 3) * 8 + (4 * hi + ((lane & 15) >> 2)) * 64;
#pragma unroll
    for (int t = 0; t < 5; ++t) DMA_KV(t, t);
    bf16x8 qr[4];
#pragma unroll
    for (int d0 = 0; d0 < 4; ++d0) qr[d0] = *reinterpret_cast<const bf16x8*>(Qw + (size_t)r32 * DM + d0 * 16 + hi * 8);
    const int qp = qpos0 + r32;
    const float rowterm = -slope2 * (float)qp;
    const int jb0 = ((qpos0 - kbase - 128) >> 5) >= 2 ? 1 : 0;
    const int krW = kbase + 64 * jb0, krF = krW + 64, krC = krW + 128;
    const bool vW = krW >= KR_REAL, vF = krF >= KR_REAL;
    f32x16 initc;
#pragma unroll
    for (int r = 0; r < 16; ++r) initc[r] = rowterm;
    WAIT_BAR0();
    f32x16 pm = initc;
    { const char* kb = shm + LDS_K + hi * 1024 + r32 * 16 + 512;
#pragma unroll
      for (int d0 = 0; d0 < 4; ++d0) pm = __builtin_amdgcn_mfma_f32_32x32x16_bf16(*reinterpret_cast<const bf16x8*>(kb + d0 * 2048), qr[d0], pm, 0, 0, 0); }
    f32x16 w0, w1, f0, f1, c0, c1;
    if (vW) qkt(w0, w1, shm + LDS_K + (1 + jb0) * SLOTB, qr, initc, r32, hi);
    if (vF) qkt(f0, f1, shm + LDS_K + (2 + jb0) * SLOTB, qr, initc, r32, hi);
    qkt(c0, c1, shm + LDS_K + (3 + jb0) * SLOTB, qr, initc, r32, hi);
    float xm[8];
    { const float base = slope2 * (float)(96 + 4 * hi);
#pragma unroll
      for (int r = 0; r < 8; ++r) xm[r] = pm[8 + r] + __builtin_fmaf(slope2, (float)(((8 + r) & 3) + 8 * ((8 + r) >> 2)), base); }
    if (vW) { const float base = slope2 * (float)(krW + 4 * hi); const int lim = qp - krW - 4 * hi;
#pragma unroll
        for (int r = 0; r < 16; ++r) { const int cr = (r & 3) + 8 * (r >> 2);
            w0[r] = (cr > lim - 128) ? w0[r] + __builtin_fmaf(slope2, (float)cr, base) : -INFINITY; w1[r] = (cr + 32 > lim - 128) ? w1[r] + __builtin_fmaf(slope2, (float)(cr + 32), base) : -INFINITY; }
    } else {
#pragma unroll
        for (int r = 0; r < 16; ++r) { w0[r] = -INFINITY; w1[r] = -INFINITY; } }
    if (vF) { const float base = slope2 * (float)(krF + 4 * hi);
#pragma unroll
        for (int r = 0; r < 16; ++r) { const int cr = (r & 3) + 8 * (r >> 2); f0[r] += __builtin_fmaf(slope2, (float)cr, base); f1[r] += __builtin_fmaf(slope2, (float)(cr + 32), base); }
    } else {
#pragma unroll
        for (int r = 0; r < 16; ++r) { f0[r] = -INFINITY; f1[r] = -INFINITY; } }
    { const float base = slope2 * (float)(krC + 4 * hi); const int lim = qp - krC - 4 * hi;
#pragma unroll
      for (int r = 0; r < 16; ++r) { const int cr = (r & 3) + 8 * (r >> 2);
          c0[r] = (cr <= lim) ? c0[r] + __builtin_fmaf(slope2, (float)cr, base) : -INFINITY; c1[r] = (cr + 32 <= lim) ? c1[r] + __builtin_fmaf(slope2, (float)(cr + 32), base) : -INFINITY; } }
    float m = __builtin_fmaxf(__builtin_fmaxf(rowmax(w0, w1), rowmax(f0, f1)), rowmax(c0, c1));
    { float mm = MX3(MX3(xm[0], xm[1], xm[2]), MX3(xm[3], xm[4], xm[5]), __builtin_fmaxf(xm[6], xm[7]));
      auto rr = __builtin_amdgcn_permlane32_swap(__float_as_uint(mm), __float_as_uint(mm), false, false); mm = __builtin_fmaxf(__uint_as_float(rr[0]), __uint_as_float(rr[1]));
      m = __builtin_fmaxf(__builtin_fmaxf(m, mm), sink2); }
    f32x16 o[2]; o[0] = f32x16{}; o[1] = f32x16{};
    float l_reg = (hi == 0) ? __builtin_amdgcn_exp2f(sink2 - m) : 0.f;
    { float sacc = 0.f;
#pragma unroll
      for (int r = 0; r < 8; ++r) { xm[r] = __builtin_amdgcn_exp2f(xm[r] - m); sacc += xm[r]; }
      l_reg += sacc;
      const u32x4 pw3 = (u32x4){cvtpk_s(xm[0], xm[1]), cvtpk_s(xm[2], xm[3]), cvtpk_s(xm[4], xm[5]), cvtpk_s(xm[6], xm[7])};
#pragma unroll
      for (int d0 = 0; d0 < 2; ++d0) { s16x4 lo, hh;
          asm volatile("ds_read_b64_tr_b16 %0,%1 offset:%c2" : "=&v"(lo) : "v"(vb0), "i"(d0 * 4096 + 3 * 1024) : "memory");
          asm volatile("ds_read_b64_tr_b16 %0,%1 offset:%c2" : "=&v"(hh) : "v"(vb0), "i"(d0 * 4096 + 3 * 1024 + 512) : "memory");
          asm volatile("s_waitcnt lgkmcnt(0)" ::: "memory"); SBAR();
          o[d0] = __builtin_amdgcn_mfma_f32_32x32x16_bf16(__builtin_bit_cast(bf16x8, pw3), (bf16x8){lo[0], lo[1], lo[2], lo[3], hh[0], hh[1], hh[2], hh[3]}, o[d0], 0, 0, 0); } }
#define SWA2_TILE(P0, P1, SLOT) do { float sacc = 0.f; \
        _Pragma("unroll") for (int r = 0; r < 16; ++r) { P0[r] = __builtin_amdgcn_exp2f(P0[r] - m); P1[r] = __builtin_amdgcn_exp2f(P1[r] - m); sacc += P0[r] + P1[r]; } \
        l_reg += sacc; \
        const u32x4 q0_ = (u32x4){cvtpk_s(P0[0], P0[1]), cvtpk_s(P0[2], P0[3]), cvtpk_s(P0[4], P0[5]), cvtpk_s(P0[6], P0[7])}; \
        const u32x4 q1_ = (u32x4){cvtpk_s(P0[8], P0[9]), cvtpk_s(P0[10], P0[11]), cvtpk_s(P0[12], P0[13]), cvtpk_s(P0[14], P0[15])}; \
        const u32x4 q2_ = (u32x4){cvtpk_s(P1[0], P1[1]), cvtpk_s(P1[2], P1[3]), cvtpk_s(P1[4], P1[5]), cvtpk_s(P1[6], P1[7])}; \
        const u32x4 q3_ = (u32x4){cvtpk_s(P1[8], P1[9]), cvtpk_s(P1[10], P1[11]), cvtpk_s(P1[12], P1[13]), cvtpk_s(P1[14], P1[15])}; \
        SBAR(); pv(o, vb0 + (SLOT) * SLOTB, __builtin_bit_cast(bf16x8, q0_), __builtin_bit_cast(bf16x8, q1_), __builtin_bit_cast(bf16x8, q2_), __builtin_bit_cast(bf16x8, q3_)); } while (0)
    if (vW) SWA2_TILE(w0, w1, 1 + jb0);
    if (vF) SWA2_TILE(f0, f1, 2 + jb0);
    SWA2_TILE(c0, c1, 3 + jb0);
#undef SWA2_TILE
    { auto rr = __builtin_amdgcn_permlane32_swap(__float_as_uint(l_reg), __float_as_uint(l_reg), false, false); l_reg = __uint_as_float(rr[0]) + __uint_as_float(rr[1]); }
    if (hi == 0) wsf[32 + r32] = l_reg;
    asm volatile("s_waitcnt lgkmcnt(0)" ::: "memory");
    float rli[16];
#pragma unroll
    for (int r = 0; r < 16; ++r) rli[r] = 1.0f / wsf[32 + crow(r, hi)];
    { __hip_bfloat16* stg = (__hip_bfloat16*)(shm + LDS_OST) + wid * 2048;
#pragma unroll
        for (int r = 0; r < 16; ++r) { const int orow = crow(r, hi);
#pragma unroll
            for (int d0 = 0; d0 < 2; ++d0) stg[orow * 64 + d0 * 32 + r32] = __float2bfloat16(o[d0][r] * rli[r]); }
        asm volatile("s_waitcnt lgkmcnt(0)" ::: "memory");
#pragma unroll
        for (int i = 0; i < 4; ++i) { const int row = i * 8 + (lane >> 3), ch = lane & 7; const u32x4 v = *(const u32x4*)(stg + row * 64 + ch * 8); *(u32x4*)(Ow + (size_t)row * DM + ch * 8) = v; } }
    asm volatile("s_waitcnt lgkmcnt(0)\n\ts_barrier" ::: "memory");
#undef DMA_KV
#undef TILE_KR0
}
#undef WAIT_BAR0
#undef SBAR
#undef MX3
}

namespace attn2 {
using bf16=__hip_bfloat16;
__device__ __forceinline__ int crow(int r,int hi){return (r&3)+8*(r>>2)+4*hi;}
#define SBAR() __builtin_amdgcn_sched_barrier(0)
__device__ __forceinline__ void cmask(f32x16&p0,f32x16&p1,int jb,int qrel,int hi){
  const float NEG=-INFINITY; int kb=64*jb+4*hi;
  #pragma unroll
  for(int r=0;r<16;++r){int kv=kb+(r&3)+8*(r>>2); if(kv>qrel)p0[r]=NEG; if(kv+32>qrel)p1[r]=NEG;}
}

constexpr int NSLOT=3, SLOTB=8192;
constexpr int NW=8;
constexpr int LDS_K=0, LDS_V=NSLOT*SLOTB, LDS_WS=2*NSLOT*SLOTB, LDS_OST=LDS_WS+NW*64*4, LDS_CL=LDS_OST+NW*4096, LDS_SCAN=LDS_CL+2064*4+64, LDS_END=LDS_SCAN+192;
__device__ __forceinline__ void glds16(const void*gsrc,unsigned lds_dst){unsigned keep;
  asm volatile("s_mov_b32 %0, m0\n\ts_mov_b32 m0, %2\n\ts_nop 0\n\tglobal_load_lds_dwordx4 %1, off\n\ts_mov_b32 m0, %0":"=&s"(keep):"v"(gsrc),"s"(lds_dst):"memory");}
__device__ __forceinline__ float max3f(float a,float b,float c){float r;asm("v_max3_f32 %0, %1, %2, %3":"=v"(r):"v"(a),"v"(b),"v"(c));return r;}
__device__ __forceinline__ float max2f(float a,float b){float r;asm("v_max_f32_e32 %0, %1, %2":"=v"(r):"v"(a),"v"(b));return r;}
__device__ __forceinline__ float fadd_s(float a,float b){float r;asm("v_add_f32_e32 %0, %1, %2":"=v"(r):"v"(a),"v"(b));return r;}
__device__ __forceinline__ float fsub_s(float a,float b){float r;asm("v_sub_f32_e32 %0, %1, %2":"=v"(r):"v"(a),"v"(b));return r;}
typedef float f32x2_t __attribute__((ext_vector_type(2))); typedef __bf16 bf16x2_t __attribute__((ext_vector_type(2)));
__device__ __forceinline__ unsigned cvtpk_s(float lo,float hi){f32x2_t v={lo,hi};bf16x2_t b=__builtin_convertvector(v,bf16x2_t);return __builtin_bit_cast(unsigned,b);}
#define WAIT_BAR(N) asm volatile("s_waitcnt vmcnt(" #N ") lgkmcnt(0)\n\ts_barrier":::"memory")

__device__ __forceinline__ void qkt(f32x16&p0,f32x16&p1,const char*Kslot,const bf16x8*qr,const f32x16&negm,int r32,int hi){
  const char*kb=Kslot+hi*1024+r32*16;
  #pragma unroll
  for(int d0=0;d0<4;++d0){
    const bf16x8 b0=*reinterpret_cast<const bf16x8*>(kb+d0*2048);
    const bf16x8 b1=*reinterpret_cast<const bf16x8*>(kb+d0*2048+512);
    if(d0==0){p0=__builtin_amdgcn_mfma_f32_32x32x16_bf16(b0,qr[0],negm,0,0,0);p1=__builtin_amdgcn_mfma_f32_32x32x16_bf16(b1,qr[0],negm,0,0,0);}
    else{p0=__builtin_amdgcn_mfma_f32_32x32x16_bf16(b0,qr[d0],p0,0,0,0);p1=__builtin_amdgcn_mfma_f32_32x32x16_bf16(b1,qr[d0],p1,0,0,0);}}
}
typedef __attribute__((address_space(3))) const char* lds_cptr;
typedef short v4i16_t __attribute__((ext_vector_type(4)));
__device__ __forceinline__ void kload8(bf16x8*kf,lds_cptr kp){
  kf[0]=*(const __attribute__((address_space(3))) bf16x8*)(kp);      kf[1]=*(const __attribute__((address_space(3))) bf16x8*)(kp+512);
  kf[2]=*(const __attribute__((address_space(3))) bf16x8*)(kp+2048); kf[3]=*(const __attribute__((address_space(3))) bf16x8*)(kp+2560);
  kf[4]=*(const __attribute__((address_space(3))) bf16x8*)(kp+4096); kf[5]=*(const __attribute__((address_space(3))) bf16x8*)(kp+4608);
  kf[6]=*(const __attribute__((address_space(3))) bf16x8*)(kp+6144); kf[7]=*(const __attribute__((address_space(3))) bf16x8*)(kp+6656);
}
__device__ __forceinline__ void kload2(bf16x8*kf,lds_cptr kp,int j){ kf[2*j]=*(const __attribute__((address_space(3))) bf16x8*)(kp+j*2048); kf[2*j+1]=*(const __attribute__((address_space(3))) bf16x8*)(kp+j*2048+512); }
__device__ __forceinline__ s16x4 vtr(lds_cptr p){ return __builtin_bit_cast(s16x4,__builtin_amdgcn_ds_read_tr16_b64_v4i16((__attribute__((address_space(3))) v4i16_t*)p)); }
__device__ __forceinline__ float rowmax(const f32x16&p0,const f32x16&p1){
  float a=max3f(p0[0],p0[1],p1[0]),b=max3f(p0[2],p0[3],p1[1]);a=max3f(a,p1[2],p1[3]);
  #pragma unroll
  for(int r=4;r<16;r+=4){a=max3f(a,p0[r],p0[r+1]);b=max3f(b,p0[r+2],p0[r+3]);a=max3f(a,p1[r],p1[r+1]);b=max3f(b,p1[r+2],p1[r+3]);}
  const float m=max2f(a,b);
  auto rr=__builtin_amdgcn_permlane32_swap(__float_as_uint(m),__float_as_uint(m),false,false);
  return max2f(__uint_as_float(rr[0]),__uint_as_float(rr[1]));
}
__device__ __forceinline__ void pv(f32x16*o,int vb,bf16x8 pa0,bf16x8 pa1,bf16x8 pa2,bf16x8 pa3){
  #pragma unroll
  for(int d0=0;d0<2;++d0){s16x4 lo[4],hi[4];
    #pragma unroll
    for(int ks=0;ks<4;++ks){
      asm volatile("ds_read_b64_tr_b16 %0,%1 offset:%c2":"=&v"(lo[ks]):"v"(vb),"i"(d0*4096+ks*1024):"memory");
      asm volatile("ds_read_b64_tr_b16 %0,%1 offset:%c2":"=&v"(hi[ks]):"v"(vb),"i"(d0*4096+ks*1024+512):"memory");}
    asm volatile("s_waitcnt lgkmcnt(0)":::"memory");SBAR();
    #define PK(k) (bf16x8){lo[k][0],lo[k][1],lo[k][2],lo[k][3],hi[k][0],hi[k][1],hi[k][2],hi[k][3]}
    o[d0]=__builtin_amdgcn_mfma_f32_32x32x16_bf16(pa0,PK(0),o[d0],0,0,0);
    o[d0]=__builtin_amdgcn_mfma_f32_32x32x16_bf16(pa1,PK(1),o[d0],0,0,0);
    o[d0]=__builtin_amdgcn_mfma_f32_32x32x16_bf16(pa2,PK(2),o[d0],0,0,0);
    o[d0]=__builtin_amdgcn_mfma_f32_32x32x16_bf16(pa3,PK(3),o[d0],0,0,0);
    #undef PK
  }
}


__device__ __forceinline__ void amask(f32x16&p0,f32x16&p1,int kr0,int qp,float slope2,int hi){
  asm volatile("":"+v"(slope2));
  const float base=slope2*(float)(kr0+4*hi); const int d0=qp-kr0-4*hi;
  #pragma unroll
  for(int r=0;r<16;++r){ const int cr=(r&3)+8*(r>>2); const int da=d0-cr, db=da-32;
    const bool ok0=((unsigned)da<128u)&&(qp-da>=KR_REAL), ok1=((unsigned)db<128u)&&(qp-db>=KR_REAL);
    p0[r]=ok0?p0[r]+__builtin_fmaf(slope2,(float)cr,base):-INFINITY; p1[r]=ok1?p1[r]+__builtin_fmaf(slope2,(float)(cr+32),base):-INFINITY; }
}
template<int MODE,int THRL> __device__ __forceinline__ void unit2(const bf16*Qw,bf16*Ow,const bf16*__restrict__ Kh,const bf16*__restrict__ Vh,int kp,int NT,int row0,int kbase,int qpos0,int qrel0,float slope2,float sink2,const float*cl,char*shm){
  const int tid=threadIdx.x; int lane_=tid&63; asm volatile("":"+v"(lane_));
  const int lane=lane_,r32=lane&31,hi=lane>>5; const int wid=__builtin_amdgcn_readfirstlane(tid>>6);
  const unsigned lds0=(unsigned)(uintptr_t)shm;
  float*wsf=(float*)(shm+LDS_WS)+wid*64;
  const bf16*ksrc=Kh+(long)lane*kp+wid*8;
  const bf16*vsrc=Vh+(long)(16*(wid&3)+(lane>>2))*kp+(wid>>2)*32+(lane&3)*8;
  const unsigned kdst=lds0+LDS_K+wid*1024, vdst=lds0+LDS_V+wid*1024;
  #define TROW(t) ((t)==0?row0:kbase+64*((t)-1))
  #define DMA_K(t,slot) glds16(ksrc+(long)TROW(t)*kp,(unsigned)__builtin_amdgcn_readfirstlane(kdst+(slot)))
  #define DMA_V(t,slot) glds16(vsrc+(long)TROW(t)*kp,(unsigned)__builtin_amdgcn_readfirstlane(vdst+(slot)))
  const int vb0=(int)(lds0+LDS_V)+((lane>>4)&1)*32+(lane&3)*8+(4*hi+((lane&15)>>2))*64;
  const char*Kbase=shm+LDS_K; bf16x8 kf[8];
  const lds_cptr shm3=(lds_cptr)shm; const lds_cptr kp0=shm3+LDS_K+hi*1024+r32*16; const lds_cptr vp0=shm3+LDS_V+((lane>>4)&1)*32+(lane&3)*8+(4*hi+((lane&15)>>2))*64;
  DMA_K(0,0);DMA_V(0,0);DMA_K(1,SLOTB);
  bf16x8 qr[4];
  #pragma unroll
  for(int d0=0;d0<4;++d0)qr[d0]=*reinterpret_cast<const bf16x8*>(&Qw[(long)r32*DM+d0*16+hi*8]);
  const int qrel=qrel0+r32, qp=qpos0+r32;
  const float rowterm=(MODE==0)?cl[qp-KR_META]:-slope2*(float)qp;
  float mhat=(MODE==0)?0.f:sink2,l_reg=(MODE==1&&hi==0)?1.f:0.f;f32x16 o[2];o[0]=f32x16{};o[1]=f32x16{};f32x16 negm;
  { const float nm_=rowterm-mhat; _Pragma("unroll") for(int r=0;r<16;++r)negm[r]=nm_; } asm volatile("":"+v"(negm));
  #define POST(C0,C1,t,MK) do{ if(MODE==0){ const float*clt_=cl+(TROW(t)-KR_META)+4*hi; \
      _Pragma("unroll") for(int g_=0;g_<4;++g_){ const f32x4 a_=*(const f32x4*)(clt_+8*g_), b_=*(const f32x4*)(clt_+32+8*g_); \
        _Pragma("unroll") for(int e_=0;e_<4;++e_){ C0[4*g_+e_]-=a_[e_]; C1[4*g_+e_]-=b_[e_]; } SBAR(); } \
      if(MK) cmask(C0,C1,(t)-(NT-4),qrel,hi); } \
    else { amask(C0,C1,TROW(t),qp,slope2,hi); } }while(0)
  #define POST0(P0,P1) do{ _Pragma("unroll") for(int r=0;r<16;++r)P0[r]=-INFINITY; _Pragma("unroll") for(int r=0;r<8;++r)P1[r]=-INFINITY; \
    if(MODE==0){ const f32x4 a_=*(const f32x4*)(cl+4*hi), b_=*(const f32x4*)(cl+8+4*hi); _Pragma("unroll") for(int e_=0;e_<4;++e_){ P1[8+e_]-=a_[e_]; P1[12+e_]-=b_[e_]; } } \
    else { _Pragma("unroll") for(int r=8;r<16;++r)P1[r]+=slope2*(float)(96+crow(r,hi)); } }while(0)
  bool resc=false;
  #define START(P0,P1) do{ const float rm=rowmax(P0,P1); resc=false; \
    { const float dl=(MODE==0)?rm:__builtin_fmaxf(rm,0.f); mhat=fadd_s(mhat,dl); \
      _Pragma("unroll") for(int r=0;r<16;++r){P0[r]=fsub_s(P0[r],dl);P1[r]=fsub_s(P1[r],dl);} \
      { const float nm_=rowterm-mhat; _Pragma("unroll") for(int r=0;r<16;++r)negm[r]=nm_; } asm volatile("":"+v"(negm)); \
      if(MODE==1) l_reg*=__builtin_amdgcn_exp2f(-dl); } \
    _Pragma("unroll") for(int r=0;r<16;++r)P0[r]=__builtin_amdgcn_exp2f(P0[r]); }while(0)
  #define RESC() do{ if(resc){ asm volatile("s_waitcnt lgkmcnt(0)":::"memory"); \
      _Pragma("unroll") for(int d_=0;d_<2;++d_) _Pragma("unroll") for(int r=0;r<16;++r)o[d_][r]*=wsf[crow(r,hi)]; } }while(0)
  f32x16 pA0,pA1,pB0,pB1;
  int sl_prev=0,sl_cur=0,sl_next=SLOTB;
  #define ROT() do{sl_prev=sl_cur;sl_cur=sl_next;sl_next=(sl_next==(NSLOT-1)*SLOTB)?0:sl_next+SLOTB;}while(0)
  DMA_K(2,2*SLOTB);
  WAIT_BAR(3);
  qkt(pA0,pA1,Kbase,qr,negm,r32,hi);asm volatile("s_nop 15\n\ts_nop 7":"+v"(pA0),"+v"(pA1));if(row0==64){POST0(pA0,pA1);}else{POST(pA0,pA1,0,false);}
  START(pA0,pA1);
  _Pragma("unroll") for(int r=0;r<16;++r)pA1[r]=__builtin_amdgcn_exp2f(pA1[r]);
  WAIT_BAR(0);
  DMA_K(3,0);DMA_V(1,SLOTB);
  ROT();
  kload8(kf,kp0+sl_cur);
  WAIT_BAR(2);
  s16x4 vlo[8],vhi[8]; u32x4 pw0,pw1,pw2,pw3;
  #define PKW(P,B) cvtpk_s(P[B],P[B+1])
  #define PAF(k) __builtin_bit_cast(bf16x8,pw##k)
  #define VFR(i) (bf16x8){vlo[i][0],vlo[i][1],vlo[i][2],vlo[i][3],vhi[i][0],vhi[i][1],vhi[i][2],vhi[i][3]}
  #define PIN(x) asm volatile("":"+v"(x))
  #define MX3(a,b,c) __builtin_fmaxf(__builtin_fmaxf((a),(b)),(c))
  #define GAPA(MF,A0,A1,A2,A3,W0,W1,PW) do{ MF; sacc+=A0; sacc+=A1; sacc+=A2; sacc+=A3; PIN(sacc); W0; W1; PIN(PW); SBAR(); }while(0)
  #define EX(v) __builtin_amdgcn_exp2f(v)
  #define GAPB(MF,X,B) do{ MF; X[B]=EX(X[B]); X[B+1]=EX(X[B+1]); X[B+2]=EX(X[B+2]); X[B+3]=EX(X[B+3]); PIN(X); SBAR(); }while(0)
  #define VRD(i) do{ vlo[i]=vtr(vp_+(((i)>>2)*4096+((i)&3)*1024)); vhi[i]=vtr(vp_+(((i)>>2)*4096+((i)&3)*1024+512)); }while(0)
  #define KRD(G,j) do{ if(G){ kload2(kf,kp0+sl_next,j); SBAR(); } }while(0)
  #define STEP(C0,C1,P0,P1,t,GK,GV,GL,MK) do{ SBAR(); \
    const lds_cptr vp_=vp0+sl_prev; \
    VRD(0); SBAR(); float sacc=(P0[0]+P0[1]); \
    GAPA(C0=__builtin_amdgcn_mfma_f32_32x32x16_bf16(kf[0],qr[0],negm,0,0,0), P0[2],P0[3],P0[4],P0[5],     pw0[0]=PKW(P0,0), pw0[1]=PKW(P0,2), pw0); \
    VRD(4); SBAR(); GAPA(C1=__builtin_amdgcn_mfma_f32_32x32x16_bf16(kf[1],qr[0],negm,0,0,0), P0[6],P0[7],P0[8],P0[9],     pw0[2]=PKW(P0,4), pw0[3]=PKW(P0,6), pw0); \
    VRD(1); SBAR(); GAPA(C0=__builtin_amdgcn_mfma_f32_32x32x16_bf16(kf[2],qr[1],C0,0,0,0),   P0[10],P0[11],P0[12],P0[13], pw1[0]=PKW(P0,8), pw1[1]=PKW(P0,10), pw1); \
    VRD(5); SBAR(); GAPA(C1=__builtin_amdgcn_mfma_f32_32x32x16_bf16(kf[3],qr[1],C1,0,0,0),   P0[14],P0[15],P1[0],P1[1],   pw1[2]=PKW(P0,12),pw1[3]=PKW(P0,14), pw1); \
    VRD(2); SBAR(); GAPA(C0=__builtin_amdgcn_mfma_f32_32x32x16_bf16(kf[4],qr[2],C0,0,0,0),   P1[2],P1[3],P1[4],P1[5],     pw2[0]=PKW(P1,0), pw2[1]=PKW(P1,2), pw2); \
    VRD(6); SBAR(); GAPA(C1=__builtin_amdgcn_mfma_f32_32x32x16_bf16(kf[5],qr[2],C1,0,0,0),   P1[6],P1[7],P1[8],P1[9],     pw2[2]=PKW(P1,4), pw2[3]=PKW(P1,6), pw2); \
    VRD(3); SBAR(); GAPA(C0=__builtin_amdgcn_mfma_f32_32x32x16_bf16(kf[6],qr[3],C0,0,0,0),   P1[10],P1[11],P1[12],P1[13], pw3[0]=PKW(P1,8), pw3[1]=PKW(P1,10), pw3); \
    VRD(7); SBAR(); GAPA(C1=__builtin_amdgcn_mfma_f32_32x32x16_bf16(kf[7],qr[3],C1,0,0,0),   P1[14],P1[15],0.f,0.f,       pw3[2]=PKW(P1,12),pw3[3]=PKW(P1,14), pw3); \
    l_reg+=sacc; \
    if(GK){DMA_K((t)+3,sl_cur);} if(GV){DMA_V((t)+1,sl_next);} \
    POST(C0,C1,t,MK); \
    { float a=MX3(C0[0],C0[1],C1[0]),b=MX3(C0[2],C0[3],C1[1]); a=MX3(a,C1[2],C1[3]); \
      _Pragma("unroll") for(int r=4;r<16;r+=4){a=MX3(a,C0[r],C0[r+1]);b=MX3(b,C0[r+2],C0[r+3]);a=MX3(a,C1[r],C1[r+1]);b=MX3(b,C1[r+2],C1[r+3]);} \
      float rm=__builtin_fmaxf(a,b); { auto rr=__builtin_amdgcn_permlane32_swap(__float_as_uint(rm),__float_as_uint(rm),false,false); rm=__builtin_fmaxf(__uint_as_float(rr[0]),__uint_as_float(rr[1])); } \
      resc=false; \
      if(__builtin_expect(__any(rm>(float)THRL),0)){ const float dl=__builtin_fmaxf(rm,0.f); mhat+=dl; \
        _Pragma("unroll") for(int r=0;r<16;++r){C0[r]-=dl;C1[r]-=dl;} \
        { const float nm_=rowterm-mhat; _Pragma("unroll") for(int r=0;r<16;++r)negm[r]=nm_; } asm volatile("":"+v"(negm)); \
        const float f=__builtin_amdgcn_exp2f(-dl); l_reg*=f; if(hi==0)wsf[r32]=f; resc=true; } } \
    SBAR(); \
    GAPB(o[0]=__builtin_amdgcn_mfma_f32_32x32x16_bf16(PAF(0),VFR(0),o[0],0,0,0), C0,0); \
    GAPB(o[1]=__builtin_amdgcn_mfma_f32_32x32x16_bf16(PAF(0),VFR(4),o[1],0,0,0), C0,4); \
    KRD(GL,0); GAPB(o[0]=__builtin_amdgcn_mfma_f32_32x32x16_bf16(PAF(1),VFR(1),o[0],0,0,0), C0,8); \
    KRD(GL,1); GAPB(o[1]=__builtin_amdgcn_mfma_f32_32x32x16_bf16(PAF(1),VFR(5),o[1],0,0,0), C0,12); \
    KRD(GL,2); GAPB(o[0]=__builtin_amdgcn_mfma_f32_32x32x16_bf16(PAF(2),VFR(2),o[0],0,0,0), C1,0); \
    KRD(GL,3); GAPB(o[1]=__builtin_amdgcn_mfma_f32_32x32x16_bf16(PAF(2),VFR(6),o[1],0,0,0), C1,4); \
    GAPB(o[0]=__builtin_amdgcn_mfma_f32_32x32x16_bf16(PAF(3),VFR(3),o[0],0,0,0), C1,8); \
    GAPB(o[1]=__builtin_amdgcn_mfma_f32_32x32x16_bf16(PAF(3),VFR(7),o[1],0,0,0), C1,12); \
    }while(0)
  int t=1;
  for(;t<NT-4;t+=2){
    STEP(pB0,pB1,pA0,pA1,t,true,true,true,false);     WAIT_BAR(2); RESC(); ROT();
    STEP(pA0,pA1,pB0,pB1,t+1,true,true,true,false);   WAIT_BAR(2); RESC(); ROT();
  }
  STEP(pB0,pB1,pA0,pA1,NT-4,true,true,true,true);     WAIT_BAR(2); RESC(); ROT();
  STEP(pA0,pA1,pB0,pB1,NT-3,false,true,true,true);    WAIT_BAR(1); RESC(); ROT();
  STEP(pB0,pB1,pA0,pA1,NT-2,false,true,true,true);    WAIT_BAR(0); RESC(); ROT();
  STEP(pA0,pA1,pB0,pB1,NT-1,false,false,false,true);  RESC();
  { float sacc=pA0[0]+pA0[1]; _Pragma("unroll") for(int r=2;r<16;++r)sacc+=pA0[r]; _Pragma("unroll") for(int r=0;r<16;++r)sacc+=pA1[r]; l_reg+=sacc;
    pw0=(u32x4){PKW(pA0,0),PKW(pA0,2),PKW(pA0,4),PKW(pA0,6)};pw1=(u32x4){PKW(pA0,8),PKW(pA0,10),PKW(pA0,12),PKW(pA0,14)};pw2=(u32x4){PKW(pA1,0),PKW(pA1,2),PKW(pA1,4),PKW(pA1,6)};pw3=(u32x4){PKW(pA1,8),PKW(pA1,10),PKW(pA1,12),PKW(pA1,14)};
    SBAR(); pv(o,vb0+sl_cur,PAF(0),PAF(1),PAF(2),PAF(3)); }
  #undef PKW
  #undef PAF
  #undef VFR
  #undef PIN
  #undef MX3
  #undef GAPA
  #undef GAPB
  #undef EX
  #undef VRD
  #undef KRD
  #undef STEP
  {auto rr=__builtin_amdgcn_permlane32_swap(__float_as_uint(l_reg),__float_as_uint(l_reg),false,false);l_reg=__uint_as_float(rr[0])+__uint_as_float(rr[1]);}
  if(hi==0)wsf[32+r32]=l_reg;asm volatile("s_waitcnt lgkmcnt(0)":::"memory");
  float rli[16];
  #pragma unroll
  for(int r=0;r<16;++r)rli[r]=__builtin_amdgcn_rcpf(wsf[32+crow(r,hi)]);
  { bf16*stg=(bf16*)(shm+LDS_OST)+wid*2048;
    #pragma unroll
    for(int r=0;r<16;++r){const int orow=crow(r,hi);
      #pragma unroll
      for(int d0=0;d0<2;++d0)stg[orow*64+d0*32+r32]=__float2bfloat16(o[d0][r]*rli[r]);}
    asm volatile("s_waitcnt lgkmcnt(0)":::"memory");
    #pragma unroll
    for(int i=0;i<4;++i){const int row=i*8+(lane>>3),ch=lane&7; const u32x4 v=*(const u32x4*)(stg+row*64+ch*8); *(u32x4*)(Ow+(long)row*DM+ch*8)=v;} }
  asm volatile("s_waitcnt lgkmcnt(0)\n\ts_barrier":::"memory");
  #undef DMA_K
  #undef DMA_V
  #undef POST
  #undef POST0
  #undef TROW
  #undef START
  #undef RESC
  #undef ROT
}

#undef SBAR
#undef WAIT_BAR
}

constexpr int NWAVES = 8;
#ifndef MK_N_LAUNCHES
#define MK_N_LAUNCHES 1
#endif
constexpr int N_PHASES = 9;
constexpr int N_LAUNCHES = MK_N_LAUNCHES;

constexpr size_t MiB = 1u << 20;
constexpr size_t WS_CTL = 0, CTL_ZERO_BYTES = 64 * 1024;
constexpr size_t WS_SSQ = 2 * MiB;
constexpr size_t WS_META = 10 * MiB;
constexpr size_t WS_LOGF = 11 * MiB;
constexpr size_t WS_QN2 = 4 * MiB, WS_KN2 = 6 * MiB;
static_assert(WS_QN2 + (size_t)MROWS * 64 <= WS_KN2 && WS_KN2 + (size_t)NKR * 64 <= WS_META, "norm partials map");
constexpr size_t WS_W1 = 16 * MiB, WS_W2 = 27 * MiB, WS_WP = 33 * MiB, WS_WAB = 42 * MiB, WS_WO = 44 * MiB, WS_W3 = 46 * MiB, WS_W4 = 57 * MiB;
constexpr size_t WS_XB = 64 * MiB;
constexpr size_t WS_R = 128 * MiB;
constexpr size_t WS_ACT = WS_R;
constexpr size_t WS_QO = WS_R, WS_KA = WS_R + 64 * MiB, WS_VA = WS_KA + 9 * MiB, WS_KB = WS_VA + 9 * MiB, WS_VB = WS_KB + 34 * MiB,
                 WS_SGA = WS_VB + 34 * MiB, WS_SGB = WS_SGA + 64 * MiB, WS_MIX = WS_SGB + 64 * MiB, WS_END = WS_MIX + 64 * MiB;
static_assert(WS_W1 + (size_t)2 * DFF * DM * 2 <= WS_W2 && WS_W2 + (size_t)DM * DFF * 2 <= WS_WP && WS_WP + (size_t)NPROJ * DM * 2 <= WS_WAB && WS_W3 + (size_t)2 * DFF * DM * 2 <= WS_W4 && WS_W4 + (size_t)DM * DFF * 2 <= WS_XB, "weights map");
static_assert((size_t)NKR * 128 * 2 <= 9 * MiB && (size_t)NKR * 512 * 2 <= 34 * MiB && (size_t)NKR * 8 * 4 <= 2 * MiB && WS_END <= 512 * MiB && WS_ACT + (size_t)MROWS * DFF * 2 <= WS_END, "activation map");
constexpr size_t MT_XB = 0, MT_SSQ0 = 32768, MT_ACT = 65536, MT_H1B = 163840, MT_SSQ1 = 196608, MT_KNM = 204800;
constexpr int CW_BAR = 4096;
constexpr int CW_PANEL = 8192;
static_assert((CW_PANEL + 64 * 128) * 4 <= (int)CTL_ZERO_BYTES, "control words inside the per-call memset");

constexpr int RING_OFF = 0, RING_BYTES = 131072;
constexpr int LDSCTL_OFF = RING_BYTES, MISC_OFF = LDSCTL_OFF + 320;
constexpr int LDS_BYTES = 147456;
static_assert(MISC_OFF + 128 <= LDS_BYTES && attn::LDS_END <= RING_BYTES && attn2::LDS_END <= RING_BYTES, "LDS map");

typedef GAS unsigned gu32;
#define RLX_AGENT __ATOMIC_RELAXED, __HIP_MEMORY_SCOPE_AGENT
#define LDS_WAIT() asm volatile("s_waitcnt lgkmcnt(0)" ::: "memory")
#define VM_WAIT() asm volatile("s_waitcnt vmcnt(0)" ::: "memory")
#define XB_TMO      128
#define XB_XCNT(j)  (256  + 64 * (j))
#define XB_XSUB(j)  (1280 + 64 * (j))
#define XB_XGEN(j)  (2304 + 64 * (j))
#define XB_TOP      3328
#define XB_TOPGEN   3392
#define XCD_BAR_WORDS 3456
#define XB_SPIN_CAP (1u << 18)

__device__ __forceinline__ unsigned xb_ld(unsigned* p)              { return __hip_atomic_load(p, __ATOMIC_RELAXED, __HIP_MEMORY_SCOPE_AGENT); }
__device__ __forceinline__ unsigned xb_add(unsigned* p, unsigned v) { return __hip_atomic_fetch_add(p, v, __ATOMIC_RELAXED, __HIP_MEMORY_SCOPE_AGENT); }
__device__ __forceinline__ unsigned xb_xcc_id() { return (unsigned)__builtin_amdgcn_s_getreg((3 << 11) | 20) & 0xFu; }
#define XB_SPIN(cond, bar) do { unsigned _sp = 0; while (cond) { __builtin_amdgcn_s_sleep(1); \
    if ((++_sp & 255u) == 0u) { if (xb_ld(&(bar)[XB_TMO])) break; if (_sp > XB_SPIN_CAP) { atomicAdd(&(bar)[XB_TMO], 1u); break; } } } } while (0)

struct XcdBarrier {
    unsigned* bar; unsigned x;
    volatile LAS unsigned* st;
};

__device__ __forceinline__ XcdBarrier xcd_barrier_post(unsigned* bar, volatile LAS unsigned* st) {
    XcdBarrier b; b.bar = bar; b.x = xb_xcc_id(); b.st = st;
    if (threadIdx.x == 0) (void)xb_add(&bar[XB_XCNT(b.x)], 1u);
    return b;
}
__device__ __forceinline__ void xcd_barrier_complete(unsigned* bar, unsigned x, unsigned& nloc, unsigned& nx) {
    const unsigned G = gridDim.x * gridDim.y * gridDim.z;
    unsigned sum, cnt, mine, sp = 0u;
    for (;;) {
        sum = 0u; cnt = 0u; mine = 0u;
#pragma unroll
        for (unsigned j = 0; j < 16; ++j) { const unsigned c = xb_ld(&bar[XB_XCNT(j)]); sum += c; cnt += (c > 0u) ? 1u : 0u; mine = (j == x) ? c : mine; }
        if (sum == G) break;
        __builtin_amdgcn_s_sleep(1);
        if ((++sp & 255u) == 0u) { if (xb_ld(&bar[XB_TMO])) break; if (sp > XB_SPIN_CAP) { atomicAdd(&bar[XB_TMO], 1u); break; } }
    }
    nloc = mine > 0u ? mine : 1u; nx = cnt > 0u ? cnt : 1u;
}

__device__ __forceinline__ void xcd_barrier(const XcdBarrier& b) {
    asm volatile("s_waitcnt vmcnt(0)" ::: "memory");
    __syncthreads();
    if (threadIdx.x == 0) {
        unsigned* bar = b.bar;
        __builtin_amdgcn_s_waitcnt(0);
        unsigned nloc = b.st[0], nx = b.st[1];
        if (nloc == 0u) { xcd_barrier_complete(bar, b.x, nloc, nx); b.st[0] = nloc; b.st[1] = nx; }
        const unsigned old = xb_add(&bar[XB_XSUB(b.x)], 1u);
        const unsigned gen = old / nloc;
        if (old + 1u == (gen + 1u) * nloc) {
            __builtin_amdgcn_fence(__ATOMIC_RELEASE, "agent");
            asm volatile("s_waitcnt vmcnt(0)" ::: "memory");
            const unsigned og = xb_add(&bar[XB_TOP], 1u);
            const unsigned tg = og / nx;
            if (og + 1u == (tg + 1u) * nx) xb_add(&bar[XB_TOPGEN], 1u);
            else XB_SPIN(xb_ld(&bar[XB_TOPGEN]) == tg, bar);
            __builtin_amdgcn_fence(__ATOMIC_ACQUIRE, "agent");
            xb_add(&bar[XB_XGEN(b.x)], 1u);
            asm volatile("s_waitcnt vmcnt(0)" ::: "memory");
        } else {
            asm volatile("buffer_inv sc1" ::: "memory");
            XB_SPIN(xb_ld(&bar[XB_XGEN(b.x)]) == gen, bar);
            asm volatile("s_waitcnt vmcnt(0)" ::: "memory");
        }
    }
    __syncthreads();
}

struct Frame {
    LAS unsigned char* lds;
    volatile LAS unsigned* MISC;
    gu32* ctl;
    int tid, lane, wave;
    int vcu, G;
    unsigned char* ws;
    const float* in[16]; float* out;
};
__device__ __forceinline__ float wave_sum(float v) {
#pragma unroll
    for (int o = 1; o < 64; o <<= 1) v += __shfl_xor(v, o);
    return v;
}
__device__ __forceinline__ void tr_item(const float* W, int ldw, int k0, int c0, int ncols, const float* gain, bf16_t* WT, int ldt, int drow0, int dk0, LAS float* scr, int lane) {
    float v[32]; const int col = lane & 31, kh = lane >> 5;
    const float* wp = W + (size_t)(k0 + kh) * ldw + c0 + (col < ncols ? col : 0);
#pragma unroll
    for (int i = 0; i < 32; ++i) v[i] = wp[(size_t)(2 * i) * ldw];
    if (gain) {
#pragma unroll
        for (int i = 0; i < 32; ++i) v[i] *= gain[k0 + 2 * i + kh];
    }
#pragma unroll
    for (int i = 0; i < 32; ++i) scr[(2 * i + kh) * 33 + col] = v[i];
    LDS_WAIT(); asm volatile("" ::: "memory");
    const int c = lane & 7;
#pragma unroll
    for (int j = 0; j < 4; ++j) { const int n = (lane >> 3) + 8 * j; const LAS float* s = scr + (8 * c) * 33 + n;
        u32x4 o; o.x = cvt_pk_bf16(s[0 * 33], s[1 * 33]); o.y = cvt_pk_bf16(s[2 * 33], s[3 * 33]); o.z = cvt_pk_bf16(s[4 * 33], s[5 * 33]); o.w = cvt_pk_bf16(s[6 * 33], s[7 * 33]);
        if (n < ncols) *(GAS u32x4*)(WT + (size_t)(drow0 + n) * ldt + dk0 + k0 + 8 * c) = o; }
    LDS_WAIT(); asm volatile("" ::: "memory");
}
__device__ __forceinline__ int swiglu_row(int c0) { const int up = c0 >= DFF, c = up ? c0 - DFF : c0; return 256 * (c / 128) + (up ? 128 : 0) + (c % 128); }
__device__ __forceinline__ void row_to_bf16(const float* xrow, bf16_t* orow, float* ssq16, int lane) {
    const GAS f32x4* xr = (const GAS f32x4*)xrow + lane;
    f32x4 v[4]; float s = 0.f;
#pragma unroll
    for (int j = 0; j < 4; ++j) { v[j] = xr[64 * j]; s += (v[j].x * v[j].x + v[j].y * v[j].y) + (v[j].z * v[j].z + v[j].w * v[j].w); }
    s = wave_sum(s);
    GAS u32x2* o8 = (GAS u32x2*)orow + lane;
#pragma unroll
    for (int j = 0; j < 4; ++j) { u32x2 w; w.x = cvt_pk_bf16(v[j].x, v[j].y); w.y = cvt_pk_bf16(v[j].z, v[j].w); o8[64 * j] = w; }
    if (ssq16 && lane < 16) ssq16[lane] = lane == 0 ? s : 0.f;
}
__device__ __forceinline__ void zero_bytes(Frame& F, void* p, size_t nbytes) {
    const size_t n16 = nbytes / 16; GAS u32x4* q = (GAS u32x4*)p;
    for (size_t i = (size_t)F.vcu * 512 + F.tid; i < n16; i += (size_t)F.G * 512) q[i] = (u32x4){0u, 0u, 0u, 0u};
}
__device__ __forceinline__ void p0_prologue(Frame& F, int part = 0) {
    LAS float* scr = (LAS float*)(F.lds + RING_OFF + F.wave * 16384);
    const int gw = F.vcu * NWAVES + F.wave, NGW = F.G * NWAVES;
    unsigned char* ws = F.ws;
    bf16_t *W1t = (bf16_t*)(ws + WS_W1), *W2t = (bf16_t*)(ws + WS_W2), *Wpt = (bf16_t*)(ws + WS_WP), *Wabt = (bf16_t*)(ws + WS_WAB), *Wot = (bf16_t*)(ws + WS_WO), *W3t = (bf16_t*)(ws + WS_W3), *W4t = (bf16_t*)(ws + WS_W4);
    constexpr int I0 = 16 * 176, I1 = 44 * 32, I2 = 16 * 72, I3 = 16 * 64, I4 = 16, I5 = 8 * 32, I6 = 8 * 32, I7 = 16 * 32, I8 = I0, I9 = I1;
    constexpr int NITEMS = I0 + I1 + I2 + I3 + I4 + I5 + I6 + I7 + I8 + I9;
    if (part != 2) for (int it = gw; it < NITEMS; it += NGW) {
        int r = it;
        if (r < I0) { const int kb = r / 176, nb = r % 176; tr_item(F.in[3], 2 * DFF, 64 * kb, 32 * nb, 32, F.in[2], W1t, DM, swiglu_row(32 * nb), 0, scr, F.lane); continue; } r -= I0;
        if (r < I1) { const int kb = r / 32, nb = r % 32; tr_item(F.in[4], DM, 64 * kb, 32 * nb, 32, nullptr, W2t, DFF, 32 * nb, 0, scr, F.lane); continue; } r -= I1;
        if (r < I2) { const int kb = r / 72, nb = r % 72; tr_item(F.in[6], 4360, 64 * kb, 32 * nb, 32, F.in[5], Wpt, DM, 32 * nb, 0, scr, F.lane); continue; } r -= I2;
        if (r < I3) { const int kb = r / 64, nb = r % 64, gb = nb >= 32, cb = gb ? nb - 32 : nb;
            tr_item(F.in[6], 4360, 64 * kb, 2312 + 32 * nb, 32, F.in[5], Wpt, DM, 2304 + 256 * (cb / 4) + (gb ? 128 : 0) + 32 * (cb % 4), 0, scr, F.lane); continue; } r -= I3;
        if (r < I4) { tr_item(F.in[6], 4360, 64 * r, 2304, 8, F.in[5], Wpt, DM, 4352, 0, scr, F.lane); continue; } r -= I4;
        if (r < I5) { const int kb = r / 32, nb = r % 32; tr_item(F.in[9], DM, 64 * kb, 32 * nb, 32, nullptr, Wabt, DM, 32 * nb, 0, scr, F.lane); continue; } r -= I5;
        if (r < I6) { const int kb = r / 32, nb = r % 32; tr_item(F.in[10], DM, 64 * kb, 32 * nb, 32, nullptr, Wabt, DM, 32 * nb, 512, scr, F.lane); continue; } r -= I6;
        if (r < I7) { const int kb = r / 32, nb = r % 32; tr_item(F.in[11], DM, 64 * kb, 32 * nb, 32, nullptr, Wot, DM, 32 * nb, 0, scr, F.lane); continue; } r -= I7;
        if (r < I8) { const int kb = r / 176, nb = r % 176; tr_item(F.in[13], 2 * DFF, 64 * kb, 32 * nb, 32, F.in[12], W3t, DM, swiglu_row(32 * nb), 0, scr, F.lane); continue; } r -= I8;
        { const int kb = r / 32, nb = r % 32; tr_item(F.in[14], DM, 64 * kb, 32 * nb, 32, nullptr, W4t, DFF, 32 * nb, 0, scr, F.lane); }
    }
    bf16_t* XB = (bf16_t*)(ws + WS_XB); float* SSQ = (float*)(ws + WS_SSQ);
    if (part != 1) for (int m0 = gw * 4; m0 < MROWS; m0 += NGW * 4) {
        f32x4 v[4][4]; float sq[4];
#pragma unroll
        for (int r = 0; r < 4; ++r)
#pragma unroll
            for (int j = 0; j < 4; ++j) v[r][j] = ((const GAS f32x4*)(F.in[0] + (size_t)(m0 + r) * DM))[64 * j + F.lane];
#pragma unroll
        for (int r = 0; r < 4; ++r) { float s_ = 0.f;
#pragma unroll
            for (int j = 0; j < 4; ++j) s_ += (v[r][j].x * v[r][j].x + v[r][j].y * v[r][j].y) + (v[r][j].z * v[r][j].z + v[r][j].w * v[r][j].w);
            sq[r] = wave_sum(s_); }
#pragma unroll
        for (int r = 0; r < 4; ++r) { GAS u32x2* o8 = (GAS u32x2*)(XB + (size_t)(m0 + r) * DM) + F.lane;
#pragma unroll
            for (int j = 0; j < 4; ++j) { u32x2 w; w.x = cvt_pk_bf16(v[r][j].x, v[r][j].y); w.y = cvt_pk_bf16(v[r][j].z, v[r][j].w); o8[64 * j] = w; } }
        if (F.lane < 16) {
#pragma unroll
            for (int r = 0; r < 4; ++r) SSQ[(size_t)(m0 + r) * 16 + F.lane] = F.lane == 0 ? sq[r] : 0.f; }
    }
    if (gw < NMETA) row_to_bf16(F.in[1] + (size_t)gw * DM, (bf16_t*)(ws + WS_META + MT_XB) + (size_t)gw * DM, (float*)(ws + WS_META + MT_SSQ0) + gw * 16, F.lane);
    zero_bytes(F, Wpt + (size_t)4360 * DM, (size_t)(NPROJ - 4360) * DM * 2);
    for (int b = 0; b < NBATCH; ++b) {
        zero_bytes(F, (bf16_t*)(ws + WS_KA) + (size_t)b * LPOS * 128, (size_t)KR_META * 128 * 2);
        zero_bytes(F, (bf16_t*)(ws + WS_VA) + (size_t)b * LPOS * 128, (size_t)KR_META * 128 * 2);
        zero_bytes(F, (bf16_t*)(ws + WS_KB) + (size_t)b * LPOS * 512, (size_t)KR_META * 512 * 2);
        zero_bytes(F, (bf16_t*)(ws + WS_VB) + (size_t)b * LPOS * 512, (size_t)KR_META * 512 * 2);
    }
}
__device__ __forceinline__ f32x4 meta_partial(const bf16_t* Wr, int ldw, const bf16_t* X, int ldx, int K, int wid, int lane) {
    const int i = lane & 15, q = lane >> 4; f32x4 acc = (f32x4){0.f, 0.f, 0.f, 0.f};
    for (int s = wid; s < K / 32; s += NWAVES) {
        const bf16x8 a = *(const bf16x8*)(Wr + (size_t)i * ldw + s * 32 + q * 8), b = *(const bf16x8*)(X + (size_t)i * ldx + s * 32 + q * 8);
        acc = __builtin_amdgcn_mfma_f32_16x16x32_bf16(a, b, acc, 0, 0, 0);
    }
    return acc;
}
__device__ __forceinline__ f32x4 meta_reduce(Frame& F, f32x4 part, int blk) {
    LAS f32x4* scr = (LAS f32x4*)(F.lds + RING_OFF + blk * 8192);
    scr[F.wave * 64 + F.lane] = part;
    __syncthreads();
    f32x4 s = scr[F.lane];
#pragma unroll
    for (int w = 1; w < NWAVES; ++w) s += scr[w * 64 + F.lane];
    __syncthreads();
    return s;
}
__device__ __forceinline__ void meta_up(Frame& F) {
    if (F.vcu >= DFF / 16) return;
    unsigned char* ws = F.ws; const int c = F.vcu, j = F.lane & 15, q = F.lane >> 4;
    const bf16_t* W1t = (const bf16_t*)(ws + WS_W1); const bf16_t* X = (const bf16_t*)(ws + WS_META + MT_XB);
    const int grow = 256 * (c / 8) + 16 * (c % 8);
    f32x4 g = meta_partial(W1t + (size_t)grow * DM, DM, X, DM, DM, F.wave, F.lane);
    f32x4 u = meta_partial(W1t + (size_t)(grow + 128) * DM, DM, X, DM, DM, F.wave, F.lane);
    g = meta_reduce(F, g, 0); u = meta_reduce(F, u, 1);
    if (F.wave == 0) {
        const float rs = 1.0f / sqrtf(((const float*)(ws + WS_META + MT_SSQ0))[j * 16] * (1.0f / 1024.0f) + EPS);
        float o[4];
#pragma unroll
        for (int e = 0; e < 4; ++e) { const float gg = g[e] * rs, uu = u[e] * rs; o[e] = gg * pg8::fast_sigmoid(gg) * uu; }
        u32x2 w; w.x = cvt_pk_bf16(o[0], o[1]); w.y = cvt_pk_bf16(o[2], o[3]);
        *(u32x2*)((bf16_t*)(ws + WS_META + MT_ACT) + (size_t)j * DFF + 16 * c + 4 * q) = w;
    }
}
__device__ __forceinline__ void meta_down(Frame& F) {
    if (F.vcu >= DM / 16) return;
    unsigned char* ws = F.ws; const int c = F.vcu, j = F.lane & 15, q = F.lane >> 4;
    const bf16_t* W2t = (const bf16_t*)(ws + WS_W2); const bf16_t* X = (const bf16_t*)(ws + WS_META + MT_ACT);
    f32x4 d = meta_partial(W2t + (size_t)(16 * c) * DFF, DFF, X, DFF, DFF, F.wave, F.lane);
    d = meta_reduce(F, d, 0);
    if (F.wave == 0) {
        const f32x4 base = *(const f32x4*)(F.in[1] + (size_t)j * DM + 16 * c + 4 * q);
        const f32x4 v = base + d * 0.5f;
        u32x2 w; w.x = cvt_pk_bf16(v[0], v[1]); w.y = cvt_pk_bf16(v[2], v[3]);
        *(u32x2*)((bf16_t*)(ws + WS_META + MT_H1B) + (size_t)j * DM + 16 * c + 4 * q) = w;
        float sq = (v[0] * v[0] + v[1] * v[1]) + (v[2] * v[2] + v[3] * v[3]);
        sq += __shfl_xor(sq, 16); sq += __shfl_xor(sq, 32);
        if (q == 0) ((float*)(ws + WS_META + MT_SSQ1))[j * 64 + c] = sq;
    }
}
__device__ __forceinline__ void meta_proj(Frame& F) {
    if (F.vcu >= 81) return;
    unsigned char* ws = F.ws; const int g = F.vcu, j = F.lane & 15, q = F.lane >> 4;
    const bf16_t* Wpt = (const bf16_t*)(ws + WS_WP); const bf16_t* X = (const bf16_t*)(ws + WS_META + MT_H1B);
    int prow; bf16_t* dst; int pitch, col;
    if (g < 8)       { prow = 512 + 16 * g;         dst = (bf16_t*)(ws + WS_KA); pitch = 128; col = 16 * g; }
    else if (g < 16) { prow = 640 + 16 * (g - 8);   dst = (bf16_t*)(ws + WS_VA); pitch = 128; col = 16 * (g - 8); }
    else if (g < 48) { prow = 1280 + 16 * (g - 16); dst = (bf16_t*)(ws + WS_KB); pitch = 512; col = 16 * (g - 16); }
    else if (g < 80) { prow = 1792 + 16 * (g - 48); dst = (bf16_t*)(ws + WS_VB); pitch = 512; col = 16 * (g - 48); }
    else             { prow = 4352;                 dst = nullptr; pitch = 0; col = 0; }
    f32x4 d = meta_partial(Wpt + (size_t)prow * DM, DM, X, DM, DM, F.wave, F.lane);
    d = meta_reduce(F, d, 0);
    if (F.wave == 0) {
        const float* s1 = (const float*)(ws + WS_META + MT_SSQ1) + j * 64 + 16 * q;
        const f32x4 a0 = *(const f32x4*)s1, a1 = *(const f32x4*)(s1 + 4), a2 = *(const f32x4*)(s1 + 8), a3 = *(const f32x4*)(s1 + 12);
        float s = ((a0[0] + a0[1]) + (a0[2] + a0[3])) + ((a1[0] + a1[1]) + (a1[2] + a1[3])) + ((a2[0] + a2[1]) + (a2[2] + a2[3])) + ((a3[0] + a3[1]) + (a3[2] + a3[3]));
        s += __shfl_xor(s, 16); s += __shfl_xor(s, 32);
        const float rs = 1.0f / sqrtf(s * (1.0f / 1024.0f) + EPS);
        const f32x4 v = d * rs;
        if (dst) {
            u32x2 w; w.x = cvt_pk_bf16(v[0], v[1]); w.y = cvt_pk_bf16(v[2], v[3]);
            for (int b = 0; b < NBATCH; ++b) *(u32x2*)(dst + (size_t)(b * LPOS + KR_META + j) * pitch + col + 4 * q) = w;
            if (g >= 16 && g < 48) {
                float s2 = (v[0] * v[0] + v[1] * v[1]) + (v[2] * v[2] + v[3] * v[3]);
                s2 += __shfl_xor(s2, 16); s2 += __shfl_xor(s2, 32);
                if (q == 0) ((float*)(ws + WS_META + MT_KNM))[(j * 8 + ((g - 16) >> 2)) * 4 + ((g - 16) & 3)] = s2;
            }
        } else if (q < 2) {
            const f32x4 bb = *(const f32x4*)(F.in[7] + 4 * q); f32x4 lf;
#pragma unroll
            for (int e = 0; e < 4; ++e) { const float x = v[e] + bb[e]; lf[e] = fminf(x, 0.f) - log1pf(expf(-fabsf(x))); }
            float* L = (float*)(ws + WS_LOGF);
            for (int b = 0; b < NBATCH; ++b) *(f32x4*)(L + (size_t)(b * LPOS + KR_META + j) * 8 + 4 * q) = lf;
        }
    }
}
__device__ __forceinline__ void attn_phase(Frame& F, char* shm, bf16_t* OB, int only) {
    unsigned char* ws = F.ws;
    bf16_t* QO = (bf16_t*)(ws + WS_QO);
    const bf16_t *KA = (const bf16_t*)(ws + WS_KA), *VA = (const bf16_t*)(ws + WS_VA), *KB = (const bf16_t*)(ws + WS_KB), *VB = (const bf16_t*)(ws + WS_VB);
    const float* LOGF = (const float*)(ws + WS_LOGF); const float* QN2 = (const float*)(ws + WS_QN2); const float* KN2 = (const float*)(ws + WS_KN2);
    float* cl = (float*)(shm + attn2::LDS_CL); float* wtot = (float*)(shm + attn2::LDS_SCAN);
    if (only != 2 && only != 4) for (int s = F.vcu; s < NBATCH * 8 * 2; s += F.G) {
        const int bh = s >> 1, half = s & 1, b = bh >> 3, h = bh & 7; float kmax2 = 0.f;
        { float v[5]; float run = 0.f; int ln = F.lane; asm volatile("" : "+v"(ln));
#pragma unroll
          for (int k = 0; k < 5; ++k) { const int e = F.tid * 5 + k; const float x = (e < 2064) ? LOGF[(size_t)(b * LPOS + KR_META + e) * 8 + h] : 0.f; run += x; v[k] = run; }
          float inc = run;
#pragma unroll
          for (int o = 1; o < 64; o <<= 1) { const float y = __shfl_up(inc, o); if (ln >= o) inc += y; }
          float km = 0.f;
#pragma unroll
          for (int k = 0; k < 5; ++k) { const int e = F.tid * 5 + k;
              if (e >= NMETA && e < 2064) { const float* kp2 = KN2 + (size_t)(b * LPOS + KR_META + e) * 16 + 2 * h; km = fmaxf(km, kp2[0] + kp2[1]); }
              else if (e < NMETA) { const float* kq = (const float*)(ws + WS_META + MT_KNM) + (e * 8 + h) * 4; km = fmaxf(km, (kq[0] + kq[1]) + (kq[2] + kq[3])); } }
#pragma unroll
          for (int o = 1; o < 64; o <<= 1) km = fmaxf(km, __shfl_xor(km, o));
          float qm4[4];
#pragma unroll
          for (int i = 0; i < 4; ++i) { const int jq = half == 0 ? (i == 0 ? 0 : i == 1 ? 7 : i == 2 ? 3 : 4) : (i == 0 ? 1 : i == 1 ? 6 : i == 2 ? 2 : 5);
              if (F.tid < 256) { const float* qp2 = QN2 + (size_t)(b * SEQ + 256 * jq + F.tid) * 16 + 2 * h; qm4[i] = qp2[0] + qp2[1]; } else qm4[i] = 0.f; }
#pragma unroll
          for (int i = 0; i < 4; ++i) {
#pragma unroll
              for (int o = 1; o < 64; o <<= 1) qm4[i] = fmaxf(qm4[i], __shfl_xor(qm4[i], o)); }
          if (ln == 63) { wtot[F.wave] = inc; wtot[8 + F.wave] = km;
#pragma unroll
              for (int i = 0; i < 4; ++i) wtot[16 + i * 8 + F.wave] = qm4[i]; }
          __syncthreads();
          kmax2 = wtot[8];
          for (int w = 1; w < NWAVES; ++w) kmax2 = fmaxf(kmax2, wtot[8 + w]);
          float woff = 0.f;
          for (int w = 0; w < F.wave; ++w) woff += wtot[w];
          const float ex = inc - run + woff;
#pragma unroll
          for (int k = 0; k < 5; ++k) { const int e = F.tid * 5 + k; if (e < 2064) cl[e] = (v[k] + ex) * LOG2E; }
          __syncthreads(); }
        for (int i = 0; i < 4; ++i) {
            const int jj = half == 0 ? (i == 0 ? 0 : i == 1 ? 7 : i == 2 ? 3 : 4) : (i == 0 ? 1 : i == 1 ? 6 : i == 2 ? 2 : 5);
            const int t0 = 256 * jj + 32 * F.wave;
            int fskip = 0;
            { float qmax2 = wtot[16 + i * 8];
              for (int w = 1; w < 4; ++w) qmax2 = fmaxf(qmax2, wtot[16 + i * 8 + w]);
              const float bound = 2.05f * sqrtf(qmax2 * kmax2) + cl[16 + 256 * jj];
              for (int T = 1; T <= 4 * jj; ++T) { if (bound - cl[79 + 64 * (T - 1)] < -152.f) fskip = T + 1; else break; }
              fskip &= ~1; }
            const int row0 = fskip ? KR_REAL + 64 * (fskip - 1) : 64, kb2 = KR_REAL + 64 * fskip, nt2 = 4 * jj + 5 - fskip;
#if defined(DBG_SKIP)
            if (blockIdx.x == 0 && F.tid == 0 && jj == 7) ((float*)(ws + WS_META + 262144))[0] = (float)fskip;
#endif
            bf16_t* qw = QO + (size_t)(b * SEQ + t0) * DM + 512 + h * 64;
            attn2::unit2<0, 8>((const attn2::bf16*)qw, (attn2::bf16*)(OB + (qw - QO)), (const attn2::bf16*)(KB + (size_t)b * LPOS * 512 + h * 64), (const attn2::bf16*)(VB + (size_t)b * LPOS * 512 + h * 64), 512, nt2, row0, kb2, KR_REAL + t0, 32 * F.wave, 0.f, 0.f, cl, shm);
        }
        __syncthreads();
    }
    if (only != 1) for (int s = F.vcu; s < 256; s += F.G) {
        for (int i = 0; i < 4; ++i) {
            const int a = s * 4 + i, b = a >> 6, rem = a & 63, n = rem >> 2, kvh = (rem >> 1) & 1, pair = rem & 1;
            const int head = kvh * 4 + pair * 2 + (F.wave >> 2), t0 = 128 * n + 32 * (F.wave & 3);
            bf16_t* qw = QO + (size_t)(b * SEQ + t0) * DM + head * 64;
            const float slope2 = exp2f(-(float)(head + 1)) * LOG2E, sink2 = F.in[8][head] * LOG2E;
            attn::unit_swa2(qw, OB + (qw - QO), KA + (size_t)b * LPOS * 128 + kvh * 64, VA + (size_t)b * LPOS * 128 + kvh * 64, 128, 128 * n, KR_REAL + t0, slope2, sink2, shm);
        }
    }
}
__device__ __forceinline__ void final_norm(Frame& F) {
    const int gw = F.vcu * NWAVES + F.wave, NGW = F.G * NWAVES;
    const float* SSQ = (const float*)(F.ws + WS_SSQ);
    f32x4 gf[4];
#pragma unroll
    for (int j = 0; j < 4; ++j) gf[j] = ((const f32x4*)F.in[15])[64 * j + F.lane];
    for (int m = gw; m < MROWS; m += NGW) {
        const f32x4 p = *(const f32x4*)(SSQ + (size_t)m * 16 + 4 * (F.lane & 3));
        float s = (p[0] + p[1]) + (p[2] + p[3]); s += __shfl_xor(s, 1); s += __shfl_xor(s, 2);
        const float rs = 1.0f / sqrtf(s * (1.0f / 1024.0f) + EPS);
        GAS f32x4* xr = (GAS f32x4*)(F.out + (size_t)m * DM) + F.lane;
#pragma unroll
        for (int j = 0; j < 4; ++j) { const f32x4 v = xr[64 * j]; xr[64 * j] = v * rs * gf[j]; }
    }
}

#ifndef EXP_ATTN_ONLY
#define EXP_ATTN_ONLY 0
#endif
#ifndef EXP_P0_PART
#define EXP_P0_PART 0
#endif
struct Args { const float* in[16]; float* out; unsigned char* ws; int ph_lo, ph_hi, alt, pad; };
__global__ void __launch_bounds__(NWAVES * 64, 2) fwd_kernel(Args args) {
    extern __shared__ __attribute__((aligned(16))) unsigned char lds[];
    Frame F;
    F.lds = (LAS unsigned char*)lds;
    F.MISC = (volatile LAS unsigned*)(F.lds + MISC_OFF);
    F.tid = threadIdx.x; F.lane = F.tid & 63; F.wave = __builtin_amdgcn_readfirstlane(F.tid >> 6);
    F.G = gridDim.x; { const int bx = blockIdx.x; F.vcu = (F.G % 8 == 0) ? (bx % 8) * (F.G / 8) + bx / 8 : bx; }
    F.ws = args.ws; F.out = args.out;
#pragma unroll
    for (int i = 0; i < 16; ++i) F.in[i] = args.in[i];
    F.ctl = (gu32*)(F.ws + WS_CTL);
    for (int u = F.tid; u < (LDS_BYTES - LDSCTL_OFF) / 4; u += NWAVES * 64) ((LAS unsigned*)(F.lds + LDSCTL_OFF))[u] = 0u;
    __syncthreads();
    XcdBarrier bar; bar.bar = (unsigned*)(F.ctl + CW_BAR); bar.x = 0; bar.st = nullptr;
    if (N_LAUNCHES == 1) bar = xcd_barrier_post((unsigned*)(F.ctl + CW_BAR), F.MISC + 8);
#if defined(DBG_BAR2)
#define GRID_BAR() do { if (N_LAUNCHES == 1) { xcd_barrier(bar); xcd_barrier(bar); } } while (0)
#else
#define GRID_BAR() do { if (N_LAUNCHES == 1) xcd_barrier(bar); } while (0)
#endif
    const int lo = args.ph_lo, hi = args.ph_hi;
#define IN(k) (lo <= (k) && (k) < hi)
#define BOTH(k) (IN(k) && IN((k) + 1))
#define ENDBAR(k) do { if (BOTH(k)) GRID_BAR(); } while (0)
    unsigned char* ws = F.ws;
    bf16_t* XB = (bf16_t*)(ws + WS_XB); bf16_t* ACT = (bf16_t*)(ws + WS_ACT); float* SSQ = (float*)(ws + WS_SSQ);
    const int bx = (int)blockIdx.x;
    LAS float* rsc = (LAS float*)(F.lds + LDSCTL_OFF + 4096);
#define RSC_RESET() do { if (F.tid < 8) ((LAS int*)(rsc + 1024))[F.tid] = 0; __syncthreads(); } while (0)
#if defined(DBG_PH)
    unsigned long long ph_c0 = 0, ph_r0 = 0, ph_c1 = 0, ph_r1 = 0;
#define STAMP0(k) do { if ((k) == DBG_PH) { ph_c0 = __builtin_amdgcn_s_memtime(); ph_r0 = __builtin_amdgcn_s_memrealtime(); asm volatile("s_waitcnt lgkmcnt(0)" ::: "memory"); } } while (0)
#define STAMP1(k) do { if ((k) == DBG_PH) { ph_c1 = __builtin_amdgcn_s_memtime(); ph_r1 = __builtin_amdgcn_s_memrealtime(); asm volatile("s_waitcnt lgkmcnt(0)" ::: "memory"); } } while (0)
#else
#define STAMP0(k) do {} while (0)
#define STAMP1(k) do {} while (0)
#endif

    if (IN(0)) { STAMP0(0); p0_prologue(F, args.alt ? EXP_P0_PART : 0); STAMP1(0); ENDBAR(0); }

#if defined(DBG_CLOCK)
    unsigned long long dbg_c0 = 0, dbg_r0 = 0, dbg_c1 = 0, dbg_r1 = 0;
#endif
    if (IN(1)) { STAMP0(1);
        meta_up(F);
        pg8::Gemm g{XB, (const bf16_t*)(ws + WS_W1), DM, DM, DM}; pg8::StaticOrder S; S.init(MROWS, 2 * DFF, F.G, bx);
        pg8::EpiSwiGLU E{ACT, SSQ, rsc}; RSC_RESET();
#if defined(DBG_CLOCK)
        dbg_c0 = __builtin_amdgcn_s_memtime(); dbg_r0 = __builtin_amdgcn_s_memrealtime(); asm volatile("s_waitcnt lgkmcnt(0)" ::: "memory");
#endif
#if defined(EXP_NULL_EPI)
        if (args.alt) { pg8::EpiNull EN; pg8::gemm_phase<pg8::EpiNull, pg8::StaticOrder, true, true>(F.lds + RING_OFF, g, S, EN); } else
#endif
        pg8::gemm_phase<pg8::EpiSwiGLU, pg8::StaticOrder, true, true>(F.lds + RING_OFF, g, S, E);
#if defined(DBG_CLOCK)
        dbg_c1 = __builtin_amdgcn_s_memtime(); dbg_r1 = __builtin_amdgcn_s_memrealtime(); asm volatile("s_waitcnt lgkmcnt(0)" ::: "memory");
#endif
        STAMP1(1); ENDBAR(1);
    }
    if (IN(2)) { STAMP0(2);
        meta_down(F);
        pg8::Gemm g{ACT, (const bf16_t*)(ws + WS_W2), DFF, DFF, DFF}; pg8::StaticOrder S; S.init(MROWS, DM, F.G, bx);
        pg8::EpiResB<false> E{XB, XB, SSQ, 0.5f};
#if defined(EXP_NULL_EPI)
        if (args.alt) { pg8::EpiNull EN; pg8::gemm_phase<pg8::EpiNull, pg8::StaticOrder, true, true>(F.lds + RING_OFF, g, S, EN); } else
#endif
        pg8::gemm_phase<pg8::EpiResB<false>, pg8::StaticOrder, true, true>(F.lds + RING_OFF, g, S, E);
        STAMP1(2); ENDBAR(2);
    }
    if (IN(3)) { STAMP0(3);
        meta_proj(F);
        pg8::Gemm g{XB, (const bf16_t*)(ws + WS_WP), DM, DM, DM}; pg8::StaticOrder S; S.init(MROWS, NPROJ, F.G, bx);
        pg8::EpiProj E{SSQ, (bf16_t*)(ws + WS_QO), (bf16_t*)(ws + WS_KA), (bf16_t*)(ws + WS_VA), (bf16_t*)(ws + WS_KB), (bf16_t*)(ws + WS_VB), (bf16_t*)(ws + WS_SGA), (bf16_t*)(ws + WS_SGB), (float*)(ws + WS_LOGF), F.in[7], (float*)(ws + WS_QN2), (float*)(ws + WS_KN2), rsc}; RSC_RESET();
#if defined(EXP_NULL_EPI)
        if (args.alt) { pg8::EpiNull EN; pg8::gemm_phase<pg8::EpiNull, pg8::StaticOrder, true, true>(F.lds + RING_OFF, g, S, EN); } else
#elif defined(EXP_PROJX)
        if (args.alt) { pg8::EpiProjX<EXP_PROJX> EX{SSQ, (bf16_t*)(ws + WS_QO)}; pg8::gemm_phase<pg8::EpiProjX<EXP_PROJX>, pg8::StaticOrder, true, true>(F.lds + RING_OFF, g, S, EX); } else
#endif
        pg8::gemm_phase<pg8::EpiProj, pg8::StaticOrder, true, true>(F.lds + RING_OFF, g, S, E);
        STAMP1(3); ENDBAR(3);
    }
    if (IN(4)) { STAMP0(4); attn_phase(F, (char*)lds + RING_OFF, args.alt ? (bf16_t*)(ws + WS_MIX) : (bf16_t*)(ws + WS_QO), args.alt ? EXP_ATTN_ONLY : 0); STAMP1(4); ENDBAR(4); }

    if (IN(5)) { STAMP0(5);
        pg8::Gemm g{(const bf16_t*)(ws + WS_QO), (const bf16_t*)(ws + WS_WAB), DM, DM, DM}; pg8::StaticOrder S; S.init(MROWS, DM, F.G, bx);
        pg8::EpiMix E{(const bf16_t*)(ws + WS_SGA), (const bf16_t*)(ws + WS_SGB), (bf16_t*)(ws + WS_MIX)};
        pg8::gemm_phase<pg8::EpiMix, pg8::StaticOrder, true, true>(F.lds + RING_OFF, g, S, E);
        STAMP1(5); ENDBAR(5);
    }
    if (IN(6)) { STAMP0(6);
        pg8::Gemm g{(const bf16_t*)(ws + WS_MIX), (const bf16_t*)(ws + WS_WO), DM, DM, DM}; pg8::StaticOrder S; S.init(MROWS, DM, F.G, bx);
        pg8::EpiResB<false> E{XB, XB, SSQ, 1.0f};
        pg8::gemm_phase<pg8::EpiResB<false>, pg8::StaticOrder, true, true>(F.lds + RING_OFF, g, S, E);
        STAMP1(6); ENDBAR(6);
    }
    if (IN(7)) { STAMP0(7);
        pg8::Gemm g{XB, (const bf16_t*)(ws + WS_W3), DM, DM, DM}; pg8::StaticOrder S; S.init(MROWS, 2 * DFF, F.G, bx);
        pg8::EpiSwiGLU E{ACT, SSQ, rsc}; RSC_RESET();
        pg8::gemm_phase<pg8::EpiSwiGLU, pg8::StaticOrder, true, true>(F.lds + RING_OFF, g, S, E);
        STAMP1(7); ENDBAR(7);
    }
    if (IN(8)) { STAMP0(8);
        pg8::Gemm g{ACT, (const bf16_t*)(ws + WS_W4), DFF, DFF, DFF}; pg8::StaticOrder S; S.init(MROWS, DM, F.G, bx);
        pg8::EpiFinal E{XB, F.out, F.in[15], SSQ, (unsigned*)(F.ctl + CW_PANEL), 0.5f};
        pg8::gemm_phase<pg8::EpiFinal, pg8::StaticOrder, true, true>(F.lds + RING_OFF, g, S, E);
        STAMP1(8);
    }
#if defined(DBG_PH)
    GRID_BAR();
    if (bx == 0 && F.tid == 0) {
        const float dc = (float)(ph_c1 - ph_c0), dr = (float)(ph_r1 - ph_r0);
#if DBG_WHAT == 0
        F.out[0] = 100.f * floorf(dc / dr + 0.5f);
#else
        F.out[0] = 1000.f + 20.f * floorf(dr * 0.01f / 20.f + 0.5f);
#endif
    }
#endif
#if defined(DBG_SKIP)
    GRID_BAR();
    if (bx == 0 && F.tid == 0) F.out[0] = 1000.f + 100.f * ((float*)(ws + WS_META + 262144))[0];
#endif
#if defined(DBG_CLOCK)
    GRID_BAR();
    if (bx == 0 && F.tid == 0) {
        const float dc = (float)(dbg_c1 - dbg_c0), dr = (float)(dbg_r1 - dbg_r0);
        float v;
        if (DBG_CLOCK == 0) v = dc / dr * 100.f;
        else if (DBG_CLOCK == 1) v = dr * 0.01f * 10.f;
        else v = dc / 176.f;
        F.out[0] = v;
    }
#endif
#undef IN
#undef BOTH
#undef GRID_BAR
}

extern "C" void kernel_launch(void* const* d_in, const int* in_sizes, int n_in, void* d_out, int out_size, void* d_ws, size_t ws_size, hipStream_t stream) {
    static int grid = 0;
    if (grid == 0) {
        if (n_in != 16 || in_sizes[0] != MROWS * DM || out_size != MROWS * DM || ws_size < WS_END) {
            fprintf(stderr, "kernel_launch: built for 16 inputs, x/out of %d floats, >= %zu bytes of workspace; got n_in %d, in0 %d, out %d, ws %zu; nothing launched\n", MROWS * DM, (size_t)WS_END, n_in, n_in > 0 ? in_sizes[0] : -1, out_size, ws_size); grid = -1; return; }
        int dev = 0, cus = 0, per_cu = 0;
        if (hipGetDevice(&dev) != hipSuccess || hipDeviceGetAttribute(&cus, hipDeviceAttributeMultiprocessorCount, dev) != hipSuccess) { fprintf(stderr, "kernel_launch: device query failed\n"); grid = -1; return; }
        if (hipFuncSetAttribute((const void*)fwd_kernel, hipFuncAttributeMaxDynamicSharedMemorySize, LDS_BYTES) != hipSuccess) { fprintf(stderr, "kernel_launch: hipFuncSetAttribute failed\n"); grid = -1; return; }
        if (hipOccupancyMaxActiveBlocksPerMultiprocessor(&per_cu, (const void*)fwd_kernel, NWAVES * 64, LDS_BYTES) != hipSuccess || per_cu < 1) { fprintf(stderr, "kernel_launch: occupancy query reports %d workgroups per CU\n", per_cu); per_cu = 1; }
        (void)hipGetLastError();
        grid = cus * (per_cu < 1 ? 1 : 1);
    }
    if (grid < 0) return;
    if (hipMemsetAsync((char*)d_ws + WS_CTL, 0, CTL_ZERO_BYTES, stream) != hipSuccess) { fprintf(stderr, "kernel_launch: hipMemsetAsync failed\n"); return; }
    Args a{};
    for (int i = 0; i < 16; ++i) a.in[i] = (const float*)d_in[i];
    a.out = (float*)d_out; a.ws = (unsigned char*)d_ws;
#ifndef EXP_REP
#define EXP_REP -1
#endif
    for (int li = 0; li < N_LAUNCHES; ++li) {
        if (N_LAUNCHES == 1) { a.ph_lo = 0; a.ph_hi = N_PHASES; } else { a.ph_lo = li; a.ph_hi = li + 1; }
        if (N_LAUNCHES != 1 && li == EXP_REP) { a.alt = 1; hipLaunchKernelGGL(fwd_kernel, dim3(grid), dim3(NWAVES * 64), LDS_BYTES, stream, a); a.alt = 0; }
        hipLaunchKernelGGL(fwd_kernel, dim3(grid), dim3(NWAVES * 64), LDS_BYTES, stream, a);
        const hipError_t le = hipPeekAtLastError();
        if (le != hipSuccess) { fprintf(stderr, "kernel_launch: launch %d failed: %s\n", li, hipGetErrorName(le)); break; }
    }
}
```

```cpp
#include <hip/hip_runtime.h>
#include <hip/hip_bf16.h>
#include <cstdio>
#include <cstdint>

#define LAS __attribute__((address_space(3)))
#define GAS __attribute__((address_space(1)))
typedef unsigned short bf16_t;
typedef short bf16x8 __attribute__((ext_vector_type(8)));
typedef float f32x4 __attribute__((ext_vector_type(4)));
typedef float f32x16 __attribute__((ext_vector_type(16)));
typedef unsigned u32x4 __attribute__((ext_vector_type(4)));
typedef unsigned u32x2 __attribute__((ext_vector_type(2)));
typedef short s16x4 __attribute__((ext_vector_type(4)));

constexpr int DM = 1024, NBATCH = 16, SEQ = 2048, MROWS = NBATCH * SEQ;
constexpr int DFF = 2816, NPROJ = 4608;
constexpr int LPOS = 2176, NKR = NBATCH * LPOS;
constexpr int NMETA = 16, KR_META = 112, KR_REAL = 128;
constexpr float EPS = 1e-6f, LOG2E = 1.4426950408889634f, QSCALE = 0.125f * 1.4426950408889634f;

__device__ __forceinline__ unsigned cvt_pk_bf16(float lo, float hi) { unsigned r; asm volatile("v_cvt_pk_bf16_f32 %0, %1, %2" : "=v"(r) : "v"(lo), "v"(hi)); return r; }
__device__ __forceinline__ void st16_wt(void* p, u32x4 v) { asm volatile("global_store_dwordx4 %0, %1, off sc1\n\ts_nop 1" :: "v"(p), "v"(v) : "memory"); }
__device__ __forceinline__ float bf_lo(unsigned w) { return __uint_as_float(w << 16); }
__device__ __forceinline__ float bf_hi(unsigned w) { return __uint_as_float(w & 0xffff0000u); }

namespace pg8 {
#define PG8_LAS __attribute__((address_space(3)))
constexpr int BM = 256, BK = 64, HALF = 128, HTB = HALF * BK * 2  , STAGE_BYTES = 8 * HTB, NXCD = 8, WGM = 8;

__host__ __device__ __forceinline__ int lds_byte(int r, int c) { const int st = (r >> 4) * 2 + (c >> 5), rr = r & 15, cc = c & 31, ob = rr * 64 + cc * 2; return st * 1024 + (ob ^ (((ob >> 9) & 1) << 5)); }
__host__ __device__ __forceinline__ void stage_rc(int b, int& R, int& C) { const int st = b / 1024, sb = b % 1024, swz = sb ^ (((sb >> 9) & 1) << 5); R = (st >> 1) * 16 + swz / 64; C = (st & 1) * 32 + (swz % 64) / 2; }
__host__ __device__ __forceinline__ int perm32(int rho) { const int n = rho >> 4, i = rho & 15; return 8 * (i >> 2) + 4 * n + (i & 3); }

struct Unit { int pm, pn, koff, br; };
struct Gemm { const bf16_t* A; const bf16_t* Bt; int lda, ldb, K; };

struct StaticOrder {
    int nM, nN, nwg, G, c;
    __host__ __device__ void init(int M, int N, int G_, int c_) { nM = M / BM; nN = N / BM; nwg = nM * nN; G = G_; c = c_; }
    __host__ __device__ bool next(int i, Unit& u) const {
        const long L = (long)i * G + c; if (L >= nwg) return false;
        int wgid = (int)L; { const int q = nwg / NXCD, r = nwg % NXCD, xcd = wgid % NXCD, off = wgid / NXCD; wgid = (xcd < r ? xcd * (q + 1) : r * (q + 1) + (xcd - r) * q) + off; }
        const int nig = WGM * nN, gid = wgid / nig, fm = gid * WGM, gsz = (nM - fm) < WGM ? (nM - fm) : WGM;
        u.pm = fm + ((wgid % nig) % gsz); u.pn = (wgid % nig) / gsz; u.koff = 0; u.br = 0; return true;
    }
    __device__ __forceinline__ void a_ready(const Unit&) const {}
    __device__ __forceinline__ void done(const Unit&) const {}
};
struct RangeOrder {
    StaticOrder S; int i0, i1;
    __host__ __device__ bool next(int i, Unit& u) const { if (i0 + i >= i1) return false; return S.next(i0 + i, u); }
    __device__ __forceinline__ void a_ready(const Unit&) const {}
    __device__ __forceinline__ void done(const Unit&) const {}
};
struct DualOrder {
    StaticOrder S;
    __host__ __device__ bool next(int i, Unit& u) const { if (!S.next(i >> 1, u)) return false; u.br = i & 1; u.koff = 512 * (i & 1); return true; }
    __device__ __forceinline__ void a_ready(const Unit&) const {}
    __device__ __forceinline__ void done(const Unit&) const {}
};

__device__ __forceinline__ float row_rs(const float* ssq, int row, int fq) {
    const f32x4 p = *(const f32x4*)(ssq + (size_t)row * 16 + 4 * fq);
    float s = (p[0] + p[1]) + (p[2] + p[3]);
    s += __shfl_xor(s, 16); s += __shfl_xor(s, 32);
    return __builtin_amdgcn_rsqf(s * (1.0f / 1024.0f) + EPS);
}
typedef float f32x2 __attribute__((ext_vector_type(2)));
__device__ __forceinline__ void row_rs8(const float* ssq, int row0, int fq, float (&rs)[8]) {
    f32x4 p[8];
#pragma unroll
    for (int i = 0; i < 8; ++i) p[i] = *(const f32x4*)(ssq + (size_t)(row0 + (i >> 2) * HALF + (i & 3) * 16) * 16 + 4 * fq);
#pragma unroll
    for (int i = 0; i < 8; ++i) { float s = (p[i][0] + p[i][1]) + (p[i][2] + p[i][3]); s += __shfl_xor(s, 16); s += __shfl_xor(s, 32); rs[i] = __builtin_amdgcn_rsqf(s * (1.0f / 1024.0f) + EPS); }
}
__device__ __forceinline__ float fast_sigmoid(float x) { return __builtin_amdgcn_rcpf(1.0f + __builtin_amdgcn_exp2f(-x * LOG2E)); }
__device__ __forceinline__ u32x4 pack8(const f32x4 a, const f32x4 b) { u32x4 w; w.x = cvt_pk_bf16(a[0], a[1]); w.y = cvt_pk_bf16(a[2], a[3]); w.z = cvt_pk_bf16(b[0], b[1]); w.w = cvt_pk_bf16(b[2], b[3]); return w; }

__device__ __forceinline__ void pf_tile(const void* base, int esz, const Unit& u, int part, int nparts, int tid, float& junk) {
    const int lpr = esz * 2, per = 256 * lpr / nparts, L = part * per + tid;
    if (tid < per) { const char* p = (const char*)base + ((size_t)(u.pm * BM + L / lpr) * DM + (size_t)u.pn * BM) * esz + (L % lpr) * 128;
        asm volatile("global_load_dword %0, %1, off" : "+v"(junk) : "v"(p) : "memory"); }
}
__device__ __forceinline__ void row_rs8_cached(const float* ssq, int pm, int row0, int fr, int fq, PG8_LAS float* rc, float (&rs)[8]) {
    const int wid = __builtin_amdgcn_readfirstlane((int)threadIdx.x >> 6);
    PG8_LAS float* mine = rc + wid * 128; PG8_LAS int* tag = (PG8_LAS int*)(rc + 1024) + wid;
    const int have = __builtin_amdgcn_readfirstlane(*tag);
    if (have != pm + 1) {
        row_rs8(ssq, row0, fq, rs);
        if (fq == 0) { *(PG8_LAS f32x4*)(mine + fr * 8) = (f32x4){rs[0], rs[1], rs[2], rs[3]}; *(PG8_LAS f32x4*)(mine + fr * 8 + 4) = (f32x4){rs[4], rs[5], rs[6], rs[7]}; }
        if ((threadIdx.x & 63) == 0) *tag = pm + 1;
    } else {
        const f32x4 a = *(const PG8_LAS f32x4*)(mine + fr * 8), b = *(const PG8_LAS f32x4*)(mine + fr * 8 + 4);
        rs[0] = a[0]; rs[1] = a[1]; rs[2] = a[2]; rs[3] = a[3]; rs[4] = b[0]; rs[5] = b[1]; rs[6] = b[2]; rs[7] = b[3];
    }
}
struct EpiSwiGLU {
    static constexpr bool PERM = true, AFTER_DRAIN = false, MID = false, PF = false;
    bf16_t* O; const float* ssq; PG8_LAS float* rsc;
    __device__ __forceinline__ void operator()(const f32x4 (&acc)[2][2][4][2], const Unit& u, int wr, int wc, int fr, int fq) const {
        const int row0 = u.pm * BM + wr * 64 + fr, col0 = u.pn * HALF + wc * 32 + 8 * fq;
        float rsv[8]; row_rs8_cached(ssq, u.pm, row0, fr, fq, rsc, rsv);
#pragma unroll
        for (int ai = 0; ai < 2; ++ai)
#pragma unroll
            for (int m = 0; m < 4; ++m) {
                const int row = row0 + ai * HALF + m * 16; const float rs = rsv[ai * 4 + m];
                f32x4 o[2]; const float c1 = -LOG2E * rs, rs2 = rs * rs;
#pragma unroll
                for (int n = 0; n < 2; ++n)
#pragma unroll
                    for (int e = 0; e < 4; e += 2) {
                        const f32x2 g = (f32x2){acc[ai][0][m][n][e], acc[ai][0][m][n][e + 1]}, uu = (f32x2){acc[ai][1][m][n][e], acc[ai][1][m][n][e + 1]};
                        const f32x2 t = g * c1; f32x2 d; d.x = __builtin_amdgcn_exp2f(t.x); d.y = __builtin_amdgcn_exp2f(t.y); d = d + 1.0f;
                        f32x2 r; r.x = __builtin_amdgcn_rcpf(d.x); r.y = __builtin_amdgcn_rcpf(d.y);
                        const f32x2 w = (g * uu) * (r * rs2); o[n][e] = w.x; o[n][e + 1] = w.y;
                    }
                *(u32x4*)(O + (size_t)row * DFF + col0) = pack8(o[0], o[1]);
            }
    }
};
template <bool BASE_F32> struct EpiResB {
    static constexpr bool PERM = true, AFTER_DRAIN = false, MID = false, PF = false;
    const void* base; bf16_t* xb; float* ssq; float scale;
    __device__ __forceinline__ void prefetch(const Unit& u, int t, int nt, int tid, float& junk) const { const int q = t - (nt - 8); if (q >= 0) pf_tile(base, BASE_F32 ? 4 : 2, u, q >> 1, 4, tid, junk); }
    __device__ __forceinline__ void operator()(const f32x4 (&acc)[2][2][4][2], const Unit& u, int wr, int wc, int fr, int fq) const {
        const int row0 = u.pm * BM + wr * 64 + fr, col0 = u.pn * BM + wc * 32 + 8 * fq;
        u32x4 wv[2][4][2];
        if (!BASE_F32) {
#pragma unroll
            for (int ai = 0; ai < 2; ++ai)
#pragma unroll
                for (int m = 0; m < 4; ++m)
#pragma unroll
                    for (int bj = 0; bj < 2; ++bj) wv[ai][m][bj] = *(const u32x4*)((const bf16_t*)base + (size_t)(row0 + ai * HALF + m * 16) * DM + col0 + bj * HALF);
        }
#pragma unroll
        for (int ai = 0; ai < 2; ++ai) {
            f32x4 fv[4][2][2];
            if (BASE_F32) {
#pragma unroll
                for (int m = 0; m < 4; ++m)
#pragma unroll
                    for (int bj = 0; bj < 2; ++bj) { const float* bp = (const float*)base + (size_t)(row0 + ai * HALF + m * 16) * DM + col0 + bj * HALF; fv[m][bj][0] = *(const f32x4*)bp; fv[m][bj][1] = *(const f32x4*)(bp + 4); }
            }
#pragma unroll
            for (int m = 0; m < 4; ++m) {
                const int row = row0 + ai * HALF + m * 16; const size_t off = (size_t)row * DM + col0; float sq = 0.f;
#pragma unroll
                for (int bj = 0; bj < 2; ++bj) {
                    const size_t c = off + bj * HALF; f32x4 b0, b1;
                    if (BASE_F32) { b0 = fv[m][bj][0]; b1 = fv[m][bj][1]; }
                    else { const u32x4 w = wv[ai][m][bj]; b0 = (f32x4){bf_lo(w.x), bf_hi(w.x), bf_lo(w.y), bf_hi(w.y)}; b1 = (f32x4){bf_lo(w.z), bf_hi(w.z), bf_lo(w.w), bf_hi(w.w)}; }
                    const f32x4 v0 = b0 + acc[ai][bj][m][0] * scale, v1 = b1 + acc[ai][bj][m][1] * scale;
                    *(u32x4*)(xb + c) = pack8(v0, v1);
                    sq += (v0[0] * v0[0] + v0[1] * v0[1]) + (v0[2] * v0[2] + v0[3] * v0[3]) + (v1[0] * v1[0] + v1[1] * v1[1]) + (v1[2] * v1[2] + v1[3] * v1[3]);
                }
                sq += __shfl_xor(sq, 16); sq += __shfl_xor(sq, 32);
                if (fq == 0) ssq[(size_t)row * 16 + u.pn * 4 + wc] = sq;
            }
            if (BASE_F32) asm volatile("" ::: "memory");
        }
    }
};
struct EpiFinal {
    static constexpr bool PERM = true, AFTER_DRAIN = false, MID = false, PF = false;
    const bf16_t* base; float* out; const float* gf; float* part; unsigned* cnt; float scale;
    __device__ __forceinline__ void prefetch(const Unit& u, int t, int nt, int tid, float& junk) const { const int q = t - (nt - 8); if (q >= 0) pf_tile(base, 2, u, q >> 1, 4, tid, junk); }
    __device__ __forceinline__ void operator()(f32x4 (&acc)[2][2][4][2], const Unit& u, int wr, int wc, int fr, int fq) const {
        const int row0 = u.pm * BM + wr * 64 + fr, col0 = u.pn * BM + wc * 32 + 8 * fq;
        u32x4 wv[2][4][2];
#pragma unroll
        for (int ai = 0; ai < 2; ++ai)
#pragma unroll
            for (int m = 0; m < 4; ++m)
#pragma unroll
                for (int bj = 0; bj < 2; ++bj) wv[ai][m][bj] = *(const u32x4*)(base + (size_t)(row0 + ai * HALF + m * 16) * DM + col0 + bj * HALF);
#pragma unroll
        for (int ai = 0; ai < 2; ++ai)
#pragma unroll
            for (int m = 0; m < 4; ++m) {
                const int row = row0 + ai * HALF + m * 16; float sq = 0.f;
#pragma unroll
                for (int bj = 0; bj < 2; ++bj) {
                    const u32x4 w = wv[ai][m][bj];
                    const f32x4 b0 = (f32x4){bf_lo(w.x), bf_hi(w.x), bf_lo(w.y), bf_hi(w.y)}, b1 = (f32x4){bf_lo(w.z), bf_hi(w.z), bf_lo(w.w), bf_hi(w.w)};
                    const f32x4 v0 = b0 + acc[ai][bj][m][0] * scale, v1 = b1 + acc[ai][bj][m][1] * scale;
                    acc[ai][bj][m][0] = v0; acc[ai][bj][m][1] = v1;
                    sq += (v0[0] * v0[0] + v0[1] * v0[1]) + (v0[2] * v0[2] + v0[3] * v0[3]) + (v1[0] * v1[0] + v1[1] * v1[1]) + (v1[2] * v1[2] + v1[3] * v1[3]);
                }
                sq += __shfl_xor(sq, 16); sq += __shfl_xor(sq, 32);
                if (fq == 0) __hip_atomic_store(part + (size_t)row * 16 + u.pn * 4 + wc, sq, __ATOMIC_RELAXED, __HIP_MEMORY_SCOPE_AGENT);
            }
        asm volatile("s_waitcnt vmcnt(0)" ::: "memory");
        unsigned* pc = cnt + 64 * u.pm;
        if ((threadIdx.x & 63) == 0) __hip_atomic_fetch_add(pc, 1u, __ATOMIC_RELAXED, __HIP_MEMORY_SCOPE_AGENT);
        for (unsigned spins = 0; spins < (1u << 22); ++spins) {
            if ((unsigned)__builtin_amdgcn_readfirstlane(__hip_atomic_load(pc, __ATOMIC_RELAXED, __HIP_MEMORY_SCOPE_AGENT)) >= 32u) break;
            __builtin_amdgcn_s_sleep(2);
        }
        asm volatile("" ::: "memory");
        const int gc0 = u.pn * BM + wc * 32 + 8 * fq;
        unsigned long long qq[8][2];
#pragma unroll
        for (int i = 0; i < 8; ++i) { const unsigned long long* pp = (const unsigned long long*)(part + (size_t)(row0 + (i >> 2) * HALF + (i & 3) * 16) * 16 + 4 * fq);
            qq[i][0] = __hip_atomic_load(pp, __ATOMIC_RELAXED, __HIP_MEMORY_SCOPE_AGENT); qq[i][1] = __hip_atomic_load(pp + 1, __ATOMIC_RELAXED, __HIP_MEMORY_SCOPE_AGENT); }
#pragma unroll
        for (int ai = 0; ai < 2; ++ai)
#pragma unroll
            for (int m = 0; m < 4; ++m) {
                const int row = row0 + ai * HALF + m * 16; const size_t off = (size_t)row * DM + col0;
                const unsigned long long q0 = qq[ai * 4 + m][0], q1 = qq[ai * 4 + m][1];
                float s = (__uint_as_float((unsigned)q0) + __uint_as_float((unsigned)(q0 >> 32))) + (__uint_as_float((unsigned)q1) + __uint_as_float((unsigned)(q1 >> 32)));
                s += __shfl_xor(s, 16); s += __shfl_xor(s, 32);
                const float rs = 1.0f / sqrtf(s * (1.0f / 1024.0f) + EPS);
#pragma unroll
                for (int bj = 0; bj < 2; ++bj) {
                    const f32x4 g0 = *(const f32x4*)(gf + gc0 + bj * HALF), g1 = *(const f32x4*)(gf + gc0 + bj * HALF + 4);
                    *(f32x4*)(out + off + bj * HALF) = acc[ai][bj][m][0] * rs * g0; *(f32x4*)(out + off + bj * HALF + 4) = acc[ai][bj][m][1] * rs * g1;
                }
            }
    }
};
struct EpiProj {
    static constexpr bool PERM = true, AFTER_DRAIN = false, MID = false, PF = false;
    const float* ssq; bf16_t *QO, *KA, *VA, *KB, *VB, *RAB, *SGB; float* LOGF; const float* bfg; float *QN2, *KN2; PG8_LAS float* rsc;
    __device__ __forceinline__ void operator()(const f32x4 (&acc)[2][2][4][2], const Unit& u, int wr, int wc, int fr, int fq) const {
        const int pn = u.pn, row0 = u.pm * BM + wr * 64 + fr, kadd = KR_REAL * (u.pm / 8 + 1);
        float rsv[8]; row_rs8_cached(ssq, u.pm, row0, fr, fq, rsc, rsv);
        if (pn == 17) {
            f32x4 bb0 = *(const f32x4*)(bfg), bb1 = *(const f32x4*)(bfg + 4);
#pragma unroll
            for (int ai = 0; ai < 2; ++ai)
#pragma unroll
                for (int m = 0; m < 4; ++m) {
                    const int row = row0 + ai * HALF + m * 16; const float rs = rsv[ai * 4 + m];
                    if (wc == 0 && fq == 0) {
                        f32x4 lf[2];
#pragma unroll
                        for (int n = 0; n < 2; ++n)
#pragma unroll
                            for (int e = 0; e < 4; ++e) { const float x = acc[ai][0][m][n][e] * rs + (n ? bb1[e] : bb0[e]); lf[n][e] = fminf(x, 0.f) - log1pf(expf(-fabsf(x))); }
                        float* d = LOGF + (size_t)(row + kadd) * 8; *(f32x4*)d = lf[0]; *(f32x4*)(d + 4) = lf[1];
                    }
                }
            return;
        }
        if (pn >= 9) {
            const int cg = (pn - 9) * HALF + wc * 32 + 8 * fq;
#pragma unroll
            for (int ai = 0; ai < 2; ++ai)
#pragma unroll
                for (int m = 0; m < 4; ++m) {
                    const int row = row0 + ai * HALF + m * 16; const float rs = rsv[ai * 4 + m]; f32x4 r[2], sb[2];
                    const float c1 = -LOG2E * rs;
#pragma unroll
                    for (int n = 0; n < 2; ++n)
#pragma unroll
                        for (int e = 0; e < 4; e += 2) {
                            f32x2 ta = (f32x2){acc[ai][0][m][n][e], acc[ai][0][m][n][e + 1]} * c1, tb = (f32x2){acc[ai][1][m][n][e], acc[ai][1][m][n][e + 1]} * c1;
                            ta.x = __builtin_amdgcn_fmed3f(ta.x, -115.4f, 115.4f); ta.y = __builtin_amdgcn_fmed3f(ta.y, -115.4f, 115.4f); tb.x = __builtin_amdgcn_fmed3f(tb.x, -115.4f, 115.4f); tb.y = __builtin_amdgcn_fmed3f(tb.y, -115.4f, 115.4f);
                            f32x2 da, db; da.x = __builtin_amdgcn_exp2f(ta.x); da.y = __builtin_amdgcn_exp2f(ta.y); db.x = __builtin_amdgcn_exp2f(tb.x); db.y = __builtin_amdgcn_exp2f(tb.y);
                            da = da + 1.0f; db = db + 1.0f;
                            f32x2 ra, rb; ra.x = __builtin_amdgcn_rcpf(da.x); ra.y = __builtin_amdgcn_rcpf(da.y); rb.x = __builtin_amdgcn_rcpf(db.x); rb.y = __builtin_amdgcn_rcpf(db.y);
                            const f32x2 q = db * ra; r[n][e] = q.x; r[n][e + 1] = q.y; sb[n][e] = rb.x; sb[n][e + 1] = rb.y;
                        }
                    *(u32x4*)(RAB + (size_t)row * DM + cg) = pack8(r[0], r[1]); *(u32x4*)(SGB + (size_t)row * DM + cg) = pack8(sb[0], sb[1]);
                }
            return;
        }
        bf16_t* d0; bf16_t* d1; int pitch, radd = 0; float mul = 1.f;
        if (pn < 2)       { d0 = QO + pn * 256; d1 = d0 + HALF; pitch = DM; mul = QSCALE; }
        else if (pn == 2) { d0 = KA; d1 = VA; pitch = 128; radd = kadd; }
        else if (pn < 5)  { d0 = QO + 512 + (pn - 3) * 256; d1 = d0 + HALF; pitch = DM; mul = QSCALE; }
        else if (pn < 7)  { d0 = KB + (pn - 5) * 256; d1 = d0 + HALF; pitch = 512; radd = kadd; }
        else              { d0 = VB + (pn - 7) * 256; d1 = d0 + HALF; pitch = 512; radd = kadd; }
        const int cw = wc * 32 + 8 * fq;
#pragma unroll
        for (int ai = 0; ai < 2; ++ai)
#pragma unroll
            for (int m = 0; m < 4; ++m) {
                const int row = row0 + ai * HALF + m * 16; const float rs = rsv[ai * 4 + m] * mul; const size_t ro = (size_t)(row + radd) * pitch + cw;
#pragma unroll
                for (int bj = 0; bj < 2; ++bj) {
                    const f32x4 v0 = acc[ai][bj][m][0] * rs, v1 = acc[ai][bj][m][1] * rs;
                    *(u32x4*)((bj ? d1 : d0) + ro) = pack8(v0, v1);
                    if (pn >= 3 && pn < 7) {
                        float s2 = (v0[0] * v0[0] + v0[1] * v0[1]) + (v0[2] * v0[2] + v0[3] * v0[3]) + (v1[0] * v1[0] + v1[1] * v1[1]) + (v1[2] * v1[2] + v1[3] * v1[3]);
                        s2 += __shfl_xor(s2, 16); s2 += __shfl_xor(s2, 32);
                        if (fq == 0) ((pn < 5 ? QN2 : KN2) + (size_t)(row + radd) * 16)[2 * (4 * ((pn - 3) & 1) + 2 * bj + (wc >> 1)) + (wc & 1)] = s2;
                    }
                }
            }
    }
};
struct EpiMix {
    static constexpr bool PERM = true, AFTER_DRAIN = false, MID = true, PF = false;
    const bf16_t *RAB, *SGB; bf16_t* MIX;
    __device__ __forceinline__ void prefetch(const Unit& u, int t, int nt, int tid, float& junk) const { const int h = nt >> 1; if (t < h) pf_tile(RAB, 2, u, t >> 1, h >> 1, tid, junk); else pf_tile(SGB, 2, u, (t - h) >> 1, h >> 1, tid, junk); }
    __device__ __forceinline__ void mid(f32x4 (&acc)[2][2][4][2], const Unit& u, int wr, int wc, int fr, int fq) const {
        int row0 = u.pm * BM + wr * 64 + fr; const int col0 = u.pn * BM + wc * 32 + 8 * fq;
        asm volatile("" : "+v"(row0));
        u32x4 gv[2][4][2];
#pragma unroll
        for (int ai = 0; ai < 2; ++ai)
#pragma unroll
            for (int m = 0; m < 4; ++m)
#pragma unroll
                for (int bj = 0; bj < 2; ++bj) gv[ai][m][bj] = *(const u32x4*)(RAB + (size_t)(row0 + ai * HALF + m * 16) * DM + col0 + bj * HALF);
#pragma unroll
        for (int ai = 0; ai < 2; ++ai)
#pragma unroll
            for (int m = 0; m < 4; ++m) {
#pragma unroll
                for (int bj = 0; bj < 2; ++bj) {
                    const u32x4 gw = gv[ai][m][bj];
                    acc[ai][bj][m][0] *= (f32x4){bf_lo(gw.x), bf_hi(gw.x), bf_lo(gw.y), bf_hi(gw.y)}; acc[ai][bj][m][1] *= (f32x4){bf_lo(gw.z), bf_hi(gw.z), bf_lo(gw.w), bf_hi(gw.w)};
                }
            }
    }
    __device__ __forceinline__ void operator()(const f32x4 (&acc)[2][2][4][2], const Unit& u, int wr, int wc, int fr, int fq) const {
        int row0 = u.pm * BM + wr * 64 + fr; const int col0 = u.pn * BM + wc * 32 + 8 * fq;
        asm volatile("" : "+v"(row0));
        u32x4 gv[2][4][2];
#pragma unroll
        for (int ai = 0; ai < 2; ++ai)
#pragma unroll
            for (int m = 0; m < 4; ++m)
#pragma unroll
                for (int bj = 0; bj < 2; ++bj) gv[ai][m][bj] = *(const u32x4*)(SGB + (size_t)(row0 + ai * HALF + m * 16) * DM + col0 + bj * HALF);
#pragma unroll
        for (int ai = 0; ai < 2; ++ai)
#pragma unroll
            for (int m = 0; m < 4; ++m) {
                const int row = row0 + ai * HALF + m * 16;
#pragma unroll
                for (int bj = 0; bj < 2; ++bj) {
                    const size_t c = (size_t)row * DM + col0 + bj * HALF;
                    const u32x4 gw = gv[ai][m][bj];
                    const f32x4 v0 = acc[ai][bj][m][0] * (f32x4){bf_lo(gw.x), bf_hi(gw.x), bf_lo(gw.y), bf_hi(gw.y)}, v1 = acc[ai][bj][m][1] * (f32x4){bf_lo(gw.z), bf_hi(gw.z), bf_lo(gw.w), bf_hi(gw.w)};
                    *(u32x4*)(MIX + c) = pack8(v0, v1);
                }
            }
    }
};
struct EpiNull {
    static constexpr bool PERM = true, AFTER_DRAIN = false, MID = false, PF = false;
    __device__ __forceinline__ void operator()(const f32x4 (&acc)[2][2][4][2], const Unit& u, int wr, int wc, int fr, int fq) const {
#pragma unroll
        for (int ai = 0; ai < 2; ++ai)
#pragma unroll
            for (int bj = 0; bj < 2; ++bj)
#pragma unroll
                for (int m = 0; m < 4; ++m)
#pragma unroll
                    for (int n = 0; n < 2; ++n) asm volatile("" :: "v"(acc[ai][bj][m][n]));
    }
};

template <int MODE> struct EpiProjX {
    static constexpr bool PERM = true, AFTER_DRAIN = false, MID = false, PF = false;
    const float* ssq; bf16_t* D;
    __device__ __forceinline__ void operator()(const f32x4 (&acc)[2][2][4][2], const Unit& u, int wr, int wc, int fr, int fq) const {
        int row0 = u.pm * BM + wr * 64 + fr; const int cw = (u.pn % 4) * 256 + wc * 32 + 8 * fq;
        asm volatile("" : "+v"(row0));
#pragma unroll
        for (int ai = 0; ai < 2; ++ai)
#pragma unroll
            for (int m = 0; m < 4; ++m) {
                const int row = row0 + ai * HALF + m * 16;
                if (MODE == 0) {
                    const float rs = row_rs(ssq, row, fq); f32x4 r[2], sb[2];
#pragma unroll
                    for (int n = 0; n < 2; ++n)
#pragma unroll
                        for (int e = 0; e < 4; ++e) {
                            const float ga = __builtin_amdgcn_fmed3f(acc[ai][0][m][n][e] * rs, -80.f, 80.f), gb = __builtin_amdgcn_fmed3f(acc[ai][1][m][n][e] * rs, -80.f, 80.f);
                            const float ea = __builtin_amdgcn_exp2f(-ga * LOG2E), eb = __builtin_amdgcn_exp2f(-gb * LOG2E);
                            r[n][e] = (1.0f + eb) * __builtin_amdgcn_rcpf(1.0f + ea); sb[n][e] = __builtin_amdgcn_rcpf(1.0f + eb);
                        }
                    u32x4 a = pack8(r[0], r[1]), b = pack8(sb[0], sb[1]); asm volatile("" :: "v"(a), "v"(b));
                } else if (MODE == 1) {
#pragma unroll
                    for (int bj = 0; bj < 2; ++bj) *(u32x4*)(D + (size_t)row * DM + cw + bj * HALF) = pack8(acc[ai][bj][m][0], acc[ai][bj][m][1]);
                } else {
                    const int lrow = (int)blockIdx.x * BM + (row & 255); const int cw2 = wc * 32 + 8 * fq;
#pragma unroll
                    for (int bj = 0; bj < 2; ++bj) *(u32x4*)(D + (size_t)lrow * DM + cw2 + bj * HALF) = pack8(acc[ai][bj][m][0], acc[ai][bj][m][1]);
                }
            }
    }
};
template <class Epi, class Sched, bool ALIGN_EPI = false, bool SP2 = false>
__device__ __forceinline__ void gemm_phase(PG8_LAS unsigned char* lds, const Gemm g, const Sched& S, const Epi& E) {
    const int tid = threadIdx.x, wid = __builtin_amdgcn_readfirstlane(tid >> 6), lane = tid & 63, wr = wid >> 2, wc = wid & 3, fr = lane & 15, fq = lane >> 4;
    const int K = g.K, nt = K / BK;
    unsigned voffA[2], voffB[2];
#pragma unroll
    for (int i = 0; i < 2; ++i) { int R, C; stage_rc(tid * 16 + i * 8192, R, C); const int Rb = Epi::PERM ? ((R & ~31) + perm32(R & 31)) : R;
        voffA[i] = (unsigned)(R * g.lda + C) * 2u; voffB[i] = (unsigned)(Rb * g.ldb + C) * 2u; }
    const size_t kstep = (size_t)(BK * 2);
    const size_t hstepA = (size_t)HALF * g.lda * 2, hstepB = (size_t)HALF * g.ldb * 2;
    const size_t tstepA = 2 * hstepA, tstepB = 2 * hstepB;
    const unsigned ldsw = (unsigned)wid * 1024u;
    const int aoff = lds_byte(wr * 64 + fr, fq * 8), boff = lds_byte(wc * 32 + fr, fq * 8);
#define PG8_SA(b, h) (((b) * 2 + (h)) * HTB)
#define PG8_SB(b, h) ((4 + (b) * 2 + (h)) * HTB)
#define PG8_STAGE(bufoff, gbase, voff) do { _Pragma("unroll") for (int _i = 0; _i < 2; ++_i) \
        __builtin_amdgcn_global_load_lds((const unsigned*)((const char*)(gbase) + (voff)[_i]), (PG8_LAS unsigned*)(lds + (bufoff) + ldsw + _i * 8192), 16, 0, 0); } while (0)
#define PG8_LDA(dst, b, h) do { _Pragma("unroll") for (int m = 0; m < 4; ++m) _Pragma("unroll") for (int k = 0; k < 2; ++k) dst[m][k] = *(const PG8_LAS bf16x8*)(lds + PG8_SA(b, h) + aoff + m * 2048 + k * 1024); } while (0)
#define PG8_LDB(dst, b, h) do { _Pragma("unroll") for (int n = 0; n < 2; ++n) _Pragma("unroll") for (int k = 0; k < 2; ++k) dst[n][k] = *(const PG8_LAS bf16x8*)(lds + PG8_SB(b, h) + boff + n * 2048 + k * 1024); } while (0)
#define PG8_MMA(ai, bj, At, Bt) do { __builtin_amdgcn_s_setprio(1); _Pragma("unroll") for (int m = 0; m < 4; ++m) _Pragma("unroll") for (int n = 0; n < 2; ++n) _Pragma("unroll") for (int k = 0; k < 2; ++k) \
        acc[ai][bj][m][n] = __builtin_amdgcn_mfma_f32_16x16x32_bf16(Bt[n][k], At[m][k], acc[ai][bj][m][n], 0, 0, 0); __builtin_amdgcn_s_setprio(0); } while (0)
#define PG8_WAIT_V(n) asm volatile("s_waitcnt vmcnt(" #n ")" ::: "memory")
#define PG8_WAIT_L(n) asm volatile("s_waitcnt lgkmcnt(" #n ")" ::: "memory")
#define PG8_BAR __builtin_amdgcn_s_barrier()
#define PG8_SCHED __builtin_amdgcn_sched_barrier(0)
    Unit cur, nxt; int ui = 0; float pfj = 0.f;
    if (!S.next(0, cur)) return;
    f32x4 acc[2][2][4][2];
#pragma unroll
    for (int a = 0; a < 2; ++a)
#pragma unroll
        for (int b = 0; b < 2; ++b)
#pragma unroll
            for (int m = 0; m < 4; ++m)
#pragma unroll
                for (int n = 0; n < 2; ++n) acc[a][b][m][n] = (f32x4){0.f, 0.f, 0.f, 0.f};
    bf16x8 At[4][2], B0[2][2], B1[2][2];
    const char* cA = (const char*)g.A + (size_t)cur.pm * tstepA + (size_t)cur.koff * 2; const char* cB = (const char*)g.Bt + (size_t)cur.pn * tstepB + (size_t)cur.koff * 2;
    S.a_ready(cur);
    if constexpr (SP2) {
        PG8_STAGE(PG8_SB(0, 0), cB, voffB); PG8_STAGE(PG8_SB(0, 1), cB + hstepB, voffB); PG8_STAGE(PG8_SA(0, 0), cA, voffA); PG8_STAGE(PG8_SA(0, 1), cA + hstepA, voffA);
        if (wr == 1) PG8_BAR;
        PG8_WAIT_V(2); PG8_BAR;
        PG8_STAGE(PG8_SB(1, 0), cB + kstep, voffB); PG8_STAGE(PG8_SA(1, 0), cA + kstep, voffA); PG8_STAGE(PG8_SB(1, 1), cB + hstepB + kstep, voffB);
        PG8_WAIT_V(6); PG8_BAR;
    } else {
        PG8_STAGE(PG8_SB(0, 0), cB, voffB); PG8_STAGE(PG8_SA(0, 0), cA, voffA); PG8_STAGE(PG8_SB(0, 1), cB + hstepB, voffB); PG8_STAGE(PG8_SA(0, 1), cA + hstepA, voffA);
        if (wr == 1) PG8_BAR;
        PG8_WAIT_V(4); PG8_BAR;
        PG8_STAGE(PG8_SB(1, 0), cB + kstep, voffB); PG8_STAGE(PG8_SA(1, 0), cA + kstep, voffA); PG8_STAGE(PG8_SB(1, 1), cB + hstepB + kstep, voffB);
        PG8_WAIT_V(6); PG8_BAR;
    }
    for (;;) {
        const bool has_next = S.next(ui + 1, nxt);
        const char* nA = has_next ? (const char*)g.A + (size_t)nxt.pm * tstepA + (size_t)nxt.koff * 2 : cA; const char* nB = has_next ? (const char*)g.Bt + (size_t)nxt.pn * tstepB + (size_t)nxt.koff * 2 : cB;
        for (int t = 0; t < nt; t += 2) {
            const bool last = (t == nt - 2);
            if constexpr (Epi::PF) E.prefetch(cur, t, nt, tid, pfj);
            if constexpr (Epi::MID) { if (t == (nt >> 1)) E.mid(acc, cur, wr, wc, fr, fq); }
            const char* a1 = cA + (size_t)(t + 1) * kstep;
            const char* a2 = last ? nA : cA + (size_t)(t + 2) * kstep; const char* b2 = last ? nB : cB + (size_t)(t + 2) * kstep;
            const char* a3 = a2 + kstep; const char* b3 = b2 + kstep;
            if (last && has_next) S.a_ready(nxt);
            if constexpr (SP2) {
            PG8_LDB(B0, 0, 0); PG8_LDB(B1, 0, 1); PG8_SCHED; PG8_LDA(At, 0, 0); PG8_STAGE(PG8_SA(1, 1), a1 + hstepA, voffA);
            PG8_WAIT_V(8); PG8_WAIT_L(0); PG8_BAR; PG8_MMA(0, 0, At, B0); PG8_MMA(0, 1, At, B1); PG8_BAR; PG8_SCHED;
            PG8_LDA(At, 0, 1); PG8_STAGE(PG8_SB(0, 0), b2, voffB); PG8_STAGE(PG8_SB(0, 1), b2 + hstepB, voffB); PG8_STAGE(PG8_SA(0, 0), a2, voffA);
            PG8_WAIT_V(8); PG8_WAIT_L(0); PG8_BAR; PG8_MMA(1, 0, At, B0); PG8_MMA(1, 1, At, B1); PG8_BAR; PG8_SCHED;
            PG8_LDB(B0, 1, 0); PG8_LDB(B1, 1, 1); PG8_SCHED; PG8_LDA(At, 1, 0); PG8_STAGE(PG8_SA(0, 1), a2 + hstepA, voffA);
            PG8_WAIT_V(8); PG8_WAIT_L(0); PG8_BAR; PG8_MMA(0, 0, At, B0); PG8_MMA(0, 1, At, B1); PG8_BAR; PG8_SCHED;
            PG8_LDA(At, 1, 1); PG8_STAGE(PG8_SB(1, 0), b3, voffB); PG8_STAGE(PG8_SB(1, 1), b3 + hstepB, voffB); PG8_STAGE(PG8_SA(1, 0), a3, voffA);
            PG8_WAIT_V(8); PG8_WAIT_L(0); PG8_BAR; PG8_MMA(1, 0, At, B0); PG8_MMA(1, 1, At, B1); PG8_BAR; PG8_SCHED;
            } else {
            PG8_LDB(B0, 0, 0); PG8_SCHED; PG8_LDA(At, 0, 0); PG8_STAGE(PG8_SA(1, 1), a1 + hstepA, voffA);
            PG8_WAIT_L(8); PG8_BAR; PG8_WAIT_L(0); PG8_MMA(0, 0, At, B0); PG8_BAR; PG8_SCHED;
            PG8_LDB(B1, 0, 1); PG8_STAGE(PG8_SB(0, 0), b2, voffB);
            PG8_BAR; PG8_WAIT_L(0); PG8_MMA(0, 1, At, B1); PG8_BAR;
            PG8_LDA(At, 0, 1); PG8_STAGE(PG8_SA(0, 0), a2, voffA);
            PG8_BAR; PG8_WAIT_L(0); PG8_MMA(1, 0, At, B0); PG8_BAR; PG8_SCHED;
            PG8_STAGE(PG8_SB(0, 1), b2 + hstepB, voffB);
            PG8_WAIT_V(6); PG8_BAR; PG8_MMA(1, 1, At, B1); PG8_BAR;
            PG8_LDB(B0, 1, 0); PG8_SCHED; PG8_LDA(At, 1, 0); PG8_STAGE(PG8_SA(0, 1), a2 + hstepA, voffA);
            PG8_WAIT_L(8); PG8_BAR; PG8_WAIT_L(0); PG8_MMA(0, 0, At, B0); PG8_BAR; PG8_SCHED;
            PG8_LDB(B1, 1, 1); PG8_STAGE(PG8_SB(1, 0), b3, voffB);
            PG8_BAR; PG8_WAIT_L(0); PG8_MMA(0, 1, At, B1); PG8_BAR;
            PG8_LDA(At, 1, 1); PG8_STAGE(PG8_SA(1, 0), a3, voffA);
            PG8_BAR; PG8_WAIT_L(0); PG8_MMA(1, 0, At, B0); PG8_BAR; PG8_SCHED;
            PG8_STAGE(PG8_SB(1, 1), b3 + hstepB, voffB);
            PG8_WAIT_V(6); PG8_BAR; PG8_MMA(1, 1, At, B1); PG8_BAR;
            }
        }
        if constexpr (ALIGN_EPI) { if (wr == 0) PG8_BAR; }
        if constexpr (!Epi::AFTER_DRAIN) { E(acc, cur, wr, wc, fr, fq); S.done(cur); }
        asm volatile("" :: "v"(pfj));
        if (!has_next) break;
#pragma unroll
        for (int a = 0; a < 2; ++a)
#pragma unroll
            for (int b = 0; b < 2; ++b)
#pragma unroll
                for (int m = 0; m < 4; ++m)
#pragma unroll
                    for (int n = 0; n < 2; ++n) acc[a][b][m][n] = (f32x4){0.f, 0.f, 0.f, 0.f};
        cur = nxt; cA = nA; cB = nB; ++ui;
        if constexpr (ALIGN_EPI) { if (wr == 1) PG8_BAR; }
    }
    PG8_WAIT_V(0);
    if constexpr (!ALIGN_EPI) { if (wr == 0) PG8_BAR; }
    PG8_BAR;
    if constexpr (Epi::AFTER_DRAIN) { E.fused(acc, cur, wr, wc, fr, fq, lds, wid, lane); S.done(cur); }
#undef PG8_SA
#undef PG8_SB
#undef PG8_STAGE
#undef PG8_LDA
#undef PG8_LDB
#undef PG8_MMA
#undef PG8_WAIT_V
#undef PG8_WAIT_L
#undef PG8_BAR
#undef PG8_SCHED
}
}

namespace attn {
constexpr int SLOTB = 8192;
constexpr int NSLOT = 5;
constexpr int LDS_K = 0, LDS_V = NSLOT * SLOTB, LDS_WS = 2 * NSLOT * SLOTB, LDS_OST = LDS_WS + 8 * 256, LDS_CL = LDS_OST + 8 * 4096, LDS_SCAN = LDS_CL + 2064 * 4 + 64, LDS_END = LDS_SCAN + 64;
#define SBAR() __builtin_amdgcn_sched_barrier(0)
__device__ __forceinline__ int crow(int r, int hi) { return (r & 3) + 8 * (r >> 2) + 4 * hi; }
__device__ __forceinline__ void glds16(const void* gsrc, unsigned lds_dst) { unsigned keep;
    asm volatile("s_mov_b32 %0, m0\n\ts_mov_b32 m0, %2\n\ts_nop 0\n\tglobal_load_lds_dwordx4 %1, off\n\ts_mov_b32 m0, %0" : "=&s"(keep) : "v"(gsrc), "s"(lds_dst) : "memory"); }
typedef float f32x2_t __attribute__((ext_vector_type(2))); typedef __bf16 bf16x2_t __attribute__((ext_vector_type(2)));
__device__ __forceinline__ unsigned cvtpk_s(float lo, float hi) { f32x2_t v = {lo, hi}; bf16x2_t b = __builtin_convertvector(v, bf16x2_t); return __builtin_bit_cast(unsigned, b); }
#define MX3(a, b, c) __builtin_fmaxf(__builtin_fmaxf((a), (b)), (c))
__device__ __forceinline__ void qkt(f32x16& p0, f32x16& p1, const char* Kslot, const bf16x8* qr, const f32x16& negm, int r32, int hi) {
    const char* kb = Kslot + hi * 1024 + r32 * 16;
#pragma unroll
    for (int d0 = 0; d0 < 4; ++d0) {
        const bf16x8 b0 = *reinterpret_cast<const bf16x8*>(kb + d0 * 2048);
        const bf16x8 b1 = *reinterpret_cast<const bf16x8*>(kb + d0 * 2048 + 512);
        if (d0 == 0) { p0 = __builtin_amdgcn_mfma_f32_32x32x16_bf16(b0, qr[0], negm, 0, 0, 0); p1 = __builtin_amdgcn_mfma_f32_32x32x16_bf16(b1, qr[0], negm, 0, 0, 0); }
        else { p0 = __builtin_amdgcn_mfma_f32_32x32x16_bf16(b0, qr[d0], p0, 0, 0, 0); p1 = __builtin_amdgcn_mfma_f32_32x32x16_bf16(b1, qr[d0], p1, 0, 0, 0); }
    }
}
__device__ __forceinline__ float rowmax(const f32x16& p0, const f32x16& p1) {
    float a = MX3(p0[0], p0[1], p1[0]), b = MX3(p0[2], p0[3], p1[1]); a = MX3(a, p1[2], p1[3]);
#pragma unroll
    for (int r = 4; r < 16; r += 4) { a = MX3(a, p0[r], p0[r + 1]); b = MX3(b, p0[r + 2], p0[r + 3]); a = MX3(a, p1[r], p1[r + 1]); b = MX3(b, p1[r + 2], p1[r + 3]); }
    const float m = __builtin_fmaxf(a, b);
    auto rr = __builtin_amdgcn_permlane32_swap(__float_as_uint(m), __float_as_uint(m), false, false);
    return __builtin_fmaxf(__uint_as_float(rr[0]), __uint_as_float(rr[1]));
}
__device__ __forceinline__ void pv(f32x16* o, int vb, bf16x8 pa0, bf16x8 pa1, bf16x8 pa2, bf16x8 pa3) {
#pragma unroll
    for (int d0 = 0; d0 < 2; ++d0) { s16x4 lo[4], hi[4];
#pragma unroll
        for (int ks = 0; ks < 4; ++ks) {
            asm volatile("ds_read_b64_tr_b16 %0,%1 offset:%c2" : "=&v"(lo[ks]) : "v"(vb), "i"(d0 * 4096 + ks * 1024) : "memory");
            asm volatile("ds_read_b64_tr_b16 %0,%1 offset:%c2" : "=&v"(hi[ks]) : "v"(vb), "i"(d0 * 4096 + ks * 1024 + 512) : "memory"); }
        asm volatile("s_waitcnt lgkmcnt(0)" ::: "memory"); SBAR();
#define PK(k) (bf16x8){lo[k][0], lo[k][1], lo[k][2], lo[k][3], hi[k][0], hi[k][1], hi[k][2], hi[k][3]}
        o[d0] = __builtin_amdgcn_mfma_f32_32x32x16_bf16(pa0, PK(0), o[d0], 0, 0, 0);
        o[d0] = __builtin_amdgcn_mfma_f32_32x32x16_bf16(pa1, PK(1), o[d0], 0, 0, 0);
        o[d0] = __builtin_amdgcn_mfma_f32_32x32x16_bf16(pa2, PK(2), o[d0], 0, 0, 0);
        o[d0] = __builtin_amdgcn_mfma_f32_32x32x16_bf16(pa3, PK(3), o[d0], 0, 0, 0);
#undef PK
    }
}
#define WAIT_BAR0() asm volatile("s_waitcnt vmcnt(0) lgkmcnt(0)\n\ts_barrier" ::: "memory")

template <int MODE>
__device__ __forceinline__ void unit(const bf16_t* Qw, bf16_t* Ow, const bf16_t* Kh, const bf16_t* Vh, int kp, int NT, int kbase, int qpos0,
                                     float slope2, float sink2, const float* cl, char* shm) {
    const int tid = threadIdx.x, lane = tid & 63, r32 = lane & 31, hi = lane >> 5; const int wid = __builtin_amdgcn_readfirstlane(tid >> 6);
    const unsigned lds0 = (unsigned)(uintptr_t)shm;
    float* wsf = (float*)(shm + LDS_WS) + wid * 64;
    const bf16_t* ksrc = Kh + (size_t)lane * kp + wid * 8;
    const bf16_t* vsrc = Vh + (size_t)(16 * (wid & 3) + (lane >> 2)) * kp + (wid >> 2) * 32 + (lane & 3) * 8;
    const unsigned kdst = lds0 + LDS_K + wid * 1024, vdst = lds0 + LDS_V + wid * 1024;
#define TILE_KR0(t) ((t) == 0 ? 64 : kbase + 64 * ((t) - 1))
#define DMA_KV(t, slot) do { const size_t ro_ = (size_t)TILE_KR0(t) * kp; \
        glds16(ksrc + ro_, (unsigned)__builtin_amdgcn_readfirstlane(kdst + (slot) * SLOTB)); glds16(vsrc + ro_, (unsigned)__builtin_amdgcn_readfirstlane(vdst + (slot) * SLOTB)); } while (0)
    const int vb0 = (int)(lds0 + LDS_V) + ((lane >> 4) & 1) * 32 + (lane & 3) * 8 + (4 * hi + ((lane & 15) >> 2)) * 64;
    DMA_KV(0, 0);
    bf16x8 qr[4];
#pragma unroll
    for (int d0 = 0; d0 < 4; ++d0) qr[d0] = *reinterpret_cast<const bf16x8*>(Qw + (size_t)r32 * DM + d0 * 16 + hi * 8);
    const int qp = qpos0 + r32;
    const float rowterm = (MODE == 0) ? cl[qp - KR_META] : -slope2 * (float)qp;
    float mhat = (MODE == 0) ? 0.f : sink2, l_reg = (MODE == 1 && hi == 0) ? 1.f : 0.f;
    f32x16 o[2]; o[0] = f32x16{}; o[1] = f32x16{};
    for (int t = 0; t < NT; ++t) {
        WAIT_BAR0();
        if (t + 1 < NT) DMA_KV(t + 1, (t + 1) & 1);
        const int slot = t & 1, kr0 = TILE_KR0(t);
        bool empty = false, full = false;
        if (MODE == 1 && t > 0) { empty = (kr0 > qpos0 + 31) || (kr0 + 63 <= qpos0 - 128) || (kr0 + 63 < KR_REAL);
            full = (kr0 >= KR_REAL) && (kr0 + 63 <= qpos0) && (qpos0 + 31 - kr0 < 128); }
        if (empty) continue;
        f32x16 negm; { const float nm = rowterm - mhat;
#pragma unroll
            for (int r = 0; r < 16; ++r) negm[r] = nm; }
        f32x16 p0, p1;
        qkt(p0, p1, shm + LDS_K + slot * SLOTB, qr, negm, r32, hi);
        const bool need_mask = (MODE == 1 && !full) || (MODE == 0 && ((kr0 < KR_META) || (kr0 + 63 > qpos0)));
        if (need_mask) {
#pragma unroll
            for (int r = 0; r < 16; ++r) {
                const int k0 = kr0 + crow(r, hi), k1 = k0 + 32;
                bool ok0, ok1; float c0, c1;
                if (MODE == 0) { ok0 = (k0 >= KR_META) && (k0 <= qp); ok1 = (k1 >= KR_META) && (k1 <= qp);
                    c0 = -cl[k0 >= KR_META ? k0 - KR_META : 0]; c1 = -cl[k1 >= KR_META ? k1 - KR_META : 0]; }
                else { ok0 = (t == 0) ? (k0 >= KR_META) : (k0 >= KR_REAL && k0 <= qp && qp - k0 < 128); ok1 = (t == 0) ? (k1 >= KR_META) : (k1 >= KR_REAL && k1 <= qp && qp - k1 < 128);
                    c0 = slope2 * (float)k0; c1 = slope2 * (float)k1; }
                p0[r] = ok0 ? p0[r] + c0 : -INFINITY; p1[r] = ok1 ? p1[r] + c1 : -INFINITY;
            }
        } else {
#pragma unroll
            for (int r = 0; r < 16; ++r) { const int k0 = kr0 + crow(r, hi);
                if (MODE == 0) { p0[r] -= cl[k0 - KR_META]; p1[r] -= cl[k0 - KR_META + 32]; }
                else { p0[r] += slope2 * (float)k0; p1[r] += slope2 * (float)(k0 + 32); } }
        }
        const float rm = rowmax(p0, p1);
        if (MODE == 0 && t == 0) {
            mhat = rm;
#pragma unroll
            for (int r = 0; r < 16; ++r) { p0[r] -= rm; p1[r] -= rm; }
        } else if (__any(rm > 0.f)) {
            const float dl = __builtin_fmaxf(rm, 0.f); mhat += dl;
#pragma unroll
            for (int r = 0; r < 16; ++r) { p0[r] -= dl; p1[r] -= dl; }
            const float f = __builtin_amdgcn_exp2f(-dl); l_reg *= f;
            if (hi == 0) wsf[r32] = f;
            asm volatile("s_waitcnt lgkmcnt(0)" ::: "memory");
#pragma unroll
            for (int d = 0; d < 2; ++d)
#pragma unroll
                for (int r = 0; r < 16; ++r) o[d][r] *= wsf[crow(r, hi)];
        }
        float sacc = 0.f;
#pragma unroll
        for (int r = 0; r < 16; ++r) { p0[r] = __builtin_amdgcn_exp2f(p0[r]); p1[r] = __builtin_amdgcn_exp2f(p1[r]); sacc += p0[r] + p1[r]; }
        l_reg += sacc;
        u32x4 pw0, pw1, pw2, pw3;
        pw0 = (u32x4){cvtpk_s(p0[0], p0[1]), cvtpk_s(p0[2], p0[3]), cvtpk_s(p0[4], p0[5]), cvtpk_s(p0[6], p0[7])};
        pw1 = (u32x4){cvtpk_s(p0[8], p0[9]), cvtpk_s(p0[10], p0[11]), cvtpk_s(p0[12], p0[13]), cvtpk_s(p0[14], p0[15])};
        pw2 = (u32x4){cvtpk_s(p1[0], p1[1]), cvtpk_s(p1[2], p1[3]), cvtpk_s(p1[4], p1[5]), cvtpk_s(p1[6], p1[7])};
        pw3 = (u32x4){cvtpk_s(p1[8], p1[9]), cvtpk_s(p1[10], p1[11]), cvtpk_s(p1[12], p1[13]), cvtpk_s(p1[14], p1[15])};
        SBAR();
        pv(o, vb0 + slot * SLOTB, __builtin_bit_cast(bf16x8, pw0), __builtin_bit_cast(bf16x8, pw1), __builtin_bit_cast(bf16x8, pw2), __builtin_bit_cast(bf16x8, pw3));
    }
    { auto rr = __builtin_amdgcn_permlane32_swap(__float_as_uint(l_reg), __float_as_uint(l_reg), false, false); l_reg = __uint_as_float(rr[0]) + __uint_as_float(rr[1]); }
    if (hi == 0) wsf[32 + r32] = l_reg;
    asm volatile("s_waitcnt lgkmcnt(0)" ::: "memory");
    float rli[16];
#pragma unroll
    for (int r = 0; r < 16; ++r) rli[r] = 1.0f / wsf[32 + crow(r, hi)];
    { __hip_bfloat16* stg = (__hip_bfloat16*)(shm + LDS_OST) + wid * 2048;
#pragma unroll
        for (int r = 0; r < 16; ++r) { const int orow = crow(r, hi);
#pragma unroll
            for (int d0 = 0; d0 < 2; ++d0) stg[orow * 64 + d0 * 32 + r32] = __float2bfloat16(o[d0][r] * rli[r]); }
        asm volatile("s_waitcnt lgkmcnt(0)" ::: "memory");
#pragma unroll
        for (int i = 0; i < 4; ++i) { const int row = i * 8 + (lane >> 3), ch = lane & 7; const u32x4 v = *(const u32x4*)(stg + row * 64 + ch * 8); *(u32x4*)(Ow + (size_t)row * DM + ch * 8) = v; } }
    asm volatile("s_waitcnt lgkmcnt(0)\n\ts_barrier" ::: "memory");
#undef DMA_KV
#undef TILE_KR0
}

__device__ __forceinline__ void unit_swa(const bf16_t* Qw, bf16_t* Ow, const bf16_t* Kh, const bf16_t* Vh, int kp, int kbase, int qpos0, float slope2, float sink2, char* shm, int dbg_nocompute = 0) {
    const int tid = threadIdx.x; int lane_ = tid & 63; asm volatile("" : "+v"(lane_));
    const int lane = lane_, r32 = lane & 31, hi = lane >> 5; const int wid = __builtin_amdgcn_readfirstlane(tid >> 6);
    const unsigned lds0 = (unsigned)(uintptr_t)shm;
    float* wsf = (float*)(shm + LDS_WS) + wid * 64;
    const bf16_t* ksrc = Kh + (size_t)lane * kp + wid * 8;
    const bf16_t* vsrc = Vh + (size_t)(16 * (wid & 3) + (lane >> 2)) * kp + (wid >> 2) * 32 + (lane & 3) * 8;
    const unsigned kdst = lds0 + LDS_K + wid * 1024, vdst = lds0 + LDS_V + wid * 1024;
#define TILE_KR0(t) ((t) == 0 ? 64 : kbase + 64 * ((t) - 1))
#define DMA_KV(t, slot) do { const size_t ro_ = (size_t)TILE_KR0(t) * kp; \
        glds16(ksrc + ro_, (unsigned)__builtin_amdgcn_readfirstlane(kdst + (slot) * SLOTB)); glds16(vsrc + ro_, (unsigned)__builtin_amdgcn_readfirstlane(vdst + (slot) * SLOTB)); } while (0)
    const int vb0 = (int)(lds0 + LDS_V) + ((lane >> 4) & 1) * 32 + (lane & 3) * 8 + (4 * hi + ((lane & 15) >> 2)) * 64;
#pragma unroll
    for (int t = 0; t < 5; ++t) DMA_KV(t, t);
    bf16x8 qr[4];
#pragma unroll
    for (int d0 = 0; d0 < 4; ++d0) qr[d0] = *reinterpret_cast<const bf16x8*>(Qw + (size_t)r32 * DM + d0 * 16 + hi * 8);
    const int qp = qpos0 + r32;
    const float rowterm = -slope2 * (float)qp;
    float mhat = sink2, l_reg = (hi == 0) ? 1.f : 0.f;
    f32x16 o[2]; o[0] = f32x16{}; o[1] = f32x16{};
#define SWA_RESCALE(RM, SUBS) do { if (__any((RM) > 8.f)) { const float dl = __builtin_fmaxf((RM), 0.f); mhat += dl; SUBS; \
        const float f = __builtin_amdgcn_exp2f(-dl); l_reg *= f; if (hi == 0) wsf[r32] = f; asm volatile("s_waitcnt lgkmcnt(0)" ::: "memory"); \
        _Pragma("unroll") for (int d = 0; d < 2; ++d) _Pragma("unroll") for (int r = 0; r < 16; ++r) o[d][r] *= wsf[crow(r, hi)]; } } while (0)
    WAIT_BAR0();
    for (int t = 0; t < 5; ++t) {
        if (dbg_nocompute) continue;
        const int slot = t, kr0 = TILE_KR0(t);
        const char* Kslot = shm + LDS_K + slot * SLOTB;
        if (t == 0) {
            f32x16 p1; { const float nm = rowterm - mhat;
#pragma unroll
                for (int r = 0; r < 16; ++r) p1[r] = nm; }
            const char* kb = Kslot + hi * 1024 + r32 * 16 + 512;
#pragma unroll
            for (int d0 = 0; d0 < 4; ++d0) p1 = __builtin_amdgcn_mfma_f32_32x32x16_bf16(*reinterpret_cast<const bf16x8*>(kb + d0 * 2048), qr[d0], p1, 0, 0, 0);
            const float base = slope2 * (float)(96 + 4 * hi);
            float x[8];
#pragma unroll
            for (int r = 0; r < 8; ++r) x[r] = p1[8 + r] + __builtin_fmaf(slope2, (float)(((8 + r) & 3) + 8 * ((8 + r) >> 2)), base);
            float rm = MX3(MX3(x[0], x[1], x[2]), MX3(x[3], x[4], x[5]), __builtin_fmaxf(x[6], x[7]));
            { auto rr = __builtin_amdgcn_permlane32_swap(__float_as_uint(rm), __float_as_uint(rm), false, false); rm = __builtin_fmaxf(__uint_as_float(rr[0]), __uint_as_float(rr[1])); }
            SWA_RESCALE(rm, _Pragma("unroll") for (int r = 0; r < 8; ++r) x[r] -= dl);
            float sacc = 0.f;
#pragma unroll
            for (int r = 0; r < 8; ++r) { x[r] = __builtin_amdgcn_exp2f(x[r]); sacc += x[r]; }
            l_reg += sacc;
            const u32x4 pw3 = (u32x4){cvtpk_s(x[0], x[1]), cvtpk_s(x[2], x[3]), cvtpk_s(x[4], x[5]), cvtpk_s(x[6], x[7])};
            const int vb = vb0 + slot * SLOTB;
#pragma unroll
            for (int d0 = 0; d0 < 2; ++d0) { s16x4 lo, hh;
                asm volatile("ds_read_b64_tr_b16 %0,%1 offset:%c2" : "=&v"(lo) : "v"(vb), "i"(d0 * 4096 + 3 * 1024) : "memory");
                asm volatile("ds_read_b64_tr_b16 %0,%1 offset:%c2" : "=&v"(hh) : "v"(vb), "i"(d0 * 4096 + 3 * 1024 + 512) : "memory");
                asm volatile("s_waitcnt lgkmcnt(0)" ::: "memory"); SBAR();
                o[d0] = __builtin_amdgcn_mfma_f32_32x32x16_bf16(__builtin_bit_cast(bf16x8, pw3), (bf16x8){lo[0], lo[1], lo[2], lo[3], hh[0], hh[1], hh[2], hh[3]}, o[d0], 0, 0, 0); }
            continue;
        }
        const int dmin = qpos0 - (kr0 + 63), dmax = qpos0 + 31 - kr0;
        if (dmax < 0 || dmin >= 128 || kr0 + 63 < KR_REAL) continue;
        f32x16 negm; { const float nm = rowterm - mhat;
#pragma unroll
            for (int r = 0; r < 16; ++r) negm[r] = nm; }
        f32x16 p0, p1;
        qkt(p0, p1, Kslot, qr, negm, r32, hi);
        const float base = slope2 * (float)(kr0 + 4 * hi);
        const int lim = qp - kr0 - 4 * hi;
        if (dmin < 0) {
#pragma unroll
            for (int r = 0; r < 16; ++r) { const int cr = (r & 3) + 8 * (r >> 2);
                p0[r] = (cr <= lim) ? p0[r] + __builtin_fmaf(slope2, (float)cr, base) : -INFINITY; p1[r] = (cr + 32 <= lim) ? p1[r] + __builtin_fmaf(slope2, (float)(cr + 32), base) : -INFINITY; }
        } else if (dmax >= 128) {
#pragma unroll
            for (int r = 0; r < 16; ++r) { const int cr = (r & 3) + 8 * (r >> 2);
                p0[r] = (cr > lim - 128) ? p0[r] + __builtin_fmaf(slope2, (float)cr, base) : -INFINITY; p1[r] = (cr + 32 > lim - 128) ? p1[r] + __builtin_fmaf(slope2, (float)(cr + 32), base) : -INFINITY; }
        } else {
#pragma unroll
            for (int r = 0; r < 16; ++r) { const int cr = (r & 3) + 8 * (r >> 2); p0[r] += __builtin_fmaf(slope2, (float)cr, base); p1[r] += __builtin_fmaf(slope2, (float)(cr + 32), base); }
        }
        const float rm = rowmax(p0, p1);
        SWA_RESCALE(rm, _Pragma("unroll") for (int r = 0; r < 16; ++r) { p0[r] -= dl; p1[r] -= dl; });
        float sacc = 0.f;
#pragma unroll
        for (int r = 0; r < 16; ++r) { p0[r] = __builtin_amdgcn_exp2f(p0[r]); p1[r] = __builtin_amdgcn_exp2f(p1[r]); sacc += p0[r] + p1[r]; }
        l_reg += sacc;
        u32x4 pw0, pw1, pw2, pw3;
        pw0 = (u32x4){cvtpk_s(p0[0], p0[1]), cvtpk_s(p0[2], p0[3]), cvtpk_s(p0[4], p0[5]), cvtpk_s(p0[6], p0[7])};
        pw1 = (u32x4){cvtpk_s(p0[8], p0[9]), cvtpk_s(p0[10], p0[11]), cvtpk_s(p0[12], p0[13]), cvtpk_s(p0[14], p0[15])};
        pw2 = (u32x4){cvtpk_s(p1[0], p1[1]), cvtpk_s(p1[2], p1[3]), cvtpk_s(p1[4], p1[5]), cvtpk_s(p1[6], p1[7])};
        pw3 = (u32x4){cvtpk_s(p1[8], p1[9]), cvtpk_s(p1[10], p1[11]), cvtpk_s(p1[12], p1[13]), cvtpk_s(p1[14], p1[15])};
        SBAR();
        pv(o, vb0 + slot * SLOTB, __builtin_bit_cast(bf16x8, pw0), __builtin_bit_cast(bf16x8, pw1), __builtin_bit_cast(bf16x8, pw2), __builtin_bit_cast(bf16x8, pw3));
    }
    { auto rr = __builtin_amdgcn_permlane32_swap(__float_as_uint(l_reg), __float_as_uint(l_reg), false, false); l_reg = __uint_as_float(rr[0]) + __uint_as_float(rr[1]); }
    if (hi == 0) wsf[32 + r32] = l_reg;
    asm volatile("s_waitcnt lgkmcnt(0)" ::: "memory");
    float rli[16];
#pragma unroll
    for (int r = 0; r < 16; ++r) rli[r] = 1.0f / wsf[32 + crow(r, hi)];
    { __hip_bfloat16* stg = (__hip_bfloat16*)(shm + LDS_OST) + wid * 2048;
#pragma unroll
        for (int r = 0; r < 16; ++r) { const int orow = crow(r, hi);
#pragma unroll
            for (int d0 = 0; d0 < 2; ++d0) stg[orow * 64 + d0 * 32 + r32] = __float2bfloat16(o[d0][r] * rli[r]); }
        asm volatile("s_waitcnt lgkmcnt(0)" ::: "memory");
#pragma unroll
        for (int i = 0; i < 4; ++i) { const int row = i * 8 + (lane >> 3), ch = lane & 7; const u32x4 v = *(const u32x4*)(stg + row * 64 + ch * 8); *(u32x4*)(Ow + (size_t)row * DM + ch * 8) = v; } }
    asm volatile("s_waitcnt lgkmcnt(0)\n\ts_barrier" ::: "memory");
#undef SWA_RESCALE
#undef DMA_KV
#undef TILE_KR0
}

__device__ __forceinline__ void unit_swa2(const bf16_t* Qw, bf16_t* Ow, const bf16_t* Kh, const bf16_t* Vh, int kp, int kbase, int qpos0, float slope2, float sink2, char* shm) {
    const int tid = threadIdx.x; int lane_ = tid & 63; asm volatile("" : "+v"(lane_));
    const int lane = lane_, r32 = lane & 31, hi = lane >> 5; const int wid = __builtin_amdgcn_readfirstlane(tid >> 6);
    const unsigned lds0 = (unsigned)(uintptr_t)shm;
    float* wsf = (float*)(shm + LDS_WS) + wid * 64;
    const bf16_t* ksrc = Kh + (size_t)lane * kp + wid * 8;
    const bf16_t* vsrc = Vh + (size_t)(16 * (wid & 3) + (lane >> 2)) * kp + (wid >> 2) * 32 + (lane & 3) * 8;
    const unsigned kdst = lds0 + LDS_K + wid * 1024, vdst = lds0 + LDS_V + wid * 1024;
#define TILE_KR0(t) ((t) == 0 ? 64 : kbase + 64 * ((t) - 1))
#define DMA_KV(t, slot) do { const size_t ro_ = (size_t)TILE_KR0(t) * kp; \
        glds16(ksrc + ro_, (unsigned)__builtin_amdgcn_readfirstlane(kdst + (slot) * SLOTB)); glds16(vsrc + ro_, (unsigned)__builtin_amdgcn_readfirstlane(vdst + (slot) * SLOTB)); } while (0)
    const int vb0 = (int)(lds0 + LDS_V) + ((lane >> 4) & 1) * 32 + (lane & 3) * 8 + (4 * hi + ((lane & 15) >> 2)) * 64;
#pragma unroll
    for (int t = 0; t < 5; ++t) DMA_KV(t, t);
    bf16x8 qr[4];
#pragma unroll
    for (int d0 = 0; d0 < 4; ++d0) qr[d0] = *reinterpret_cast<const bf16x8*>(Qw + (size_t)r32 * DM + d0 * 16 + hi * 8);
    const int qp = qpos0 + r32;
    const float rowterm = -slope2 * (float)qp;
    const int jb0 = ((qpos0 - kbase - 128) >> 5) >= 2 ? 1 : 0;
    const int krW = kbase + 64 * jb0, krF = krW + 64, krC = krW + 128;
    const bool vW = krW >= KR_REAL, vF = krF >= KR_REAL;
    f32x16 initc;
#pragma unroll
    for (int r = 0; r < 16; ++r) initc[r] = rowterm;
    WAIT_BAR0();
    f32x16 pm = initc;
    { const char* kb = shm + LDS_K + hi * 1024 + r32 * 16 + 512;
#pragma unroll
      for (int d0 = 0; d0 < 4; ++d0) pm = __builtin_amdgcn_mfma_f32_32x32x16_bf16(*reinterpret_cast<const bf16x8*>(kb + d0 * 2048), qr[d0], pm, 0, 0, 0); }
    f32x16 w0, w1, f0, f1, c0, c1;
    if (vW) qkt(w0, w1, shm + LDS_K + (1 + jb0) * SLOTB, qr, initc, r32, hi);
    if (vF) qkt(f0, f1, shm + LDS_K + (2 + jb0) * SLOTB, qr, initc, r32, hi);
    qkt(c0, c1, shm + LDS_K + (3 + jb0) * SLOTB, qr, initc, r32, hi);
    float xm[8];
    { const float base = slope2 * (float)(96 + 4 * hi);
#pragma unroll
      for (int r = 0; r < 8; ++r) xm[r] = pm[8 + r] + __builtin_fmaf(slope2, (float)(((8 + r) & 3) + 8 * ((8 + r) >> 2)), base); }
    if (vW) { const float base = slope2 * (float)(krW + 4 * hi); const int lim = qp - krW - 4 * hi;
#pragma unroll
        for (int r = 0; r < 16; ++r) { const int cr = (r & 3) + 8 * (r >> 2);
            w0[r] = (cr > lim - 128) ? w0[r] + __builtin_fmaf(slope2, (float)cr, base) : -INFINITY; w1[r] = (cr + 32 > lim - 128) ? w1[r] + __builtin_fmaf(slope2, (float)(cr + 32), base) : -INFINITY; }
    } else {
#pragma unroll
        for (int r = 0; r < 16; ++r) { w0[r] = -INFINITY; w1[r] = -INFINITY; } }
    if (vF) { const float base = slope2 * (float)(krF + 4 * hi);
#pragma unroll
        for (int r = 0; r < 16; ++r) { const int cr = (r & 3) + 8 * (r >> 2); f0[r] += __builtin_fmaf(slope2, (float)cr, base); f1[r] += __builtin_fmaf(slope2, (float)(cr + 32), base); }
    } else {
#pragma unroll
        for (int r = 0; r < 16; ++r) { f0[r] = -INFINITY; f1[r] = -INFINITY; } }
    { const float base = slope2 * (float)(krC + 4 * hi); const int lim = qp - krC - 4 * hi;
#pragma unroll
      for (int r = 0; r < 16; ++r) { const int cr = (r & 3) + 8 * (r >> 2);
          c0[r] = (cr <= lim) ? c0[r] + __builtin_fmaf(slope2, (float)cr, base) : -INFINITY; c1[r] = (cr + 32 <= lim) ? c1[r] + __builtin_fmaf(slope2, (float)(cr + 32), base) : -INFINITY; } }
    float m = __builtin_fmaxf(__builtin_fmaxf(rowmax(w0, w1), rowmax(f0, f1)), rowmax(c0, c1));
    { float mm = MX3(MX3(xm[0], xm[1], xm[2]), MX3(xm[3], xm[4], xm[5]), __builtin_fmaxf(xm[6], xm[7]));
      auto rr = __builtin_amdgcn_permlane32_swap(__float_as_uint(mm), __float_as_uint(mm), false, false); mm = __builtin_fmaxf(__uint_as_float(rr[0]), __uint_as_float(rr[1]));
      m = __builtin_fmaxf(__builtin_fmaxf(m, mm), sink2); }
    f32x16 o[2]; o[0] = f32x16{}; o[1] = f32x16{};
    float l_reg = (hi == 0) ? __builtin_amdgcn_exp2f(sink2 - m) : 0.f;
    { float sacc = 0.f;
#pragma unroll
      for (int r = 0; r < 8; ++r) { xm[r] = __builtin_amdgcn_exp2f(xm[r] - m); sacc += xm[r]; }
      l_reg += sacc;
      const u32x4 pw3 = (u32x4){cvtpk_s(xm[0], xm[1]), cvtpk_s(xm[2], xm[3]), cvtpk_s(xm[4], xm[5]), cvtpk_s(xm[6], xm[7])};
#pragma unroll
      for (int d0 = 0; d0 < 2; ++d0) { s16x4 lo, hh;
          asm volatile("ds_read_b64_tr_b16 %0,%1 offset:%c2" : "=&v"(lo) : "v"(vb0), "i"(d0 * 4096 + 3 * 1024) : "memory");
          asm volatile("ds_read_b64_tr_b16 %0,%1 offset:%c2" : "=&v"(hh) : "v"(vb0), "i"(d0 * 4096 + 3 * 1024 + 512) : "memory");
          asm volatile("s_waitcnt lgkmcnt(0)" ::: "memory"); SBAR();
          o[d0] = __builtin_amdgcn_mfma_f32_32x32x16_bf16(__builtin_bit_cast(bf16x8, pw3), (bf16x8){lo[0], lo[1], lo[2], lo[3], hh[0], hh[1], hh[2], hh[3]}, o[d0], 0, 0, 0); } }
#define SWA2_TILE(P0, P1, SLOT) do { float sacc = 0.f; \
        _Pragma("unroll") for (int r = 0; r < 16; ++r) { P0[r] = __builtin_amdgcn_exp2f(P0[r] - m); P1[r] = __builtin_amdgcn_exp2f(P1[r] - m); sacc += P0[r] + P1[r]; } \
        l_reg += sacc; \
        const u32x4 q0_ = (u32x4){cvtpk_s(P0[0], P0[1]), cvtpk_s(P0[2], P0[3]), cvtpk_s(P0[4], P0[5]), cvtpk_s(P0[6], P0[7])}; \
        const u32x4 q1_ = (u32x4){cvtpk_s(P0[8], P0[9]), cvtpk_s(P0[10], P0[11]), cvtpk_s(P0[12], P0[13]), cvtpk_s(P0[14], P0[15])}; \
        const u32x4 q2_ = (u32x4){cvtpk_s(P1[0], P1[1]), cvtpk_s(P1[2], P1[3]), cvtpk_s(P1[4], P1[5]), cvtpk_s(P1[6], P1[7])}; \
        const u32x4 q3_ = (u32x4){cvtpk_s(P1[8], P1[9]), cvtpk_s(P1[10], P1[11]), cvtpk_s(P1[12], P1[13]), cvtpk_s(P1[14], P1[15])}; \
        SBAR(); pv(o, vb0 + (SLOT) * SLOTB, __builtin_bit_cast(bf16x8, q0_), __builtin_bit_cast(bf16x8, q1_), __builtin_bit_cast(bf16x8, q2_), __builtin_bit_cast(bf16x8, q3_)); } while (0)
    if (vW) SWA2_TILE(w0, w1, 1 + jb0);
    if (vF) SWA2_TILE(f0, f1, 2 + jb0);
    SWA2_TILE(c0, c1, 3 + jb0);
#undef SWA2_TILE
    { auto rr = __builtin_amdgcn_permlane32_swap(__float_as_uint(l_reg), __float_as_uint(l_reg), false, false); l_reg = __uint_as_float(rr[0]) + __uint_as_float(rr[1]); }
    if (hi == 0) wsf[32 + r32] = l_reg;
    asm volatile("s_waitcnt lgkmcnt(0)" ::: "memory");
    float rli[16];
#pragma unroll
    for (int r = 0; r < 16; ++r) rli[r] = 1.0f / wsf[32 + crow(r, hi)];
    { __hip_bfloat16* stg = (__hip_bfloat16*)(shm + LDS_OST) + wid * 2048;
#pragma unroll
        for (int r = 0; r < 16; ++r) { const int orow = crow(r, hi);
#pragma unroll
            for (int d0 = 0; d0 < 2; ++d0) stg[orow * 64 + d0 * 32 + r32] = __float2bfloat16(o[d0][r] * rli[r]); }
        asm volatile("s_waitcnt lgkmcnt(0)" ::: "memory");
#pragma unroll
        for (int i = 0; i < 4; ++i) { const int row = i * 8 + (lane >> 3), ch = lane & 7; const u32x4 v = *(const u32x4*)(stg + row * 64 + ch * 8); *(u32x4*)(Ow + (size_t)row * DM + ch * 8) = v; } }
    asm volatile("s_waitcnt lgkmcnt(0)\n\ts_barrier" ::: "memory");
#undef DMA_KV
#undef TILE_KR0
}
#undef WAIT_BAR0
#undef SBAR
#undef MX3
}

namespace attn2 {
using bf16=__hip_bfloat16;
__device__ __forceinline__ int crow(int r,int hi){return (r&3)+8*(r>>2)+4*hi;}
#define SBAR() __builtin_amdgcn_sched_barrier(0)
__device__ __forceinline__ void cmask(f32x16&p0,f32x16&p1,int jb,int qrel,int hi){
  const float NEG=-INFINITY; int kb=64*jb+4*hi;
  #pragma unroll
  for(int r=0;r<16;++r){int kv=kb+(r&3)+8*(r>>2); if(kv>qrel)p0[r]=NEG; if(kv+32>qrel)p1[r]=NEG;}
}

constexpr int NSLOT=3, SLOTB=8192;
constexpr int NW=8;
constexpr int LDS_K=0, LDS_V=NSLOT*SLOTB, LDS_WS=2*NSLOT*SLOTB, LDS_OST=LDS_WS+NW*64*4, LDS_CL=LDS_OST+NW*4096, LDS_SCAN=LDS_CL+2064*4+64, LDS_END=LDS_SCAN+192;
__device__ __forceinline__ void glds16(const void*gsrc,unsigned lds_dst){unsigned keep;
  asm volatile("s_mov_b32 %0, m0\n\ts_mov_b32 m0, %2\n\ts_nop 0\n\tglobal_load_lds_dwordx4 %1, off\n\ts_mov_b32 m0, %0":"=&s"(keep):"v"(gsrc),"s"(lds_dst):"memory");}
__device__ __forceinline__ float max3f(float a,float b,float c){float r;asm("v_max3_f32 %0, %1, %2, %3":"=v"(r):"v"(a),"v"(b),"v"(c));return r;}
__device__ __forceinline__ float max2f(float a,float b){float r;asm("v_max_f32_e32 %0, %1, %2":"=v"(r):"v"(a),"v"(b));return r;}
__device__ __forceinline__ float fadd_s(float a,float b){float r;asm("v_add_f32_e32 %0, %1, %2":"=v"(r):"v"(a),"v"(b));return r;}
__device__ __forceinline__ float fsub_s(float a,float b){float r;asm("v_sub_f32_e32 %0, %1, %2":"=v"(r):"v"(a),"v"(b));return r;}
typedef float f32x2_t __attribute__((ext_vector_type(2))); typedef __bf16 bf16x2_t __attribute__((ext_vector_type(2)));
__device__ __forceinline__ unsigned cvtpk_s(float lo,float hi){f32x2_t v={lo,hi};bf16x2_t b=__builtin_convertvector(v,bf16x2_t);return __builtin_bit_cast(unsigned,b);}
#define WAIT_BAR(N) asm volatile("s_waitcnt vmcnt(" #N ") lgkmcnt(0)\n\ts_barrier":::"memory")

__device__ __forceinline__ void qkt(f32x16&p0,f32x16&p1,const char*Kslot,const bf16x8*qr,const f32x16&negm,int r32,int hi){
  const char*kb=Kslot+hi*1024+r32*16;
  #pragma unroll
  for(int d0=0;d0<4;++d0){
    const bf16x8 b0=*reinterpret_cast<const bf16x8*>(kb+d0*2048);
    const bf16x8 b1=*reinterpret_cast<const bf16x8*>(kb+d0*2048+512);
    if(d0==0){p0=__builtin_amdgcn_mfma_f32_32x32x16_bf16(b0,qr[0],negm,0,0,0);p1=__builtin_amdgcn_mfma_f32_32x32x16_bf16(b1,qr[0],negm,0,0,0);}
    else{p0=__builtin_amdgcn_mfma_f32_32x32x16_bf16(b0,qr[d0],p0,0,0,0);p1=__builtin_amdgcn_mfma_f32_32x32x16_bf16(b1,qr[d0],p1,0,0,0);}}
}
typedef __attribute__((address_space(3))) const char* lds_cptr;
typedef short v4i16_t __attribute__((ext_vector_type(4)));
__device__ __forceinline__ void kload8(bf16x8*kf,lds_cptr kp){
  kf[0]=*(const __attribute__((address_space(3))) bf16x8*)(kp);      kf[1]=*(const __attribute__((address_space(3))) bf16x8*)(kp+512);
  kf[2]=*(const __attribute__((address_space(3))) bf16x8*)(kp+2048); kf[3]=*(const __attribute__((address_space(3))) bf16x8*)(kp+2560);
  kf[4]=*(const __attribute__((address_space(3))) bf16x8*)(kp+4096); kf[5]=*(const __attribute__((address_space(3))) bf16x8*)(kp+4608);
  kf[6]=*(const __attribute__((address_space(3))) bf16x8*)(kp+6144); kf[7]=*(const __attribute__((address_space(3))) bf16x8*)(kp+6656);
}
__device__ __forceinline__ void kload2(bf16x8*kf,lds_cptr kp,int j){ kf[2*j]=*(const __attribute__((address_space(3))) bf16x8*)(kp+j*2048); kf[2*j+1]=*(const __attribute__((address_space(3))) bf16x8*)(kp+j*2048+512); }
__device__ __forceinline__ s16x4 vtr(lds_cptr p){ return __builtin_bit_cast(s16x4,__builtin_amdgcn_ds_read_tr16_b64_v4i16((__attribute__((address_space(3))) v4i16_t*)p)); }
__device__ __forceinline__ float rowmax(const f32x16&p0,const f32x16&p1){
  float a=max3f(p0[0],p0[1],p1[0]),b=max3f(p0[2],p0[3],p1[1]);a=max3f(a,p1[2],p1[3]);
  #pragma unroll
  for(int r=4;r<16;r+=4){a=max3f(a,p0[r],p0[r+1]);b=max3f(b,p0[r+2],p0[r+3]);a=max3f(a,p1[r],p1[r+1]);b=max3f(b,p1[r+2],p1[r+3]);}
  const float m=max2f(a,b);
  auto rr=__builtin_amdgcn_permlane32_swap(__float_as_uint(m),__float_as_uint(m),false,false);
  return max2f(__uint_as_float(rr[0]),__uint_as_float(rr[1]));
}
__device__ __forceinline__ void pv(f32x16*o,int vb,bf16x8 pa0,bf16x8 pa1,bf16x8 pa2,bf16x8 pa3){
  #pragma unroll
  for(int d0=0;d0<2;++d0){s16x4 lo[4],hi[4];
    #pragma unroll
    for(int ks=0;ks<4;++ks){
      asm volatile("ds_read_b64_tr_b16 %0,%1 offset:%c2":"=&v"(lo[ks]):"v"(vb),"i"(d0*4096+ks*1024):"memory");
      asm volatile("ds_read_b64_tr_b16 %0,%1 offset:%c2":"=&v"(hi[ks]):"v"(vb),"i"(d0*4096+ks*1024+512):"memory");}
    asm volatile("s_waitcnt lgkmcnt(0)":::"memory");SBAR();
    #define PK(k) (bf16x8){lo[k][0],lo[k][1],lo[k][2],lo[k][3],hi[k][0],hi[k][1],hi[k][2],hi[k][3]}
    o[d0]=__builtin_amdgcn_mfma_f32_32x32x16_bf16(pa0,PK(0),o[d0],0,0,0);
    o[d0]=__builtin_amdgcn_mfma_f32_32x32x16_bf16(pa1,PK(1),o[d0],0,0,0);
    o[d0]=__builtin_amdgcn_mfma_f32_32x32x16_bf16(pa2,PK(2),o[d0],0,0,0);
    o[d0]=__builtin_amdgcn_mfma_f32_32x32x16_bf16(pa3,PK(3),o[d0],0,0,0);
    #undef PK
  }
}


__device__ __forceinline__ void amask(f32x16&p0,f32x16&p1,int kr0,int qp,float slope2,int hi){
  asm volatile("":"+v"(slope2));
  const float base=slope2*(float)(kr0+4*hi); const int d0=qp-kr0-4*hi;
  #pragma unroll
  for(int r=0;r<16;++r){ const int cr=(r&3)+8*(r>>2); const int da=d0-cr, db=da-32;
    const bool ok0=((unsigned)da<128u)&&(qp-da>=KR_REAL), ok1=((unsigned)db<128u)&&(qp-db>=KR_REAL);
    p0[r]=ok0?p0[r]+__builtin_fmaf(slope2,(float)cr,base):-INFINITY; p1[r]=ok1?p1[r]+__builtin_fmaf(slope2,(float)(cr+32),base):-INFINITY; }
}
template<int MODE,int THRL> __device__ __forceinline__ void unit2(const bf16*Qw,bf16*Ow,const bf16*__restrict__ Kh,const bf16*__restrict__ Vh,int kp,int NT,int row0,int kbase,int qpos0,int qrel0,float slope2,float sink2,const float*cl,char*shm){
  const int tid=threadIdx.x; int lane_=tid&63; asm volatile("":"+v"(lane_));
  const int lane=lane_,r32=lane&31,hi=lane>>5; const int wid=__builtin_amdgcn_readfirstlane(tid>>6);
  const unsigned lds0=(unsigned)(uintptr_t)shm;
  float*wsf=(float*)(shm+LDS_WS)+wid*64;
  const bf16*ksrc=Kh+(long)lane*kp+wid*8;
  const bf16*vsrc=Vh+(long)(16*(wid&3)+(lane>>2))*kp+(wid>>2)*32+(lane&3)*8;
  const unsigned kdst=lds0+LDS_K+wid*1024, vdst=lds0+LDS_V+wid*1024;
  #define TROW(t) ((t)==0?row0:kbase+64*((t)-1))
  #define DMA_K(t,slot) glds16(ksrc+(long)TROW(t)*kp,(unsigned)__builtin_amdgcn_readfirstlane(kdst+(slot)))
  #define DMA_V(t,slot) glds16(vsrc+(long)TROW(t)*kp,(unsigned)__builtin_amdgcn_readfirstlane(vdst+(slot)))
  const int vb0=(int)(lds0+LDS_V)+((lane>>4)&1)*32+(lane&3)*8+(4*hi+((lane&15)>>2))*64;
  const char*Kbase=shm+LDS_K; bf16x8 kf[8];
  const lds_cptr shm3=(lds_cptr)shm; const lds_cptr kp0=shm3+LDS_K+hi*1024+r32*16; const lds_cptr vp0=shm3+LDS_V+((lane>>4)&1)*32+(lane&3)*8+(4*hi+((lane&15)>>2))*64;
  DMA_K(0,0);DMA_V(0,0);DMA_K(1,SLOTB);
  bf16x8 qr[4];
  #pragma unroll
  for(int d0=0;d0<4;++d0)qr[d0]=*reinterpret_cast<const bf16x8*>(&Qw[(long)r32*DM+d0*16+hi*8]);
  const int qrel=qrel0+r32, qp=qpos0+r32;
  const float rowterm=(MODE==0)?cl[qp-KR_META]:-slope2*(float)qp;
  float mhat=(MODE==0)?0.f:sink2,l_reg=(MODE==1&&hi==0)?1.f:0.f;f32x16 o[2];o[0]=f32x16{};o[1]=f32x16{};f32x16 negm;
  { const float nm_=rowterm-mhat; _Pragma("unroll") for(int r=0;r<16;++r)negm[r]=nm_; } asm volatile("":"+v"(negm));
  #define POST(C0,C1,t,MK) do{ if(MODE==0){ const float*clt_=cl+(TROW(t)-KR_META)+4*hi; \
      _Pragma("unroll") for(int g_=0;g_<4;++g_){ const f32x4 a_=*(const f32x4*)(clt_+8*g_), b_=*(const f32x4*)(clt_+32+8*g_); \
        _Pragma("unroll") for(int e_=0;e_<4;++e_){ C0[4*g_+e_]-=a_[e_]; C1[4*g_+e_]-=b_[e_]; } SBAR(); } \
      if(MK) cmask(C0,C1,(t)-(NT-4),qrel,hi); } \
    else { amask(C0,C1,TROW(t),qp,slope2,hi); } }while(0)
  #define POST0(P0,P1) do{ _Pragma("unroll") for(int r=0;r<16;++r)P0[r]=-INFINITY; _Pragma("unroll") for(int r=0;r<8;++r)P1[r]=-INFINITY; \
    if(MODE==0){ const f32x4 a_=*(const f32x4*)(cl+4*hi), b_=*(const f32x4*)(cl+8+4*hi); _Pragma("unroll") for(int e_=0;e_<4;++e_){ P1[8+e_]-=a_[e_]; P1[12+e_]-=b_[e_]; } } \
    else { _Pragma("unroll") for(int r=8;r<16;++r)P1[r]+=slope2*(float)(96+crow(r,hi)); } }while(0)
  bool resc=false;
  #define START(P0,P1) do{ const float rm=rowmax(P0,P1); resc=false; \
    { const float dl=(MODE==0)?rm:__builtin_fmaxf(rm,0.f); mhat=fadd_s(mhat,dl); \
      _Pragma("unroll") for(int r=0;r<16;++r){P0[r]=fsub_s(P0[r],dl);P1[r]=fsub_s(P1[r],dl);} \
      { const float nm_=rowterm-mhat; _Pragma("unroll") for(int r=0;r<16;++r)negm[r]=nm_; } asm volatile("":"+v"(negm)); \
      if(MODE==1) l_reg*=__builtin_amdgcn_exp2f(-dl); } \
    _Pragma("unroll") for(int r=0;r<16;++r)P0[r]=__builtin_amdgcn_exp2f(P0[r]); }while(0)
  #define RESC() do{ if(resc){ asm volatile("s_waitcnt lgkmcnt(0)":::"memory"); \
      _Pragma("unroll") for(int d_=0;d_<2;++d_) _Pragma("unroll") for(int r=0;r<16;++r)o[d_][r]*=wsf[crow(r,hi)]; } }while(0)
  f32x16 pA0,pA1,pB0,pB1;
  int sl_prev=0,sl_cur=0,sl_next=SLOTB;
  #define ROT() do{sl_prev=sl_cur;sl_cur=sl_next;sl_next=(sl_next==(NSLOT-1)*SLOTB)?0:sl_next+SLOTB;}while(0)
  DMA_K(2,2*SLOTB);
  WAIT_BAR(3);
  qkt(pA0,pA1,Kbase,qr,negm,r32,hi);asm volatile("s_nop 15\n\ts_nop 7":"+v"(pA0),"+v"(pA1));if(row0==64){POST0(pA0,pA1);}else{POST(pA0,pA1,0,false);}
  START(pA0,pA1);
  _Pragma("unroll") for(int r=0;r<16;++r)pA1[r]=__builtin_amdgcn_exp2f(pA1[r]);
  WAIT_BAR(0);
  DMA_K(3,0);DMA_V(1,SLOTB);
  ROT();
  kload8(kf,kp0+sl_cur);
  WAIT_BAR(2);
  s16x4 vlo[8],vhi[8]; u32x4 pw0,pw1,pw2,pw3;
  #define PKW(P,B) cvtpk_s(P[B],P[B+1])
  #define PAF(k) __builtin_bit_cast(bf16x8,pw##k)
  #define VFR(i) (bf16x8){vlo[i][0],vlo[i][1],vlo[i][2],vlo[i][3],vhi[i][0],vhi[i][1],vhi[i][2],vhi[i][3]}
  #define PIN(x) asm volatile("":"+v"(x))
  #define MX3(a,b,c) __builtin_fmaxf(__builtin_fmaxf((a),(b)),(c))
  #define GAPA(MF,A0,A1,A2,A3,W0,W1,PW) do{ MF; sacc+=A0; sacc+=A1; sacc+=A2; sacc+=A3; PIN(sacc); W0; W1; PIN(PW); SBAR(); }while(0)
  #define EX(v) __builtin_amdgcn_exp2f(v)
  #define GAPB(MF,X,B) do{ MF; X[B]=EX(X[B]); X[B+1]=EX(X[B+1]); X[B+2]=EX(X[B+2]); X[B+3]=EX(X[B+3]); PIN(X); SBAR(); }while(0)
  #define VRD(i) do{ vlo[i]=vtr(vp_+(((i)>>2)*4096+((i)&3)*1024)); vhi[i]=vtr(vp_+(((i)>>2)*4096+((i)&3)*1024+512)); }while(0)
  #define KRD(G,j) do{ if(G){ kload2(kf,kp0+sl_next,j); SBAR(); } }while(0)
  #define STEP(C0,C1,P0,P1,t,GK,GV,GL,MK) do{ SBAR(); \
    const lds_cptr vp_=vp0+sl_prev; \
    VRD(0); SBAR(); float sacc=(P0[0]+P0[1]); \
    GAPA(C0=__builtin_amdgcn_mfma_f32_32x32x16_bf16(kf[0],qr[0],negm,0,0,0), P0[2],P0[3],P0[4],P0[5],     pw0[0]=PKW(P0,0), pw0[1]=PKW(P0,2), pw0); \
    VRD(4); SBAR(); GAPA(C1=__builtin_amdgcn_mfma_f32_32x32x16_bf16(kf[1],qr[0],negm,0,0,0), P0[6],P0[7],P0[8],P0[9],     pw0[2]=PKW(P0,4), pw0[3]=PKW(P0,6), pw0); \
    VRD(1); SBAR(); GAPA(C0=__builtin_amdgcn_mfma_f32_32x32x16_bf16(kf[2],qr[1],C0,0,0,0),   P0[10],P0[11],P0[12],P0[13], pw1[0]=PKW(P0,8), pw1[1]=PKW(P0,10), pw1); \
    VRD(5); SBAR(); GAPA(C1=__builtin_amdgcn_mfma_f32_32x32x16_bf16(kf[3],qr[1],C1,0,0,0),   P0[14],P0[15],P1[0],P1[1],   pw1[2]=PKW(P0,12),pw1[3]=PKW(P0,14), pw1); \
    VRD(2); SBAR(); GAPA(C0=__builtin_amdgcn_mfma_f32_32x32x16_bf16(kf[4],qr[2],C0,0,0,0),   P1[2],P1[3],P1[4],P1[5],     pw2[0]=PKW(P1,0), pw2[1]=PKW(P1,2), pw2); \
    VRD(6); SBAR(); GAPA(C1=__builtin_amdgcn_mfma_f32_32x32x16_bf16(kf[5],qr[2],C1,0,0,0),   P1[6],P1[7],P1[8],P1[9],     pw2[2]=PKW(P1,4), pw2[3]=PKW(P1,6), pw2); \
    VRD(3); SBAR(); GAPA(C0=__builtin_amdgcn_mfma_f32_32x32x16_bf16(kf[6],qr[3],C0,0,0,0),   P1[10],P1[11],P1[12],P1[13], pw3[0]=PKW(P1,8), pw3[1]=PKW(P1,10), pw3); \
    VRD(7); SBAR(); GAPA(C1=__builtin_amdgcn_mfma_f32_32x32x16_bf16(kf[7],qr[3],C1,0,0,0),   P1[14],P1[15],0.f,0.f,       pw3[2]=PKW(P1,12),pw3[3]=PKW(P1,14), pw3); \
    l_reg+=sacc; \
    if(GK){DMA_K((t)+3,sl_cur);} if(GV){DMA_V((t)+1,sl_next);} \
    POST(C0,C1,t,MK); \
    { float a=MX3(C0[0],C0[1],C1[0]),b=MX3(C0[2],C0[3],C1[1]); a=MX3(a,C1[2],C1[3]); \
      _Pragma("unroll") for(int r=4;r<16;r+=4){a=MX3(a,C0[r],C0[r+1]);b=MX3(b,C0[r+2],C0[r+3]);a=MX3(a,C1[r],C1[r+1]);b=MX3(b,C1[r+2],C1[r+3]);} \
      float rm=__builtin_fmaxf(a,b); { auto rr=__builtin_amdgcn_permlane32_swap(__float_as_uint(rm),__float_as_uint(rm),false,false); rm=__builtin_fmaxf(__uint_as_float(rr[0]),__uint_as_float(rr[1])); } \
      resc=false; \
      if(__builtin_expect(__any(rm>(float)THRL),0)){ const float dl=__builtin_fmaxf(rm,0.f); mhat+=dl; \
        _Pragma("unroll") for(int r=0;r<16;++r){C0[r]-=dl;C1[r]-=dl;} \
        { const float nm_=rowterm-mhat; _Pragma("unroll") for(int r=0;r<16;++r)negm[r]=nm_; } asm volatile("":"+v"(negm)); \
        const float f=__builtin_amdgcn_exp2f(-dl); l_reg*=f; if(hi==0)wsf[r32]=f; resc=true; } } \
    SBAR(); \
    GAPB(o[0]=__builtin_amdgcn_mfma_f32_32x32x16_bf16(PAF(0),VFR(0),o[0],0,0,0), C0,0); \
    GAPB(o[1]=__builtin_amdgcn_mfma_f32_32x32x16_bf16(PAF(0),VFR(4),o[1],0,0,0), C0,4); \
    KRD(GL,0); GAPB(o[0]=__builtin_amdgcn_mfma_f32_32x32x16_bf16(PAF(1),VFR(1),o[0],0,0,0), C0,8); \
    KRD(GL,1); GAPB(o[1]=__builtin_amdgcn_mfma_f32_32x32x16_bf16(PAF(1),VFR(5),o[1],0,0,0), C0,12); \
    KRD(GL,2); GAPB(o[0]=__builtin_amdgcn_mfma_f32_32x32x16_bf16(PAF(2),VFR(2),o[0],0,0,0), C1,0); \
    KRD(GL,3); GAPB(o[1]=__builtin_amdgcn_mfma_f32_32x32x16_bf16(PAF(2),VFR(6),o[1],0,0,0), C1,4); \
    GAPB(o[0]=__builtin_amdgcn_mfma_f32_32x32x16_bf16(PAF(3),VFR(3),o[0],0,0,0), C1,8); \
    GAPB(o[1]=__builtin_amdgcn_mfma_f32_32x32x16_bf16(PAF(3),VFR(7),o[1],0,0,0), C1,12); \
    }while(0)
  int t=1;
  for(;t<NT-4;t+=2){
    STEP(pB0,pB1,pA0,pA1,t,true,true,true,false);     WAIT_BAR(2); RESC(); ROT();
    STEP(pA0,pA1,pB0,pB1,t+1,true,true,true,false);   WAIT_BAR(2); RESC(); ROT();
  }
  STEP(pB0,pB1,pA0,pA1,NT-4,true,true,true,true);     WAIT_BAR(2); RESC(); ROT();
  STEP(pA0,pA1,pB0,pB1,NT-3,false,true,true,true);    WAIT_BAR(1); RESC(); ROT();
  STEP(pB0,pB1,pA0,pA1,NT-2,false,true,true,true);    WAIT_BAR(0); RESC(); ROT();
  STEP(pA0,pA1,pB0,pB1,NT-1,false,false,false,true);  RESC();
  { float sacc=pA0[0]+pA0[1]; _Pragma("unroll") for(int r=2;r<16;++r)sacc+=pA0[r]; _Pragma("unroll") for(int r=0;r<16;++r)sacc+=pA1[r]; l_reg+=sacc;
    pw0=(u32x4){PKW(pA0,0),PKW(pA0,2),PKW(pA0,4),PKW(pA0,6)};pw1=(u32x4){PKW(pA0,8),PKW(pA0,10),PKW(pA0,12),PKW(pA0,14)};pw2=(u32x4){PKW(pA1,0),PKW(pA1,2),PKW(pA1,4),PKW(pA1,6)};pw3=(u32x4){PKW(pA1,8),PKW(pA1,10),PKW(pA1,12),PKW(pA1,14)};
    SBAR(); pv(o,vb0+sl_cur,PAF(0),PAF(1),PAF(2),PAF(3)); }
  #undef PKW
  #undef PAF
  #undef VFR
  #undef PIN
  #undef MX3
  #undef GAPA
  #undef GAPB
  #undef EX
  #undef VRD
  #undef KRD
  #undef STEP
  {auto rr=__builtin_amdgcn_permlane32_swap(__float_as_uint(l_reg),__float_as_uint(l_reg),false,false);l_reg=__uint_as_float(rr[0])+__uint_as_float(rr[1]);}
  if(hi==0)wsf[32+r32]=l_reg;asm volatile("s_waitcnt lgkmcnt(0)":::"memory");
  float rli[16];
  #pragma unroll
  for(int r=0;r<16;++r)rli[r]=__builtin_amdgcn_rcpf(wsf[32+crow(r,hi)]);
  { bf16*stg=(bf16*)(shm+LDS_OST)+wid*2048;
    #pragma unroll
    for(int r=0;r<16;++r){const int orow=crow(r,hi);
      #pragma unroll
      for(int d0=0;d0<2;++d0)stg[orow*64+d0*32+r32]=__float2bfloat16(o[d0][r]*rli[r]);}
    asm volatile("s_waitcnt lgkmcnt(0)":::"memory");
    #pragma unroll
    for(int i=0;i<4;++i){const int row=i*8+(lane>>3),ch=lane&7; const u32x4 v=*(const u32x4*)(stg+row*64+ch*8); *(u32x4*)(Ow+(long)row*DM+ch*8)=v;} }
  asm volatile("s_waitcnt lgkmcnt(0)\n\ts_barrier":::"memory");
  #undef DMA_K
  #undef DMA_V
  #undef POST
  #undef POST0
  #undef TROW
  #undef START
  #undef RESC
  #undef ROT
}

#undef SBAR
#undef WAIT_BAR
}

constexpr int NWAVES = 8;
#ifndef MK_N_LAUNCHES
#define MK_N_LAUNCHES 1
#endif
constexpr int N_PHASES = 9;
constexpr int N_LAUNCHES = MK_N_LAUNCHES;

constexpr size_t MiB = 1u << 20;
constexpr size_t WS_CTL = 0, CTL_ZERO_BYTES = 64 * 1024;
constexpr size_t WS_SSQ = 2 * MiB;
constexpr size_t WS_META = 10 * MiB;
constexpr size_t WS_LOGF = 11 * MiB;
constexpr size_t WS_QN2 = 4 * MiB, WS_KN2 = 6 * MiB;
static_assert(WS_QN2 + (size_t)MROWS * 64 <= WS_KN2 && WS_KN2 + (size_t)NKR * 64 <= WS_META, "norm partials map");
constexpr size_t WS_W1 = 16 * MiB, WS_W2 = 27 * MiB, WS_WP = 33 * MiB, WS_WAB = 42 * MiB, WS_WO = 44 * MiB, WS_W3 = 46 * MiB, WS_W4 = 57 * MiB;
constexpr size_t WS_XB = 64 * MiB;
constexpr size_t WS_R = 128 * MiB;
constexpr size_t WS_ACT = WS_R;
constexpr size_t WS_QO = WS_R, WS_KA = WS_R + 64 * MiB, WS_VA = WS_KA + 9 * MiB, WS_KB = WS_VA + 9 * MiB, WS_VB = WS_KB + 34 * MiB,
                 WS_SGA = WS_VB + 34 * MiB, WS_SGB = WS_SGA + 64 * MiB, WS_MIX = WS_SGB + 64 * MiB, WS_END = WS_MIX + 64 * MiB;
static_assert(WS_W1 + (size_t)2 * DFF * DM * 2 <= WS_W2 && WS_W2 + (size_t)DM * DFF * 2 <= WS_WP && WS_WP + (size_t)NPROJ * DM * 2 <= WS_WAB && WS_W3 + (size_t)2 * DFF * DM * 2 <= WS_W4 && WS_W4 + (size_t)DM * DFF * 2 <= WS_XB, "weights map");
static_assert((size_t)NKR * 128 * 2 <= 9 * MiB && (size_t)NKR * 512 * 2 <= 34 * MiB && (size_t)NKR * 8 * 4 <= 2 * MiB && WS_END <= 512 * MiB && WS_ACT + (size_t)MROWS * DFF * 2 <= WS_END, "activation map");
constexpr size_t MT_XB = 0, MT_SSQ0 = 32768, MT_ACT = 65536, MT_H1B = 163840, MT_SSQ1 = 196608, MT_KNM = 204800;
constexpr int CW_BAR = 4096;
constexpr int CW_PANEL = 8192;
static_assert((CW_PANEL + 64 * 128) * 4 <= (int)CTL_ZERO_BYTES, "control words inside the per-call memset");

constexpr int RING_OFF = 0, RING_BYTES = 131072;
constexpr int LDSCTL_OFF = RING_BYTES, MISC_OFF = LDSCTL_OFF + 320;
constexpr int LDS_BYTES = 147456;
static_assert(MISC_OFF + 128 <= LDS_BYTES && attn::LDS_END <= RING_BYTES && attn2::LDS_END <= RING_BYTES, "LDS map");

typedef GAS unsigned gu32;
#define RLX_AGENT __ATOMIC_RELAXED, __HIP_MEMORY_SCOPE_AGENT
#define LDS_WAIT() asm volatile("s_waitcnt lgkmcnt(0)" ::: "memory")
#define VM_WAIT() asm volatile("s_waitcnt vmcnt(0)" ::: "memory")
#define XB_TMO      128
#define XB_XCNT(j)  (256  + 64 * (j))
#define XB_XSUB(j)  (1280 + 64 * (j))
#define XB_XGEN(j)  (2304 + 64 * (j))
#define XB_TOP      3328
#define XB_TOPGEN   3392
#define XB_LSUB(j)  (3456 + 16 * (j))
#define XB_LGEN(j)  (3712 + 16 * (j))
#define XCD_BAR_WORDS 3968
#define XB_SPIN_CAP (1u << 18)

__device__ __forceinline__ unsigned xb_ld(unsigned* p)              { return __hip_atomic_load(p, __ATOMIC_RELAXED, __HIP_MEMORY_SCOPE_AGENT); }
__device__ __forceinline__ unsigned xb_add(unsigned* p, unsigned v) { return __hip_atomic_fetch_add(p, v, __ATOMIC_RELAXED, __HIP_MEMORY_SCOPE_AGENT); }
__device__ __forceinline__ unsigned xb_xcc_id() { return (unsigned)__builtin_amdgcn_s_getreg((3 << 11) | 20) & 0xFu; }
#define XB_SPIN(cond, bar) do { unsigned _sp = 0; while (cond) { __builtin_amdgcn_s_sleep(1); \
    if ((++_sp & 255u) == 0u) { if (xb_ld(&(bar)[XB_TMO])) break; if (_sp > XB_SPIN_CAP) { atomicAdd(&(bar)[XB_TMO], 1u); break; } } } } while (0)

struct XcdBarrier {
    unsigned* bar; unsigned x;
    volatile LAS unsigned* st;
};

__device__ __forceinline__ XcdBarrier xcd_barrier_post(unsigned* bar, volatile LAS unsigned* st) {
    XcdBarrier b; b.bar = bar; b.x = xb_xcc_id(); b.st = st;
    if (threadIdx.x == 0) (void)xb_add(&bar[XB_XCNT(b.x)], 1u + ((b.x == (blockIdx.x & 7u)) ? 0x10000u : 0u));
    return b;
}
__device__ __forceinline__ void xcd_barrier_complete(unsigned* bar, unsigned x, unsigned& nloc, unsigned& nx, unsigned& rr) {
    const unsigned G = gridDim.x * gridDim.y * gridDim.z;
    unsigned sum, cnt, mine, mt, sp = 0u;
    for (;;) {
        sum = 0u; cnt = 0u; mine = 0u; mt = 0u;
#pragma unroll
        for (unsigned j = 0; j < 16; ++j) { const unsigned cw = xb_ld(&bar[XB_XCNT(j)]); const unsigned c = cw & 0xFFFFu; mt += cw >> 16; sum += c; cnt += (c > 0u) ? 1u : 0u; mine = (j == x) ? c : mine; }
        if (sum == G) break;
        __builtin_amdgcn_s_sleep(1);
        if ((++sp & 255u) == 0u) { if (xb_ld(&bar[XB_TMO])) break; if (sp > XB_SPIN_CAP) { atomicAdd(&bar[XB_TMO], 1u); break; } }
    }
    nloc = mine > 0u ? mine : 1u; nx = cnt > 0u ? cnt : 1u;
    rr = (sum == G && mt == G && G == 256u && cnt == 8u) ? 1u : 0u;
}

__device__ __forceinline__ void xcd_barrier(const XcdBarrier& b) {
    asm volatile("s_waitcnt vmcnt(0)" ::: "memory");
    __syncthreads();
    if (threadIdx.x == 0) {
        unsigned* bar = b.bar;
        __builtin_amdgcn_s_waitcnt(0);
        unsigned nloc = b.st[0], nx = b.st[1];
        if (nloc == 0u) { unsigned rr; xcd_barrier_complete(bar, b.x, nloc, nx, rr); b.st[0] = nloc; b.st[1] = nx; b.st[2] = rr; }
        const unsigned old = xb_add(&bar[XB_XSUB(b.x)], 1u);
        const unsigned gen = old / nloc;
        if (old + 1u == (gen + 1u) * nloc) {
            __builtin_amdgcn_fence(__ATOMIC_RELEASE, "agent");
            asm volatile("s_waitcnt vmcnt(0)" ::: "memory");
            const unsigned og = xb_add(&bar[XB_TOP], 1u);
            const unsigned tg = og / nx;
            if (og + 1u == (tg + 1u) * nx) xb_add(&bar[XB_TOPGEN], 1u);
            else XB_SPIN(xb_ld(&bar[XB_TOPGEN]) == tg, bar);
            __builtin_amdgcn_fence(__ATOMIC_ACQUIRE, "agent");
            xb_add(&bar[XB_XGEN(b.x)], 1u);
            asm volatile("s_waitcnt vmcnt(0)" ::: "memory");
        } else {
            asm volatile("buffer_inv sc1" ::: "memory");
            XB_SPIN(xb_ld(&bar[XB_XGEN(b.x)]) == gen, bar);
            asm volatile("s_waitcnt vmcnt(0)" ::: "memory");
        }
    }
    __syncthreads();
}

__device__ __forceinline__ void xcd_barrier_local(const XcdBarrier& b) {
    if (b.st[2] == 0u) { xcd_barrier(b); return; }
    asm volatile("s_waitcnt vmcnt(0)" ::: "memory");
    __syncthreads();
    if (threadIdx.x == 0) {
        unsigned* bar = b.bar;
        __builtin_amdgcn_s_waitcnt(0);
        const unsigned nloc = b.st[0];
        const unsigned old = xb_add(&bar[XB_LSUB(b.x)], 1u);
        const unsigned gen = old / nloc;
        if (old + 1u == (gen + 1u) * nloc) xb_add(&bar[XB_LGEN(b.x)], 1u);
        else XB_SPIN(xb_ld(&bar[XB_LGEN(b.x)]) == gen, bar);
    }
    __syncthreads();
}
#if defined(EXP_SEAM)
__device__ __forceinline__ void xcd_barrier_nf(const XcdBarrier& b) {
    asm volatile("s_waitcnt vmcnt(0)" ::: "memory");
    __syncthreads();
    if (threadIdx.x == 0) {
        unsigned* bar = b.bar;
        __builtin_amdgcn_s_waitcnt(0);
        unsigned nloc = b.st[0], nx = b.st[1];
        if (nloc == 0u) { unsigned rr; xcd_barrier_complete(bar, b.x, nloc, nx, rr); b.st[0] = nloc; b.st[1] = nx; b.st[2] = rr; }
        const unsigned old = xb_add(&bar[XB_XSUB(b.x)], 1u);
        const unsigned gen = old / nloc;
        if (old + 1u == (gen + 1u) * nloc) {
            asm volatile("s_waitcnt vmcnt(0)" ::: "memory");
            const unsigned og = xb_add(&bar[XB_TOP], 1u);
            const unsigned tg = og / nx;
            if (og + 1u == (tg + 1u) * nx) xb_add(&bar[XB_TOPGEN], 1u);
            else XB_SPIN(xb_ld(&bar[XB_TOPGEN]) == tg, bar);
            xb_add(&bar[XB_XGEN(b.x)], 1u);
            asm volatile("s_waitcnt vmcnt(0)" ::: "memory");
        } else {
            XB_SPIN(xb_ld(&bar[XB_XGEN(b.x)]) == gen, bar);
            asm volatile("s_waitcnt vmcnt(0)" ::: "memory");
        }
    }
    __syncthreads();
}
__device__ __forceinline__ void xcd_barrier_norel(const XcdBarrier& b) {
    asm volatile("s_waitcnt vmcnt(0)" ::: "memory");
    __syncthreads();
    if (threadIdx.x == 0) {
        unsigned* bar = b.bar;
        __builtin_amdgcn_s_waitcnt(0);
        unsigned nloc = b.st[0], nx = b.st[1];
        if (nloc == 0u) { unsigned rr; xcd_barrier_complete(bar, b.x, nloc, nx, rr); b.st[0] = nloc; b.st[1] = nx; b.st[2] = rr; }
        const unsigned old = xb_add(&bar[XB_XSUB(b.x)], 1u);
        const unsigned gen = old / nloc;
        if (old + 1u == (gen + 1u) * nloc) {
            asm volatile("s_waitcnt vmcnt(0)" ::: "memory");
            const unsigned og = xb_add(&bar[XB_TOP], 1u);
            const unsigned tg = og / nx;
            if (og + 1u == (tg + 1u) * nx) xb_add(&bar[XB_TOPGEN], 1u);
            else XB_SPIN(xb_ld(&bar[XB_TOPGEN]) == tg, bar);
            __builtin_amdgcn_fence(__ATOMIC_ACQUIRE, "agent");
            xb_add(&bar[XB_XGEN(b.x)], 1u);
            asm volatile("s_waitcnt vmcnt(0)" ::: "memory");
        } else {
            asm volatile("buffer_inv sc1" ::: "memory");
            XB_SPIN(xb_ld(&bar[XB_XGEN(b.x)]) == gen, bar);
            asm volatile("s_waitcnt vmcnt(0)" ::: "memory");
        }
    }
    __syncthreads();
}

__device__ __forceinline__ void xcd_barrier_noacq(const XcdBarrier& b) {
    asm volatile("s_waitcnt vmcnt(0)" ::: "memory");
    __syncthreads();
    if (threadIdx.x == 0) {
        unsigned* bar = b.bar;
        __builtin_amdgcn_s_waitcnt(0);
        unsigned nloc = b.st[0], nx = b.st[1];
        if (nloc == 0u) { unsigned rr; xcd_barrier_complete(bar, b.x, nloc, nx, rr); b.st[0] = nloc; b.st[1] = nx; b.st[2] = rr; }
        const unsigned old = xb_add(&bar[XB_XSUB(b.x)], 1u);
        const unsigned gen = old / nloc;
        if (old + 1u == (gen + 1u) * nloc) {
            __builtin_amdgcn_fence(__ATOMIC_RELEASE, "agent");
            asm volatile("s_waitcnt vmcnt(0)" ::: "memory");
            const unsigned og = xb_add(&bar[XB_TOP], 1u);
            const unsigned tg = og / nx;
            if (og + 1u == (tg + 1u) * nx) xb_add(&bar[XB_TOPGEN], 1u);
            else XB_SPIN(xb_ld(&bar[XB_TOPGEN]) == tg, bar);
            xb_add(&bar[XB_XGEN(b.x)], 1u);
            asm volatile("s_waitcnt vmcnt(0)" ::: "memory");
        } else {
            XB_SPIN(xb_ld(&bar[XB_XGEN(b.x)]) == gen, bar);
            asm volatile("s_waitcnt vmcnt(0)" ::: "memory");
        }
    }
    __syncthreads();
}

#endif

struct Frame {
    LAS unsigned char* lds;
    volatile LAS unsigned* MISC;
    gu32* ctl;
    int tid, lane, wave;
    int vcu, G;
    unsigned char* ws;
    const float* in[16]; float* out;
};
__device__ __forceinline__ float wave_sum(float v) {
#pragma unroll
    for (int o = 1; o < 64; o <<= 1) v += __shfl_xor(v, o);
    return v;
}
__device__ __forceinline__ void tr_item(const float* W, int ldw, int k0, int c0, int ncols, const float* gain, bf16_t* WT, int ldt, int drow0, int dk0, LAS float* scr, int lane) {
    float v[32]; const int col = lane & 31, kh = lane >> 5;
    const float* wp = W + (size_t)(k0 + kh) * ldw + c0 + (col < ncols ? col : 0);
#pragma unroll
    for (int i = 0; i < 32; ++i) v[i] = wp[(size_t)(2 * i) * ldw];
    if (gain) {
#pragma unroll
        for (int i = 0; i < 32; ++i) v[i] *= gain[k0 + 2 * i + kh];
    }
#pragma unroll
    for (int i = 0; i < 32; ++i) scr[(2 * i + kh) * 33 + col] = v[i];
    LDS_WAIT(); asm volatile("" ::: "memory");
    const int c = lane & 7;
#pragma unroll
    for (int j = 0; j < 4; ++j) { const int n = (lane >> 3) + 8 * j; const LAS float* s = scr + (8 * c) * 33 + n;
        u32x4 o; o.x = cvt_pk_bf16(s[0 * 33], s[1 * 33]); o.y = cvt_pk_bf16(s[2 * 33], s[3 * 33]); o.z = cvt_pk_bf16(s[4 * 33], s[5 * 33]); o.w = cvt_pk_bf16(s[6 * 33], s[7 * 33]);
        if (n < ncols) *(GAS u32x4*)(WT + (size_t)(drow0 + n) * ldt + dk0 + k0 + 8 * c) = o; }
    LDS_WAIT(); asm volatile("" ::: "memory");
}
__device__ __forceinline__ int swiglu_row(int c0) { const int up = c0 >= DFF, c = up ? c0 - DFF : c0; return 256 * (c / 128) + (up ? 128 : 0) + (c % 128); }
__device__ __forceinline__ void row_to_bf16(const float* xrow, bf16_t* orow, float* ssq16, int lane) {
    const GAS f32x4* xr = (const GAS f32x4*)xrow + lane;
    f32x4 v[4]; float s = 0.f;
#pragma unroll
    for (int j = 0; j < 4; ++j) { v[j] = xr[64 * j]; s += (v[j].x * v[j].x + v[j].y * v[j].y) + (v[j].z * v[j].z + v[j].w * v[j].w); }
    s = wave_sum(s);
    GAS u32x2* o8 = (GAS u32x2*)orow + lane;
#pragma unroll
    for (int j = 0; j < 4; ++j) { u32x2 w; w.x = cvt_pk_bf16(v[j].x, v[j].y); w.y = cvt_pk_bf16(v[j].z, v[j].w); o8[64 * j] = w; }
    if (ssq16 && lane < 16) ssq16[lane] = lane == 0 ? s : 0.f;
}
__device__ __forceinline__ void zero_bytes(Frame& F, void* p, size_t nbytes) {
    const size_t n16 = nbytes / 16; GAS u32x4* q = (GAS u32x4*)p;
    for (size_t i = (size_t)F.vcu * 512 + F.tid; i < n16; i += (size_t)F.G * 512) q[i] = (u32x4){0u, 0u, 0u, 0u};
}
__device__ __forceinline__ void p0_prologue(Frame& F, int part = 0) {
    LAS float* scr = (LAS float*)(F.lds + RING_OFF + F.wave * 16384);
    const int gw = F.vcu * NWAVES + F.wave, NGW = F.G * NWAVES;
    unsigned char* ws = F.ws;
    bf16_t *W1t = (bf16_t*)(ws + WS_W1), *W2t = (bf16_t*)(ws + WS_W2), *Wpt = (bf16_t*)(ws + WS_WP), *Wabt = (bf16_t*)(ws + WS_WAB), *Wot = (bf16_t*)(ws + WS_WO), *W3t = (bf16_t*)(ws + WS_W3), *W4t = (bf16_t*)(ws + WS_W4);
    constexpr int I0 = 16 * 176, I1 = 44 * 32, I2 = 16 * 72, I3 = 16 * 64, I4 = 16, I5 = 8 * 32, I6 = 8 * 32, I7 = 16 * 32, I8 = I0, I9 = I1;
    constexpr int NITEMS = I0 + I1 + I2 + I3 + I4 + I5 + I6 + I7 + I8 + I9;
    if (part != 2) for (int it = gw; it < NITEMS; it += NGW) {
        int r = it;
        if (r < I0) { const int kb = r / 176, nb = r % 176; tr_item(F.in[3], 2 * DFF, 64 * kb, 32 * nb, 32, F.in[2], W1t, DM, swiglu_row(32 * nb), 0, scr, F.lane); continue; } r -= I0;
        if (r < I1) { const int kb = r / 32, nb = r % 32; tr_item(F.in[4], DM, 64 * kb, 32 * nb, 32, nullptr, W2t, DFF, 32 * nb, 0, scr, F.lane); continue; } r -= I1;
        if (r < I2) { const int kb = r / 72, nb = r % 72; tr_item(F.in[6], 4360, 64 * kb, 32 * nb, 32, F.in[5], Wpt, DM, 32 * nb, 0, scr, F.lane); continue; } r -= I2;
        if (r < I3) { const int kb = r / 64, nb = r % 64, gb = nb >= 32, cb = gb ? nb - 32 : nb;
            tr_item(F.in[6], 4360, 64 * kb, 2312 + 32 * nb, 32, F.in[5], Wpt, DM, 2304 + 256 * (cb / 4) + (gb ? 128 : 0) + 32 * (cb % 4), 0, scr, F.lane); continue; } r -= I3;
        if (r < I4) { tr_item(F.in[6], 4360, 64 * r, 2304, 8, F.in[5], Wpt, DM, 4352, 0, scr, F.lane); continue; } r -= I4;
        if (r < I5) { const int kb = r / 32, nb = r % 32; tr_item(F.in[9], DM, 64 * kb, 32 * nb, 32, nullptr, Wabt, DM, 32 * nb, 0, scr, F.lane); continue; } r -= I5;
        if (r < I6) { const int kb = r / 32, nb = r % 32; tr_item(F.in[10], DM, 64 * kb, 32 * nb, 32, nullptr, Wabt, DM, 32 * nb, 512, scr, F.lane); continue; } r -= I6;
        if (r < I7) { const int kb = r / 32, nb = r % 32; tr_item(F.in[11], DM, 64 * kb, 32 * nb, 32, nullptr, Wot, DM, 32 * nb, 0, scr, F.lane); continue; } r -= I7;
        if (r < I8) { const int kb = r / 176, nb = r % 176; tr_item(F.in[13], 2 * DFF, 64 * kb, 32 * nb, 32, F.in[12], W3t, DM, swiglu_row(32 * nb), 0, scr, F.lane); continue; } r -= I8;
        { const int kb = r / 32, nb = r % 32; tr_item(F.in[14], DM, 64 * kb, 32 * nb, 32, nullptr, W4t, DFF, 32 * nb, 0, scr, F.lane); }
    }
    bf16_t* XB = (bf16_t*)(ws + WS_XB); float* SSQ = (float*)(ws + WS_SSQ);
    if (part != 1) for (int m0 = gw * 4; m0 < MROWS; m0 += NGW * 4) {
        f32x4 v[4][4]; float sq[4];
#pragma unroll
        for (int r = 0; r < 4; ++r)
#pragma unroll
            for (int j = 0; j < 4; ++j) v[r][j] = ((const GAS f32x4*)(F.in[0] + (size_t)(m0 + r) * DM))[64 * j + F.lane];
#pragma unroll
        for (int r = 0; r < 4; ++r) { float s_ = 0.f;
#pragma unroll
            for (int j = 0; j < 4; ++j) s_ += (v[r][j].x * v[r][j].x + v[r][j].y * v[r][j].y) + (v[r][j].z * v[r][j].z + v[r][j].w * v[r][j].w);
            sq[r] = wave_sum(s_); }
#pragma unroll
        for (int r = 0; r < 4; ++r) { GAS u32x2* o8 = (GAS u32x2*)(XB + (size_t)(m0 + r) * DM) + F.lane;
#pragma unroll
            for (int j = 0; j < 4; ++j) { u32x2 w; w.x = cvt_pk_bf16(v[r][j].x, v[r][j].y); w.y = cvt_pk_bf16(v[r][j].z, v[r][j].w); o8[64 * j] = w; } }
        if (F.lane < 16) {
#pragma unroll
            for (int r = 0; r < 4; ++r) SSQ[(size_t)(m0 + r) * 16 + F.lane] = F.lane == 0 ? sq[r] : 0.f; }
    }
    if (gw < NMETA) row_to_bf16(F.in[1] + (size_t)gw * DM, (bf16_t*)(ws + WS_META + MT_XB) + (size_t)gw * DM, (float*)(ws + WS_META + MT_SSQ0) + gw * 16, F.lane);
    zero_bytes(F, Wpt + (size_t)4360 * DM, (size_t)(NPROJ - 4360) * DM * 2);
    for (int b = 0; b < NBATCH; ++b) {
        zero_bytes(F, (bf16_t*)(ws + WS_KA) + (size_t)b * LPOS * 128, (size_t)KR_META * 128 * 2);
        zero_bytes(F, (bf16_t*)(ws + WS_VA) + (size_t)b * LPOS * 128, (size_t)KR_META * 128 * 2);
        zero_bytes(F, (bf16_t*)(ws + WS_KB) + (size_t)b * LPOS * 512, (size_t)KR_META * 512 * 2);
        zero_bytes(F, (bf16_t*)(ws + WS_VB) + (size_t)b * LPOS * 512, (size_t)KR_META * 512 * 2);
    }
}
template <int K> __device__ __forceinline__ f32x4 meta_partial(const bf16_t* Wr, int ldw, const bf16_t* X, int ldx, int wid, int lane) {
    constexpr int NI = K / 32 / NWAVES; static_assert(K % (32 * NWAVES) == 0, "K split over the 8 waves");
    const int i = lane & 15, q = lane >> 4; f32x4 acc = (f32x4){0.f, 0.f, 0.f, 0.f};
    bf16x8 a[NI], b[NI];
#pragma unroll
    for (int t = 0; t < NI; ++t) { const int s = wid + t * NWAVES; a[t] = *(const bf16x8*)(Wr + (size_t)i * ldw + s * 32 + q * 8); b[t] = *(const bf16x8*)(X + (size_t)i * ldx + s * 32 + q * 8); }
#pragma unroll
    for (int t = 0; t < NI; ++t) acc = __builtin_amdgcn_mfma_f32_16x16x32_bf16(a[t], b[t], acc, 0, 0, 0);
    return acc;
}
__device__ __forceinline__ f32x4 meta_reduce(Frame& F, f32x4 part, int blk) {
    LAS f32x4* scr = (LAS f32x4*)(F.lds + RING_OFF + blk * 8192);
    scr[F.wave * 64 + F.lane] = part;
    __syncthreads();
    f32x4 s = scr[F.lane];
#pragma unroll
    for (int w = 1; w < NWAVES; ++w) s += scr[w * 64 + F.lane];
    __syncthreads();
    return s;
}
__device__ __forceinline__ void meta_up(Frame& F) {
    if (F.vcu >= DFF / 16) return;
    unsigned char* ws = F.ws; const int c = F.vcu, j = F.lane & 15, q = F.lane >> 4;
    const bf16_t* W1t = (const bf16_t*)(ws + WS_W1); const bf16_t* X = (const bf16_t*)(ws + WS_META + MT_XB);
    const int grow = 256 * (c / 8) + 16 * (c % 8);
    f32x4 g = meta_partial<DM>(W1t + (size_t)grow * DM, DM, X, DM, F.wave, F.lane);
    f32x4 u = meta_partial<DM>(W1t + (size_t)(grow + 128) * DM, DM, X, DM, F.wave, F.lane);
    g = meta_reduce(F, g, 0); u = meta_reduce(F, u, 1);
    if (F.wave == 0) {
        const float rs = 1.0f / sqrtf(((const float*)(ws + WS_META + MT_SSQ0))[j * 16] * (1.0f / 1024.0f) + EPS);
        float o[4];
#pragma unroll
        for (int e = 0; e < 4; ++e) { const float gg = g[e] * rs, uu = u[e] * rs; o[e] = gg * pg8::fast_sigmoid(gg) * uu; }
        u32x2 w; w.x = cvt_pk_bf16(o[0], o[1]); w.y = cvt_pk_bf16(o[2], o[3]);
        *(u32x2*)((bf16_t*)(ws + WS_META + MT_ACT) + (size_t)j * DFF + 16 * c + 4 * q) = w;
    }
}
__device__ __forceinline__ void meta_down(Frame& F) {
    if (F.vcu >= DM / 16) return;
    unsigned char* ws = F.ws; const int c = F.vcu, j = F.lane & 15, q = F.lane >> 4;
    const bf16_t* W2t = (const bf16_t*)(ws + WS_W2); const bf16_t* X = (const bf16_t*)(ws + WS_META + MT_ACT);
    f32x4 d = meta_partial<DFF>(W2t + (size_t)(16 * c) * DFF, DFF, X, DFF, F.wave, F.lane);
    d = meta_reduce(F, d, 0);
    if (F.wave == 0) {
        const f32x4 base = *(const f32x4*)(F.in[1] + (size_t)j * DM + 16 * c + 4 * q);
        const f32x4 v = base + d * 0.5f;
        u32x2 w; w.x = cvt_pk_bf16(v[0], v[1]); w.y = cvt_pk_bf16(v[2], v[3]);
        *(u32x2*)((bf16_t*)(ws + WS_META + MT_H1B) + (size_t)j * DM + 16 * c + 4 * q) = w;
        float sq = (v[0] * v[0] + v[1] * v[1]) + (v[2] * v[2] + v[3] * v[3]);
        sq += __shfl_xor(sq, 16); sq += __shfl_xor(sq, 32);
        if (q == 0) ((float*)(ws + WS_META + MT_SSQ1))[j * 64 + c] = sq;
    }
}
__device__ __forceinline__ void meta_proj(Frame& F) {
    if (F.vcu >= 81) return;
    unsigned char* ws = F.ws; const int g = F.vcu, j = F.lane & 15, q = F.lane >> 4;
    const bf16_t* Wpt = (const bf16_t*)(ws + WS_WP); const bf16_t* X = (const bf16_t*)(ws + WS_META + MT_H1B);
    int prow; bf16_t* dst; int pitch, col;
    if (g < 8)       { prow = 512 + 16 * g;         dst = (bf16_t*)(ws + WS_KA); pitch = 128; col = 16 * g; }
    else if (g < 16) { prow = 640 + 16 * (g - 8);   dst = (bf16_t*)(ws + WS_VA); pitch = 128; col = 16 * (g - 8); }
    else if (g < 48) { prow = 1280 + 16 * (g - 16); dst = (bf16_t*)(ws + WS_KB); pitch = 512; col = 16 * (g - 16); }
    else if (g < 80) { prow = 1792 + 16 * (g - 48); dst = (bf16_t*)(ws + WS_VB); pitch = 512; col = 16 * (g - 48); }
    else             { prow = 4352;                 dst = nullptr; pitch = 0; col = 0; }
    f32x4 d = meta_partial<DM>(Wpt + (size_t)prow * DM, DM, X, DM, F.wave, F.lane);
    d = meta_reduce(F, d, 0);
    if (F.wave == 0) {
        const float* s1 = (const float*)(ws + WS_META + MT_SSQ1) + j * 64 + 16 * q;
        const f32x4 a0 = *(const f32x4*)s1, a1 = *(const f32x4*)(s1 + 4), a2 = *(const f32x4*)(s1 + 8), a3 = *(const f32x4*)(s1 + 12);
        float s = ((a0[0] + a0[1]) + (a0[2] + a0[3])) + ((a1[0] + a1[1]) + (a1[2] + a1[3])) + ((a2[0] + a2[1]) + (a2[2] + a2[3])) + ((a3[0] + a3[1]) + (a3[2] + a3[3]));
        s += __shfl_xor(s, 16); s += __shfl_xor(s, 32);
        const float rs = 1.0f / sqrtf(s * (1.0f / 1024.0f) + EPS);
        const f32x4 v = d * rs;
        if (dst) {
            u32x2 w; w.x = cvt_pk_bf16(v[0], v[1]); w.y = cvt_pk_bf16(v[2], v[3]);
            for (int b = 0; b < NBATCH; ++b) *(u32x2*)(dst + (size_t)(b * LPOS + KR_META + j) * pitch + col + 4 * q) = w;
            if (g >= 16 && g < 48) {
                float s2 = (v[0] * v[0] + v[1] * v[1]) + (v[2] * v[2] + v[3] * v[3]);
                s2 += __shfl_xor(s2, 16); s2 += __shfl_xor(s2, 32);
                if (q == 0) ((float*)(ws + WS_META + MT_KNM))[(j * 8 + ((g - 16) >> 2)) * 4 + ((g - 16) & 3)] = s2;
            }
        } else if (q < 2) {
            const f32x4 bb = *(const f32x4*)(F.in[7] + 4 * q); f32x4 lf;
#pragma unroll
            for (int e = 0; e < 4; ++e) { const float x = v[e] + bb[e]; lf[e] = fminf(x, 0.f) - log1pf(expf(-fabsf(x))); }
            float* L = (float*)(ws + WS_LOGF);
            for (int b = 0; b < NBATCH; ++b) *(f32x4*)(L + (size_t)(b * LPOS + KR_META + j) * 8 + 4 * q) = lf;
        }
    }
}
__device__ __forceinline__ void attn_phase(Frame& F, char* shm, bf16_t* OB, int only) {
    unsigned char* ws = F.ws;
    bf16_t* QO = (bf16_t*)(ws + WS_QO);
    const bf16_t *KA = (const bf16_t*)(ws + WS_KA), *VA = (const bf16_t*)(ws + WS_VA), *KB = (const bf16_t*)(ws + WS_KB), *VB = (const bf16_t*)(ws + WS_VB);
    const float* LOGF = (const float*)(ws + WS_LOGF); const float* QN2 = (const float*)(ws + WS_QN2); const float* KN2 = (const float*)(ws + WS_KN2);
    float* cl = (float*)(shm + attn2::LDS_CL); float* wtot = (float*)(shm + attn2::LDS_SCAN);
    if (only != 2 && only != 4) for (int s = F.vcu; s < NBATCH * 8 * 2; s += F.G) {
        const int bh = s >> 1, half = s & 1, b = bh >> 3, h = bh & 7; float kmax2 = 0.f;
        { float v[5]; float run = 0.f; int ln = F.lane; asm volatile("" : "+v"(ln));
#pragma unroll
          for (int k = 0; k < 5; ++k) { const int e = F.tid * 5 + k; const float x = (e < 2064) ? LOGF[(size_t)(b * LPOS + KR_META + e) * 8 + h] : 0.f; run += x; v[k] = run; }
          float inc = run;
#pragma unroll
          for (int o = 1; o < 64; o <<= 1) { const float y = __shfl_up(inc, o); if (ln >= o) inc += y; }
          float km = 0.f;
#pragma unroll
          for (int k = 0; k < 5; ++k) { const int e = F.tid * 5 + k;
              if (e >= NMETA && e < 2064) { const float* kp2 = KN2 + (size_t)(b * LPOS + KR_META + e) * 16 + 2 * h; km = fmaxf(km, kp2[0] + kp2[1]); }
              else if (e < NMETA) { const float* kq = (const float*)(ws + WS_META + MT_KNM) + (e * 8 + h) * 4; km = fmaxf(km, (kq[0] + kq[1]) + (kq[2] + kq[3])); } }
#pragma unroll
          for (int o = 1; o < 64; o <<= 1) km = fmaxf(km, __shfl_xor(km, o));
          float qm4[4];
#pragma unroll
          for (int i = 0; i < 4; ++i) { const int jq = half == 0 ? (i == 0 ? 0 : i == 1 ? 7 : i == 2 ? 3 : 4) : (i == 0 ? 1 : i == 1 ? 6 : i == 2 ? 2 : 5);
              if (F.tid < 256) { const float* qp2 = QN2 + (size_t)(b * SEQ + 256 * jq + F.tid) * 16 + 2 * h; qm4[i] = qp2[0] + qp2[1]; } else qm4[i] = 0.f; }
#pragma unroll
          for (int i = 0; i < 4; ++i) {
#pragma unroll
              for (int o = 1; o < 64; o <<= 1) qm4[i] = fmaxf(qm4[i], __shfl_xor(qm4[i], o)); }
          if (ln == 63) { wtot[F.wave] = inc; wtot[8 + F.wave] = km;
#pragma unroll
              for (int i = 0; i < 4; ++i) wtot[16 + i * 8 + F.wave] = qm4[i]; }
          __syncthreads();
          kmax2 = wtot[8];
          for (int w = 1; w < NWAVES; ++w) kmax2 = fmaxf(kmax2, wtot[8 + w]);
          float woff = 0.f;
          for (int w = 0; w < F.wave; ++w) woff += wtot[w];
          const float ex = inc - run + woff;
#pragma unroll
          for (int k = 0; k < 5; ++k) { const int e = F.tid * 5 + k; if (e < 2064) cl[e] = (v[k] + ex) * LOG2E; }
          __syncthreads(); }
        for (int i = 0; i < 4; ++i) {
            const int jj = half == 0 ? (i == 0 ? 0 : i == 1 ? 7 : i == 2 ? 3 : 4) : (i == 0 ? 1 : i == 1 ? 6 : i == 2 ? 2 : 5);
            const int t0 = 256 * jj + 32 * F.wave;
            int fskip = 0;
            { float qmax2 = wtot[16 + i * 8];
              for (int w = 1; w < 4; ++w) qmax2 = fmaxf(qmax2, wtot[16 + i * 8 + w]);
              const float bound = 2.05f * sqrtf(qmax2 * kmax2) + cl[16 + 256 * jj];
              for (int T = 1; T <= 4 * jj; ++T) { if (bound - cl[79 + 64 * (T - 1)] < -152.f) fskip = T + 1; else break; }
              fskip &= ~1; }
            const int row0 = fskip ? KR_REAL + 64 * (fskip - 1) : 64, kb2 = KR_REAL + 64 * fskip, nt2 = 4 * jj + 5 - fskip;
#if defined(DBG_SKIP)
            if (blockIdx.x == 0 && F.tid == 0 && jj == 7) ((float*)(ws + WS_META + 262144))[0] = (float)fskip;
#endif
            bf16_t* qw = QO + (size_t)(b * SEQ + t0) * DM + 512 + h * 64;
            attn2::unit2<0, 8>((const attn2::bf16*)qw, (attn2::bf16*)(OB + (qw - QO)), (const attn2::bf16*)(KB + (size_t)b * LPOS * 512 + h * 64), (const attn2::bf16*)(VB + (size_t)b * LPOS * 512 + h * 64), 512, nt2, row0, kb2, KR_REAL + t0, 32 * F.wave, 0.f, 0.f, cl, shm);
        }
        __syncthreads();
    }
    if (only != 1) for (int s = F.vcu; s < 256; s += F.G) {
        for (int i = 0; i < 4; ++i) {
            const int a = s * 4 + i, b = a >> 6, rem = a & 63, n = rem >> 2, kvh = (rem >> 1) & 1, pair = rem & 1;
            const int head = kvh * 4 + pair * 2 + (F.wave >> 2), t0 = 128 * n + 32 * (F.wave & 3);
            bf16_t* qw = QO + (size_t)(b * SEQ + t0) * DM + head * 64;
            const float slope2 = exp2f(-(float)(head + 1)) * LOG2E, sink2 = F.in[8][head] * LOG2E;
            attn::unit_swa2(qw, OB + (qw - QO), KA + (size_t)b * LPOS * 128 + kvh * 64, VA + (size_t)b * LPOS * 128 + kvh * 64, 128, 128 * n, KR_REAL + t0, slope2, sink2, shm);
        }
    }
}
__device__ __forceinline__ void final_norm(Frame& F) {
    const int gw = F.vcu * NWAVES + F.wave, NGW = F.G * NWAVES;
    const float* SSQ = (const float*)(F.ws + WS_SSQ);
    f32x4 gf[4];
#pragma unroll
    for (int j = 0; j < 4; ++j) gf[j] = ((const f32x4*)F.in[15])[64 * j + F.lane];
    for (int m = gw; m < MROWS; m += NGW) {
        const f32x4 p = *(const f32x4*)(SSQ + (size_t)m * 16 + 4 * (F.lane & 3));
        float s = (p[0] + p[1]) + (p[2] + p[3]); s += __shfl_xor(s, 1); s += __shfl_xor(s, 2);
        const float rs = 1.0f / sqrtf(s * (1.0f / 1024.0f) + EPS);
        GAS f32x4* xr = (GAS f32x4*)(F.out + (size_t)m * DM) + F.lane;
#pragma unroll
        for (int j = 0; j < 4; ++j) { const f32x4 v = xr[64 * j]; xr[64 * j] = v * rs * gf[j]; }
    }
}

#ifndef EXP_ATTN_ONLY
#define EXP_ATTN_ONLY 0
#endif
#ifndef EXP_P0_PART
#define EXP_P0_PART 0
#endif
struct Args { const float* in[16]; float* out; unsigned char* ws; int ph_lo, ph_hi, alt, pad; };
__global__ void __launch_bounds__(NWAVES * 64, 2) fwd_kernel(Args args) {
    extern __shared__ __attribute__((aligned(16))) unsigned char lds[];
    Frame F;
    F.lds = (LAS unsigned char*)lds;
    F.MISC = (volatile LAS unsigned*)(F.lds + MISC_OFF);
    F.tid = threadIdx.x; F.lane = F.tid & 63; F.wave = __builtin_amdgcn_readfirstlane(F.tid >> 6);
    F.G = gridDim.x; { const int bx = blockIdx.x; F.vcu = (F.G % 8 == 0) ? (bx % 8) * (F.G / 8) + bx / 8 : bx; }
    F.ws = args.ws; F.out = args.out;
#pragma unroll
    for (int i = 0; i < 16; ++i) F.in[i] = args.in[i];
    F.ctl = (gu32*)(F.ws + WS_CTL);
    for (int u = F.tid; u < (LDS_BYTES - LDSCTL_OFF) / 4; u += NWAVES * 64) ((LAS unsigned*)(F.lds + LDSCTL_OFF))[u] = 0u;
    __syncthreads();
    XcdBarrier bar; bar.bar = (unsigned*)(F.ctl + CW_BAR); bar.x = 0; bar.st = nullptr;
    if (N_LAUNCHES == 1) bar = xcd_barrier_post((unsigned*)(F.ctl + CW_BAR), F.MISC + 8);
#if defined(DBG_BAR2)
#define GRID_BAR() do { if (N_LAUNCHES == 1) { xcd_barrier(bar); xcd_barrier(bar); } } while (0)
#else
#define GRID_BAR() do { if (N_LAUNCHES == 1) xcd_barrier(bar); } while (0)
#endif
    const int lo = args.ph_lo, hi = args.ph_hi;
#define IN(k) (lo <= (k) && (k) < hi)
#define BOTH(k) (IN(k) && IN((k) + 1))
#define ENDBAR(k) do { if (BOTH(k)) GRID_BAR(); } while (0)
#define ENDBAR_L(k) do { if (BOTH(k)) { if (N_LAUNCHES == 1) xcd_barrier_local(bar); } } while (0)
    unsigned char* ws = F.ws;
    bf16_t* XB = (bf16_t*)(ws + WS_XB); bf16_t* ACT = (bf16_t*)(ws + WS_ACT); float* SSQ = (float*)(ws + WS_SSQ);
    const int bx = (int)blockIdx.x;
    LAS float* rsc = (LAS float*)(F.lds + LDSCTL_OFF + 4096);
#define RSC_RESET() do { if (F.tid < 8) ((LAS int*)(rsc + 1024))[F.tid] = 0; __syncthreads(); } while (0)
#if defined(DBG_PH)
    unsigned long long ph_c0 = 0, ph_r0 = 0, ph_c1 = 0, ph_r1 = 0;
#define STAMP0(k) do { if ((k) == DBG_PH) { ph_c0 = __builtin_amdgcn_s_memtime(); ph_r0 = __builtin_amdgcn_s_memrealtime(); asm volatile("s_waitcnt lgkmcnt(0)" ::: "memory"); } } while (0)
#define STAMP1(k) do { if ((k) == DBG_PH) { ph_c1 = __builtin_amdgcn_s_memtime(); ph_r1 = __builtin_amdgcn_s_memrealtime(); asm volatile("s_waitcnt lgkmcnt(0)" ::: "memory"); } } while (0)
#else
#define STAMP0(k) do {} while (0)
#define STAMP1(k) do {} while (0)
#endif

    if (IN(0)) { STAMP0(0); p0_prologue(F, args.alt ? EXP_P0_PART : 0); STAMP1(0); ENDBAR(0); }

#if defined(DBG_CLOCK)
    unsigned long long dbg_c0 = 0, dbg_r0 = 0, dbg_c1 = 0, dbg_r1 = 0;
#endif
    if (IN(1)) { STAMP0(1);
        meta_up(F);
        pg8::Gemm g{XB, (const bf16_t*)(ws + WS_W1), DM, DM, DM}; pg8::StaticOrder S; S.init(MROWS, 2 * DFF, F.G, bx);
        pg8::EpiSwiGLU E{ACT, SSQ, rsc}; RSC_RESET();
#if defined(EXP_STAGGER)
        if (args.alt) { const unsigned long long t0 = __builtin_amdgcn_s_memrealtime(); const unsigned long long dly = (unsigned long long)((F.vcu % EXP_STAGGER_G) * EXP_STAGGER);
            while (__builtin_amdgcn_s_memrealtime() - t0 < dly) __builtin_amdgcn_s_sleep(8); }
#endif
#if defined(DBG_CLOCK)
        dbg_c0 = __builtin_amdgcn_s_memtime(); dbg_r0 = __builtin_amdgcn_s_memrealtime(); asm volatile("s_waitcnt lgkmcnt(0)" ::: "memory");
#endif
#if defined(EXP_NULL_EPI)
        if (args.alt) { pg8::EpiNull EN; pg8::gemm_phase<pg8::EpiNull, pg8::StaticOrder, true, true>(F.lds + RING_OFF, g, S, EN); } else
#endif
#if defined(EXP_SEAM)
        { pg8::RangeOrder R0{S, 0, 6}, R1{S, 6, 1 << 20};
          pg8::gemm_phase<pg8::EpiSwiGLU, pg8::RangeOrder, true, true>(F.lds + RING_OFF, g, R0, E);
#if EXP_SEAM == 1
          GRID_BAR();
#elif EXP_SEAM == 2
          xcd_barrier_nf(bar);
#elif EXP_SEAM == 3
          xcd_barrier_norel(bar);
#elif EXP_SEAM == 4
          xcd_barrier_noacq(bar);
#endif
          pg8::gemm_phase<pg8::EpiSwiGLU, pg8::RangeOrder, true, true>(F.lds + RING_OFF, g, R1, E); }
#else
        pg8::gemm_phase<pg8::EpiSwiGLU, pg8::StaticOrder, true, true>(F.lds + RING_OFF, g, S, E);
#endif
#if defined(DBG_CLOCK)
        dbg_c1 = __builtin_amdgcn_s_memtime(); dbg_r1 = __builtin_amdgcn_s_memrealtime(); asm volatile("s_waitcnt lgkmcnt(0)" ::: "memory");
#endif
        STAMP1(1); ENDBAR(1);
    }
    if (IN(2)) { STAMP0(2);
        meta_down(F);
        pg8::Gemm g{ACT, (const bf16_t*)(ws + WS_W2), DFF, DFF, DFF}; pg8::StaticOrder S; S.init(MROWS, DM, F.G, bx);
        pg8::EpiResB<false> E{XB, XB, SSQ, 0.5f};
#if defined(EXP_NULL_EPI)
        if (args.alt) { pg8::EpiNull EN; pg8::gemm_phase<pg8::EpiNull, pg8::StaticOrder, true, true>(F.lds + RING_OFF, g, S, EN); } else
#endif
        pg8::gemm_phase<pg8::EpiResB<false>, pg8::StaticOrder, true, true>(F.lds + RING_OFF, g, S, E);
        STAMP1(2); ENDBAR(2);
    }
    if (IN(3)) { STAMP0(3);
        meta_proj(F);
        pg8::Gemm g{XB, (const bf16_t*)(ws + WS_WP), DM, DM, DM}; pg8::StaticOrder S; S.init(MROWS, NPROJ, F.G, bx);
        pg8::EpiProj E{SSQ, (bf16_t*)(ws + WS_QO), (bf16_t*)(ws + WS_KA), (bf16_t*)(ws + WS_VA), (bf16_t*)(ws + WS_KB), (bf16_t*)(ws + WS_VB), (bf16_t*)(ws + WS_SGA), (bf16_t*)(ws + WS_SGB), (float*)(ws + WS_LOGF), F.in[7], (float*)(ws + WS_QN2), (float*)(ws + WS_KN2), rsc}; RSC_RESET();
#if defined(EXP_NULL_EPI)
        if (args.alt) { pg8::EpiNull EN; pg8::gemm_phase<pg8::EpiNull, pg8::StaticOrder, true, true>(F.lds + RING_OFF, g, S, EN); } else
#elif defined(EXP_PROJX)
        if (args.alt) { pg8::EpiProjX<EXP_PROJX> EX{SSQ, (bf16_t*)(ws + WS_QO)}; pg8::gemm_phase<pg8::EpiProjX<EXP_PROJX>, pg8::StaticOrder, true, true>(F.lds + RING_OFF, g, S, EX); } else
#endif
        pg8::gemm_phase<pg8::EpiProj, pg8::StaticOrder, true, true>(F.lds + RING_OFF, g, S, E);
        STAMP1(3); ENDBAR(3);
    }
    if (IN(4)) { STAMP0(4); attn_phase(F, (char*)lds + RING_OFF, args.alt ? (bf16_t*)(ws + WS_MIX) : (bf16_t*)(ws + WS_QO), args.alt ? EXP_ATTN_ONLY : 0); STAMP1(4); ENDBAR_L(4); }

    if (IN(5)) { STAMP0(5);
        pg8::Gemm g{(const bf16_t*)(ws + WS_QO), (const bf16_t*)(ws + WS_WAB), DM, DM, DM}; pg8::StaticOrder S; S.init(MROWS, DM, F.G, bx);
        pg8::EpiMix E{(const bf16_t*)(ws + WS_SGA), (const bf16_t*)(ws + WS_SGB), (bf16_t*)(ws + WS_MIX)};
        pg8::gemm_phase<pg8::EpiMix, pg8::StaticOrder, true, true>(F.lds + RING_OFF, g, S, E);
        STAMP1(5); ENDBAR_L(5);
    }
    if (IN(6)) { STAMP0(6);
        pg8::Gemm g{(const bf16_t*)(ws + WS_MIX), (const bf16_t*)(ws + WS_WO), DM, DM, DM}; pg8::StaticOrder S; S.init(MROWS, DM, F.G, bx);
        pg8::EpiResB<false> E{XB, XB, SSQ, 1.0f};
        pg8::gemm_phase<pg8::EpiResB<false>, pg8::StaticOrder, true, true>(F.lds + RING_OFF, g, S, E);
        STAMP1(6); ENDBAR(6);
    }
    if (IN(7)) { STAMP0(7);
        pg8::Gemm g{XB, (const bf16_t*)(ws + WS_W3), DM, DM, DM}; pg8::StaticOrder S; S.init(MROWS, 2 * DFF, F.G, bx);
        pg8::EpiSwiGLU E{ACT, SSQ, rsc}; RSC_RESET();
        pg8::gemm_phase<pg8::EpiSwiGLU, pg8::StaticOrder, true, true>(F.lds + RING_OFF, g, S, E);
        STAMP1(7); ENDBAR_L(7);
    }
    if (IN(8)) { STAMP0(8);
        pg8::Gemm g{ACT, (const bf16_t*)(ws + WS_W4), DFF, DFF, DFF}; pg8::StaticOrder S; S.init(MROWS, DM, F.G, bx);
        pg8::EpiFinal E{XB, F.out, F.in[15], SSQ, (unsigned*)(F.ctl + CW_PANEL), 0.5f};
        pg8::gemm_phase<pg8::EpiFinal, pg8::StaticOrder, true, true>(F.lds + RING_OFF, g, S, E);
        STAMP1(8);
    }
#if defined(DBG_PH)
    GRID_BAR();
    if (bx == 0 && F.tid == 0) {
        const float dc = (float)(ph_c1 - ph_c0), dr = (float)(ph_r1 - ph_r0);
#if DBG_WHAT == 2
        F.out[0] = 400.f * floorf(dc / dr * 100.f / 400.f + 0.5f);
#elif DBG_WHAT == 0
        F.out[0] = 100.f * floorf(dc / dr + 0.5f);
#else
        F.out[0] = 1000.f + 20.f * floorf(dr * 0.01f / 20.f + 0.5f);
#endif
    }
#endif
#if defined(DBG_SKIP)
    GRID_BAR();
    if (bx == 0 && F.tid == 0) F.out[0] = 1000.f + 100.f * ((float*)(ws + WS_META + 262144))[0];
#endif
#if defined(DBG_CLOCK)
    GRID_BAR();
    if (bx == 0 && F.tid == 0) {
        const float dc = (float)(dbg_c1 - dbg_c0), dr = (float)(dbg_r1 - dbg_r0);
        float v;
        if (DBG_CLOCK == 0) v = dc / dr * 100.f;
        else if (DBG_CLOCK == 1) v = dr * 0.01f * 10.f;
        else v = dc / 176.f;
        F.out[0] = v;
    }
#endif
#undef IN
#undef BOTH
#undef GRID_BAR
}

extern "C" void kernel_launch(void* const* d_in, const int* in_sizes, int n_in, void* d_out, int out_size, void* d_ws, size_t ws_size, hipStream_t stream) {
    static int grid = 0;
    if (grid == 0) {
        if (n_in != 16 || in_sizes[0] != MROWS * DM || out_size != MROWS * DM || ws_size < WS_END) {
            fprintf(stderr, "kernel_launch: built for 16 inputs, x/out of %d floats, >= %zu bytes of workspace; got n_in %d, in0 %d, out %d, ws %zu; nothing launched\n", MROWS * DM, (size_t)WS_END, n_in, n_in > 0 ? in_sizes[0] : -1, out_size, ws_size); grid = -1; return; }
        int dev = 0, cus = 0, per_cu = 0;
        if (hipGetDevice(&dev) != hipSuccess || hipDeviceGetAttribute(&cus, hipDeviceAttributeMultiprocessorCount, dev) != hipSuccess) { fprintf(stderr, "kernel_launch: device query failed\n"); grid = -1; return; }
        if (hipFuncSetAttribute((const void*)fwd_kernel, hipFuncAttributeMaxDynamicSharedMemorySize, LDS_BYTES) != hipSuccess) { fprintf(stderr, "kernel_launch: hipFuncSetAttribute failed\n"); grid = -1; return; }
        if (hipOccupancyMaxActiveBlocksPerMultiprocessor(&per_cu, (const void*)fwd_kernel, NWAVES * 64, LDS_BYTES) != hipSuccess || per_cu < 1) { fprintf(stderr, "kernel_launch: occupancy query reports %d workgroups per CU\n", per_cu); per_cu = 1; }
        (void)hipGetLastError();
        grid = cus * (per_cu < 1 ? 1 : 1);
    }
    if (grid < 0) return;
    if (hipMemsetAsync((char*)d_ws + WS_CTL, 0, CTL_ZERO_BYTES, stream) != hipSuccess) { fprintf(stderr, "kernel_launch: hipMemsetAsync failed\n"); return; }
    Args a{};
    for (int i = 0; i < 16; ++i) a.in[i] = (const float*)d_in[i];
    a.out = (float*)d_out; a.ws = (unsigned char*)d_ws;
#ifndef EXP_REP
#define EXP_REP -1
#endif
    for (int li = 0; li < N_LAUNCHES; ++li) {
        if (N_LAUNCHES == 1) { a.ph_lo = 0; a.ph_hi = N_PHASES; } else { a.ph_lo = li; a.ph_hi = li + 1; }
        if (N_LAUNCHES != 1 && li == EXP_REP) { a.alt = 1; hipLaunchKernelGGL(fwd_kernel, dim3(grid), dim3(NWAVES * 64), LDS_BYTES, stream, a); a.alt = 0; }
        hipLaunchKernelGGL(fwd_kernel, dim3(grid), dim3(NWAVES * 64), LDS_BYTES, stream, a);
        const hipError_t le = hipPeekAtLastError();
        if (le != hipSuccess) { fprintf(stderr, "kernel_launch: launch %d failed: %s\n", li, hipGetErrorName(le)); break; }
    }
}
```

```cpp
#include <hip/hip_runtime.h>
#include <hip/hip_bf16.h>
#include <cstdio>
#include <cstdint>

#define LAS __attribute__((address_space(3)))
#define GAS __attribute__((address_space(1)))
typedef unsigned short bf16_t;
typedef short bf16x8 __attribute__((ext_vector_type(8)));
typedef float f32x4 __attribute__((ext_vector_type(4)));
typedef float f32x16 __attribute__((ext_vector_type(16)));
typedef unsigned u32x4 __attribute__((ext_vector_type(4)));
typedef unsigned u32x2 __attribute__((ext_vector_type(2)));
typedef short s16x4 __attribute__((ext_vector_type(4)));

constexpr int DM = 1024, NBATCH = 16, SEQ = 2048, MROWS = NBATCH * SEQ;
constexpr int DFF = 2816, NPROJ = 4608;
constexpr int LPOS = 2176, NKR = NBATCH * LPOS;
constexpr int NMETA = 16, KR_META = 112, KR_REAL = 128;
constexpr float EPS = 1e-6f, LOG2E = 1.4426950408889634f, QSCALE = 0.125f * 1.4426950408889634f;

__device__ __forceinline__ unsigned cvt_pk_bf16(float lo, float hi) { unsigned r; asm volatile("v_cvt_pk_bf16_f32 %0, %1, %2" : "=v"(r) : "v"(lo), "v"(hi)); return r; }
__device__ __forceinline__ void st16_wt(void* p, u32x4 v) { asm volatile("global_store_dwordx4 %0, %1, off sc1\n\ts_nop 1" :: "v"(p), "v"(v) : "memory"); }
__device__ __forceinline__ float bf_lo(unsigned w) { return __uint_as_float(w << 16); }
__device__ __forceinline__ float bf_hi(unsigned w) { return __uint_as_float(w & 0xffff0000u); }

namespace pg8 {
#define PG8_LAS __attribute__((address_space(3)))
constexpr int BM = 256, BK = 64, HALF = 128, HTB = HALF * BK * 2  , STAGE_BYTES = 8 * HTB, NXCD = 8, WGM = 8;

__host__ __device__ __forceinline__ int lds_byte(int r, int c) { const int st = (r >> 4) * 2 + (c >> 5), rr = r & 15, cc = c & 31, ob = rr * 64 + cc * 2; return st * 1024 + (ob ^ (((ob >> 9) & 1) << 5)); }
__host__ __device__ __forceinline__ void stage_rc(int b, int& R, int& C) { const int st = b / 1024, sb = b % 1024, swz = sb ^ (((sb >> 9) & 1) << 5); R = (st >> 1) * 16 + swz / 64; C = (st & 1) * 32 + (swz % 64) / 2; }
__host__ __device__ __forceinline__ int perm32(int rho) { const int n = rho >> 4, i = rho & 15; return 8 * (i >> 2) + 4 * n + (i & 3); }

struct Unit { int pm, pn, koff, br; };
struct Gemm { const bf16_t* A; const bf16_t* Bt; int lda, ldb, K; };

struct StaticOrder {
    int nM, nN, nwg, G, c;
    __host__ __device__ void init(int M, int N, int G_, int c_) { nM = M / BM; nN = N / BM; nwg = nM * nN; G = G_; c = c_; }
    __host__ __device__ bool next(int i, Unit& u) const {
        const long L = (long)i * G + c; if (L >= nwg) return false;
        int wgid = (int)L; { const int q = nwg / NXCD, r = nwg % NXCD, xcd = wgid % NXCD, off = wgid / NXCD; wgid = (xcd < r ? xcd * (q + 1) : r * (q + 1) + (xcd - r) * q) + off; }
        const int nig = WGM * nN, gid = wgid / nig, fm = gid * WGM, gsz = (nM - fm) < WGM ? (nM - fm) : WGM;
        u.pm = fm + ((wgid % nig) % gsz); u.pn = (wgid % nig) / gsz; u.koff = 0; u.br = 0; return true;
    }
    __device__ __forceinline__ void a_ready(const Unit&) const {}
    __device__ __forceinline__ void done(const Unit&) const {}
};
struct RangeOrder {
    StaticOrder S; int i0, i1;
    __host__ __device__ bool next(int i, Unit& u) const { if (i0 + i >= i1) return false; return S.next(i0 + i, u); }
    __device__ __forceinline__ void a_ready(const Unit&) const {}
    __device__ __forceinline__ void done(const Unit&) const {}
};
struct DualOrder {
    StaticOrder S;
    __host__ __device__ bool next(int i, Unit& u) const { if (!S.next(i >> 1, u)) return false; u.br = i & 1; u.koff = 512 * (i & 1); return true; }
    __device__ __forceinline__ void a_ready(const Unit&) const {}
    __device__ __forceinline__ void done(const Unit&) const {}
};

__device__ __forceinline__ float row_rs(const float* ssq, int row, int fq) {
    const f32x4 p = *(const f32x4*)(ssq + (size_t)row * 16 + 4 * fq);
    float s = (p[0] + p[1]) + (p[2] + p[3]);
    s += __shfl_xor(s, 16); s += __shfl_xor(s, 32);
    return __builtin_amdgcn_rsqf(s * (1.0f / 1024.0f) + EPS);
}
typedef float f32x2 __attribute__((ext_vector_type(2)));
__device__ __forceinline__ void row_rs8(const float* ssq, int row0, int fq, float (&rs)[8]) {
    f32x4 p[8];
#pragma unroll
    for (int i = 0; i < 8; ++i) p[i] = *(const f32x4*)(ssq + (size_t)(row0 + (i >> 2) * HALF + (i & 3) * 16) * 16 + 4 * fq);
#pragma unroll
    for (int i = 0; i < 8; ++i) { float s = (p[i][0] + p[i][1]) + (p[i][2] + p[i][3]); s += __shfl_xor(s, 16); s += __shfl_xor(s, 32); rs[i] = __builtin_amdgcn_rsqf(s * (1.0f / 1024.0f) + EPS); }
}
__device__ __forceinline__ float fast_sigmoid(float x) { return __builtin_amdgcn_rcpf(1.0f + __builtin_amdgcn_exp2f(-x * LOG2E)); }
__device__ __forceinline__ u32x4 pack8(const f32x4 a, const f32x4 b) { u32x4 w; w.x = cvt_pk_bf16(a[0], a[1]); w.y = cvt_pk_bf16(a[2], a[3]); w.z = cvt_pk_bf16(b[0], b[1]); w.w = cvt_pk_bf16(b[2], b[3]); return w; }

__device__ __forceinline__ void pf_tile(const void* base, int esz, const Unit& u, int part, int nparts, int tid, float& junk) {
    const int lpr = esz * 2, per = 256 * lpr / nparts, L = part * per + tid;
    if (tid < per) { const char* p = (const char*)base + ((size_t)(u.pm * BM + L / lpr) * DM + (size_t)u.pn * BM) * esz + (L % lpr) * 128;
        asm volatile("global_load_dword %0, %1, off" : "+v"(junk) : "v"(p) : "memory"); }
}
__device__ __forceinline__ void row_rs8_cached(const float* ssq, int pm, int row0, int fr, int fq, PG8_LAS float* rc, float (&rs)[8]) {
    const int wid = __builtin_amdgcn_readfirstlane((int)threadIdx.x >> 6);
    PG8_LAS float* mine = rc + wid * 128; PG8_LAS int* tag = (PG8_LAS int*)(rc + 1024) + wid;
    const int have = __builtin_amdgcn_readfirstlane(*tag);
    if (have != pm + 1) {
        row_rs8(ssq, row0, fq, rs);
        if (fq == 0) { *(PG8_LAS f32x4*)(mine + fr * 8) = (f32x4){rs[0], rs[1], rs[2], rs[3]}; *(PG8_LAS f32x4*)(mine + fr * 8 + 4) = (f32x4){rs[4], rs[5], rs[6], rs[7]}; }
        if ((threadIdx.x & 63) == 0) *tag = pm + 1;
    } else {
        const f32x4 a = *(const PG8_LAS f32x4*)(mine + fr * 8), b = *(const PG8_LAS f32x4*)(mine + fr * 8 + 4);
        rs[0] = a[0]; rs[1] = a[1]; rs[2] = a[2]; rs[3] = a[3]; rs[4] = b[0]; rs[5] = b[1]; rs[6] = b[2]; rs[7] = b[3];
    }
}
struct EpiSwiGLU {
    static constexpr bool PERM = true, AFTER_DRAIN = false, MID = false, PF = false;
    bf16_t* O; const float* ssq; PG8_LAS float* rsc;
    __device__ __forceinline__ void operator()(const f32x4 (&acc)[2][2][4][2], const Unit& u, int wr, int wc, int fr, int fq) const {
        const int row0 = u.pm * BM + wr * 64 + fr, col0 = u.pn * HALF + wc * 32 + 8 * fq;
        float rsv[8]; row_rs8_cached(ssq, u.pm, row0, fr, fq, rsc, rsv);
#pragma unroll
        for (int ai = 0; ai < 2; ++ai)
#pragma unroll
            for (int m = 0; m < 4; ++m) {
                const int row = row0 + ai * HALF + m * 16; const float rs = rsv[ai * 4 + m];
                f32x4 o[2]; const float c1 = -LOG2E * rs, irs2 = __builtin_amdgcn_rcpf(rs * rs);
#pragma unroll
                for (int n = 0; n < 2; ++n)
#pragma unroll
                    for (int e = 0; e < 4; e += 2) {
                        const f32x2 g = (f32x2){acc[ai][0][m][n][e], acc[ai][0][m][n][e + 1]}, uu = (f32x2){acc[ai][1][m][n][e], acc[ai][1][m][n][e + 1]};
                        const f32x2 t = g * c1; f32x2 d; d.x = __builtin_amdgcn_exp2f(t.x); d.y = __builtin_amdgcn_exp2f(t.y); d = d * irs2 + irs2;
                        f32x2 r; r.x = __builtin_amdgcn_rcpf(d.x); r.y = __builtin_amdgcn_rcpf(d.y);
                        const f32x2 w = (g * uu) * r; o[n][e] = w.x; o[n][e + 1] = w.y;
                    }
                *(u32x4*)(O + (size_t)row * DFF + col0) = pack8(o[0], o[1]);
            }
    }
};
template <bool BASE_F32> struct EpiResB {
    static constexpr bool PERM = true, AFTER_DRAIN = false, MID = false, PF = false;
    const void* base; bf16_t* xb; float* ssq; float scale;
    __device__ __forceinline__ void prefetch(const Unit& u, int t, int nt, int tid, float& junk) const { const int q = t - (nt - 8); if (q >= 0) pf_tile(base, BASE_F32 ? 4 : 2, u, q >> 1, 4, tid, junk); }
    __device__ __forceinline__ void operator()(const f32x4 (&acc)[2][2][4][2], const Unit& u, int wr, int wc, int fr, int fq) const {
        const int row0 = u.pm * BM + wr * 64 + fr, col0 = u.pn * BM + wc * 32 + 8 * fq;
        u32x4 wv[2][4][2];
        if (!BASE_F32) {
#pragma unroll
            for (int ai = 0; ai < 2; ++ai)
#pragma unroll
                for (int m = 0; m < 4; ++m)
#pragma unroll
                    for (int bj = 0; bj < 2; ++bj) wv[ai][m][bj] = *(const u32x4*)((const bf16_t*)base + (size_t)(row0 + ai * HALF + m * 16) * DM + col0 + bj * HALF);
        }
#pragma unroll
        for (int ai = 0; ai < 2; ++ai) {
            f32x4 fv[4][2][2];
            if (BASE_F32) {
#pragma unroll
                for (int m = 0; m < 4; ++m)
#pragma unroll
                    for (int bj = 0; bj < 2; ++bj) { const float* bp = (const float*)base + (size_t)(row0 + ai * HALF + m * 16) * DM + col0 + bj * HALF; fv[m][bj][0] = *(const f32x4*)bp; fv[m][bj][1] = *(const f32x4*)(bp + 4); }
            }
#pragma unroll
            for (int m = 0; m < 4; ++m) {
                const int row = row0 + ai * HALF + m * 16; const size_t off = (size_t)row * DM + col0; float sq = 0.f;
#pragma unroll
                for (int bj = 0; bj < 2; ++bj) {
                    const size_t c = off + bj * HALF; f32x4 b0, b1;
                    if (BASE_F32) { b0 = fv[m][bj][0]; b1 = fv[m][bj][1]; }
                    else { const u32x4 w = wv[ai][m][bj]; b0 = (f32x4){bf_lo(w.x), bf_hi(w.x), bf_lo(w.y), bf_hi(w.y)}; b1 = (f32x4){bf_lo(w.z), bf_hi(w.z), bf_lo(w.w), bf_hi(w.w)}; }
                    const f32x4 v0 = b0 + acc[ai][bj][m][0] * scale, v1 = b1 + acc[ai][bj][m][1] * scale;
                    *(u32x4*)(xb + c) = pack8(v0, v1);
                    sq += (v0[0] * v0[0] + v0[1] * v0[1]) + (v0[2] * v0[2] + v0[3] * v0[3]) + (v1[0] * v1[0] + v1[1] * v1[1]) + (v1[2] * v1[2] + v1[3] * v1[3]);
                }
                sq += __shfl_xor(sq, 16); sq += __shfl_xor(sq, 32);
                if (fq == 0) ssq[(size_t)row * 16 + u.pn * 4 + wc] = sq;
            }
            if (BASE_F32) asm volatile("" ::: "memory");
        }
    }
};
struct EpiFinal {
    static constexpr bool PERM = true, AFTER_DRAIN = false, MID = false, PF = false;
    const bf16_t* base; float* out; const float* gf; float* part; unsigned* cnt; float scale;
    __device__ __forceinline__ void prefetch(const Unit& u, int t, int nt, int tid, float& junk) const { const int q = t - (nt - 8); if (q >= 0) pf_tile(base, 2, u, q >> 1, 4, tid, junk); }
    __device__ __forceinline__ void operator()(f32x4 (&acc)[2][2][4][2], const Unit& u, int wr, int wc, int fr, int fq) const {
        const int row0 = u.pm * BM + wr * 64 + fr, col0 = u.pn * BM + wc * 32 + 8 * fq;
        u32x4 wv[2][4][2];
#pragma unroll
        for (int ai = 0; ai < 2; ++ai)
#pragma unroll
            for (int m = 0; m < 4; ++m)
#pragma unroll
                for (int bj = 0; bj < 2; ++bj) wv[ai][m][bj] = *(const u32x4*)(base + (size_t)(row0 + ai * HALF + m * 16) * DM + col0 + bj * HALF);
#pragma unroll
        for (int ai = 0; ai < 2; ++ai)
#pragma unroll
            for (int m = 0; m < 4; ++m) {
                const int row = row0 + ai * HALF + m * 16; float sq = 0.f;
#pragma unroll
                for (int bj = 0; bj < 2; ++bj) {
                    const u32x4 w = wv[ai][m][bj];
                    const f32x4 b0 = (f32x4){bf_lo(w.x), bf_hi(w.x), bf_lo(w.y), bf_hi(w.y)}, b1 = (f32x4){bf_lo(w.z), bf_hi(w.z), bf_lo(w.w), bf_hi(w.w)};
                    const f32x4 v0 = b0 + acc[ai][bj][m][0] * scale, v1 = b1 + acc[ai][bj][m][1] * scale;
                    acc[ai][bj][m][0] = v0; acc[ai][bj][m][1] = v1;
                    sq += (v0[0] * v0[0] + v0[1] * v0[1]) + (v0[2] * v0[2] + v0[3] * v0[3]) + (v1[0] * v1[0] + v1[1] * v1[1]) + (v1[2] * v1[2] + v1[3] * v1[3]);
                }
                sq += __shfl_xor(sq, 16); sq += __shfl_xor(sq, 32);
                if (fq == 0) __hip_atomic_store(part + (size_t)row * 16 + u.pn * 4 + wc, sq, __ATOMIC_RELAXED, __HIP_MEMORY_SCOPE_AGENT);
            }
        asm volatile("s_waitcnt vmcnt(0)" ::: "memory");
        unsigned* pc = cnt + 64 * u.pm;
        if ((threadIdx.x & 63) == 0) __hip_atomic_fetch_add(pc, 1u, __ATOMIC_RELAXED, __HIP_MEMORY_SCOPE_AGENT);
        for (unsigned spins = 0; spins < (1u << 22); ++spins) {
            if ((unsigned)__builtin_amdgcn_readfirstlane(__hip_atomic_load(pc, __ATOMIC_RELAXED, __HIP_MEMORY_SCOPE_AGENT)) >= 32u) break;
            __builtin_amdgcn_s_sleep(2);
        }
        asm volatile("" ::: "memory");
        const int gc0 = u.pn * BM + wc * 32 + 8 * fq;
        unsigned long long qq[8][2];
#pragma unroll
        for (int i = 0; i < 8; ++i) { const unsigned long long* pp = (const unsigned long long*)(part + (size_t)(row0 + (i >> 2) * HALF + (i & 3) * 16) * 16 + 4 * fq);
            qq[i][0] = __hip_atomic_load(pp, __ATOMIC_RELAXED, __HIP_MEMORY_SCOPE_AGENT); qq[i][1] = __hip_atomic_load(pp + 1, __ATOMIC_RELAXED, __HIP_MEMORY_SCOPE_AGENT); }
#pragma unroll
        for (int ai = 0; ai < 2; ++ai)
#pragma unroll
            for (int m = 0; m < 4; ++m) {
                const int row = row0 + ai * HALF + m * 16; const size_t off = (size_t)row * DM + col0;
                const unsigned long long q0 = qq[ai * 4 + m][0], q1 = qq[ai * 4 + m][1];
                float s = (__uint_as_float((unsigned)q0) + __uint_as_float((unsigned)(q0 >> 32))) + (__uint_as_float((unsigned)q1) + __uint_as_float((unsigned)(q1 >> 32)));
                s += __shfl_xor(s, 16); s += __shfl_xor(s, 32);
                const float rs = 1.0f / sqrtf(s * (1.0f / 1024.0f) + EPS);
#pragma unroll
                for (int bj = 0; bj < 2; ++bj) {
                    const f32x4 g0 = *(const f32x4*)(gf + gc0 + bj * HALF), g1 = *(const f32x4*)(gf + gc0 + bj * HALF + 4);
                    *(f32x4*)(out + off + bj * HALF) = acc[ai][bj][m][0] * rs * g0; *(f32x4*)(out + off + bj * HALF + 4) = acc[ai][bj][m][1] * rs * g1;
                }
            }
    }
};
struct EpiProj {
    static constexpr bool PERM = true, AFTER_DRAIN = false, MID = false, PF = false;
    const float* ssq; bf16_t *QO, *KA, *VA, *KB, *VB, *RAB, *SGB; float* LOGF; const float* bfg; float *QN2, *KN2; PG8_LAS float* rsc;
    __device__ __forceinline__ void operator()(const f32x4 (&acc)[2][2][4][2], const Unit& u, int wr, int wc, int fr, int fq) const {
        const int pn = u.pn, row0 = u.pm * BM + wr * 64 + fr, kadd = KR_REAL * (u.pm / 8 + 1);
        float rsv[8]; row_rs8_cached(ssq, u.pm, row0, fr, fq, rsc, rsv);
        if (pn == 17) {
            f32x4 bb0 = *(const f32x4*)(bfg), bb1 = *(const f32x4*)(bfg + 4);
#pragma unroll
            for (int ai = 0; ai < 2; ++ai)
#pragma unroll
                for (int m = 0; m < 4; ++m) {
                    const int row = row0 + ai * HALF + m * 16; const float rs = rsv[ai * 4 + m];
                    if (wc == 0 && fq == 0) {
                        f32x4 lf[2];
#pragma unroll
                        for (int n = 0; n < 2; ++n)
#pragma unroll
                            for (int e = 0; e < 4; ++e) { const float x = acc[ai][0][m][n][e] * rs + (n ? bb1[e] : bb0[e]); lf[n][e] = fminf(x, 0.f) - log1pf(expf(-fabsf(x))); }
                        float* d = LOGF + (size_t)(row + kadd) * 8; *(f32x4*)d = lf[0]; *(f32x4*)(d + 4) = lf[1];
                    }
                }
            return;
        }
        if (pn >= 9) {
            const int cg = (pn - 9) * HALF + wc * 32 + 8 * fq;
#pragma unroll
            for (int ai = 0; ai < 2; ++ai)
#pragma unroll
                for (int m = 0; m < 4; ++m) {
                    const int row = row0 + ai * HALF + m * 16; const float rs = rsv[ai * 4 + m]; f32x4 r[2], sb[2];
                    const float c1 = -LOG2E * rs;
#pragma unroll
                    for (int n = 0; n < 2; ++n)
#pragma unroll
                        for (int e = 0; e < 4; e += 2) {
                            f32x2 ta = (f32x2){acc[ai][0][m][n][e], acc[ai][0][m][n][e + 1]} * c1, tb = (f32x2){acc[ai][1][m][n][e], acc[ai][1][m][n][e + 1]} * c1;
                            tb.x = __builtin_amdgcn_fmed3f(tb.x, -115.4f, 115.4f); tb.y = __builtin_amdgcn_fmed3f(tb.y, -115.4f, 115.4f);
                            f32x2 da, db; da.x = __builtin_amdgcn_exp2f(ta.x); da.y = __builtin_amdgcn_exp2f(ta.y); db.x = __builtin_amdgcn_exp2f(tb.x); db.y = __builtin_amdgcn_exp2f(tb.y);
                            da = da + 1.0f; db = db + 1.0f;
                            f32x2 ra, rb; ra.x = __builtin_amdgcn_rcpf(da.x); ra.y = __builtin_amdgcn_rcpf(da.y); rb.x = __builtin_amdgcn_rcpf(db.x); rb.y = __builtin_amdgcn_rcpf(db.y);
                            const f32x2 q = db * ra; r[n][e] = q.x; r[n][e + 1] = q.y; sb[n][e] = rb.x; sb[n][e + 1] = rb.y;
                        }
                    *(u32x4*)(RAB + (size_t)row * DM + cg) = pack8(r[0], r[1]); *(u32x4*)(SGB + (size_t)row * DM + cg) = pack8(sb[0], sb[1]);
                }
            return;
        }
        bf16_t* d0; bf16_t* d1; int pitch, radd = 0; float mul = 1.f;
        if (pn < 2)       { d0 = QO + pn * 256; d1 = d0 + HALF; pitch = DM; mul = QSCALE; }
        else if (pn == 2) { d0 = KA; d1 = VA; pitch = 128; radd = kadd; }
        else if (pn < 5)  { d0 = QO + 512 + (pn - 3) * 256; d1 = d0 + HALF; pitch = DM; mul = QSCALE; }
        else if (pn < 7)  { d0 = KB + (pn - 5) * 256; d1 = d0 + HALF; pitch = 512; radd = kadd; }
        else              { d0 = VB + (pn - 7) * 256; d1 = d0 + HALF; pitch = 512; radd = kadd; }
        const int cw = wc * 32 + 8 * fq;
#pragma unroll
        for (int ai = 0; ai < 2; ++ai)
#pragma unroll
            for (int m = 0; m < 4; ++m) {
                const int row = row0 + ai * HALF + m * 16; const float rs = rsv[ai * 4 + m] * mul; const size_t ro = (size_t)(row + radd) * pitch + cw;
#pragma unroll
                for (int bj = 0; bj < 2; ++bj) {
                    const f32x4 v0 = acc[ai][bj][m][0] * rs, v1 = acc[ai][bj][m][1] * rs;
                    *(u32x4*)((bj ? d1 : d0) + ro) = pack8(v0, v1);
                    if (pn >= 3 && pn < 7) {
                        float s2 = (v0[0] * v0[0] + v0[1] * v0[1]) + (v0[2] * v0[2] + v0[3] * v0[3]) + (v1[0] * v1[0] + v1[1] * v1[1]) + (v1[2] * v1[2] + v1[3] * v1[3]);
                        s2 += __shfl_xor(s2, 16); s2 += __shfl_xor(s2, 32);
                        if (fq == 0) ((pn < 5 ? QN2 : KN2) + (size_t)(row + radd) * 16)[2 * (4 * ((pn - 3) & 1) + 2 * bj + (wc >> 1)) + (wc & 1)] = s2;
                    }
                }
            }
    }
};
struct EpiMix {
    static constexpr bool PERM = true, AFTER_DRAIN = false, MID = true, PF = false;
    const bf16_t *RAB, *SGB; bf16_t* MIX;
    __device__ __forceinline__ void prefetch(const Unit& u, int t, int nt, int tid, float& junk) const { const int h = nt >> 1; if (t < h) pf_tile(RAB, 2, u, t >> 1, h >> 1, tid, junk); else pf_tile(SGB, 2, u, (t - h) >> 1, h >> 1, tid, junk); }
    __device__ __forceinline__ void mid(f32x4 (&acc)[2][2][4][2], const Unit& u, int wr, int wc, int fr, int fq) const {
        int row0 = u.pm * BM + wr * 64 + fr; const int col0 = u.pn * BM + wc * 32 + 8 * fq;
        asm volatile("" : "+v"(row0));
        u32x4 gv[2][4][2];
#pragma unroll
        for (int ai = 0; ai < 2; ++ai)
#pragma unroll
            for (int m = 0; m < 4; ++m)
#pragma unroll
                for (int bj = 0; bj < 2; ++bj) gv[ai][m][bj] = *(const u32x4*)(RAB + (size_t)(row0 + ai * HALF + m * 16) * DM + col0 + bj * HALF);
#pragma unroll
        for (int ai = 0; ai < 2; ++ai)
#pragma unroll
            for (int m = 0; m < 4; ++m) {
#pragma unroll
                for (int bj = 0; bj < 2; ++bj) {
                    const u32x4 gw = gv[ai][m][bj];
                    acc[ai][bj][m][0] *= (f32x4){bf_lo(gw.x), bf_hi(gw.x), bf_lo(gw.y), bf_hi(gw.y)}; acc[ai][bj][m][1] *= (f32x4){bf_lo(gw.z), bf_hi(gw.z), bf_lo(gw.w), bf_hi(gw.w)};
                }
            }
    }
    __device__ __forceinline__ void operator()(const f32x4 (&acc)[2][2][4][2], const Unit& u, int wr, int wc, int fr, int fq) const {
        int row0 = u.pm * BM + wr * 64 + fr; const int col0 = u.pn * BM + wc * 32 + 8 * fq;
        asm volatile("" : "+v"(row0));
        u32x4 gv[2][4][2];
#pragma unroll
        for (int ai = 0; ai < 2; ++ai)
#pragma unroll
            for (int m = 0; m < 4; ++m)
#pragma unroll
                for (int bj = 0; bj < 2; ++bj) gv[ai][m][bj] = *(const u32x4*)(SGB + (size_t)(row0 + ai * HALF + m * 16) * DM + col0 + bj * HALF);
#pragma unroll
        for (int ai = 0; ai < 2; ++ai)
#pragma unroll
            for (int m = 0; m < 4; ++m) {
                const int row = row0 + ai * HALF + m * 16;
#pragma unroll
                for (int bj = 0; bj < 2; ++bj) {
                    const size_t c = (size_t)row * DM + col0 + bj * HALF;
                    const u32x4 gw = gv[ai][m][bj];
                    const f32x4 v0 = acc[ai][bj][m][0] * (f32x4){bf_lo(gw.x), bf_hi(gw.x), bf_lo(gw.y), bf_hi(gw.y)}, v1 = acc[ai][bj][m][1] * (f32x4){bf_lo(gw.z), bf_hi(gw.z), bf_lo(gw.w), bf_hi(gw.w)};
                    *(u32x4*)(MIX + c) = pack8(v0, v1);
                }
            }
    }
};
struct EpiNull {
    static constexpr bool PERM = true, AFTER_DRAIN = false, MID = false, PF = false;
    __device__ __forceinline__ void operator()(const f32x4 (&acc)[2][2][4][2], const Unit& u, int wr, int wc, int fr, int fq) const {
#pragma unroll
        for (int ai = 0; ai < 2; ++ai)
#pragma unroll
            for (int bj = 0; bj < 2; ++bj)
#pragma unroll
                for (int m = 0; m < 4; ++m)
#pragma unroll
                    for (int n = 0; n < 2; ++n) asm volatile("" :: "v"(acc[ai][bj][m][n]));
    }
};

template <int MODE> struct EpiProjX {
    static constexpr bool PERM = true, AFTER_DRAIN = false, MID = false, PF = false;
    const float* ssq; bf16_t* D;
    __device__ __forceinline__ void operator()(const f32x4 (&acc)[2][2][4][2], const Unit& u, int wr, int wc, int fr, int fq) const {
        int row0 = u.pm * BM + wr * 64 + fr; const int cw = (u.pn % 4) * 256 + wc * 32 + 8 * fq;
        asm volatile("" : "+v"(row0));
#pragma unroll
        for (int ai = 0; ai < 2; ++ai)
#pragma unroll
            for (int m = 0; m < 4; ++m) {
                const int row = row0 + ai * HALF + m * 16;
                if (MODE == 0) {
                    const float rs = row_rs(ssq, row, fq); f32x4 r[2], sb[2];
#pragma unroll
                    for (int n = 0; n < 2; ++n)
#pragma unroll
                        for (int e = 0; e < 4; ++e) {
                            const float ga = __builtin_amdgcn_fmed3f(acc[ai][0][m][n][e] * rs, -80.f, 80.f), gb = __builtin_amdgcn_fmed3f(acc[ai][1][m][n][e] * rs, -80.f, 80.f);
                            const float ea = __builtin_amdgcn_exp2f(-ga * LOG2E), eb = __builtin_amdgcn_exp2f(-gb * LOG2E);
                            r[n][e] = (1.0f + eb) * __builtin_amdgcn_rcpf(1.0f + ea); sb[n][e] = __builtin_amdgcn_rcpf(1.0f + eb);
                        }
                    u32x4 a = pack8(r[0], r[1]), b = pack8(sb[0], sb[1]); asm volatile("" :: "v"(a), "v"(b));
                } else if (MODE == 1) {
#pragma unroll
                    for (int bj = 0; bj < 2; ++bj) *(u32x4*)(D + (size_t)row * DM + cw + bj * HALF) = pack8(acc[ai][bj][m][0], acc[ai][bj][m][1]);
                } else {
                    const int lrow = (int)blockIdx.x * BM + (row & 255); const int cw2 = wc * 32 + 8 * fq;
#pragma unroll
                    for (int bj = 0; bj < 2; ++bj) *(u32x4*)(D + (size_t)lrow * DM + cw2 + bj * HALF) = pack8(acc[ai][bj][m][0], acc[ai][bj][m][1]);
                }
            }
    }
};
template <class Epi, class Sched, bool ALIGN_EPI = false, bool SP2 = false>
__device__ __forceinline__ void gemm_phase(PG8_LAS unsigned char* lds, const Gemm g, const Sched& S, const Epi& E) {
    const int tid = threadIdx.x, wid = __builtin_amdgcn_readfirstlane(tid >> 6), lane = tid & 63, wr = wid >> 2, wc = wid & 3, fr = lane & 15, fq = lane >> 4;
    const int K = g.K, nt = K / BK;
    unsigned voffA[2], voffB[2];
#pragma unroll
    for (int i = 0; i < 2; ++i) { int R, C; stage_rc(tid * 16 + i * 8192, R, C); const int Rb = Epi::PERM ? ((R & ~31) + perm32(R & 31)) : R;
        voffA[i] = (unsigned)(R * g.lda + C) * 2u; voffB[i] = (unsigned)(Rb * g.ldb + C) * 2u; }
    const size_t kstep = (size_t)(BK * 2);
    const size_t hstepA = (size_t)HALF * g.lda * 2, hstepB = (size_t)HALF * g.ldb * 2;
    const size_t tstepA = 2 * hstepA, tstepB = 2 * hstepB;
    const unsigned ldsw = (unsigned)wid * 1024u;
    const int aoff = lds_byte(wr * 64 + fr, fq * 8), boff = lds_byte(wc * 32 + fr, fq * 8);
#define PG8_SA(b, h) (((b) * 2 + (h)) * HTB)
#define PG8_SB(b, h) ((4 + (b) * 2 + (h)) * HTB)
#define PG8_STAGE(bufoff, gbase, voff) do { _Pragma("unroll") for (int _i = 0; _i < 2; ++_i) \
        __builtin_amdgcn_global_load_lds((const unsigned*)((const char*)(gbase) + (voff)[_i]), (PG8_LAS unsigned*)(lds + (bufoff) + ldsw + _i * 8192), 16, 0, 0); } while (0)
#define PG8_LDA(dst, b, h) do { _Pragma("unroll") for (int m = 0; m < 4; ++m) _Pragma("unroll") for (int k = 0; k < 2; ++k) dst[m][k] = *(const PG8_LAS bf16x8*)(lds + PG8_SA(b, h) + aoff + m * 2048 + k * 1024); } while (0)
#define PG8_LDB(dst, b, h) do { _Pragma("unroll") for (int n = 0; n < 2; ++n) _Pragma("unroll") for (int k = 0; k < 2; ++k) dst[n][k] = *(const PG8_LAS bf16x8*)(lds + PG8_SB(b, h) + boff + n * 2048 + k * 1024); } while (0)
#define PG8_MMA(ai, bj, At, Bt) do { __builtin_amdgcn_s_setprio(1); _Pragma("unroll") for (int m = 0; m < 4; ++m) _Pragma("unroll") for (int n = 0; n < 2; ++n) _Pragma("unroll") for (int k = 0; k < 2; ++k) \
        acc[ai][bj][m][n] = __builtin_amdgcn_mfma_f32_16x16x32_bf16(Bt[n][k], At[m][k], acc[ai][bj][m][n], 0, 0, 0); __builtin_amdgcn_s_setprio(0); } while (0)
#define PG8_WAIT_V(n) asm volatile("s_waitcnt vmcnt(" #n ")" ::: "memory")
#define PG8_WAIT_L(n) asm volatile("s_waitcnt lgkmcnt(" #n ")" ::: "memory")
#define PG8_BAR __builtin_amdgcn_s_barrier()
#define PG8_SCHED __builtin_amdgcn_sched_barrier(0)
    Unit cur, nxt; int ui = 0; float pfj = 0.f;
    if (!S.next(0, cur)) return;
    f32x4 acc[2][2][4][2];
#pragma unroll
    for (int a = 0; a < 2; ++a)
#pragma unroll
        for (int b = 0; b < 2; ++b)
#pragma unroll
            for (int m = 0; m < 4; ++m)
#pragma unroll
                for (int n = 0; n < 2; ++n) acc[a][b][m][n] = (f32x4){0.f, 0.f, 0.f, 0.f};
    bf16x8 At[4][2], B0[2][2], B1[2][2];
    const char* cA = (const char*)g.A + (size_t)cur.pm * tstepA + (size_t)cur.koff * 2; const char* cB = (const char*)g.Bt + (size_t)cur.pn * tstepB + (size_t)cur.koff * 2;
    S.a_ready(cur);
    if constexpr (SP2) {
        PG8_STAGE(PG8_SB(0, 0), cB, voffB); PG8_STAGE(PG8_SB(0, 1), cB + hstepB, voffB); PG8_STAGE(PG8_SA(0, 0), cA, voffA); PG8_STAGE(PG8_SA(0, 1), cA + hstepA, voffA);
        if (wr == 1) PG8_BAR;
        PG8_WAIT_V(2); PG8_BAR;
        PG8_STAGE(PG8_SB(1, 0), cB + kstep, voffB); PG8_STAGE(PG8_SA(1, 0), cA + kstep, voffA); PG8_STAGE(PG8_SB(1, 1), cB + hstepB + kstep, voffB);
        PG8_WAIT_V(6); PG8_BAR;
    } else {
        PG8_STAGE(PG8_SB(0, 0), cB, voffB); PG8_STAGE(PG8_SA(0, 0), cA, voffA); PG8_STAGE(PG8_SB(0, 1), cB + hstepB, voffB); PG8_STAGE(PG8_SA(0, 1), cA + hstepA, voffA);
        if (wr == 1) PG8_BAR;
        PG8_WAIT_V(4); PG8_BAR;
        PG8_STAGE(PG8_SB(1, 0), cB + kstep, voffB); PG8_STAGE(PG8_SA(1, 0), cA + kstep, voffA); PG8_STAGE(PG8_SB(1, 1), cB + hstepB + kstep, voffB);
        PG8_WAIT_V(6); PG8_BAR;
    }
    for (;;) {
        const bool has_next = S.next(ui + 1, nxt);
        const char* nA = has_next ? (const char*)g.A + (size_t)nxt.pm * tstepA + (size_t)nxt.koff * 2 : cA; const char* nB = has_next ? (const char*)g.Bt + (size_t)nxt.pn * tstepB + (size_t)nxt.koff * 2 : cB;
        for (int t = 0; t < nt; t += 2) {
            const bool last = (t == nt - 2);
            if constexpr (Epi::PF) E.prefetch(cur, t, nt, tid, pfj);
            if constexpr (Epi::MID) { if (t == (nt >> 1)) E.mid(acc, cur, wr, wc, fr, fq); }
            const char* a1 = cA + (size_t)(t + 1) * kstep;
            const char* a2 = last ? nA : cA + (size_t)(t + 2) * kstep; const char* b2 = last ? nB : cB + (size_t)(t + 2) * kstep;
            const char* a3 = a2 + kstep; const char* b3 = b2 + kstep;
            if (last && has_next) S.a_ready(nxt);
            if constexpr (SP2) {
            PG8_LDB(B0, 0, 0); PG8_LDB(B1, 0, 1); PG8_SCHED; PG8_LDA(At, 0, 0); PG8_STAGE(PG8_SA(1, 1), a1 + hstepA, voffA);
            PG8_WAIT_V(8); PG8_WAIT_L(0); PG8_BAR; PG8_MMA(0, 0, At, B0); PG8_MMA(0, 1, At, B1); PG8_BAR; PG8_SCHED;
            PG8_LDA(At, 0, 1); PG8_STAGE(PG8_SB(0, 0), b2, voffB); PG8_STAGE(PG8_SB(0, 1), b2 + hstepB, voffB); PG8_STAGE(PG8_SA(0, 0), a2, voffA);
            PG8_WAIT_V(8); PG8_WAIT_L(0); PG8_BAR; PG8_MMA(1, 0, At, B0); PG8_MMA(1, 1, At, B1); PG8_BAR; PG8_SCHED;
            PG8_LDB(B0, 1, 0); PG8_LDB(B1, 1, 1); PG8_SCHED; PG8_LDA(At, 1, 0); PG8_STAGE(PG8_SA(0, 1), a2 + hstepA, voffA);
            PG8_WAIT_V(8); PG8_WAIT_L(0); PG8_BAR; PG8_MMA(0, 0, At, B0); PG8_MMA(0, 1, At, B1); PG8_BAR; PG8_SCHED;
            PG8_LDA(At, 1, 1); PG8_STAGE(PG8_SB(1, 0), b3, voffB); PG8_STAGE(PG8_SB(1, 1), b3 + hstepB, voffB); PG8_STAGE(PG8_SA(1, 0), a3, voffA);
            PG8_WAIT_V(8); PG8_WAIT_L(0); PG8_BAR; PG8_MMA(1, 0, At, B0); PG8_MMA(1, 1, At, B1); PG8_BAR; PG8_SCHED;
            } else {
            PG8_LDB(B0, 0, 0); PG8_SCHED; PG8_LDA(At, 0, 0); PG8_STAGE(PG8_SA(1, 1), a1 + hstepA, voffA);
            PG8_WAIT_L(8); PG8_BAR; PG8_WAIT_L(0); PG8_MMA(0, 0, At, B0); PG8_BAR; PG8_SCHED;
            PG8_LDB(B1, 0, 1); PG8_STAGE(PG8_SB(0, 0), b2, voffB);
            PG8_BAR; PG8_WAIT_L(0); PG8_MMA(0, 1, At, B1); PG8_BAR;
            PG8_LDA(At, 0, 1); PG8_STAGE(PG8_SA(0, 0), a2, voffA);
            PG8_BAR; PG8_WAIT_L(0); PG8_MMA(1, 0, At, B0); PG8_BAR; PG8_SCHED;
            PG8_STAGE(PG8_SB(0, 1), b2 + hstepB, voffB);
            PG8_WAIT_V(6); PG8_BAR; PG8_MMA(1, 1, At, B1); PG8_BAR;
            PG8_LDB(B0, 1, 0); PG8_SCHED; PG8_LDA(At, 1, 0); PG8_STAGE(PG8_SA(0, 1), a2 + hstepA, voffA);
            PG8_WAIT_L(8); PG8_BAR; PG8_WAIT_L(0); PG8_MMA(0, 0, At, B0); PG8_BAR; PG8_SCHED;
            PG8_LDB(B1, 1, 1); PG8_STAGE(PG8_SB(1, 0), b3, voffB);
            PG8_BAR; PG8_WAIT_L(0); PG8_MMA(0, 1, At, B1); PG8_BAR;
            PG8_LDA(At, 1, 1); PG8_STAGE(PG8_SA(1, 0), a3, voffA);
            PG8_BAR; PG8_WAIT_L(0); PG8_MMA(1, 0, At, B0); PG8_BAR; PG8_SCHED;
            PG8_STAGE(PG8_SB(1, 1), b3 + hstepB, voffB);
            PG8_WAIT_V(6); PG8_BAR; PG8_MMA(1, 1, At, B1); PG8_BAR;
            }
        }
        if constexpr (ALIGN_EPI) { if (wr == 0) PG8_BAR; }
        if constexpr (!Epi::AFTER_DRAIN) { E(acc, cur, wr, wc, fr, fq); S.done(cur); }
        asm volatile("" :: "v"(pfj));
        if (!has_next) break;
#pragma unroll
        for (int a = 0; a < 2; ++a)
#pragma unroll
            for (int b = 0; b < 2; ++b)
#pragma unroll
                for (int m = 0; m < 4; ++m)
#pragma unroll
                    for (int n = 0; n < 2; ++n) acc[a][b][m][n] = (f32x4){0.f, 0.f, 0.f, 0.f};
        cur = nxt; cA = nA; cB = nB; ++ui;
        if constexpr (ALIGN_EPI) { if (wr == 1) PG8_BAR; }
    }
    PG8_WAIT_V(0);
    if constexpr (!ALIGN_EPI) { if (wr == 0) PG8_BAR; }
    PG8_BAR;
    if constexpr (Epi::AFTER_DRAIN) { E.fused(acc, cur, wr, wc, fr, fq, lds, wid, lane); S.done(cur); }
#undef PG8_SA
#undef PG8_SB
#undef PG8_STAGE
#undef PG8_LDA
#undef PG8_LDB
#undef PG8_MMA
#undef PG8_WAIT_V
#undef PG8_WAIT_L
#undef PG8_BAR
#undef PG8_SCHED
}
}

namespace attn {
constexpr int SLOTB = 8192;
constexpr int NSLOT = 5;
constexpr int LDS_K = 0, LDS_V = NSLOT * SLOTB, LDS_WS = 2 * NSLOT * SLOTB, LDS_OST = LDS_WS + 8 * 256, LDS_CL = LDS_OST + 8 * 4096, LDS_SCAN = LDS_CL + 2064 * 4 + 64, LDS_END = LDS_SCAN + 64;
#define SBAR() __builtin_amdgcn_sched_barrier(0)
__device__ __forceinline__ int crow(int r, int hi) { return (r & 3) + 8 * (r >> 2) + 4 * hi; }
__device__ __forceinline__ void glds16(const void* gsrc, unsigned lds_dst) { unsigned keep;
    asm volatile("s_mov_b32 %0, m0\n\ts_mov_b32 m0, %2\n\ts_nop 0\n\tglobal_load_lds_dwordx4 %1, off\n\ts_mov_b32 m0, %0" : "=&s"(keep) : "v"(gsrc), "s"(lds_dst) : "memory"); }
typedef float f32x2_t __attribute__((ext_vector_type(2))); typedef __bf16 bf16x2_t __attribute__((ext_vector_type(2)));
__device__ __forceinline__ unsigned cvtpk_s(float lo, float hi) { f32x2_t v = {lo, hi}; bf16x2_t b = __builtin_convertvector(v, bf16x2_t); return __builtin_bit_cast(unsigned, b); }
#define MX3(a, b, c) __builtin_fmaxf(__builtin_fmaxf((a), (b)), (c))
__device__ __forceinline__ void qkt(f32x16& p0, f32x16& p1, const char* Kslot, const bf16x8* qr, const f32x16& negm, int r32, int hi) {
    const char* kb = Kslot + hi * 1024 + r32 * 16;
#pragma unroll
    for (int d0 = 0; d0 < 4; ++d0) {
        const bf16x8 b0 = *reinterpret_cast<const bf16x8*>(kb + d0 * 2048);
        const bf16x8 b1 = *reinterpret_cast<const bf16x8*>(kb + d0 * 2048 + 512);
        if (d0 == 0) { p0 = __builtin_amdgcn_mfma_f32_32x32x16_bf16(b0, qr[0], negm, 0, 0, 0); p1 = __builtin_amdgcn_mfma_f32_32x32x16_bf16(b1, qr[0], negm, 0, 0, 0); }
        else { p0 = __builtin_amdgcn_mfma_f32_32x32x16_bf16(b0, qr[d0], p0, 0, 0, 0); p1 = __builtin_amdgcn_mfma_f32_32x32x16_bf16(b1, qr[d0], p1, 0, 0, 0); }
    }
}
__device__ __forceinline__ float rowmax(const f32x16& p0, const f32x16& p1) {
    float a = MX3(p0[0], p0[1], p1[0]), b = MX3(p0[2], p0[3], p1[1]); a = MX3(a, p1[2], p1[3]);
#pragma unroll
    for (int r = 4; r < 16; r += 4) { a = MX3(a, p0[r], p0[r + 1]); b = MX3(b, p0[r + 2], p0[r + 3]); a = MX3(a, p1[r], p1[r + 1]); b = MX3(b, p1[r + 2], p1[r + 3]); }
    const float m = __builtin_fmaxf(a, b);
    auto rr = __builtin_amdgcn_permlane32_swap(__float_as_uint(m), __float_as_uint(m), false, false);
    return __builtin_fmaxf(__uint_as_float(rr[0]), __uint_as_float(rr[1]));
}
__device__ __forceinline__ void pv(f32x16* o, int vb, bf16x8 pa0, bf16x8 pa1, bf16x8 pa2, bf16x8 pa3) {
#pragma unroll
    for (int d0 = 0; d0 < 2; ++d0) { s16x4 lo[4], hi[4];
#pragma unroll
        for (int ks = 0; ks < 4; ++ks) {
            asm volatile("ds_read_b64_tr_b16 %0,%1 offset:%c2" : "=&v"(lo[ks]) : "v"(vb), "i"(d0 * 4096 + ks * 1024) : "memory");
            asm volatile("ds_read_b64_tr_b16 %0,%1 offset:%c2" : "=&v"(hi[ks]) : "v"(vb), "i"(d0 * 4096 + ks * 1024 + 512) : "memory"); }
        asm volatile("s_waitcnt lgkmcnt(0)" ::: "memory"); SBAR();
#define PK(k) (bf16x8){lo[k][0], lo[k][1], lo[k][2], lo[k][3], hi[k][0], hi[k][1], hi[k][2], hi[k][3]}
        o[d0] = __builtin_amdgcn_mfma_f32_32x32x16_bf16(pa0, PK(0), o[d0], 0, 0, 0);
        o[d0] = __builtin_amdgcn_mfma_f32_32x32x16_bf16(pa1, PK(1), o[d0], 0, 0, 0);
        o[d0] = __builtin_amdgcn_mfma_f32_32x32x16_bf16(pa2, PK(2), o[d0], 0, 0, 0);
        o[d0] = __builtin_amdgcn_mfma_f32_32x32x16_bf16(pa3, PK(3), o[d0], 0, 0, 0);
#undef PK
    }
}
#define WAIT_BAR0() asm volatile("s_waitcnt vmcnt(0) lgkmcnt(0)\n\ts_barrier" ::: "memory")

template <int MODE>
__device__ __forceinline__ void unit(const bf16_t* Qw, bf16_t* Ow, const bf16_t* Kh, const bf16_t* Vh, int kp, int NT, int kbase, int qpos0,
                                     float slope2, float sink2, const float* cl, char* shm) {
    const int tid = threadIdx.x, lane = tid & 63, r32 = lane & 31, hi = lane >> 5; const int wid = __builtin_amdgcn_readfirstlane(tid >> 6);
    const unsigned lds0 = (unsigned)(uintptr_t)shm;
    float* wsf = (float*)(shm + LDS_WS) + wid * 64;
    const bf16_t* ksrc = Kh + (size_t)lane * kp + wid * 8;
    const bf16_t* vsrc = Vh + (size_t)(16 * (wid & 3) + (lane >> 2)) * kp + (wid >> 2) * 32 + (lane & 3) * 8;
    const unsigned kdst = lds0 + LDS_K + wid * 1024, vdst = lds0 + LDS_V + wid * 1024;
#define TILE_KR0(t) ((t) == 0 ? 64 : kbase + 64 * ((t) - 1))
#define DMA_KV(t, slot) do { const size_t ro_ = (size_t)TILE_KR0(t) * kp; \
        glds16(ksrc + ro_, (unsigned)__builtin_amdgcn_readfirstlane(kdst + (slot) * SLOTB)); glds16(vsrc + ro_, (unsigned)__builtin_amdgcn_readfirstlane(vdst + (slot) * SLOTB)); } while (0)
    const int vb0 = (int)(lds0 + LDS_V) + ((lane >> 4) & 1) * 32 + (lane & 3) * 8 + (4 * hi + ((lane & 15) >> 2)) * 64;
    DMA_KV(0, 0);
    bf16x8 qr[4];
#pragma unroll
    for (int d0 = 0; d0 < 4; ++d0) qr[d0] = *reinterpret_cast<const bf16x8*>(Qw + (size_t)r32 * DM + d0 * 16 + hi * 8);
    const int qp = qpos0 + r32;
    const float rowterm = (MODE == 0) ? cl[qp - KR_META] : -slope2 * (float)qp;
    float mhat = (MODE == 0) ? 0.f : sink2, l_reg = (MODE == 1 && hi == 0) ? 1.f : 0.f;
    f32x16 o[2]; o[0] = f32x16{}; o[1] = f32x16{};
    for (int t = 0; t < NT; ++t) {
        WAIT_BAR0();
        if (t + 1 < NT) DMA_KV(t + 1, (t + 1) & 1);
        const int slot = t & 1, kr0 = TILE_KR0(t);
        bool empty = false, full = false;
        if (MODE == 1 && t > 0) { empty = (kr0 > qpos0 + 31) || (kr0 + 63 <= qpos0 - 128) || (kr0 + 63 < KR_REAL);
            full = (kr0 >= KR_REAL) && (kr0 + 63 <= qpos0) && (qpos0 + 31 - kr0 < 128); }
        if (empty) continue;
        f32x16 negm; { const float nm = rowterm - mhat;
#pragma unroll
            for (int r = 0; r < 16; ++r) negm[r] = nm; }
        f32x16 p0, p1;
        qkt(p0, p1, shm + LDS_K + slot * SLOTB, qr, negm, r32, hi);
        const bool need_mask = (MODE == 1 && !full) || (MODE == 0 && ((kr0 < KR_META) || (kr0 + 63 > qpos0)));
        if (need_mask) {
#pragma unroll
            for (int r = 0; r < 16; ++r) {
                const int k0 = kr0 + crow(r, hi), k1 = k0 + 32;
                bool ok0, ok1; float c0, c1;
                if (MODE == 0) { ok0 = (k0 >= KR_META) && (k0 <= qp); ok1 = (k1 >= KR_META) && (k1 <= qp);
                    c0 = -cl[k0 >= KR_META ? k0 - KR_META : 0]; c1 = -cl[k1 >= KR_META ? k1 - KR_META : 0]; }
                else { ok0 = (t == 0) ? (k0 >= KR_META) : (k0 >= KR_REAL && k0 <= qp && qp - k0 < 128); ok1 = (t == 0) ? (k1 >= KR_META) : (k1 >= KR_REAL && k1 <= qp && qp - k1 < 128);
                    c0 = slope2 * (float)k0; c1 = slope2 * (float)k1; }
                p0[r] = ok0 ? p0[r] + c0 : -INFINITY; p1[r] = ok1 ? p1[r] + c1 : -INFINITY;
            }
        } else {
#pragma unroll
            for (int r = 0; r < 16; ++r) { const int k0 = kr0 + crow(r, hi);
                if (MODE == 0) { p0[r] -= cl[k0 - KR_META]; p1[r] -= cl[k0 - KR_META + 32]; }
                else { p0[r] += slope2 * (float)k0; p1[r] += slope2 * (float)(k0 + 32); } }
        }
        const float rm = rowmax(p0, p1);
        if (MODE == 0 && t == 0) {
            mhat = rm;
#pragma unroll
            for (int r = 0; r < 16; ++r) { p0[r] -= rm; p1[r] -= rm; }
        } else if (__any(rm > 0.f)) {
            const float dl = __builtin_fmaxf(rm, 0.f); mhat += dl;
#pragma unroll
            for (int r = 0; r < 16; ++r) { p0[r] -= dl; p1[r] -= dl; }
            const float f = __builtin_amdgcn_exp2f(-dl); l_reg *= f;
            if (hi == 0) wsf[r32] = f;
            asm volatile("s_waitcnt lgkmcnt(0)" ::: "memory");
#pragma unroll
            for (int d = 0; d < 2; ++d)
#pragma unroll
                for (int r = 0; r < 16; ++r) o[d][r] *= wsf[crow(r, hi)];
        }
        float sacc = 0.f;
#pragma unroll
        for (int r = 0; r < 16; ++r) { p0[r] = __builtin_amdgcn_exp2f(p0[r]); p1[r] = __builtin_amdgcn_exp2f(p1[r]); sacc += p0[r] + p1[r]; }
        l_reg += sacc;
        u32x4 pw0, pw1, pw2, pw3;
        pw0 = (u32x4){cvtpk_s(p0[0], p0[1]), cvtpk_s(p0[2], p0[3]), cvtpk_s(p0[4], p0[5]), cvtpk_s(p0[6], p0[7])};
        pw1 = (u32x4){cvtpk_s(p0[8], p0[9]), cvtpk_s(p0[10], p0[11]), cvtpk_s(p0[12], p0[13]), cvtpk_s(p0[14], p0[15])};
        pw2 = (u32x4){cvtpk_s(p1[0], p1[1]), cvtpk_s(p1[2], p1[3]), cvtpk_s(p1[4], p1[5]), cvtpk_s(p1[6], p1[7])};
        pw3 = (u32x4){cvtpk_s(p1[8], p1[9]), cvtpk_s(p1[10], p1[11]), cvtpk_s(p1[12], p1[13]), cvtpk_s(p1[14], p1[15])};
        SBAR();
        pv(o, vb0 + slot * SLOTB, __builtin_bit_cast(bf16x8, pw0), __builtin_bit_cast(bf16x8, pw1), __builtin_bit_cast(bf16x8, pw2), __builtin_bit_cast(bf16x8, pw3));
    }
    { auto rr = __builtin_amdgcn_permlane32_swap(__float_as_uint(l_reg), __float_as_uint(l_reg), false, false); l_reg = __uint_as_float(rr[0]) + __uint_as_float(rr[1]); }
    if (hi == 0) wsf[32 + r32] = l_reg;
    asm volatile("s_waitcnt lgkmcnt(0)" ::: "memory");
    float rli[16];
#pragma unroll
    for (int r = 0; r < 16; ++r) rli[r] = 1.0f / wsf[32 + crow(r, hi)];
    { __hip_bfloat16* stg = (__hip_bfloat16*)(shm + LDS_OST) + wid * 2048;
#pragma unroll
        for (int r = 0; r < 16; ++r) { const int orow = crow(r, hi);
#pragma unroll
            for (int d0 = 0; d0 < 2; ++d0) stg[orow * 64 + d0 * 32 + r32] = __float2bfloat16(o[d0][r] * rli[r]); }
        asm volatile("s_waitcnt lgkmcnt(0)" ::: "memory");
#pragma unroll
        for (int i = 0; i < 4; ++i) { const int row = i * 8 + (lane >> 3), ch = lane & 7; const u32x4 v = *(const u32x4*)(stg + row * 64 + ch * 8); *(u32x4*)(Ow + (size_t)row * DM + ch * 8) = v; } }
    asm volatile("s_waitcnt lgkmcnt(0)\n\ts_barrier" ::: "memory");
#undef DMA_KV
#undef TILE_KR0
}

__device__ __forceinline__ void unit_swa(const bf16_t* Qw, bf16_t* Ow, const bf16_t* Kh, const bf16_t* Vh, int kp, int kbase, int qpos0, float slope2, float sink2, char* shm, int dbg_nocompute = 0) {
    const int tid = threadIdx.x; int lane_ = tid & 63; asm volatile("" : "+v"(lane_));
    const int lane = lane_, r32 = lane & 31, hi = lane >> 5; const int wid = __builtin_amdgcn_readfirstlane(tid >> 6);
    const unsigned lds0 = (unsigned)(uintptr_t)shm;
    float* wsf = (float*)(shm + LDS_WS) + wid * 64;
    const bf16_t* ksrc = Kh + (size_t)lane * kp + wid * 8;
    const bf16_t* vsrc = Vh + (size_t)(16 * (wid & 3) + (lane >> 2)) * kp + (wid >> 2) * 32 + (lane & 3) * 8;
    const unsigned kdst = lds0 + LDS_K + wid * 1024, vdst = lds0 + LDS_V + wid * 1024;
#define TILE_KR0(t) ((t) == 0 ? 64 : kbase + 64 * ((t) - 1))
#define DMA_KV(t, slot) do { const size_t ro_ = (size_t)TILE_KR0(t) * kp; \
        glds16(ksrc + ro_, (unsigned)__builtin_amdgcn_readfirstlane(kdst + (slot) * SLOTB)); glds16(vsrc + ro_, (unsigned)__builtin_amdgcn_readfirstlane(vdst + (slot) * SLOTB)); } while (0)
    const int vb0 = (int)(lds0 + LDS_V) + ((lane >> 4) & 1) * 32 + (lane & 3) * 8 + (4 * hi + ((lane & 15) >> 2)) * 64;
#pragma unroll
    for (int t = 0; t < 5; ++t) DMA_KV(t, t);
    bf16x8 qr[4];
#pragma unroll
    for (int d0 = 0; d0 < 4; ++d0) qr[d0] = *reinterpret_cast<const bf16x8*>(Qw + (size_t)r32 * DM + d0 * 16 + hi * 8);
    const int qp = qpos0 + r32;
    const float rowterm = -slope2 * (float)qp;
    float mhat = sink2, l_reg = (hi == 0) ? 1.f : 0.f;
    f32x16 o[2]; o[0] = f32x16{}; o[1] = f32x16{};
#define SWA_RESCALE(RM, SUBS) do { if (__any((RM) > 8.f)) { const float dl = __builtin_fmaxf((RM), 0.f); mhat += dl; SUBS; \
        const float f = __builtin_amdgcn_exp2f(-dl); l_reg *= f; if (hi == 0) wsf[r32] = f; asm volatile("s_waitcnt lgkmcnt(0)" ::: "memory"); \
        _Pragma("unroll") for (int d = 0; d < 2; ++d) _Pragma("unroll") for (int r = 0; r < 16; ++r) o[d][r] *= wsf[crow(r, hi)]; } } while (0)
    WAIT_BAR0();
    for (int t = 0; t < 5; ++t) {
        if (dbg_nocompute) continue;
        const int slot = t, kr0 = TILE_KR0(t);
        const char* Kslot = shm + LDS_K + slot * SLOTB;
        if (t == 0) {
            f32x16 p1; { const float nm = rowterm - mhat;
#pragma unroll
                for (int r = 0; r < 16; ++r) p1[r] = nm; }
            const char* kb = Kslot + hi * 1024 + r32 * 16 + 512;
#pragma unroll
            for (int d0 = 0; d0 < 4; ++d0) p1 = __builtin_amdgcn_mfma_f32_32x32x16_bf16(*reinterpret_cast<const bf16x8*>(kb + d0 * 2048), qr[d0], p1, 0, 0, 0);
            const float base = slope2 * (float)(96 + 4 * hi);
            float x[8];
#pragma unroll
            for (int r = 0; r < 8; ++r) x[r] = p1[8 + r] + __builtin_fmaf(slope2, (float)(((8 + r) & 3) + 8 * ((8 + r) >> 2)), base);
            float rm = MX3(MX3(x[0], x[1], x[2]), MX3(x[3], x[4], x[5]), __builtin_fmaxf(x[6], x[7]));
            { auto rr = __builtin_amdgcn_permlane32_swap(__float_as_uint(rm), __float_as_uint(rm), false, false); rm = __builtin_fmaxf(__uint_as_float(rr[0]), __uint_as_float(rr[1])); }
            SWA_RESCALE(rm, _Pragma("unroll") for (int r = 0; r < 8; ++r) x[r] -= dl);
            float sacc = 0.f;
#pragma unroll
            for (int r = 0; r < 8; ++r) { x[r] = __builtin_amdgcn_exp2f(x[r]); sacc += x[r]; }
            l_reg += sacc;
            const u32x4 pw3 = (u32x4){cvtpk_s(x[0], x[1]), cvtpk_s(x[2], x[3]), cvtpk_s(x[4], x[5]), cvtpk_s(x[6], x[7])};
            const int vb = vb0 + slot * SLOTB;
#pragma unroll
            for (int d0 = 0; d0 < 2; ++d0) { s16x4 lo, hh;
                asm volatile("ds_read_b64_tr_b16 %0,%1 offset:%c2" : "=&v"(lo) : "v"(vb), "i"(d0 * 4096 + 3 * 1024) : "memory");
                asm volatile("ds_read_b64_tr_b16 %0,%1 offset:%c2" : "=&v"(hh) : "v"(vb), "i"(d0 * 4096 + 3 * 1024 + 512) : "memory");
                asm volatile("s_waitcnt lgkmcnt(0)" ::: "memory"); SBAR();
                o[d0] = __builtin_amdgcn_mfma_f32_32x32x16_bf16(__builtin_bit_cast(bf16x8, pw3), (bf16x8){lo[0], lo[1], lo[2], lo[3], hh[0], hh[1], hh[2], hh[3]}, o[d0], 0, 0, 0); }
            continue;
        }
        const int dmin = qpos0 - (kr0 + 63), dmax = qpos0 + 31 - kr0;
        if (dmax < 0 || dmin >= 128 || kr0 + 63 < KR_REAL) continue;
        f32x16 negm; { const float nm = rowterm - mhat;
#pragma unroll
            for (int r = 0; r < 16; ++r) negm[r] = nm; }
        f32x16 p0, p1;
        qkt(p0, p1, Kslot, qr, negm, r32, hi);
        const float base = slope2 * (float)(kr0 + 4 * hi);
        const int lim = qp - kr0 - 4 * hi;
        if (dmin < 0) {
#pragma unroll
            for (int r = 0; r < 16; ++r) { const int cr = (r & 3) + 8 * (r >> 2);
                p0[r] = (cr <= lim) ? p0[r] + __builtin_fmaf(slope2, (float)cr, base) : -INFINITY; p1[r] = (cr + 32 <= lim) ? p1[r] + __builtin_fmaf(slope2, (float)(cr + 32), base) : -INFINITY; }
        } else if (dmax >= 128) {
#pragma unroll
            for (int r = 0; r < 16; ++r) { const int cr = (r & 3) + 8 * (r >> 2);
                p0[r] = (cr > lim - 128) ? p0[r] + __builtin_fmaf(slope2, (float)cr, base) : -INFINITY; p1[r] = (cr + 32 > lim - 128) ? p1[r] + __builtin_fmaf(slope2, (float)(cr + 32), base) : -INFINITY; }
        } else {
#pragma unroll
            for (int r = 0; r < 16; ++r) { const int cr = (r & 3) + 8 * (r >> 2); p0[r] += __builtin_fmaf(slope2, (float)cr, base); p1[r] += __builtin_fmaf(slope2, (float)(cr + 32), base); }
        }
        const float rm = rowmax(p0, p1);
        SWA_RESCALE(rm, _Pragma("unroll") for (int r = 0; r < 16; ++r) { p0[r] -= dl; p1[r] -= dl; });
        float sacc = 0.f;
#pragma unroll
        for (int r = 0; r < 16; ++r) { p0[r] = __builtin_amdgcn_exp2f(p0[r]); p1[r] = __builtin_amdgcn_exp2f(p1[r]); sacc += p0[r] + p1[r]; }
        l_reg += sacc;
        u32x4 pw0, pw1, pw2, pw3;
        pw0 = (u32x4){cvtpk_s(p0[0], p0[1]), cvtpk_s(p0[2], p0[3]), cvtpk_s(p0[4], p0[5]), cvtpk_s(p0[6], p0[7])};
        pw1 = (u32x4){cvtpk_s(p0[8], p0[9]), cvtpk_s(p0[10], p0[11]), cvtpk_s(p0[12], p0[13]), cvtpk_s(p0[14], p0[15])};
        pw2 = (u32x4){cvtpk_s(p1[0], p1[1]), cvtpk_s(p1[2], p1[3]), cvtpk_s(p1[4], p1[5]), cvtpk_s(p1[6], p1[7])};
        pw3 = (u32x4){cvtpk_s(p1[8], p1[9]), cvtpk_s(p1[10], p1[11]), cvtpk_s(p1[12], p1[13]), cvtpk_s(p1[14], p1[15])};
        SBAR();
        pv(o, vb0 + slot * SLOTB, __builtin_bit_cast(bf16x8, pw0), __builtin_bit_cast(bf16x8, pw1), __builtin_bit_cast(bf16x8, pw2), __builtin_bit_cast(bf16x8, pw3));
    }
    { auto rr = __builtin_amdgcn_permlane32_swap(__float_as_uint(l_reg), __float_as_uint(l_reg), false, false); l_reg = __uint_as_float(rr[0]) + __uint_as_float(rr[1]); }
    if (hi == 0) wsf[32 + r32] = l_reg;
    asm volatile("s_waitcnt lgkmcnt(0)" ::: "memory");
    float rli[16];
#pragma unroll
    for (int r = 0; r < 16; ++r) rli[r] = 1.0f / wsf[32 + crow(r, hi)];
    { __hip_bfloat16* stg = (__hip_bfloat16*)(shm + LDS_OST) + wid * 2048;
#pragma unroll
        for (int r = 0; r < 16; ++r) { const int orow = crow(r, hi);
#pragma unroll
            for (int d0 = 0; d0 < 2; ++d0) stg[orow * 64 + d0 * 32 + r32] = __float2bfloat16(o[d0][r] * rli[r]); }
        asm volatile("s_waitcnt lgkmcnt(0)" ::: "memory");
#pragma unroll
        for (int i = 0; i < 4; ++i) { const int row = i * 8 + (lane >> 3), ch = lane & 7; const u32x4 v = *(const u32x4*)(stg + row * 64 + ch * 8); *(u32x4*)(Ow + (size_t)row * DM + ch * 8) = v; } }
    asm volatile("s_waitcnt lgkmcnt(0)\n\ts_barrier" ::: "memory");
#undef SWA_RESCALE
#undef DMA_KV
#undef TILE_KR0
}

__device__ __forceinline__ void unit_swa2(const bf16_t* Qw, bf16_t* Ow, const bf16_t* Kh, const bf16_t* Vh, int kp, int kbase, int qpos0, float slope2, float sink2, char* shm) {
    const int tid = threadIdx.x; int lane_ = tid & 63; asm volatile("" : "+v"(lane_));
    const int lane = lane_, r32 = lane & 31, hi = lane >> 5; const int wid = __builtin_amdgcn_readfirstlane(tid >> 6);
    const unsigned lds0 = (unsigned)(uintptr_t)shm;
    float* wsf = (float*)(shm + LDS_WS) + wid * 64;
    const bf16_t* ksrc = Kh + (size_t)lane * kp + wid * 8;
    const bf16_t* vsrc = Vh + (size_t)(16 * (wid & 3) + (lane >> 2)) * kp + (wid >> 2) * 32 + (lane & 3) * 8;
    const unsigned kdst = lds0 + LDS_K + wid * 1024, vdst = lds0 + LDS_V + wid * 1024;
#define TILE_KR0(t) ((t) == 0 ? 64 : kbase + 64 * ((t) - 1))
#define DMA_KV(t, slot) do { const size_t ro_ = (size_t)TILE_KR0(t) * kp; \
        glds16(ksrc + ro_, (unsigned)__builtin_amdgcn_readfirstlane(kdst + (slot) * SLOTB)); glds16(vsrc + ro_, (unsigned)__builtin_amdgcn_readfirstlane(vdst + (slot) * SLOTB)); } while (0)
    const int vb0 = (int)(lds0 + LDS_V) + ((lane >> 4) & 1) * 32 + (lane & 3) * 8 + (4 * hi + ((lane & 15) >> 2)) * 64;
#pragma unroll
    for (int t = 0; t < 5; ++t) DMA_KV(t, t);
    bf16x8 qr[4];
#pragma unroll
    for (int d0 = 0; d0 < 4; ++d0) qr[d0] = *reinterpret_cast<const bf16x8*>(Qw + (size_t)r32 * DM + d0 * 16 + hi * 8);
    const int qp = qpos0 + r32;
    const float rowterm = -slope2 * (float)qp;
    const int jb0 = ((qpos0 - kbase - 128) >> 5) >= 2 ? 1 : 0;
    const int krW = kbase + 64 * jb0, krF = krW + 64, krC = krW + 128;
    const bool vW = krW >= KR_REAL, vF = krF >= KR_REAL;
    f32x16 initc;
#pragma unroll
    for (int r = 0; r < 16; ++r) initc[r] = rowterm;
    WAIT_BAR0();
    f32x16 pm = initc;
    { const char* kb = shm + LDS_K + hi * 1024 + r32 * 16 + 512;
#pragma unroll
      for (int d0 = 0; d0 < 4; ++d0) pm = __builtin_amdgcn_mfma_f32_32x32x16_bf16(*reinterpret_cast<const bf16x8*>(kb + d0 * 2048), qr[d0], pm, 0, 0, 0); }
    f32x16 w0, w1, f0, f1, c0, c1;
    if (vW) qkt(w0, w1, shm + LDS_K + (1 + jb0) * SLOTB, qr, initc, r32, hi);
    if (vF) qkt(f0, f1, shm + LDS_K + (2 + jb0) * SLOTB, qr, initc, r32, hi);
    qkt(c0, c1, shm + LDS_K + (3 + jb0) * SLOTB, qr, initc, r32, hi);
    float xm[8];
    { const float base = slope2 * (float)(96 + 4 * hi);
#pragma unroll
      for (int r = 0; r < 8; ++r) xm[r] = pm[8 + r] + __builtin_fmaf(slope2, (float)(((8 + r) & 3) + 8 * ((8 + r) >> 2)), base); }
    if (vW) { const float base = slope2 * (float)(krW + 4 * hi); const int lim = qp - krW - 4 * hi;
#pragma unroll
        for (int r = 0; r < 16; ++r) { const int cr = (r & 3) + 8 * (r >> 2);
            w0[r] = (cr > lim - 128) ? w0[r] + __builtin_fmaf(slope2, (float)cr, base) : -INFINITY; w1[r] = (cr + 32 > lim - 128) ? w1[r] + __builtin_fmaf(slope2, (float)(cr + 32), base) : -INFINITY; }
    } else {
#pragma unroll
        for (int r = 0; r < 16; ++r) { w0[r] = -INFINITY; w1[r] = -INFINITY; } }
    if (vF) { const float base = slope2 * (float)(krF + 4 * hi);
#pragma unroll
        for (int r = 0; r < 16; ++r) { const int cr = (r & 3) + 8 * (r >> 2); f0[r] += __builtin_fmaf(slope2, (float)cr, base); f1[r] += __builtin_fmaf(slope2, (float)(cr + 32), base); }
    } else {
#pragma unroll
        for (int r = 0; r < 16; ++r) { f0[r] = -INFINITY; f1[r] = -INFINITY; } }
    { const float base = slope2 * (float)(krC + 4 * hi); const int lim = qp - krC - 4 * hi;
#pragma unroll
      for (int r = 0; r < 16; ++r) { const int cr = (r & 3) + 8 * (r >> 2);
          c0[r] = (cr <= lim) ? c0[r] + __builtin_fmaf(slope2, (float)cr, base) : -INFINITY; c1[r] = (cr + 32 <= lim) ? c1[r] + __builtin_fmaf(slope2, (float)(cr + 32), base) : -INFINITY; } }
    float m = __builtin_fmaxf(__builtin_fmaxf(rowmax(w0, w1), rowmax(f0, f1)), rowmax(c0, c1));
    { float mm = MX3(MX3(xm[0], xm[1], xm[2]), MX3(xm[3], xm[4], xm[5]), __builtin_fmaxf(xm[6], xm[7]));
      auto rr = __builtin_amdgcn_permlane32_swap(__float_as_uint(mm), __float_as_uint(mm), false, false); mm = __builtin_fmaxf(__uint_as_float(rr[0]), __uint_as_float(rr[1]));
      m = __builtin_fmaxf(__builtin_fmaxf(m, mm), sink2); }
    f32x16 o[2]; o[0] = f32x16{}; o[1] = f32x16{};
    float l_reg = (hi == 0) ? __builtin_amdgcn_exp2f(sink2 - m) : 0.f;
    { float sacc = 0.f;
#pragma unroll
      for (int r = 0; r < 8; ++r) { xm[r] = __builtin_amdgcn_exp2f(xm[r] - m); sacc += xm[r]; }
      l_reg += sacc;
      const u32x4 pw3 = (u32x4){cvtpk_s(xm[0], xm[1]), cvtpk_s(xm[2], xm[3]), cvtpk_s(xm[4], xm[5]), cvtpk_s(xm[6], xm[7])};
#pragma unroll
      for (int d0 = 0; d0 < 2; ++d0) { s16x4 lo, hh;
          asm volatile("ds_read_b64_tr_b16 %0,%1 offset:%c2" : "=&v"(lo) : "v"(vb0), "i"(d0 * 4096 + 3 * 1024) : "memory");
          asm volatile("ds_read_b64_tr_b16 %0,%1 offset:%c2" : "=&v"(hh) : "v"(vb0), "i"(d0 * 4096 + 3 * 1024 + 512) : "memory");
          asm volatile("s_waitcnt lgkmcnt(0)" ::: "memory"); SBAR();
          o[d0] = __builtin_amdgcn_mfma_f32_32x32x16_bf16(__builtin_bit_cast(bf16x8, pw3), (bf16x8){lo[0], lo[1], lo[2], lo[3], hh[0], hh[1], hh[2], hh[3]}, o[d0], 0, 0, 0); } }
#define SWA2_TILE(P0, P1, SLOT) do { float sacc = 0.f; \
        _Pragma("unroll") for (int r = 0; r < 16; ++r) { P0[r] = __builtin_amdgcn_exp2f(P0[r] - m); P1[r] = __builtin_amdgcn_exp2f(P1[r] - m); sacc += P0[r] + P1[r]; } \
        l_reg += sacc; \
        const u32x4 q0_ = (u32x4){cvtpk_s(P0[0], P0[1]), cvtpk_s(P0[2], P0[3]), cvtpk_s(P0[4], P0[5]), cvtpk_s(P0[6], P0[7])}; \
        const u32x4 q1_ = (u32x4){cvtpk_s(P0[8], P0[9]), cvtpk_s(P0[10], P0[11]), cvtpk_s(P0[12], P0[13]), cvtpk_s(P0[14], P0[15])}; \
        const u32x4 q2_ = (u32x4){cvtpk_s(P1[0], P1[1]), cvtpk_s(P1[2], P1[3]), cvtpk_s(P1[4], P1[5]), cvtpk_s(P1[6], P1[7])}; \
        const u32x4 q3_ = (u32x4){cvtpk_s(P1[8], P1[9]), cvtpk_s(P1[10], P1[11]), cvtpk_s(P1[12], P1[13]), cvtpk_s(P1[14], P1[15])}; \
        SBAR(); pv(o, vb0 + (SLOT) * SLOTB, __builtin_bit_cast(bf16x8, q0_), __builtin_bit_cast(bf16x8, q1_), __builtin_bit_cast(bf16x8, q2_), __builtin_bit_cast(bf16x8, q3_)); } while (0)
    if (vW) SWA2_TILE(w0, w1, 1 + jb0);
    if (vF) SWA2_TILE(f0, f1, 2 + jb0);
    SWA2_TILE(c0, c1, 3 + jb0);
#undef SWA2_TILE
    { auto rr = __builtin_amdgcn_permlane32_swap(__float_as_uint(l_reg), __float_as_uint(l_reg), false, false); l_reg = __uint_as_float(rr[0]) + __uint_as_float(rr[1]); }
    if (hi == 0) wsf[32 + r32] = l_reg;
    asm volatile("s_waitcnt lgkmcnt(0)" ::: "memory");
    float rli[16];
#pragma unroll
    for (int r = 0; r < 16; ++r) rli[r] = 1.0f / wsf[32 + crow(r, hi)];
    { __hip_bfloat16* stg = (__hip_bfloat16*)(shm + LDS_OST) + wid * 2048;
#pragma unroll
        for (int r = 0; r < 16; ++r) { const int orow = crow(r, hi);
#pragma unroll
            for (int d0 = 0; d0 < 2; ++d0) stg[orow * 64 + d0 * 32 + r32] = __float2bfloat16(o[d0][r] * rli[r]); }
        asm volatile("s_waitcnt lgkmcnt(0)" ::: "memory");
#pragma unroll
        for (int i = 0; i < 4; ++i) { const int row = i * 8 + (lane >> 3), ch = lane & 7; const u32x4 v = *(const u32x4*)(stg + row * 64 + ch * 8); *(u32x4*)(Ow + (size_t)row * DM + ch * 8) = v; } }
    asm volatile("s_waitcnt lgkmcnt(0)\n\ts_barrier" ::: "memory");
#undef DMA_KV
#undef TILE_KR0
}
#undef WAIT_BAR0
#undef SBAR
#undef MX3
}

namespace attn2 {
using bf16=__hip_bfloat16;
__device__ __forceinline__ int crow(int r,int hi){return (r&3)+8*(r>>2)+4*hi;}
#define SBAR() __builtin_amdgcn_sched_barrier(0)
__device__ __forceinline__ void cmask(f32x16&p0,f32x16&p1,int jb,int qrel,int hi){
  const float NEG=-INFINITY; int kb=64*jb+4*hi;
  #pragma unroll
  for(int r=0;r<16;++r){int kv=kb+(r&3)+8*(r>>2); if(kv>qrel)p0[r]=NEG; if(kv+32>qrel)p1[r]=NEG;}
}

constexpr int NSLOT=3, SLOTB=8192;
constexpr int NW=8;
constexpr int LDS_K=0, LDS_V=NSLOT*SLOTB, LDS_WS=2*NSLOT*SLOTB, LDS_OST=LDS_WS+NW*64*4, LDS_CL=LDS_OST+NW*4096, LDS_SCAN=LDS_CL+2064*4+64, LDS_END=LDS_SCAN+192;
__device__ __forceinline__ void glds16(const void*gsrc,unsigned lds_dst){unsigned keep;
  asm volatile("s_mov_b32 %0, m0\n\ts_mov_b32 m0, %2\n\ts_nop 0\n\tglobal_load_lds_dwordx4 %1, off\n\ts_mov_b32 m0, %0":"=&s"(keep):"v"(gsrc),"s"(lds_dst):"memory");}
__device__ __forceinline__ float max3f(float a,float b,float c){float r;asm("v_max3_f32 %0, %1, %2, %3":"=v"(r):"v"(a),"v"(b),"v"(c));return r;}
__device__ __forceinline__ float max2f(float a,float b){float r;asm("v_max_f32_e32 %0, %1, %2":"=v"(r):"v"(a),"v"(b));return r;}
__device__ __forceinline__ float fadd_s(float a,float b){float r;asm("v_add_f32_e32 %0, %1, %2":"=v"(r):"v"(a),"v"(b));return r;}
__device__ __forceinline__ float fsub_s(float a,float b){float r;asm("v_sub_f32_e32 %0, %1, %2":"=v"(r):"v"(a),"v"(b));return r;}
typedef float f32x2_t __attribute__((ext_vector_type(2))); typedef __bf16 bf16x2_t __attribute__((ext_vector_type(2)));
__device__ __forceinline__ unsigned cvtpk_s(float lo,float hi){f32x2_t v={lo,hi};bf16x2_t b=__builtin_convertvector(v,bf16x2_t);return __builtin_bit_cast(unsigned,b);}
#define WAIT_BAR(N) asm volatile("s_waitcnt vmcnt(" #N ") lgkmcnt(0)\n\ts_barrier":::"memory")

__device__ __forceinline__ void qkt(f32x16&p0,f32x16&p1,const char*Kslot,const bf16x8*qr,const f32x16&negm,int r32,int hi){
  const char*kb=Kslot+hi*1024+r32*16;
  #pragma unroll
  for(int d0=0;d0<4;++d0){
    const bf16x8 b0=*reinterpret_cast<const bf16x8*>(kb+d0*2048);
    const bf16x8 b1=*reinterpret_cast<const bf16x8*>(kb+d0*2048+512);
    if(d0==0){p0=__builtin_amdgcn_mfma_f32_32x32x16_bf16(b0,qr[0],negm,0,0,0);p1=__builtin_amdgcn_mfma_f32_32x32x16_bf16(b1,qr[0],negm,0,0,0);}
    else{p0=__builtin_amdgcn_mfma_f32_32x32x16_bf16(b0,qr[d0],p0,0,0,0);p1=__builtin_amdgcn_mfma_f32_32x32x16_bf16(b1,qr[d0],p1,0,0,0);}}
}
typedef __attribute__((address_space(3))) const char* lds_cptr;
typedef short v4i16_t __attribute__((ext_vector_type(4)));
__device__ __forceinline__ void kload8(bf16x8*kf,lds_cptr kp){
  kf[0]=*(const __attribute__((address_space(3))) bf16x8*)(kp);      kf[1]=*(const __attribute__((address_space(3))) bf16x8*)(kp+512);
  kf[2]=*(const __attribute__((address_space(3))) bf16x8*)(kp+2048); kf[3]=*(const __attribute__((address_space(3))) bf16x8*)(kp+2560);
  kf[4]=*(const __attribute__((address_space(3))) bf16x8*)(kp+4096); kf[5]=*(const __attribute__((address_space(3))) bf16x8*)(kp+4608);
  kf[6]=*(const __attribute__((address_space(3))) bf16x8*)(kp+6144); kf[7]=*(const __attribute__((address_space(3))) bf16x8*)(kp+6656);
}
__device__ __forceinline__ void kload2(bf16x8*kf,lds_cptr kp,int j){ kf[2*j]=*(const __attribute__((address_space(3))) bf16x8*)(kp+j*2048); kf[2*j+1]=*(const __attribute__((address_space(3))) bf16x8*)(kp+j*2048+512); }
__device__ __forceinline__ s16x4 vtr(lds_cptr p){ return __builtin_bit_cast(s16x4,__builtin_amdgcn_ds_read_tr16_b64_v4i16((__attribute__((address_space(3))) v4i16_t*)p)); }
__device__ __forceinline__ float rowmax(const f32x16&p0,const f32x16&p1){
  float a=max3f(p0[0],p0[1],p1[0]),b=max3f(p0[2],p0[3],p1[1]);a=max3f(a,p1[2],p1[3]);
  #pragma unroll
  for(int r=4;r<16;r+=4){a=max3f(a,p0[r],p0[r+1]);b=max3f(b,p0[r+2],p0[r+3]);a=max3f(a,p1[r],p1[r+1]);b=max3f(b,p1[r+2],p1[r+3]);}
  const float m=max2f(a,b);
  auto rr=__builtin_amdgcn_permlane32_swap(__float_as_uint(m),__float_as_uint(m),false,false);
  return max2f(__uint_as_float(rr[0]),__uint_as_float(rr[1]));
}
__device__ __forceinline__ void pv(f32x16*o,int vb,bf16x8 pa0,bf16x8 pa1,bf16x8 pa2,bf16x8 pa3){
  #pragma unroll
  for(int d0=0;d0<2;++d0){s16x4 lo[4],hi[4];
    #pragma unroll
    for(int ks=0;ks<4;++ks){
      asm volatile("ds_read_b64_tr_b16 %0,%1 offset:%c2":"=&v"(lo[ks]):"v"(vb),"i"(d0*4096+ks*1024):"memory");
      asm volatile("ds_read_b64_tr_b16 %0,%1 offset:%c2":"=&v"(hi[ks]):"v"(vb),"i"(d0*4096+ks*1024+512):"memory");}
    asm volatile("s_waitcnt lgkmcnt(0)":::"memory");SBAR();
    #define PK(k) (bf16x8){lo[k][0],lo[k][1],lo[k][2],lo[k][3],hi[k][0],hi[k][1],hi[k][2],hi[k][3]}
    o[d0]=__builtin_amdgcn_mfma_f32_32x32x16_bf16(pa0,PK(0),o[d0],0,0,0);
    o[d0]=__builtin_amdgcn_mfma_f32_32x32x16_bf16(pa1,PK(1),o[d0],0,0,0);
    o[d0]=__builtin_amdgcn_mfma_f32_32x32x16_bf16(pa2,PK(2),o[d0],0,0,0);
    o[d0]=__builtin_amdgcn_mfma_f32_32x32x16_bf16(pa3,PK(3),o[d0],0,0,0);
    #undef PK
  }
}


__device__ __forceinline__ void amask(f32x16&p0,f32x16&p1,int kr0,int qp,float slope2,int hi){
  asm volatile("":"+v"(slope2));
  const float base=slope2*(float)(kr0+4*hi); const int d0=qp-kr0-4*hi;
  #pragma unroll
  for(int r=0;r<16;++r){ const int cr=(r&3)+8*(r>>2); const int da=d0-cr, db=da-32;
    const bool ok0=((unsigned)da<128u)&&(qp-da>=KR_REAL), ok1=((unsigned)db<128u)&&(qp-db>=KR_REAL);
    p0[r]=ok0?p0[r]+__builtin_fmaf(slope2,(float)cr,base):-INFINITY; p1[r]=ok1?p1[r]+__builtin_fmaf(slope2,(float)(cr+32),base):-INFINITY; }
}
template<int MODE,int THRL> __device__ __forceinline__ void unit2(const bf16*Qw,bf16*Ow,const bf16*__restrict__ Kh,const bf16*__restrict__ Vh,int kp,int NT,int row0,int kbase,int qpos0,int qrel0,float slope2,float sink2,const float*cl,char*shm){
  const int tid=threadIdx.x; int lane_=tid&63; asm volatile("":"+v"(lane_));
  const int lane=lane_,r32=lane&31,hi=lane>>5; const int wid=__builtin_amdgcn_readfirstlane(tid>>6);
  const unsigned lds0=(unsigned)(uintptr_t)shm;
  float*wsf=(float*)(shm+LDS_WS)+wid*64;
  const bf16*ksrc=Kh+(long)lane*kp+wid*8;
  const bf16*vsrc=Vh+(long)(16*(wid&3)+(lane>>2))*kp+(wid>>2)*32+(lane&3)*8;
  const unsigned kdst=lds0+LDS_K+wid*1024, vdst=lds0+LDS_V+wid*1024;
  #define TROW(t) ((t)==0?row0:kbase+64*((t)-1))
  #define DMA_K(t,slot) glds16(ksrc+(long)TROW(t)*kp,(unsigned)__builtin_amdgcn_readfirstlane(kdst+(slot)))
  #define DMA_V(t,slot) glds16(vsrc+(long)TROW(t)*kp,(unsigned)__builtin_amdgcn_readfirstlane(vdst+(slot)))
  const int vb0=(int)(lds0+LDS_V)+((lane>>4)&1)*32+(lane&3)*8+(4*hi+((lane&15)>>2))*64;
  const char*Kbase=shm+LDS_K; bf16x8 kf[8];
  const lds_cptr shm3=(lds_cptr)shm; const lds_cptr kp0=shm3+LDS_K+hi*1024+r32*16; const lds_cptr vp0=shm3+LDS_V+((lane>>4)&1)*32+(lane&3)*8+(4*hi+((lane&15)>>2))*64;
  DMA_K(0,0);DMA_V(0,0);DMA_K(1,SLOTB);
  bf16x8 qr[4];
  #pragma unroll
  for(int d0=0;d0<4;++d0)qr[d0]=*reinterpret_cast<const bf16x8*>(&Qw[(long)r32*DM+d0*16+hi*8]);
  const int qrel=qrel0+r32, qp=qpos0+r32;
  const float rowterm=(MODE==0)?cl[qp-KR_META]:-slope2*(float)qp;
  float mhat=(MODE==0)?0.f:sink2,l_reg=(MODE==1&&hi==0)?1.f:0.f;f32x16 o[2];o[0]=f32x16{};o[1]=f32x16{};f32x16 negm;
  { const float nm_=rowterm-mhat; _Pragma("unroll") for(int r=0;r<16;++r)negm[r]=nm_; } asm volatile("":"+v"(negm));
  #define POST(C0,C1,t,MK) do{ if(MODE==0){ const float*clt_=cl+(TROW(t)-KR_META)+4*hi; \
      _Pragma("unroll") for(int g_=0;g_<4;++g_){ const f32x4 a_=*(const f32x4*)(clt_+8*g_), b_=*(const f32x4*)(clt_+32+8*g_); \
        _Pragma("unroll") for(int e_=0;e_<4;++e_){ C0[4*g_+e_]-=a_[e_]; C1[4*g_+e_]-=b_[e_]; } SBAR(); } \
      if(MK) cmask(C0,C1,(t)-(NT-4),qrel,hi); } \
    else { amask(C0,C1,TROW(t),qp,slope2,hi); } }while(0)
  #define POST0(P0,P1) do{ _Pragma("unroll") for(int r=0;r<16;++r)P0[r]=-INFINITY; _Pragma("unroll") for(int r=0;r<8;++r)P1[r]=-INFINITY; \
    if(MODE==0){ const f32x4 a_=*(const f32x4*)(cl+4*hi), b_=*(const f32x4*)(cl+8+4*hi); _Pragma("unroll") for(int e_=0;e_<4;++e_){ P1[8+e_]-=a_[e_]; P1[12+e_]-=b_[e_]; } } \
    else { _Pragma("unroll") for(int r=8;r<16;++r)P1[r]+=slope2*(float)(96+crow(r,hi)); } }while(0)
  bool resc=false;
  #define START(P0,P1) do{ const float rm=rowmax(P0,P1); resc=false; \
    { const float dl=(MODE==0)?rm:__builtin_fmaxf(rm,0.f); mhat=fadd_s(mhat,dl); \
      _Pragma("unroll") for(int r=0;r<16;++r){P0[r]=fsub_s(P0[r],dl);P1[r]=fsub_s(P1[r],dl);} \
      { const float nm_=rowterm-mhat; _Pragma("unroll") for(int r=0;r<16;++r)negm[r]=nm_; } asm volatile("":"+v"(negm)); \
      if(MODE==1) l_reg*=__builtin_amdgcn_exp2f(-dl); } \
    _Pragma("unroll") for(int r=0;r<16;++r)P0[r]=__builtin_amdgcn_exp2f(P0[r]); }while(0)
  #define RESC() do{ if(resc){ asm volatile("s_waitcnt lgkmcnt(0)":::"memory"); \
      _Pragma("unroll") for(int d_=0;d_<2;++d_) _Pragma("unroll") for(int r=0;r<16;++r)o[d_][r]*=wsf[crow(r,hi)]; } }while(0)
  f32x16 pA0,pA1,pB0,pB1;
  int sl_prev=0,sl_cur=0,sl_next=SLOTB;
  #define ROT() do{sl_prev=sl_cur;sl_cur=sl_next;sl_next=(sl_next==(NSLOT-1)*SLOTB)?0:sl_next+SLOTB;}while(0)
  DMA_K(2,2*SLOTB);
  WAIT_BAR(3);
  qkt(pA0,pA1,Kbase,qr,negm,r32,hi);asm volatile("s_nop 15\n\ts_nop 7":"+v"(pA0),"+v"(pA1));if(row0==64){POST0(pA0,pA1);}else{POST(pA0,pA1,0,false);}
  START(pA0,pA1);
  _Pragma("unroll") for(int r=0;r<16;++r)pA1[r]=__builtin_amdgcn_exp2f(pA1[r]);
  WAIT_BAR(0);
  DMA_K(3,0);DMA_V(1,SLOTB);
  ROT();
  kload8(kf,kp0+sl_cur);
  WAIT_BAR(2);
  s16x4 vlo[8],vhi[8]; u32x4 pw0,pw1,pw2,pw3;
  #define PKW(P,B) cvtpk_s(P[B],P[B+1])
  #define PAF(k) __builtin_bit_cast(bf16x8,pw##k)
  #define VFR(i) (bf16x8){vlo[i][0],vlo[i][1],vlo[i][2],vlo[i][3],vhi[i][0],vhi[i][1],vhi[i][2],vhi[i][3]}
  #define PIN(x) asm volatile("":"+v"(x))
  #define MX3(a,b,c) __builtin_fmaxf(__builtin_fmaxf((a),(b)),(c))
  #define GAPA(MF,A0,A1,A2,A3,W0,W1,PW) do{ MF; sacc+=A0; sacc+=A1; sacc+=A2; sacc+=A3; PIN(sacc); W0; W1; PIN(PW); SBAR(); }while(0)
  #define EX(v) __builtin_amdgcn_exp2f(v)
  #define GAPB(MF,X,B) do{ MF; X[B]=EX(X[B]); X[B+1]=EX(X[B+1]); X[B+2]=EX(X[B+2]); X[B+3]=EX(X[B+3]); PIN(X); SBAR(); }while(0)
  #define VRD(i) do{ vlo[i]=vtr(vp_+(((i)>>2)*4096+((i)&3)*1024)); vhi[i]=vtr(vp_+(((i)>>2)*4096+((i)&3)*1024+512)); }while(0)
  #define KRD(G,j) do{ if(G){ kload2(kf,kp0+sl_next,j); SBAR(); } }while(0)
  #define STEP(C0,C1,P0,P1,t,GK,GV,GL,MK) do{ SBAR(); \
    const lds_cptr vp_=vp0+sl_prev; \
    VRD(0); SBAR(); float sacc=(P0[0]+P0[1]); \
    GAPA(C0=__builtin_amdgcn_mfma_f32_32x32x16_bf16(kf[0],qr[0],negm,0,0,0), P0[2],P0[3],P0[4],P0[5],     pw0[0]=PKW(P0,0), pw0[1]=PKW(P0,2), pw0); \
    VRD(4); SBAR(); GAPA(C1=__builtin_amdgcn_mfma_f32_32x32x16_bf16(kf[1],qr[0],negm,0,0,0), P0[6],P0[7],P0[8],P0[9],     pw0[2]=PKW(P0,4), pw0[3]=PKW(P0,6), pw0); \
    VRD(1); SBAR(); GAPA(C0=__builtin_amdgcn_mfma_f32_32x32x16_bf16(kf[2],qr[1],C0,0,0,0),   P0[10],P0[11],P0[12],P0[13], pw1[0]=PKW(P0,8), pw1[1]=PKW(P0,10), pw1); \
    VRD(5); SBAR(); GAPA(C1=__builtin_amdgcn_mfma_f32_32x32x16_bf16(kf[3],qr[1],C1,0,0,0),   P0[14],P0[15],P1[0],P1[1],   pw1[2]=PKW(P0,12),pw1[3]=PKW(P0,14), pw1); \
    VRD(2); SBAR(); GAPA(C0=__builtin_amdgcn_mfma_f32_32x32x16_bf16(kf[4],qr[2],C0,0,0,0),   P1[2],P1[3],P1[4],P1[5],     pw2[0]=PKW(P1,0), pw2[1]=PKW(P1,2), pw2); \
    VRD(6); SBAR(); GAPA(C1=__builtin_amdgcn_mfma_f32_32x32x16_bf16(kf[5],qr[2],C1,0,0,0),   P1[6],P1[7],P1[8],P1[9],     pw2[2]=PKW(P1,4), pw2[3]=PKW(P1,6), pw2); \
    VRD(3); SBAR(); GAPA(C0=__builtin_amdgcn_mfma_f32_32x32x16_bf16(kf[6],qr[3],C0,0,0,0),   P1[10],P1[11],P1[12],P1[13], pw3[0]=PKW(P1,8), pw3[1]=PKW(P1,10), pw3); \
    VRD(7); SBAR(); GAPA(C1=__builtin_amdgcn_mfma_f32_32x32x16_bf16(kf[7],qr[3],C1,0,0,0),   P1[14],P1[15],0.f,0.f,       pw3[2]=PKW(P1,12),pw3[3]=PKW(P1,14), pw3); \
    l_reg+=sacc; \
    if(GK){DMA_K((t)+3,sl_cur);} if(GV){DMA_V((t)+1,sl_next);} \
    POST(C0,C1,t,MK); \
    { float a=MX3(C0[0],C0[1],C1[0]),b=MX3(C0[2],C0[3],C1[1]); a=MX3(a,C1[2],C1[3]); \
      _Pragma("unroll") for(int r=4;r<16;r+=4){a=MX3(a,C0[r],C0[r+1]);b=MX3(b,C0[r+2],C0[r+3]);a=MX3(a,C1[r],C1[r+1]);b=MX3(b,C1[r+2],C1[r+3]);} \
      float rm=__builtin_fmaxf(a,b); { auto rr=__builtin_amdgcn_permlane32_swap(__float_as_uint(rm),__float_as_uint(rm),false,false); rm=__builtin_fmaxf(__uint_as_float(rr[0]),__uint_as_float(rr[1])); } \
      resc=false; \
      if(__builtin_expect(__any(rm>(float)THRL),0)){ const float dl=__builtin_fmaxf(rm,0.f); mhat+=dl; \
        _Pragma("unroll") for(int r=0;r<16;++r){C0[r]-=dl;C1[r]-=dl;} \
        { const float nm_=rowterm-mhat; _Pragma("unroll") for(int r=0;r<16;++r)negm[r]=nm_; } asm volatile("":"+v"(negm)); \
        const float f=__builtin_amdgcn_exp2f(-dl); l_reg*=f; if(hi==0)wsf[r32]=f; resc=true; } } \
    SBAR(); \
    GAPB(o[0]=__builtin_amdgcn_mfma_f32_32x32x16_bf16(PAF(0),VFR(0),o[0],0,0,0), C0,0); \
    GAPB(o[1]=__builtin_amdgcn_mfma_f32_32x32x16_bf16(PAF(0),VFR(4),o[1],0,0,0), C0,4); \
    KRD(GL,0); GAPB(o[0]=__builtin_amdgcn_mfma_f32_32x32x16_bf16(PAF(1),VFR(1),o[0],0,0,0), C0,8); \
    KRD(GL,1); GAPB(o[1]=__builtin_amdgcn_mfma_f32_32x32x16_bf16(PAF(1),VFR(5),o[1],0,0,0), C0,12); \
    KRD(GL,2); GAPB(o[0]=__builtin_amdgcn_mfma_f32_32x32x16_bf16(PAF(2),VFR(2),o[0],0,0,0), C1,0); \
    KRD(GL,3); GAPB(o[1]=__builtin_amdgcn_mfma_f32_32x32x16_bf16(PAF(2),VFR(6),o[1],0,0,0), C1,4); \
    GAPB(o[0]=__builtin_amdgcn_mfma_f32_32x32x16_bf16(PAF(3),VFR(3),o[0],0,0,0), C1,8); \
    GAPB(o[1]=__builtin_amdgcn_mfma_f32_32x32x16_bf16(PAF(3),VFR(7),o[1],0,0,0), C1,12); \
    }while(0)
  int t=1;
  for(;t<NT-4;t+=2){
    STEP(pB0,pB1,pA0,pA1,t,true,true,true,false);     WAIT_BAR(2); RESC(); ROT();
    STEP(pA0,pA1,pB0,pB1,t+1,true,true,true,false);   WAIT_BAR(2); RESC(); ROT();
  }
  STEP(pB0,pB1,pA0,pA1,NT-4,true,true,true,true);     WAIT_BAR(2); RESC(); ROT();
  STEP(pA0,pA1,pB0,pB1,NT-3,false,true,true,true);    WAIT_BAR(1); RESC(); ROT();
  STEP(pB0,pB1,pA0,pA1,NT-2,false,true,true,true);    WAIT_BAR(0); RESC(); ROT();
  STEP(pA0,pA1,pB0,pB1,NT-1,false,false,false,true);  RESC();
  { float sacc=pA0[0]+pA0[1]; _Pragma("unroll") for(int r=2;r<16;++r)sacc+=pA0[r]; _Pragma("unroll") for(int r=0;r<16;++r)sacc+=pA1[r]; l_reg+=sacc;
    pw0=(u32x4){PKW(pA0,0),PKW(pA0,2),PKW(pA0,4),PKW(pA0,6)};pw1=(u32x4){PKW(pA0,8),PKW(pA0,10),PKW(pA0,12),PKW(pA0,14)};pw2=(u32x4){PKW(pA1,0),PKW(pA1,2),PKW(pA1,4),PKW(pA1,6)};pw3=(u32x4){PKW(pA1,8),PKW(pA1,10),PKW(pA1,12),PKW(pA1,14)};
    SBAR(); pv(o,vb0+sl_cur,PAF(0),PAF(1),PAF(2),PAF(3)); }
  #undef PKW
  #undef PAF
  #undef VFR
  #undef PIN
  #undef MX3
  #undef GAPA
  #undef GAPB
  #undef EX
  #undef VRD
  #undef KRD
  #undef STEP
  {auto rr=__builtin_amdgcn_permlane32_swap(__float_as_uint(l_reg),__float_as_uint(l_reg),false,false);l_reg=__uint_as_float(rr[0])+__uint_as_float(rr[1]);}
  if(hi==0)wsf[32+r32]=l_reg;asm volatile("s_waitcnt lgkmcnt(0)":::"memory");
  float rli[16];
  #pragma unroll
  for(int r=0;r<16;++r)rli[r]=__builtin_amdgcn_rcpf(wsf[32+crow(r,hi)]);
  { bf16*stg=(bf16*)(shm+LDS_OST)+wid*2048;
    #pragma unroll
    for(int r=0;r<16;++r){const int orow=crow(r,hi);
      #pragma unroll
      for(int d0=0;d0<2;++d0)stg[orow*64+d0*32+r32]=__float2bfloat16(o[d0][r]*rli[r]);}
    asm volatile("s_waitcnt lgkmcnt(0)":::"memory");
    #pragma unroll
    for(int i=0;i<4;++i){const int row=i*8+(lane>>3),ch=lane&7; const u32x4 v=*(const u32x4*)(stg+row*64+ch*8); *(u32x4*)(Ow+(long)row*DM+ch*8)=v;} }
  asm volatile("s_waitcnt lgkmcnt(0)\n\ts_barrier":::"memory");
  #undef DMA_K
  #undef DMA_V
  #undef POST
  #undef POST0
  #undef TROW
  #undef START
  #undef RESC
  #undef ROT
}

#undef SBAR
#undef WAIT_BAR
}

constexpr int NWAVES = 8;
#ifndef MK_N_LAUNCHES
#define MK_N_LAUNCHES 1
#endif
constexpr int N_PHASES = 9;
constexpr int N_LAUNCHES = MK_N_LAUNCHES;

constexpr size_t MiB = 1u << 20;
constexpr size_t WS_CTL = 0, CTL_ZERO_BYTES = 64 * 1024;
constexpr size_t WS_SSQ = 2 * MiB;
constexpr size_t WS_META = 10 * MiB;
constexpr size_t WS_LOGF = 11 * MiB;
constexpr size_t WS_QN2 = 4 * MiB, WS_KN2 = 6 * MiB;
static_assert(WS_QN2 + (size_t)MROWS * 64 <= WS_KN2 && WS_KN2 + (size_t)NKR * 64 <= WS_META, "norm partials map");
constexpr size_t WS_W1 = 16 * MiB, WS_W2 = 27 * MiB, WS_WP = 33 * MiB, WS_WAB = 42 * MiB, WS_WO = 44 * MiB, WS_W3 = 46 * MiB, WS_W4 = 57 * MiB;
constexpr size_t WS_XB = 64 * MiB;
constexpr size_t WS_R = 128 * MiB;
constexpr size_t WS_ACT = WS_R;
constexpr size_t WS_QO = WS_R, WS_KA = WS_R + 64 * MiB, WS_VA = WS_KA + 9 * MiB, WS_KB = WS_VA + 9 * MiB, WS_VB = WS_KB + 34 * MiB,
                 WS_SGA = WS_VB + 34 * MiB, WS_SGB = WS_SGA + 64 * MiB, WS_MIX = WS_SGB + 64 * MiB, WS_END = WS_MIX + 64 * MiB;
static_assert(WS_W1 + (size_t)2 * DFF * DM * 2 <= WS_W2 && WS_W2 + (size_t)DM * DFF * 2 <= WS_WP && WS_WP + (size_t)NPROJ * DM * 2 <= WS_WAB && WS_W3 + (size_t)2 * DFF * DM * 2 <= WS_W4 && WS_W4 + (size_t)DM * DFF * 2 <= WS_XB, "weights map");
static_assert((size_t)NKR * 128 * 2 <= 9 * MiB && (size_t)NKR * 512 * 2 <= 34 * MiB && (size_t)NKR * 8 * 4 <= 2 * MiB && WS_END <= 512 * MiB && WS_ACT + (size_t)MROWS * DFF * 2 <= WS_END, "activation map");
constexpr size_t MT_XB = 0, MT_SSQ0 = 32768, MT_ACT = 65536, MT_H1B = 163840, MT_SSQ1 = 196608, MT_KNM = 204800;
constexpr int CW_BAR = 4096;
constexpr int CW_PANEL = 8192;
static_assert((CW_PANEL + 64 * 128) * 4 <= (int)CTL_ZERO_BYTES, "control words inside the per-call memset");

constexpr int RING_OFF = 0, RING_BYTES = 131072;
constexpr int LDSCTL_OFF = RING_BYTES, MISC_OFF = LDSCTL_OFF + 320;
constexpr int LDS_BYTES = 147456;
static_assert(MISC_OFF + 128 <= LDS_BYTES && attn::LDS_END <= RING_BYTES && attn2::LDS_END <= RING_BYTES, "LDS map");

typedef GAS unsigned gu32;
#define RLX_AGENT __ATOMIC_RELAXED, __HIP_MEMORY_SCOPE_AGENT
#define LDS_WAIT() asm volatile("s_waitcnt lgkmcnt(0)" ::: "memory")
#define VM_WAIT() asm volatile("s_waitcnt vmcnt(0)" ::: "memory")
#define XB_TMO      128
#define XB_XCNT(j)  (256  + 64 * (j))
#define XB_XSUB(j)  (1280 + 64 * (j))
#define XB_XGEN(j)  (2304 + 64 * (j))
#define XB_TOP      3328
#define XB_TOPGEN   3392
#define XB_LSUB(j)  (3456 + 16 * (j))
#define XB_LGEN(j)  (3712 + 16 * (j))
#define XCD_BAR_WORDS 3968
#define XB_SPIN_CAP (1u << 18)

__device__ __forceinline__ unsigned xb_ld(unsigned* p)              { return __hip_atomic_load(p, __ATOMIC_RELAXED, __HIP_MEMORY_SCOPE_AGENT); }
__device__ __forceinline__ unsigned xb_add(unsigned* p, unsigned v) { return __hip_atomic_fetch_add(p, v, __ATOMIC_RELAXED, __HIP_MEMORY_SCOPE_AGENT); }
__device__ __forceinline__ unsigned xb_xcc_id() { return (unsigned)__builtin_amdgcn_s_getreg((3 << 11) | 20) & 0xFu; }
#define XB_SPIN(cond, bar) do { unsigned _sp = 0; while (cond) { __builtin_amdgcn_s_sleep(1); \
    if ((++_sp & 255u) == 0u) { if (xb_ld(&(bar)[XB_TMO])) break; if (_sp > XB_SPIN_CAP) { atomicAdd(&(bar)[XB_TMO], 1u); break; } } } } while (0)

struct XcdBarrier {
    unsigned* bar; unsigned x;
    volatile LAS unsigned* st;
};

__device__ __forceinline__ XcdBarrier xcd_barrier_post(unsigned* bar, volatile LAS unsigned* st) {
    XcdBarrier b; b.bar = bar; b.x = xb_xcc_id(); b.st = st;
    if (threadIdx.x == 0) (void)xb_add(&bar[XB_XCNT(b.x)], 1u + ((b.x == (blockIdx.x & 7u)) ? 0x10000u : 0u));
    return b;
}
__device__ __forceinline__ void xcd_barrier_complete(unsigned* bar, unsigned x, unsigned& nloc, unsigned& nx, unsigned& rr) {
    const unsigned G = gridDim.x * gridDim.y * gridDim.z;
    unsigned sum, cnt, mine, mt, sp = 0u;
    for (;;) {
        sum = 0u; cnt = 0u; mine = 0u; mt = 0u;
#pragma unroll
        for (unsigned j = 0; j < 16; ++j) { const unsigned cw = xb_ld(&bar[XB_XCNT(j)]); const unsigned c = cw & 0xFFFFu; mt += cw >> 16; sum += c; cnt += (c > 0u) ? 1u : 0u; mine = (j == x) ? c : mine; }
        if (sum == G) break;
        __builtin_amdgcn_s_sleep(1);
        if ((++sp & 255u) == 0u) { if (xb_ld(&bar[XB_TMO])) break; if (sp > XB_SPIN_CAP) { atomicAdd(&bar[XB_TMO], 1u); break; } }
    }
    nloc = mine > 0u ? mine : 1u; nx = cnt > 0u ? cnt : 1u;
    rr = (sum == G && mt == G && G == 256u && cnt == 8u) ? 1u : 0u;
}

__device__ __forceinline__ void xcd_barrier(const XcdBarrier& b) {
    asm volatile("s_waitcnt vmcnt(0)" ::: "memory");
    __syncthreads();
    if (threadIdx.x == 0) {
        unsigned* bar = b.bar;
        __builtin_amdgcn_s_waitcnt(0);
        unsigned nloc = b.st[0], nx = b.st[1];
        if (nloc == 0u) { unsigned rr; xcd_barrier_complete(bar, b.x, nloc, nx, rr); b.st[0] = nloc; b.st[1] = nx; b.st[2] = rr; }
        const unsigned old = xb_add(&bar[XB_XSUB(b.x)], 1u);
        const unsigned gen = old / nloc;
        if (old + 1u == (gen + 1u) * nloc) {
            __builtin_amdgcn_fence(__ATOMIC_RELEASE, "agent");
            asm volatile("s_waitcnt vmcnt(0)" ::: "memory");
            const unsigned og = xb_add(&bar[XB_TOP], 1u);
            const unsigned tg = og / nx;
            if (og + 1u == (tg + 1u) * nx) xb_add(&bar[XB_TOPGEN], 1u);
            else XB_SPIN(xb_ld(&bar[XB_TOPGEN]) == tg, bar);
            __builtin_amdgcn_fence(__ATOMIC_ACQUIRE, "agent");
            xb_add(&bar[XB_XGEN(b.x)], 1u);
            asm volatile("s_waitcnt vmcnt(0)" ::: "memory");
        } else {
            asm volatile("buffer_inv sc1" ::: "memory");
            XB_SPIN(xb_ld(&bar[XB_XGEN(b.x)]) == gen, bar);
            asm volatile("s_waitcnt vmcnt(0)" ::: "memory");
        }
    }
    __syncthreads();
}

__device__ __forceinline__ void xcd_barrier_local(const XcdBarrier& b) {
    if (b.st[2] == 0u) { xcd_barrier(b); return; }
    asm volatile("s_waitcnt vmcnt(0)" ::: "memory");
    __syncthreads();
    if (threadIdx.x == 0) {
        unsigned* bar = b.bar;
        __builtin_amdgcn_s_waitcnt(0);
        const unsigned nloc = b.st[0];
        const unsigned old = xb_add(&bar[XB_LSUB(b.x)], 1u);
        const unsigned gen = old / nloc;
        if (old + 1u == (gen + 1u) * nloc) xb_add(&bar[XB_LGEN(b.x)], 1u);
        else XB_SPIN(xb_ld(&bar[XB_LGEN(b.x)]) == gen, bar);
    }
    __syncthreads();
}
#if defined(EXP_SEAM)
__device__ __forceinline__ void xcd_barrier_nf(const XcdBarrier& b) {
    asm volatile("s_waitcnt vmcnt(0)" ::: "memory");
    __syncthreads();
    if (threadIdx.x == 0) {
        unsigned* bar = b.bar;
        __builtin_amdgcn_s_waitcnt(0);
        unsigned nloc = b.st[0], nx = b.st[1];
        if (nloc == 0u) { unsigned rr; xcd_barrier_complete(bar, b.x, nloc, nx, rr); b.st[0] = nloc; b.st[1] = nx; b.st[2] = rr; }
        const unsigned old = xb_add(&bar[XB_XSUB(b.x)], 1u);
        const unsigned gen = old / nloc;
        if (old + 1u == (gen + 1u) * nloc) {
            asm volatile("s_waitcnt vmcnt(0)" ::: "memory");
            const unsigned og = xb_add(&bar[XB_TOP], 1u);
            const unsigned tg = og / nx;
            if (og + 1u == (tg + 1u) * nx) xb_add(&bar[XB_TOPGEN], 1u);
            else XB_SPIN(xb_ld(&bar[XB_TOPGEN]) == tg, bar);
            xb_add(&bar[XB_XGEN(b.x)], 1u);
            asm volatile("s_waitcnt vmcnt(0)" ::: "memory");
        } else {
            XB_SPIN(xb_ld(&bar[XB_XGEN(b.x)]) == gen, bar);
            asm volatile("s_waitcnt vmcnt(0)" ::: "memory");
        }
    }
    __syncthreads();
}
__device__ __forceinline__ void xcd_barrier_norel(const XcdBarrier& b) {
    asm volatile("s_waitcnt vmcnt(0)" ::: "memory");
    __syncthreads();
    if (threadIdx.x == 0) {
        unsigned* bar = b.bar;
        __builtin_amdgcn_s_waitcnt(0);
        unsigned nloc = b.st[0], nx = b.st[1];
        if (nloc == 0u) { unsigned rr; xcd_barrier_complete(bar, b.x, nloc, nx, rr); b.st[0] = nloc; b.st[1] = nx; b.st[2] = rr; }
        const unsigned old = xb_add(&bar[XB_XSUB(b.x)], 1u);
        const unsigned gen = old / nloc;
        if (old + 1u == (gen + 1u) * nloc) {
            asm volatile("s_waitcnt vmcnt(0)" ::: "memory");
            const unsigned og = xb_add(&bar[XB_TOP], 1u);
            const unsigned tg = og / nx;
            if (og + 1u == (tg + 1u) * nx) xb_add(&bar[XB_TOPGEN], 1u);
            else XB_SPIN(xb_ld(&bar[XB_TOPGEN]) == tg, bar);
            __builtin_amdgcn_fence(__ATOMIC_ACQUIRE, "agent");
            xb_add(&bar[XB_XGEN(b.x)], 1u);
            asm volatile("s_waitcnt vmcnt(0)" ::: "memory");
        } else {
            asm volatile("buffer_inv sc1" ::: "memory");
            XB_SPIN(xb_ld(&bar[XB_XGEN(b.x)]) == gen, bar);
            asm volatile("s_waitcnt vmcnt(0)" ::: "memory");
        }
    }
    __syncthreads();
}

__device__ __forceinline__ void xcd_barrier_noacq(const XcdBarrier& b) {
    asm volatile("s_waitcnt vmcnt(0)" ::: "memory");
    __syncthreads();
    if (threadIdx.x == 0) {
        unsigned* bar = b.bar;
        __builtin_amdgcn_s_waitcnt(0);
        unsigned nloc = b.st[0], nx = b.st[1];
        if (nloc == 0u) { unsigned rr; xcd_barrier_complete(bar, b.x, nloc, nx, rr); b.st[0] = nloc; b.st[1] = nx; b.st[2] = rr; }
        const unsigned old = xb_add(&bar[XB_XSUB(b.x)], 1u);
        const unsigned gen = old / nloc;
        if (old + 1u == (gen + 1u) * nloc) {
            __builtin_amdgcn_fence(__ATOMIC_RELEASE, "agent");
            asm volatile("s_waitcnt vmcnt(0)" ::: "memory");
            const unsigned og = xb_add(&bar[XB_TOP], 1u);
            const unsigned tg = og / nx;
            if (og + 1u == (tg + 1u) * nx) xb_add(&bar[XB_TOPGEN], 1u);
            else XB_SPIN(xb_ld(&bar[XB_TOPGEN]) == tg, bar);
            xb_add(&bar[XB_XGEN(b.x)], 1u);
            asm volatile("s_waitcnt vmcnt(0)" ::: "memory");
        } else {
            XB_SPIN(xb_ld(&bar[XB_XGEN(b.x)]) == gen, bar);
            asm volatile("s_waitcnt vmcnt(0)" ::: "memory");
        }
    }
    __syncthreads();
}

#endif

struct Frame {
    LAS unsigned char* lds;
    volatile LAS unsigned* MISC;
    gu32* ctl;
    int tid, lane, wave;
    int vcu, G;
    unsigned char* ws;
    const float* in[16]; float* out;
};
__device__ __forceinline__ float wave_sum(float v) {
#pragma unroll
    for (int o = 1; o < 64; o <<= 1) v += __shfl_xor(v, o);
    return v;
}
__device__ __forceinline__ void tr_item(const float* W, int ldw, int k0, int c0, int ncols, const float* gain, bf16_t* WT, int ldt, int drow0, int dk0, LAS float* scr, int lane) {
    float v[32]; const int col = lane & 31, kh = lane >> 5;
    const float* wp = W + (size_t)(k0 + kh) * ldw + c0 + (col < ncols ? col : 0);
#pragma unroll
    for (int i = 0; i < 32; ++i) v[i] = wp[(size_t)(2 * i) * ldw];
    if (gain) {
#pragma unroll
        for (int i = 0; i < 32; ++i) v[i] *= gain[k0 + 2 * i + kh];
    }
#pragma unroll
    for (int i = 0; i < 32; ++i) scr[(2 * i + kh) * 33 + col] = v[i];
    LDS_WAIT(); asm volatile("" ::: "memory");
    const int c = lane & 7;
#pragma unroll
    for (int j = 0; j < 4; ++j) { const int n = (lane >> 3) + 8 * j; const LAS float* s = scr + (8 * c) * 33 + n;
        u32x4 o; o.x = cvt_pk_bf16(s[0 * 33], s[1 * 33]); o.y = cvt_pk_bf16(s[2 * 33], s[3 * 33]); o.z = cvt_pk_bf16(s[4 * 33], s[5 * 33]); o.w = cvt_pk_bf16(s[6 * 33], s[7 * 33]);
        if (n < ncols) *(GAS u32x4*)(WT + (size_t)(drow0 + n) * ldt + dk0 + k0 + 8 * c) = o; }
    LDS_WAIT(); asm volatile("" ::: "memory");
}
__device__ __forceinline__ int swiglu_row(int c0) { const int up = c0 >= DFF, c = up ? c0 - DFF : c0; return 256 * (c / 128) + (up ? 128 : 0) + (c % 128); }
__device__ __forceinline__ void row_to_bf16(const float* xrow, bf16_t* orow, float* ssq16, int lane) {
    const GAS f32x4* xr = (const GAS f32x4*)xrow + lane;
    f32x4 v[4]; float s = 0.f;
#pragma unroll
    for (int j = 0; j < 4; ++j) { v[j] = xr[64 * j]; s += (v[j].x * v[j].x + v[j].y * v[j].y) + (v[j].z * v[j].z + v[j].w * v[j].w); }
    s = wave_sum(s);
    GAS u32x2* o8 = (GAS u32x2*)orow + lane;
#pragma unroll
    for (int j = 0; j < 4; ++j) { u32x2 w; w.x = cvt_pk_bf16(v[j].x, v[j].y); w.y = cvt_pk_bf16(v[j].z, v[j].w); o8[64 * j] = w; }
    if (ssq16 && lane < 16) ssq16[lane] = lane == 0 ? s : 0.f;
}
__device__ __forceinline__ void zero_bytes(Frame& F, void* p, size_t nbytes) {
    const size_t n16 = nbytes / 16; GAS u32x4* q = (GAS u32x4*)p;
    for (size_t i = (size_t)F.vcu * 512 + F.tid; i < n16; i += (size_t)F.G * 512) q[i] = (u32x4){0u, 0u, 0u, 0u};
}
__device__ __forceinline__ void p0_prologue(Frame& F, int part = 0) {
    LAS float* scr = (LAS float*)(F.lds + RING_OFF + F.wave * 16384);
    const int gw = F.vcu * NWAVES + F.wave, NGW = F.G * NWAVES;
    unsigned char* ws = F.ws;
    bf16_t *W1t = (bf16_t*)(ws + WS_W1), *W2t = (bf16_t*)(ws + WS_W2), *Wpt = (bf16_t*)(ws + WS_WP), *Wabt = (bf16_t*)(ws + WS_WAB), *Wot = (bf16_t*)(ws + WS_WO), *W3t = (bf16_t*)(ws + WS_W3), *W4t = (bf16_t*)(ws + WS_W4);
    constexpr int I0 = 16 * 176, I1 = 44 * 32, I2 = 16 * 72, I3 = 16 * 64, I4 = 16, I5 = 8 * 32, I6 = 8 * 32, I7 = 16 * 32, I8 = I0, I9 = I1;
    constexpr int NITEMS = I0 + I1 + I2 + I3 + I4 + I5 + I6 + I7 + I8 + I9;
    if (part != 2) for (int it = gw; it < NITEMS; it += NGW) {
        int r = it;
        if (r < I0) { const int kb = r / 176, nb = r % 176; tr_item(F.in[3], 2 * DFF, 64 * kb, 32 * nb, 32, F.in[2], W1t, DM, swiglu_row(32 * nb), 0, scr, F.lane); continue; } r -= I0;
        if (r < I1) { const int kb = r / 32, nb = r % 32; tr_item(F.in[4], DM, 64 * kb, 32 * nb, 32, nullptr, W2t, DFF, 32 * nb, 0, scr, F.lane); continue; } r -= I1;
        if (r < I2) { const int kb = r / 72, nb = r % 72; tr_item(F.in[6], 4360, 64 * kb, 32 * nb, 32, F.in[5], Wpt, DM, 32 * nb, 0, scr, F.lane); continue; } r -= I2;
        if (r < I3) { const int kb = r / 64, nb = r % 64, gb = nb >= 32, cb = gb ? nb - 32 : nb;
            tr_item(F.in[6], 4360, 64 * kb, 2312 + 32 * nb, 32, F.in[5], Wpt, DM, 2304 + 256 * (cb / 4) + (gb ? 128 : 0) + 32 * (cb % 4), 0, scr, F.lane); continue; } r -= I3;
        if (r < I4) { tr_item(F.in[6], 4360, 64 * r, 2304, 8, F.in[5], Wpt, DM, 4352, 0, scr, F.lane); continue; } r -= I4;
        if (r < I5) { const int kb = r / 32, nb = r % 32; tr_item(F.in[9], DM, 64 * kb, 32 * nb, 32, nullptr, Wabt, DM, 32 * nb, 0, scr, F.lane); continue; } r -= I5;
        if (r < I6) { const int kb = r / 32, nb = r % 32; tr_item(F.in[10], DM, 64 * kb, 32 * nb, 32, nullptr, Wabt, DM, 32 * nb, 512, scr, F.lane); continue; } r -= I6;
        if (r < I7) { const int kb = r / 32, nb = r % 32; tr_item(F.in[11], DM, 64 * kb, 32 * nb, 32, nullptr, Wot, DM, 32 * nb, 0, scr, F.lane); continue; } r -= I7;
        if (r < I8) { const int kb = r / 176, nb = r % 176; tr_item(F.in[13], 2 * DFF, 64 * kb, 32 * nb, 32, F.in[12], W3t, DM, swiglu_row(32 * nb), 0, scr, F.lane); continue; } r -= I8;
        { const int kb = r / 32, nb = r % 32; tr_item(F.in[14], DM, 64 * kb, 32 * nb, 32, nullptr, W4t, DFF, 32 * nb, 0, scr, F.lane); }
    }
    bf16_t* XB = (bf16_t*)(ws + WS_XB); float* SSQ = (float*)(ws + WS_SSQ);
    if (part != 1) for (int m0 = gw * 4; m0 < MROWS; m0 += NGW * 4) {
        f32x4 v[4][4]; float sq[4];
#pragma unroll
        for (int r = 0; r < 4; ++r)
#pragma unroll
            for (int j = 0; j < 4; ++j) v[r][j] = ((const GAS f32x4*)(F.in[0] + (size_t)(m0 + r) * DM))[64 * j + F.lane];
#pragma unroll
        for (int r = 0; r < 4; ++r) { float s_ = 0.f;
#pragma unroll
            for (int j = 0; j < 4; ++j) s_ += (v[r][j].x * v[r][j].x + v[r][j].y * v[r][j].y) + (v[r][j].z * v[r][j].z + v[r][j].w * v[r][j].w);
            sq[r] = wave_sum(s_); }
#pragma unroll
        for (int r = 0; r < 4; ++r) { GAS u32x2* o8 = (GAS u32x2*)(XB + (size_t)(m0 + r) * DM) + F.lane;
#pragma unroll
            for (int j = 0; j < 4; ++j) { u32x2 w; w.x = cvt_pk_bf16(v[r][j].x, v[r][j].y); w.y = cvt_pk_bf16(v[r][j].z, v[r][j].w); o8[64 * j] = w; } }
        if (F.lane < 16) {
#pragma unroll
            for (int r = 0; r < 4; ++r) SSQ[(size_t)(m0 + r) * 16 + F.lane] = F.lane == 0 ? sq[r] : 0.f; }
    }
    if (gw < NMETA) row_to_bf16(F.in[1] + (size_t)gw * DM, (bf16_t*)(ws + WS_META + MT_XB) + (size_t)gw * DM, (float*)(ws + WS_META + MT_SSQ0) + gw * 16, F.lane);
    zero_bytes(F, Wpt + (size_t)4360 * DM, (size_t)(NPROJ - 4360) * DM * 2);
    for (int b = 0; b < NBATCH; ++b) {
        zero_bytes(F, (bf16_t*)(ws + WS_KA) + (size_t)b * LPOS * 128, (size_t)KR_META * 128 * 2);
        zero_bytes(F, (bf16_t*)(ws + WS_VA) + (size_t)b * LPOS * 128, (size_t)KR_META * 128 * 2);
        zero_bytes(F, (bf16_t*)(ws + WS_KB) + (size_t)b * LPOS * 512, (size_t)KR_META * 512 * 2);
        zero_bytes(F, (bf16_t*)(ws + WS_VB) + (size_t)b * LPOS * 512, (size_t)KR_META * 512 * 2);
    }
}
template <int K> __device__ __forceinline__ f32x4 meta_partial(const bf16_t* Wr, int ldw, const bf16_t* X, int ldx, int wid, int lane) {
    constexpr int NI = K / 32 / NWAVES; static_assert(K % (32 * NWAVES) == 0, "K split over the 8 waves");
    const int i = lane & 15, q = lane >> 4; f32x4 acc = (f32x4){0.f, 0.f, 0.f, 0.f};
    bf16x8 a[NI], b[NI];
#pragma unroll
    for (int t = 0; t < NI; ++t) { const int s = wid + t * NWAVES; a[t] = *(const bf16x8*)(Wr + (size_t)i * ldw + s * 32 + q * 8); b[t] = *(const bf16x8*)(X + (size_t)i * ldx + s * 32 + q * 8); }
#pragma unroll
    for (int t = 0; t < NI; ++t) acc = __builtin_amdgcn_mfma_f32_16x16x32_bf16(a[t], b[t], acc, 0, 0, 0);
    return acc;
}
__device__ __forceinline__ f32x4 meta_reduce(Frame& F, f32x4 part, int blk) {
    LAS f32x4* scr = (LAS f32x4*)(F.lds + RING_OFF + blk * 8192);
    scr[F.wave * 64 + F.lane] = part;
    __syncthreads();
    f32x4 s = scr[F.lane];
#pragma unroll
    for (int w = 1; w < NWAVES; ++w) s += scr[w * 64 + F.lane];
    __syncthreads();
    return s;
}
__device__ __forceinline__ void meta_up(Frame& F) {
    if (F.vcu >= DFF / 16) return;
    unsigned char* ws = F.ws; const int c = F.vcu, j = F.lane & 15, q = F.lane >> 4;
    const bf16_t* W1t = (const bf16_t*)(ws + WS_W1); const bf16_t* X = (const bf16_t*)(ws + WS_META + MT_XB);
    const int grow = 256 * (c / 8) + 16 * (c % 8);
    f32x4 g = meta_partial<DM>(W1t + (size_t)grow * DM, DM, X, DM, F.wave, F.lane);
    f32x4 u = meta_partial<DM>(W1t + (size_t)(grow + 128) * DM, DM, X, DM, F.wave, F.lane);
    g = meta_reduce(F, g, 0); u = meta_reduce(F, u, 1);
    if (F.wave == 0) {
        const float rs = 1.0f / sqrtf(((const float*)(ws + WS_META + MT_SSQ0))[j * 16] * (1.0f / 1024.0f) + EPS);
        float o[4];
#pragma unroll
        for (int e = 0; e < 4; ++e) { const float gg = g[e] * rs, uu = u[e] * rs; o[e] = gg * pg8::fast_sigmoid(gg) * uu; }
        u32x2 w; w.x = cvt_pk_bf16(o[0], o[1]); w.y = cvt_pk_bf16(o[2], o[3]);
        *(u32x2*)((bf16_t*)(ws + WS_META + MT_ACT) + (size_t)j * DFF + 16 * c + 4 * q) = w;
    }
}
__device__ __forceinline__ void meta_down(Frame& F) {
    if (F.vcu >= DM / 16) return;
    unsigned char* ws = F.ws; const int c = F.vcu, j = F.lane & 15, q = F.lane >> 4;
    const bf16_t* W2t = (const bf16_t*)(ws + WS_W2); const bf16_t* X = (const bf16_t*)(ws + WS_META + MT_ACT);
    f32x4 d = meta_partial<DFF>(W2t + (size_t)(16 * c) * DFF, DFF, X, DFF, F.wave, F.lane);
    d = meta_reduce(F, d, 0);
    if (F.wave == 0) {
        const f32x4 base = *(const f32x4*)(F.in[1] + (size_t)j * DM + 16 * c + 4 * q);
        const f32x4 v = base + d * 0.5f;
        u32x2 w; w.x = cvt_pk_bf16(v[0], v[1]); w.y = cvt_pk_bf16(v[2], v[3]);
        *(u32x2*)((bf16_t*)(ws + WS_META + MT_H1B) + (size_t)j * DM + 16 * c + 4 * q) = w;
        float sq = (v[0] * v[0] + v[1] * v[1]) + (v[2] * v[2] + v[3] * v[3]);
        sq += __shfl_xor(sq, 16); sq += __shfl_xor(sq, 32);
        if (q == 0) ((float*)(ws + WS_META + MT_SSQ1))[j * 64 + c] = sq;
    }
}
__device__ __forceinline__ void meta_proj(Frame& F) {
    if (F.vcu >= 81) return;
    unsigned char* ws = F.ws; const int g = F.vcu, j = F.lane & 15, q = F.lane >> 4;
    const bf16_t* Wpt = (const bf16_t*)(ws + WS_WP); const bf16_t* X = (const bf16_t*)(ws + WS_META + MT_H1B);
    int prow; bf16_t* dst; int pitch, col;
    if (g < 8)       { prow = 512 + 16 * g;         dst = (bf16_t*)(ws + WS_KA); pitch = 128; col = 16 * g; }
    else if (g < 16) { prow = 640 + 16 * (g - 8);   dst = (bf16_t*)(ws + WS_VA); pitch = 128; col = 16 * (g - 8); }
    else if (g < 48) { prow = 1280 + 16 * (g - 16); dst = (bf16_t*)(ws + WS_KB); pitch = 512; col = 16 * (g - 16); }
    else if (g < 80) { prow = 1792 + 16 * (g - 48); dst = (bf16_t*)(ws + WS_VB); pitch = 512; col = 16 * (g - 48); }
    else             { prow = 4352;                 dst = nullptr; pitch = 0; col = 0; }
    f32x4 d = meta_partial<DM>(Wpt + (size_t)prow * DM, DM, X, DM, F.wave, F.lane);
    d = meta_reduce(F, d, 0);
    if (F.wave == 0) {
        const float* s1 = (const float*)(ws + WS_META + MT_SSQ1) + j * 64 + 16 * q;
        const f32x4 a0 = *(const f32x4*)s1, a1 = *(const f32x4*)(s1 + 4), a2 = *(const f32x4*)(s1 + 8), a3 = *(const f32x4*)(s1 + 12);
        float s = ((a0[0] + a0[1]) + (a0[2] + a0[3])) + ((a1[0] + a1[1]) + (a1[2] + a1[3])) + ((a2[0] + a2[1]) + (a2[2] + a2[3])) + ((a3[0] + a3[1]) + (a3[2] + a3[3]));
        s += __shfl_xor(s, 16); s += __shfl_xor(s, 32);
        const float rs = 1.0f / sqrtf(s * (1.0f / 1024.0f) + EPS);
        const f32x4 v = d * rs;
        if (dst) {
            u32x2 w; w.x = cvt_pk_bf16(v[0], v[1]); w.y = cvt_pk_bf16(v[2], v[3]);
            for (int b = 0; b < NBATCH; ++b) *(u32x2*)(dst + (size_t)(b * LPOS + KR_META + j) * pitch + col + 4 * q) = w;
            if (g >= 16 && g < 48) {
                float s2 = (v[0] * v[0] + v[1] * v[1]) + (v[2] * v[2] + v[3] * v[3]);
                s2 += __shfl_xor(s2, 16); s2 += __shfl_xor(s2, 32);
                if (q == 0) ((float*)(ws + WS_META + MT_KNM))[(j * 8 + ((g - 16) >> 2)) * 4 + ((g - 16) & 3)] = s2;
            }
        } else if (q < 2) {
            const f32x4 bb = *(const f32x4*)(F.in[7] + 4 * q); f32x4 lf;
#pragma unroll
            for (int e = 0; e < 4; ++e) { const float x = v[e] + bb[e]; lf[e] = fminf(x, 0.f) - log1pf(expf(-fabsf(x))); }
            float* L = (float*)(ws + WS_LOGF);
            for (int b = 0; b < NBATCH; ++b) *(f32x4*)(L + (size_t)(b * LPOS + KR_META + j) * 8 + 4 * q) = lf;
        }
    }
}
__device__ __forceinline__ void attn_phase(Frame& F, char* shm, bf16_t* OB, int only) {
    unsigned char* ws = F.ws;
    bf16_t* QO = (bf16_t*)(ws + WS_QO);
    const bf16_t *KA = (const bf16_t*)(ws + WS_KA), *VA = (const bf16_t*)(ws + WS_VA), *KB = (const bf16_t*)(ws + WS_KB), *VB = (const bf16_t*)(ws + WS_VB);
    const float* LOGF = (const float*)(ws + WS_LOGF); const float* QN2 = (const float*)(ws + WS_QN2); const float* KN2 = (const float*)(ws + WS_KN2);
    float* cl = (float*)(shm + attn2::LDS_CL); float* wtot = (float*)(shm + attn2::LDS_SCAN);
    if (only != 2 && only != 4) for (int s = F.vcu; s < NBATCH * 8 * 2; s += F.G) {
        const int bh = s >> 1, half = s & 1, b = bh >> 3, h = bh & 7; float kmax2 = 0.f;
        { float v[5]; float run = 0.f; int ln = F.lane; asm volatile("" : "+v"(ln));
#pragma unroll
          for (int k = 0; k < 5; ++k) { const int e = F.tid * 5 + k; const float x = (e < 2064) ? LOGF[(size_t)(b * LPOS + KR_META + e) * 8 + h] : 0.f; run += x; v[k] = run; }
          float inc = run;
#pragma unroll
          for (int o = 1; o < 64; o <<= 1) { const float y = __shfl_up(inc, o); if (ln >= o) inc += y; }
          float km = 0.f;
#pragma unroll
          for (int k = 0; k < 5; ++k) { const int e = F.tid * 5 + k;
              if (e >= NMETA && e < 2064) { const float* kp2 = KN2 + (size_t)(b * LPOS + KR_META + e) * 16 + 2 * h; km = fmaxf(km, kp2[0] + kp2[1]); }
              else if (e < NMETA) { const float* kq = (const float*)(ws + WS_META + MT_KNM) + (e * 8 + h) * 4; km = fmaxf(km, (kq[0] + kq[1]) + (kq[2] + kq[3])); } }
#pragma unroll
          for (int o = 1; o < 64; o <<= 1) km = fmaxf(km, __shfl_xor(km, o));
          float qm4[4];
#pragma unroll
          for (int i = 0; i < 4; ++i) { const int jq = half == 0 ? (i == 0 ? 0 : i == 1 ? 7 : i == 2 ? 3 : 4) : (i == 0 ? 1 : i == 1 ? 6 : i == 2 ? 2 : 5);
              if (F.tid < 256) { const float* qp2 = QN2 + (size_t)(b * SEQ + 256 * jq + F.tid) * 16 + 2 * h; qm4[i] = qp2[0] + qp2[1]; } else qm4[i] = 0.f; }
#pragma unroll
          for (int i = 0; i < 4; ++i) {
#pragma unroll
              for (int o = 1; o < 64; o <<= 1) qm4[i] = fmaxf(qm4[i], __shfl_xor(qm4[i], o)); }
          if (ln == 63) { wtot[F.wave] = inc; wtot[8 + F.wave] = km;
#pragma unroll
              for (int i = 0; i < 4; ++i) wtot[16 + i * 8 + F.wave] = qm4[i]; }
          __syncthreads();
          kmax2 = wtot[8];
          for (int w = 1; w < NWAVES; ++w) kmax2 = fmaxf(kmax2, wtot[8 + w]);
          float woff = 0.f;
          for (int w = 0; w < F.wave; ++w) woff += wtot[w];
          const float ex = inc - run + woff;
#pragma unroll
          for (int k = 0; k < 5; ++k) { const int e = F.tid * 5 + k; if (e < 2064) cl[e] = (v[k] + ex) * LOG2E; }
          __syncthreads(); }
        for (int i = 0; i < 4; ++i) {
            const int jj = half == 0 ? (i == 0 ? 0 : i == 1 ? 7 : i == 2 ? 3 : 4) : (i == 0 ? 1 : i == 1 ? 6 : i == 2 ? 2 : 5);
            const int t0 = 256 * jj + 32 * F.wave;
            int fskip = 0;
            { float qmax2 = wtot[16 + i * 8];
              for (int w = 1; w < 4; ++w) qmax2 = fmaxf(qmax2, wtot[16 + i * 8 + w]);
              const float bound = 2.05f * sqrtf(qmax2 * kmax2) + cl[16 + 256 * jj];
              for (int T = 1; T <= 4 * jj; ++T) { if (bound - cl[79 + 64 * (T - 1)] < -152.f) fskip = T + 1; else break; }
              fskip &= ~1; }
            const int row0 = fskip ? KR_REAL + 64 * (fskip - 1) : 64, kb2 = KR_REAL + 64 * fskip, nt2 = 4 * jj + 5 - fskip;
#if defined(DBG_SKIP)
            if (blockIdx.x == 0 && F.tid == 0 && jj == 7) ((float*)(ws + WS_META + 262144))[0] = (float)fskip;
#endif
            bf16_t* qw = QO + (size_t)(b * SEQ + t0) * DM + 512 + h * 64;
            attn2::unit2<0, 8>((const attn2::bf16*)qw, (attn2::bf16*)(OB + (qw - QO)), (const attn2::bf16*)(KB + (size_t)b * LPOS * 512 + h * 64), (const attn2::bf16*)(VB + (size_t)b * LPOS * 512 + h * 64), 512, nt2, row0, kb2, KR_REAL + t0, 32 * F.wave, 0.f, 0.f, cl, shm);
        }
        __syncthreads();
    }
    if (only != 1) for (int s = F.vcu; s < 256; s += F.G) {
        for (int i = 0; i < 4; ++i) {
            const int a = s * 4 + i, b = a >> 6, rem = a & 63, n = rem >> 2, kvh = (rem >> 1) & 1, pair = rem & 1;
            const int head = kvh * 4 + pair * 2 + (F.wave >> 2), t0 = 128 * n + 32 * (F.wave & 3);
            bf16_t* qw = QO + (size_t)(b * SEQ + t0) * DM + head * 64;
            const float slope2 = exp2f(-(float)(head + 1)) * LOG2E, sink2 = F.in[8][head] * LOG2E;
            attn::unit_swa2(qw, OB + (qw - QO), KA + (size_t)b * LPOS * 128 + kvh * 64, VA + (size_t)b * LPOS * 128 + kvh * 64, 128, 128 * n, KR_REAL + t0, slope2, sink2, shm);
        }
    }
}
__device__ __forceinline__ void final_norm(Frame& F) {
    const int gw = F.vcu * NWAVES + F.wave, NGW = F.G * NWAVES;
    const float* SSQ = (const float*)(F.ws + WS_SSQ);
    f32x4 gf[4];
#pragma unroll
    for (int j = 0; j < 4; ++j) gf[j] = ((const f32x4*)F.in[15])[64 * j + F.lane];
    for (int m = gw; m < MROWS; m += NGW) {
        const f32x4 p = *(const f32x4*)(SSQ + (size_t)m * 16 + 4 * (F.lane & 3));
        float s = (p[0] + p[1]) + (p[2] + p[3]); s += __shfl_xor(s, 1); s += __shfl_xor(s, 2);
        const float rs = 1.0f / sqrtf(s * (1.0f / 1024.0f) + EPS);
        GAS f32x4* xr = (GAS f32x4*)(F.out + (size_t)m * DM) + F.lane;
#pragma unroll
        for (int j = 0; j < 4; ++j) { const f32x4 v = xr[64 * j]; xr[64 * j] = v * rs * gf[j]; }
    }
}

#ifndef EXP_ATTN_ONLY
#define EXP_ATTN_ONLY 0
#endif
#ifndef EXP_P0_PART
#define EXP_P0_PART 0
#endif
struct Args { const float* in[16]; float* out; unsigned char* ws; int ph_lo, ph_hi, alt, pad; };
__global__ void __launch_bounds__(NWAVES * 64, 2) fwd_kernel(Args args) {
    extern __shared__ __attribute__((aligned(16))) unsigned char lds[];
    Frame F;
    F.lds = (LAS unsigned char*)lds;
    F.MISC = (volatile LAS unsigned*)(F.lds + MISC_OFF);
    F.tid = threadIdx.x; F.lane = F.tid & 63; F.wave = __builtin_amdgcn_readfirstlane(F.tid >> 6);
    F.G = gridDim.x; { const int bx = blockIdx.x; F.vcu = (F.G % 8 == 0) ? (bx % 8) * (F.G / 8) + bx / 8 : bx; }
    F.ws = args.ws; F.out = args.out;
#pragma unroll
    for (int i = 0; i < 16; ++i) F.in[i] = args.in[i];
    F.ctl = (gu32*)(F.ws + WS_CTL);
    for (int u = F.tid; u < (LDS_BYTES - LDSCTL_OFF) / 4; u += NWAVES * 64) ((LAS unsigned*)(F.lds + LDSCTL_OFF))[u] = 0u;
    __syncthreads();
    XcdBarrier bar; bar.bar = (unsigned*)(F.ctl + CW_BAR); bar.x = 0; bar.st = nullptr;
    if (N_LAUNCHES == 1) bar = xcd_barrier_post((unsigned*)(F.ctl + CW_BAR), F.MISC + 8);
#if defined(DBG_BAR2)
#define GRID_BAR() do { if (N_LAUNCHES == 1) { xcd_barrier(bar); xcd_barrier(bar); } } while (0)
#else
#define GRID_BAR() do { if (N_LAUNCHES == 1) xcd_barrier(bar); } while (0)
#endif
    const int lo = args.ph_lo, hi = args.ph_hi;
#define IN(k) (lo <= (k) && (k) < hi)
#define BOTH(k) (IN(k) && IN((k) + 1))
#define ENDBAR(k) do { if (BOTH(k)) GRID_BAR(); } while (0)
#define ENDBAR_L(k) do { if (BOTH(k)) { if (N_LAUNCHES == 1) xcd_barrier_local(bar); } } while (0)
    unsigned char* ws = F.ws;
    bf16_t* XB = (bf16_t*)(ws + WS_XB); bf16_t* ACT = (bf16_t*)(ws + WS_ACT); float* SSQ = (float*)(ws + WS_SSQ);
    const int bx = (int)blockIdx.x;
    LAS float* rsc = (LAS float*)(F.lds + LDSCTL_OFF + 4096);
#define RSC_RESET() do { if (F.tid < 8) ((LAS int*)(rsc + 1024))[F.tid] = 0; __syncthreads(); } while (0)
#if defined(DBG_PH)
    unsigned long long ph_c0 = 0, ph_r0 = 0, ph_c1 = 0, ph_r1 = 0;
#define STAMP0(k) do { if ((k) == DBG_PH) { ph_c0 = __builtin_amdgcn_s_memtime(); ph_r0 = __builtin_amdgcn_s_memrealtime(); asm volatile("s_waitcnt lgkmcnt(0)" ::: "memory"); } } while (0)
#define STAMP1(k) do { if ((k) == DBG_PH) { ph_c1 = __builtin_amdgcn_s_memtime(); ph_r1 = __builtin_amdgcn_s_memrealtime(); asm volatile("s_waitcnt lgkmcnt(0)" ::: "memory"); } } while (0)
#else
#define STAMP0(k) do {} while (0)
#define STAMP1(k) do {} while (0)
#endif

    if (IN(0)) { STAMP0(0); p0_prologue(F, args.alt ? EXP_P0_PART : 0); STAMP1(0); ENDBAR(0); }

#if defined(DBG_CLOCK)
    unsigned long long dbg_c0 = 0, dbg_r0 = 0, dbg_c1 = 0, dbg_r1 = 0;
#endif
    if (IN(1)) { STAMP0(1);
        meta_up(F);
        pg8::Gemm g{XB, (const bf16_t*)(ws + WS_W1), DM, DM, DM}; pg8::StaticOrder S; S.init(MROWS, 2 * DFF, F.G, bx);
        pg8::EpiSwiGLU E{ACT, SSQ, rsc}; RSC_RESET();
#if defined(EXP_STAGGER)
        if (args.alt) { const unsigned long long t0 = __builtin_amdgcn_s_memrealtime(); const unsigned long long dly = (unsigned long long)((F.vcu % EXP_STAGGER_G) * EXP_STAGGER);
            while (__builtin_amdgcn_s_memrealtime() - t0 < dly) __builtin_amdgcn_s_sleep(8); }
#endif
#if defined(DBG_CLOCK)
        dbg_c0 = __builtin_amdgcn_s_memtime(); dbg_r0 = __builtin_amdgcn_s_memrealtime(); asm volatile("s_waitcnt lgkmcnt(0)" ::: "memory");
#endif
#if defined(EXP_NULL_EPI)
        if (args.alt) { pg8::EpiNull EN; pg8::gemm_phase<pg8::EpiNull, pg8::StaticOrder, true, true>(F.lds + RING_OFF, g, S, EN); } else
#endif
#if defined(EXP_SEAM)
        { pg8::RangeOrder R0{S, 0, 6}, R1{S, 6, 1 << 20};
          pg8::gemm_phase<pg8::EpiSwiGLU, pg8::RangeOrder, true, true>(F.lds + RING_OFF, g, R0, E);
#if EXP_SEAM == 1
          GRID_BAR();
#elif EXP_SEAM == 2
          xcd_barrier_nf(bar);
#elif EXP_SEAM == 3
          xcd_barrier_norel(bar);
#elif EXP_SEAM == 4
          xcd_barrier_noacq(bar);
#endif
          pg8::gemm_phase<pg8::EpiSwiGLU, pg8::RangeOrder, true, true>(F.lds + RING_OFF, g, R1, E); }
#else
        pg8::gemm_phase<pg8::EpiSwiGLU, pg8::StaticOrder, true, true>(F.lds + RING_OFF, g, S, E);
#endif
#if defined(DBG_CLOCK)
        dbg_c1 = __builtin_amdgcn_s_memtime(); dbg_r1 = __builtin_amdgcn_s_memrealtime(); asm volatile("s_waitcnt lgkmcnt(0)" ::: "memory");
#endif
        STAMP1(1); ENDBAR(1);
    }
    if (IN(2)) { STAMP0(2);
        meta_down(F);
        pg8::Gemm g{ACT, (const bf16_t*)(ws + WS_W2), DFF, DFF, DFF}; pg8::StaticOrder S; S.init(MROWS, DM, F.G, bx);
        pg8::EpiResB<false> E{XB, XB, SSQ, 0.5f};
#if defined(EXP_NULL_EPI)
        if (args.alt) { pg8::EpiNull EN; pg8::gemm_phase<pg8::EpiNull, pg8::StaticOrder, true, true>(F.lds + RING_OFF, g, S, EN); } else
#endif
        pg8::gemm_phase<pg8::EpiResB<false>, pg8::StaticOrder, true, true>(F.lds + RING_OFF, g, S, E);
        STAMP1(2); ENDBAR(2);
    }
    if (IN(3)) { STAMP0(3);
        meta_proj(F);
        pg8::Gemm g{XB, (const bf16_t*)(ws + WS_WP), DM, DM, DM}; pg8::StaticOrder S; S.init(MROWS, NPROJ, F.G, bx);
        pg8::EpiProj E{SSQ, (bf16_t*)(ws + WS_QO), (bf16_t*)(ws + WS_KA), (bf16_t*)(ws + WS_VA), (bf16_t*)(ws + WS_KB), (bf16_t*)(ws + WS_VB), (bf16_t*)(ws + WS_SGA), (bf16_t*)(ws + WS_SGB), (float*)(ws + WS_LOGF), F.in[7], (float*)(ws + WS_QN2), (float*)(ws + WS_KN2), rsc}; RSC_RESET();
#if defined(EXP_NULL_EPI)
        if (args.alt) { pg8::EpiNull EN; pg8::gemm_phase<pg8::EpiNull, pg8::StaticOrder, true, true>(F.lds + RING_OFF, g, S, EN); } else
#elif defined(EXP_PROJX)
        if (args.alt) { pg8::EpiProjX<EXP_PROJX> EX{SSQ, (bf16_t*)(ws + WS_QO)}; pg8::gemm_phase<pg8::EpiProjX<EXP_PROJX>, pg8::StaticOrder, true, true>(F.lds + RING_OFF, g, S, EX); } else
#endif
        pg8::gemm_phase<pg8::EpiProj, pg8::StaticOrder, true, true>(F.lds + RING_OFF, g, S, E);
        STAMP1(3); ENDBAR(3);
    }
    if (IN(4)) { STAMP0(4); attn_phase(F, (char*)lds + RING_OFF, args.alt ? (bf16_t*)(ws + WS_MIX) : (bf16_t*)(ws + WS_QO), args.alt ? EXP_ATTN_ONLY : 0); STAMP1(4); ENDBAR_L(4); }

    if (IN(5)) { STAMP0(5);
        pg8::Gemm g{(const bf16_t*)(ws + WS_QO), (const bf16_t*)(ws + WS_WAB), DM, DM, DM}; pg8::StaticOrder S; S.init(MROWS, DM, F.G, bx);
        pg8::EpiMix E{(const bf16_t*)(ws + WS_SGA), (const bf16_t*)(ws + WS_SGB), (bf16_t*)(ws + WS_MIX)};
        pg8::gemm_phase<pg8::EpiMix, pg8::StaticOrder, true, true>(F.lds + RING_OFF, g, S, E);
        STAMP1(5); ENDBAR_L(5);
    }
    if (IN(6)) { STAMP0(6);
        pg8::Gemm g{(const bf16_t*)(ws + WS_MIX), (const bf16_t*)(ws + WS_WO), DM, DM, DM}; pg8::StaticOrder S; S.init(MROWS, DM, F.G, bx);
        pg8::EpiResB<false> E{XB, XB, SSQ, 1.0f};
        pg8::gemm_phase<pg8::EpiResB<false>, pg8::StaticOrder, true, true>(F.lds + RING_OFF, g, S, E);
        STAMP1(6); ENDBAR(6);
    }
    if (IN(7)) { STAMP0(7);
        pg8::Gemm g{XB, (const bf16_t*)(ws + WS_W3), DM, DM, DM}; pg8::StaticOrder S; S.init(MROWS, 2 * DFF, F.G, bx);
        pg8::EpiSwiGLU E{ACT, SSQ, rsc}; RSC_RESET();
        pg8::gemm_phase<pg8::EpiSwiGLU, pg8::StaticOrder, true, true>(F.lds + RING_OFF, g, S, E);
        STAMP1(7); ENDBAR_L(7);
    }
    if (IN(8)) { STAMP0(8);
        pg8::Gemm g{ACT, (const bf16_t*)(ws + WS_W4), DFF, DFF, DFF}; pg8::StaticOrder S; S.init(MROWS, DM, F.G, bx);
        pg8::EpiFinal E{XB, F.out, F.in[15], SSQ, (unsigned*)(F.ctl + CW_PANEL), 0.5f};
        pg8::gemm_phase<pg8::EpiFinal, pg8::StaticOrder, true, true>(F.lds + RING_OFF, g, S, E);
        STAMP1(8);
    }
#if defined(DBG_PH)
    GRID_BAR();
    if (bx == 0 && F.tid == 0) {
        const float dc = (float)(ph_c1 - ph_c0), dr = (float)(ph_r1 - ph_r0);
#if DBG_WHAT == 2
        F.out[0] = 400.f * floorf(dc / dr * 100.f / 400.f + 0.5f);
#elif DBG_WHAT == 0
        F.out[0] = 100.f * floorf(dc / dr + 0.5f);
#else
        F.out[0] = 1000.f + 20.f * floorf(dr * 0.01f / 20.f + 0.5f);
#endif
    }
#endif
#if defined(DBG_SKIP)
    GRID_BAR();
    if (bx == 0 && F.tid == 0) F.out[0] = 1000.f + 100.f * ((float*)(ws + WS_META + 262144))[0];
#endif
#if defined(DBG_CLOCK)
    GRID_BAR();
    if (bx == 0 && F.tid == 0) {
        const float dc = (float)(dbg_c1 - dbg_c0), dr = (float)(dbg_r1 - dbg_r0);
        float v;
        if (DBG_CLOCK == 0) v = dc / dr * 100.f;
        else if (DBG_CLOCK == 1) v = dr * 0.01f * 10.f;
        else v = dc / 176.f;
        F.out[0] = v;
    }
#endif
#undef IN
#undef BOTH
#undef GRID_BAR
}

extern "C" void kernel_launch(void* const* d_in, const int* in_sizes, int n_in, void* d_out, int out_size, void* d_ws, size_t ws_size, hipStream_t stream) {
    static int grid = 0;
    if (grid == 0) {
        if (n_in != 16 || in_sizes[0] != MROWS * DM || out_size != MROWS * DM || ws_size < WS_END) {
            fprintf(stderr, "kernel_launch: built for 16 inputs, x/out of %d floats, >= %zu bytes of workspace; got n_in %d, in0 %d, out %d, ws %zu; nothing launched\n", MROWS * DM, (size_t)WS_END, n_in, n_in > 0 ? in_sizes[0] : -1, out_size, ws_size); grid = -1; return; }
        int dev = 0, cus = 0, per_cu = 0;
        if (hipGetDevice(&dev) != hipSuccess || hipDeviceGetAttribute(&cus, hipDeviceAttributeMultiprocessorCount, dev) != hipSuccess) { fprintf(stderr, "kernel_launch: device query failed\n"); grid = -1; return; }
        if (hipFuncSetAttribute((const void*)fwd_kernel, hipFuncAttributeMaxDynamicSharedMemorySize, LDS_BYTES) != hipSuccess) { fprintf(stderr, "kernel_launch: hipFuncSetAttribute failed\n"); grid = -1; return; }
        if (hipOccupancyMaxActiveBlocksPerMultiprocessor(&per_cu, (const void*)fwd_kernel, NWAVES * 64, LDS_BYTES) != hipSuccess || per_cu < 1) { fprintf(stderr, "kernel_launch: occupancy query reports %d workgroups per CU\n", per_cu); per_cu = 1; }
        (void)hipGetLastError();
        grid = cus * (per_cu < 1 ? 1 : 1);
    }
    if (grid < 0) return;
    if (hipMemsetAsync((char*)d_ws + WS_CTL, 0, CTL_ZERO_BYTES, stream) != hipSuccess) { fprintf(stderr, "kernel_launch: hipMemsetAsync failed\n"); return; }
    Args a{};
    for (int i = 0; i < 16; ++i) a.in[i] = (const float*)d_in[i];
    a.out = (float*)d_out; a.ws = (unsigned char*)d_ws;
#ifndef EXP_REP
#define EXP_REP -1
#endif
    for (int li = 0; li < N_LAUNCHES; ++li) {
        if (N_LAUNCHES == 1) { a.ph_lo = 0; a.ph_hi = N_PHASES; } else { a.ph_lo = li; a.ph_hi = li + 1; }
        if (N_LAUNCHES != 1 && li == EXP_REP) { a.alt = 1; hipLaunchKernelGGL(fwd_kernel, dim3(grid), dim3(NWAVES * 64), LDS_BYTES, stream, a); a.alt = 0; }
        hipLaunchKernelGGL(fwd_kernel, dim3(grid), dim3(NWAVES * 64), LDS_BYTES, stream, a);
        const hipError_t le = hipPeekAtLastError();
        if (le != hipSuccess) { fprintf(stderr, "kernel_launch: launch %d failed: %s\n", li, hipGetErrorName(le)); break; }
    }
}
```

```cpp
#include <hip/hip_runtime.h>
#include <hip/hip_bf16.h>
#include <cstdio>
#include <cstdint>

#define LAS __attribute__((address_space(3)))
#define GAS __attribute__((address_space(1)))
typedef unsigned short bf16_t;
typedef short bf16x8 __attribute__((ext_vector_type(8)));
typedef float f32x4 __attribute__((ext_vector_type(4)));
typedef float f32x16 __attribute__((ext_vector_type(16)));
typedef unsigned u32x4 __attribute__((ext_vector_type(4)));
typedef unsigned u32x2 __attribute__((ext_vector_type(2)));
typedef short s16x4 __attribute__((ext_vector_type(4)));

constexpr int DM = 1024, NBATCH = 16, SEQ = 2048, MROWS = NBATCH * SEQ;
constexpr int DFF = 2816, NPROJ = 4608;
constexpr int LPOS = 2176, NKR = NBATCH * LPOS;
constexpr int NMETA = 16, KR_META = 112, KR_REAL = 128;
constexpr float EPS = 1e-6f, LOG2E = 1.4426950408889634f, QSCALE = 0.125f * 1.4426950408889634f;

__device__ __forceinline__ unsigned cvt_pk_bf16(float lo, float hi) { unsigned r; asm volatile("v_cvt_pk_bf16_f32 %0, %1, %2" : "=v"(r) : "v"(lo), "v"(hi)); return r; }
__device__ __forceinline__ void st16_wt(void* p, u32x4 v) { asm volatile("global_store_dwordx4 %0, %1, off sc1\n\ts_nop 1" :: "v"(p), "v"(v) : "memory"); }
__device__ __forceinline__ float bf_lo(unsigned w) { return __uint_as_float(w << 16); }
__device__ __forceinline__ float bf_hi(unsigned w) { return __uint_as_float(w & 0xffff0000u); }

namespace pg8 {
#define PG8_LAS __attribute__((address_space(3)))
constexpr int BM = 256, BK = 64, HALF = 128, HTB = HALF * BK * 2  , STAGE_BYTES = 8 * HTB, NXCD = 8, WGM = 8;

__host__ __device__ __forceinline__ int lds_byte(int r, int c) { const int st = (r >> 4) * 2 + (c >> 5), rr = r & 15, cc = c & 31, ob = rr * 64 + cc * 2; return st * 1024 + (ob ^ (((ob >> 9) & 1) << 5)); }
__host__ __device__ __forceinline__ void stage_rc(int b, int& R, int& C) { const int st = b / 1024, sb = b % 1024, swz = sb ^ (((sb >> 9) & 1) << 5); R = (st >> 1) * 16 + swz / 64; C = (st & 1) * 32 + (swz % 64) / 2; }
__host__ __device__ __forceinline__ int perm32(int rho) { const int n = rho >> 4, i = rho & 15; return 8 * (i >> 2) + 4 * n + (i & 3); }

struct Unit { int pm, pn, koff, br; };
struct Gemm { const bf16_t* A; const bf16_t* Bt; int lda, ldb, K; };

struct StaticOrder {
    int nM, nN, nwg, G, c, flip;
    __host__ __device__ void init(int M, int N, int G_, int c_, int flip_ = 0) { nM = M / BM; nN = N / BM; nwg = nM * nN; G = G_; c = c_; flip = flip_; }
    __host__ __device__ bool next(int i, Unit& u) const {
        const long L = (long)i * G + c; if (L >= nwg) return false;
        int wgid = (int)L; { const int q = nwg / NXCD, r = nwg % NXCD, xcd = wgid % NXCD, off = wgid / NXCD; wgid = (xcd < r ? xcd * (q + 1) : r * (q + 1) + (xcd - r) * q) + off; }
        const int nig = WGM * nN, gid = wgid / nig, fm = gid * WGM, gsz = (nM - fm) < WGM ? (nM - fm) : WGM;
        u.pm = (fm + ((wgid % nig) % gsz)) ^ flip; u.pn = (wgid % nig) / gsz; u.koff = 0; u.br = 0; return true;
    }
    __device__ __forceinline__ void a_ready(const Unit&) const {}
    __device__ __forceinline__ void done(const Unit&) const {}
};
struct RangeOrder {
    StaticOrder S; int i0, i1;
    __host__ __device__ bool next(int i, Unit& u) const { if (i0 + i >= i1) return false; return S.next(i0 + i, u); }
    __device__ __forceinline__ void a_ready(const Unit&) const {}
    __device__ __forceinline__ void done(const Unit&) const {}
};
struct DualOrder {
    StaticOrder S;
    __host__ __device__ bool next(int i, Unit& u) const { if (!S.next(i >> 1, u)) return false; u.br = i & 1; u.koff = 512 * (i & 1); return true; }
    __device__ __forceinline__ void a_ready(const Unit&) const {}
    __device__ __forceinline__ void done(const Unit&) const {}
};

__device__ __forceinline__ float row_rs(const float* ssq, int row, int fq) {
    const f32x4 p = *(const f32x4*)(ssq + (size_t)row * 16 + 4 * fq);
    float s = (p[0] + p[1]) + (p[2] + p[3]);
    s += __shfl_xor(s, 16); s += __shfl_xor(s, 32);
    return __builtin_amdgcn_rsqf(s * (1.0f / 1024.0f) + EPS);
}
typedef float f32x2 __attribute__((ext_vector_type(2)));
__device__ __forceinline__ void row_rs8(const float* ssq, int row0, int fq, float (&rs)[8]) {
    f32x4 p[8];
#pragma unroll
    for (int i = 0; i < 8; ++i) p[i] = *(const f32x4*)(ssq + (size_t)(row0 + (i >> 2) * HALF + (i & 3) * 16) * 16 + 4 * fq);
#pragma unroll
    for (int i = 0; i < 8; ++i) { float s = (p[i][0] + p[i][1]) + (p[i][2] + p[i][3]); s += __shfl_xor(s, 16); s += __shfl_xor(s, 32); rs[i] = __builtin_amdgcn_rsqf(s * (1.0f / 1024.0f) + EPS); }
}
__device__ __forceinline__ float fast_sigmoid(float x) { return __builtin_amdgcn_rcpf(1.0f + __builtin_amdgcn_exp2f(-x * LOG2E)); }
__device__ __forceinline__ u32x4 pack8(const f32x4 a, const f32x4 b) { u32x4 w; w.x = cvt_pk_bf16(a[0], a[1]); w.y = cvt_pk_bf16(a[2], a[3]); w.z = cvt_pk_bf16(b[0], b[1]); w.w = cvt_pk_bf16(b[2], b[3]); return w; }

__device__ __forceinline__ void pf_tile(const void* base, int esz, const Unit& u, int part, int nparts, int tid, float& junk) {
    const int lpr = esz * 2, per = 256 * lpr / nparts, L = part * per + tid;
    if (tid < per) { const char* p = (const char*)base + ((size_t)(u.pm * BM + L / lpr) * DM + (size_t)u.pn * BM) * esz + (L % lpr) * 128;
        asm volatile("global_load_dword %0, %1, off" : "+v"(junk) : "v"(p) : "memory"); }
}
__device__ __forceinline__ void row_rs8_cached(const float* ssq, int pm, int row0, int fr, int fq, PG8_LAS float* rc, float (&rs)[8]) {
    const int wid = __builtin_amdgcn_readfirstlane((int)threadIdx.x >> 6);
    PG8_LAS float* mine = rc + wid * 128; PG8_LAS int* tag = (PG8_LAS int*)(rc + 1024) + wid;
    const int have = __builtin_amdgcn_readfirstlane(*tag);
    if (have != pm + 1) {
        row_rs8(ssq, row0, fq, rs);
        if (fq == 0) { *(PG8_LAS f32x4*)(mine + fr * 8) = (f32x4){rs[0], rs[1], rs[2], rs[3]}; *(PG8_LAS f32x4*)(mine + fr * 8 + 4) = (f32x4){rs[4], rs[5], rs[6], rs[7]}; }
        if ((threadIdx.x & 63) == 0) *tag = pm + 1;
    } else {
        const f32x4 a = *(const PG8_LAS f32x4*)(mine + fr * 8), b = *(const PG8_LAS f32x4*)(mine + fr * 8 + 4);
        rs[0] = a[0]; rs[1] = a[1]; rs[2] = a[2]; rs[3] = a[3]; rs[4] = b[0]; rs[5] = b[1]; rs[6] = b[2]; rs[7] = b[3];
    }
}
struct EpiSwiGLU {
    static constexpr bool PERM = true, AFTER_DRAIN = false, MID = false, PF = false;
    bf16_t* O; const float* ssq; PG8_LAS float* rsc;
    __device__ __forceinline__ void operator()(const f32x4 (&acc)[2][2][4][2], const Unit& u, int wr, int wc, int fr, int fq) const {
        const int row0 = u.pm * BM + wr * 64 + fr, col0 = u.pn * HALF + wc * 32 + 8 * fq;
        float rsv[8]; row_rs8_cached(ssq, u.pm, row0, fr, fq, rsc, rsv);
#pragma unroll
        for (int ai = 0; ai < 2; ++ai)
#pragma unroll
            for (int m = 0; m < 4; ++m) {
                const int row = row0 + ai * HALF + m * 16; const float rs = rsv[ai * 4 + m];
                f32x4 o[2]; const float c1 = -LOG2E * rs, irs2 = __builtin_amdgcn_rcpf(rs * rs);
#pragma unroll
                for (int n = 0; n < 2; ++n)
#pragma unroll
                    for (int e = 0; e < 4; e += 2) {
                        const f32x2 g = (f32x2){acc[ai][0][m][n][e], acc[ai][0][m][n][e + 1]}, uu = (f32x2){acc[ai][1][m][n][e], acc[ai][1][m][n][e + 1]};
                        const f32x2 t = g * c1; f32x2 d; d.x = __builtin_amdgcn_exp2f(t.x); d.y = __builtin_amdgcn_exp2f(t.y); d = d * irs2 + irs2;
                        f32x2 r; r.x = __builtin_amdgcn_rcpf(d.x); r.y = __builtin_amdgcn_rcpf(d.y);
                        const f32x2 w = (g * uu) * r; o[n][e] = w.x; o[n][e + 1] = w.y;
                    }
                *(u32x4*)(O + (size_t)row * DFF + col0) = pack8(o[0], o[1]);
            }
    }
};
template <bool BASE_F32> struct EpiResB {
    static constexpr bool PERM = true, AFTER_DRAIN = false, MID = false, PF = false;
    const void* base; bf16_t* xb; float* ssq; float scale;
    __device__ __forceinline__ void prefetch(const Unit& u, int t, int nt, int tid, float& junk) const { const int q = t - (nt - 8); if (q >= 0) pf_tile(base, BASE_F32 ? 4 : 2, u, q >> 1, 4, tid, junk); }
    __device__ __forceinline__ void operator()(const f32x4 (&acc)[2][2][4][2], const Unit& u, int wr, int wc, int fr, int fq) const {
        const int row0 = u.pm * BM + wr * 64 + fr, col0 = u.pn * BM + wc * 32 + 8 * fq;
        u32x4 wv[2][4][2];
        if (!BASE_F32) {
#pragma unroll
            for (int ai = 0; ai < 2; ++ai)
#pragma unroll
                for (int m = 0; m < 4; ++m)
#pragma unroll
                    for (int bj = 0; bj < 2; ++bj) wv[ai][m][bj] = *(const u32x4*)((const bf16_t*)base + (size_t)(row0 + ai * HALF + m * 16) * DM + col0 + bj * HALF);
        }
#pragma unroll
        for (int ai = 0; ai < 2; ++ai) {
            f32x4 fv[4][2][2];
            if (BASE_F32) {
#pragma unroll
                for (int m = 0; m < 4; ++m)
#pragma unroll
                    for (int bj = 0; bj < 2; ++bj) { const float* bp = (const float*)base + (size_t)(row0 + ai * HALF + m * 16) * DM + col0 + bj * HALF; fv[m][bj][0] = *(const f32x4*)bp; fv[m][bj][1] = *(const f32x4*)(bp + 4); }
            }
#pragma unroll
            for (int m = 0; m < 4; ++m) {
                const int row = row0 + ai * HALF + m * 16; const size_t off = (size_t)row * DM + col0; float sq = 0.f;
#pragma unroll
                for (int bj = 0; bj < 2; ++bj) {
                    const size_t c = off + bj * HALF; f32x4 b0, b1;
                    if (BASE_F32) { b0 = fv[m][bj][0]; b1 = fv[m][bj][1]; }
                    else { const u32x4 w = wv[ai][m][bj]; b0 = (f32x4){bf_lo(w.x), bf_hi(w.x), bf_lo(w.y), bf_hi(w.y)}; b1 = (f32x4){bf_lo(w.z), bf_hi(w.z), bf_lo(w.w), bf_hi(w.w)}; }
                    const f32x4 v0 = b0 + acc[ai][bj][m][0] * scale, v1 = b1 + acc[ai][bj][m][1] * scale;
                    *(u32x4*)(xb + c) = pack8(v0, v1);
                    sq += (v0[0] * v0[0] + v0[1] * v0[1]) + (v0[2] * v0[2] + v0[3] * v0[3]) + (v1[0] * v1[0] + v1[1] * v1[1]) + (v1[2] * v1[2] + v1[3] * v1[3]);
                }
                sq += __shfl_xor(sq, 16); sq += __shfl_xor(sq, 32);
                if (fq == 0) ssq[(size_t)row * 16 + u.pn * 4 + wc] = sq;
            }
            if (BASE_F32) asm volatile("" ::: "memory");
        }
    }
};
struct EpiFinal {
    static constexpr bool PERM = true, AFTER_DRAIN = false, MID = false, PF = false;
    const bf16_t* base; float* out; const float* gf; float* part; unsigned* cnt; float scale;
    __device__ __forceinline__ void prefetch(const Unit& u, int t, int nt, int tid, float& junk) const { const int q = t - (nt - 8); if (q >= 0) pf_tile(base, 2, u, q >> 1, 4, tid, junk); }
    __device__ __forceinline__ void operator()(f32x4 (&acc)[2][2][4][2], const Unit& u, int wr, int wc, int fr, int fq) const {
        const int row0 = u.pm * BM + wr * 64 + fr, col0 = u.pn * BM + wc * 32 + 8 * fq;
        u32x4 wv[2][4][2];
#pragma unroll
        for (int ai = 0; ai < 2; ++ai)
#pragma unroll
            for (int m = 0; m < 4; ++m)
#pragma unroll
                for (int bj = 0; bj < 2; ++bj) wv[ai][m][bj] = *(const u32x4*)(base + (size_t)(row0 + ai * HALF + m * 16) * DM + col0 + bj * HALF);
#pragma unroll
        for (int ai = 0; ai < 2; ++ai)
#pragma unroll
            for (int m = 0; m < 4; ++m) {
                const int row = row0 + ai * HALF + m * 16; float sq = 0.f;
#pragma unroll
                for (int bj = 0; bj < 2; ++bj) {
                    const u32x4 w = wv[ai][m][bj];
                    const f32x4 b0 = (f32x4){bf_lo(w.x), bf_hi(w.x), bf_lo(w.y), bf_hi(w.y)}, b1 = (f32x4){bf_lo(w.z), bf_hi(w.z), bf_lo(w.w), bf_hi(w.w)};
                    const f32x4 v0 = b0 + acc[ai][bj][m][0] * scale, v1 = b1 + acc[ai][bj][m][1] * scale;
                    acc[ai][bj][m][0] = v0; acc[ai][bj][m][1] = v1;
                    sq += (v0[0] * v0[0] + v0[1] * v0[1]) + (v0[2] * v0[2] + v0[3] * v0[3]) + (v1[0] * v1[0] + v1[1] * v1[1]) + (v1[2] * v1[2] + v1[3] * v1[3]);
                }
                sq += __shfl_xor(sq, 16); sq += __shfl_xor(sq, 32);
                if (fq == 0) __hip_atomic_store(part + (size_t)row * 16 + u.pn * 4 + wc, sq, __ATOMIC_RELAXED, __HIP_MEMORY_SCOPE_AGENT);
            }
        asm volatile("s_waitcnt vmcnt(0)" ::: "memory");
        unsigned* pc = cnt + 64 * u.pm;
        if ((threadIdx.x & 63) == 0) __hip_atomic_fetch_add(pc, 1u, __ATOMIC_RELAXED, __HIP_MEMORY_SCOPE_AGENT);
        for (unsigned spins = 0; spins < (1u << 22); ++spins) {
            if ((unsigned)__builtin_amdgcn_readfirstlane(__hip_atomic_load(pc, __ATOMIC_RELAXED, __HIP_MEMORY_SCOPE_AGENT)) >= 32u) break;
            __builtin_amdgcn_s_sleep(2);
        }
        asm volatile("" ::: "memory");
        const int gc0 = u.pn * BM + wc * 32 + 8 * fq;
        unsigned long long qq[8][2];
#pragma unroll
        for (int i = 0; i < 8; ++i) { const unsigned long long* pp = (const unsigned long long*)(part + (size_t)(row0 + (i >> 2) * HALF + (i & 3) * 16) * 16 + 4 * fq);
            qq[i][0] = __hip_atomic_load(pp, __ATOMIC_RELAXED, __HIP_MEMORY_SCOPE_AGENT); qq[i][1] = __hip_atomic_load(pp + 1, __ATOMIC_RELAXED, __HIP_MEMORY_SCOPE_AGENT); }
#pragma unroll
        for (int ai = 0; ai < 2; ++ai)
#pragma unroll
            for (int m = 0; m < 4; ++m) {
                const int row = row0 + ai * HALF + m * 16; const size_t off = (size_t)row * DM + col0;
                const unsigned long long q0 = qq[ai * 4 + m][0], q1 = qq[ai * 4 + m][1];
                float s = (__uint_as_float((unsigned)q0) + __uint_as_float((unsigned)(q0 >> 32))) + (__uint_as_float((unsigned)q1) + __uint_as_float((unsigned)(q1 >> 32)));
                s += __shfl_xor(s, 16); s += __shfl_xor(s, 32);
                const float rs = 1.0f / sqrtf(s * (1.0f / 1024.0f) + EPS);
#pragma unroll
                for (int bj = 0; bj < 2; ++bj) {
                    const f32x4 g0 = *(const f32x4*)(gf + gc0 + bj * HALF), g1 = *(const f32x4*)(gf + gc0 + bj * HALF + 4);
                    *(f32x4*)(out + off + bj * HALF) = acc[ai][bj][m][0] * rs * g0; *(f32x4*)(out + off + bj * HALF + 4) = acc[ai][bj][m][1] * rs * g1;
                }
            }
    }
};
struct EpiProj {
    static constexpr bool PERM = true, AFTER_DRAIN = false, MID = false, PF = false;
    const float* ssq; bf16_t *QO, *KA, *VA, *KB, *VB, *RAB, *SGB; float* LOGF; const float* bfg; float *QN2, *KN2; PG8_LAS float* rsc;
    __device__ __forceinline__ void operator()(const f32x4 (&acc)[2][2][4][2], const Unit& u, int wr, int wc, int fr, int fq) const {
        const int pn = u.pn, row0 = u.pm * BM + wr * 64 + fr, kadd = KR_REAL * (u.pm / 8 + 1);
        float rsv[8]; row_rs8_cached(ssq, u.pm, row0, fr, fq, rsc, rsv);
        if (pn == 17) {
            f32x4 bb0 = *(const f32x4*)(bfg), bb1 = *(const f32x4*)(bfg + 4);
#pragma unroll
            for (int ai = 0; ai < 2; ++ai)
#pragma unroll
                for (int m = 0; m < 4; ++m) {
                    const int row = row0 + ai * HALF + m * 16; const float rs = rsv[ai * 4 + m];
                    if (wc == 0 && fq == 0) {
                        f32x4 lf[2];
#pragma unroll
                        for (int n = 0; n < 2; ++n)
#pragma unroll
                            for (int e = 0; e < 4; ++e) { const float x = acc[ai][0][m][n][e] * rs + (n ? bb1[e] : bb0[e]); lf[n][e] = fminf(x, 0.f) - log1pf(expf(-fabsf(x))); }
                        float* d = LOGF + (size_t)(row + kadd) * 8; *(f32x4*)d = lf[0]; *(f32x4*)(d + 4) = lf[1];
                    }
                }
            return;
        }
        if (pn >= 9) {
            const int cg = (pn - 9) * HALF + wc * 32 + 8 * fq;
#pragma unroll
            for (int ai = 0; ai < 2; ++ai)
#pragma unroll
                for (int m = 0; m < 4; ++m) {
                    const int row = row0 + ai * HALF + m * 16; const float rs = rsv[ai * 4 + m]; f32x4 r[2], sb[2];
                    const float c1 = -LOG2E * rs;
#pragma unroll
                    for (int n = 0; n < 2; ++n)
#pragma unroll
                        for (int e = 0; e < 4; e += 2) {
                            f32x2 ta = (f32x2){acc[ai][0][m][n][e], acc[ai][0][m][n][e + 1]} * c1, tb = (f32x2){acc[ai][1][m][n][e], acc[ai][1][m][n][e + 1]} * c1;
                            tb.x = __builtin_amdgcn_fmed3f(tb.x, -115.4f, 115.4f); tb.y = __builtin_amdgcn_fmed3f(tb.y, -115.4f, 115.4f);
                            f32x2 da, db; da.x = __builtin_amdgcn_exp2f(ta.x); da.y = __builtin_amdgcn_exp2f(ta.y); db.x = __builtin_amdgcn_exp2f(tb.x); db.y = __builtin_amdgcn_exp2f(tb.y);
                            da = da + 1.0f; db = db + 1.0f;
                            f32x2 ra, rb; ra.x = __builtin_amdgcn_rcpf(da.x); ra.y = __builtin_amdgcn_rcpf(da.y); rb.x = __builtin_amdgcn_rcpf(db.x); rb.y = __builtin_amdgcn_rcpf(db.y);
                            const f32x2 q = db * ra; r[n][e] = q.x; r[n][e + 1] = q.y; sb[n][e] = rb.x; sb[n][e + 1] = rb.y;
                        }
                    *(u32x4*)(RAB + (size_t)row * DM + cg) = pack8(r[0], r[1]); *(u32x4*)(SGB + (size_t)row * DM + cg) = pack8(sb[0], sb[1]);
                }
            return;
        }
        bf16_t* d0; bf16_t* d1; int pitch, radd = 0; float mul = 1.f;
        if (pn < 2)       { d0 = QO + pn * 256; d1 = d0 + HALF; pitch = DM; mul = QSCALE; }
        else if (pn == 2) { d0 = KA; d1 = VA; pitch = 128; radd = kadd; }
        else if (pn < 5)  { d0 = QO + 512 + (pn - 3) * 256; d1 = d0 + HALF; pitch = DM; mul = QSCALE; }
        else if (pn < 7)  { d0 = KB + (pn - 5) * 256; d1 = d0 + HALF; pitch = 512; radd = kadd; }
        else              { d0 = VB + (pn - 7) * 256; d1 = d0 + HALF; pitch = 512; radd = kadd; }
        const int cw = wc * 32 + 8 * fq;
#pragma unroll
        for (int ai = 0; ai < 2; ++ai)
#pragma unroll
            for (int m = 0; m < 4; ++m) {
                const int row = row0 + ai * HALF + m * 16; const float rs = rsv[ai * 4 + m] * mul; const size_t ro = (size_t)(row + radd) * pitch + cw;
#pragma unroll
                for (int bj = 0; bj < 2; ++bj) {
                    const f32x4 v0 = acc[ai][bj][m][0] * rs, v1 = acc[ai][bj][m][1] * rs;
                    *(u32x4*)((bj ? d1 : d0) + ro) = pack8(v0, v1);
                    if (pn >= 3 && pn < 7) {
                        float s2 = (v0[0] * v0[0] + v0[1] * v0[1]) + (v0[2] * v0[2] + v0[3] * v0[3]) + (v1[0] * v1[0] + v1[1] * v1[1]) + (v1[2] * v1[2] + v1[3] * v1[3]);
                        s2 += __shfl_xor(s2, 16); s2 += __shfl_xor(s2, 32);
                        if (fq == 0) ((pn < 5 ? QN2 : KN2) + (size_t)(row + radd) * 16)[2 * (4 * ((pn - 3) & 1) + 2 * bj + (wc >> 1)) + (wc & 1)] = s2;
                    }
                }
            }
    }
};
struct EpiMix {
    static constexpr bool PERM = true, AFTER_DRAIN = false, MID = true, PF = false;
    const bf16_t *RAB, *SGB; bf16_t* MIX;
    __device__ __forceinline__ void prefetch(const Unit& u, int t, int nt, int tid, float& junk) const { const int h = nt >> 1; if (t < h) pf_tile(RAB, 2, u, t >> 1, h >> 1, tid, junk); else pf_tile(SGB, 2, u, (t - h) >> 1, h >> 1, tid, junk); }
    __device__ __forceinline__ void mid(f32x4 (&acc)[2][2][4][2], const Unit& u, int wr, int wc, int fr, int fq) const {
        int row0 = u.pm * BM + wr * 64 + fr; const int col0 = u.pn * BM + wc * 32 + 8 * fq;
        asm volatile("" : "+v"(row0));
        u32x4 gv[2][4][2];
#pragma unroll
        for (int ai = 0; ai < 2; ++ai)
#pragma unroll
            for (int m = 0; m < 4; ++m)
#pragma unroll
                for (int bj = 0; bj < 2; ++bj) gv[ai][m][bj] = *(const u32x4*)(RAB + (size_t)(row0 + ai * HALF + m * 16) * DM + col0 + bj * HALF);
#pragma unroll
        for (int ai = 0; ai < 2; ++ai)
#pragma unroll
            for (int m = 0; m < 4; ++m) {
#pragma unroll
                for (int bj = 0; bj < 2; ++bj) {
                    const u32x4 gw = gv[ai][m][bj];
                    acc[ai][bj][m][0] *= (f32x4){bf_lo(gw.x), bf_hi(gw.x), bf_lo(gw.y), bf_hi(gw.y)}; acc[ai][bj][m][1] *= (f32x4){bf_lo(gw.z), bf_hi(gw.z), bf_lo(gw.w), bf_hi(gw.w)};
                }
            }
    }
    __device__ __forceinline__ void operator()(const f32x4 (&acc)[2][2][4][2], const Unit& u, int wr, int wc, int fr, int fq) const {
        int row0 = u.pm * BM + wr * 64 + fr; const int col0 = u.pn * BM + wc * 32 + 8 * fq;
        asm volatile("" : "+v"(row0));
        u32x4 gv[2][4][2];
#pragma unroll
        for (int ai = 0; ai < 2; ++ai)
#pragma unroll
            for (int m = 0; m < 4; ++m)
#pragma unroll
                for (int bj = 0; bj < 2; ++bj) gv[ai][m][bj] = *(const u32x4*)(SGB + (size_t)(row0 + ai * HALF + m * 16) * DM + col0 + bj * HALF);
#pragma unroll
        for (int ai = 0; ai < 2; ++ai)
#pragma unroll
            for (int m = 0; m < 4; ++m) {
                const int row = row0 + ai * HALF + m * 16;
#pragma unroll
                for (int bj = 0; bj < 2; ++bj) {
                    const size_t c = (size_t)row * DM + col0 + bj * HALF;
                    const u32x4 gw = gv[ai][m][bj];
                    const f32x4 v0 = acc[ai][bj][m][0] * (f32x4){bf_lo(gw.x), bf_hi(gw.x), bf_lo(gw.y), bf_hi(gw.y)}, v1 = acc[ai][bj][m][1] * (f32x4){bf_lo(gw.z), bf_hi(gw.z), bf_lo(gw.w), bf_hi(gw.w)};
                    *(u32x4*)(MIX + c) = pack8(v0, v1);
                }
            }
    }
};
struct EpiNull {
    static constexpr bool PERM = true, AFTER_DRAIN = false, MID = false, PF = false;
    __device__ __forceinline__ void operator()(const f32x4 (&acc)[2][2][4][2], const Unit& u, int wr, int wc, int fr, int fq) const {
#pragma unroll
        for (int ai = 0; ai < 2; ++ai)
#pragma unroll
            for (int bj = 0; bj < 2; ++bj)
#pragma unroll
                for (int m = 0; m < 4; ++m)
#pragma unroll
                    for (int n = 0; n < 2; ++n) asm volatile("" :: "v"(acc[ai][bj][m][n]));
    }
};

template <int MODE> struct EpiProjX {
    static constexpr bool PERM = true, AFTER_DRAIN = false, MID = false, PF = false;
    const float* ssq; bf16_t* D;
    __device__ __forceinline__ void operator()(const f32x4 (&acc)[2][2][4][2], const Unit& u, int wr, int wc, int fr, int fq) const {
        int row0 = u.pm * BM + wr * 64 + fr; const int cw = (u.pn % 4) * 256 + wc * 32 + 8 * fq;
        asm volatile("" : "+v"(row0));
#pragma unroll
        for (int ai = 0; ai < 2; ++ai)
#pragma unroll
            for (int m = 0; m < 4; ++m) {
                const int row = row0 + ai * HALF + m * 16;
                if (MODE == 0) {
                    const float rs = row_rs(ssq, row, fq); f32x4 r[2], sb[2];
#pragma unroll
                    for (int n = 0; n < 2; ++n)
#pragma unroll
                        for (int e = 0; e < 4; ++e) {
                            const float ga = __builtin_amdgcn_fmed3f(acc[ai][0][m][n][e] * rs, -80.f, 80.f), gb = __builtin_amdgcn_fmed3f(acc[ai][1][m][n][e] * rs, -80.f, 80.f);
                            const float ea = __builtin_amdgcn_exp2f(-ga * LOG2E), eb = __builtin_amdgcn_exp2f(-gb * LOG2E);
                            r[n][e] = (1.0f + eb) * __builtin_amdgcn_rcpf(1.0f + ea); sb[n][e] = __builtin_amdgcn_rcpf(1.0f + eb);
                        }
                    u32x4 a = pack8(r[0], r[1]), b = pack8(sb[0], sb[1]); asm volatile("" :: "v"(a), "v"(b));
                } else if (MODE == 1) {
#pragma unroll
                    for (int bj = 0; bj < 2; ++bj) *(u32x4*)(D + (size_t)row * DM + cw + bj * HALF) = pack8(acc[ai][bj][m][0], acc[ai][bj][m][1]);
                } else {
                    const int lrow = (int)blockIdx.x * BM + (row & 255); const int cw2 = wc * 32 + 8 * fq;
#pragma unroll
                    for (int bj = 0; bj < 2; ++bj) *(u32x4*)(D + (size_t)lrow * DM + cw2 + bj * HALF) = pack8(acc[ai][bj][m][0], acc[ai][bj][m][1]);
                }
            }
    }
};
template <class Epi, class Sched, bool ALIGN_EPI = false, bool SP2 = false>
__device__ __forceinline__ void gemm_phase(PG8_LAS unsigned char* lds, const Gemm g, const Sched& S, const Epi& E) {
    const int tid = threadIdx.x, wid = __builtin_amdgcn_readfirstlane(tid >> 6), lane = tid & 63, wr = wid >> 2, wc = wid & 3, fr = lane & 15, fq = lane >> 4;
    const int K = g.K, nt = K / BK;
    unsigned voffA[2], voffB[2];
#pragma unroll
    for (int i = 0; i < 2; ++i) { int R, C; stage_rc(tid * 16 + i * 8192, R, C); const int Rb = Epi::PERM ? ((R & ~31) + perm32(R & 31)) : R;
        voffA[i] = (unsigned)(R * g.lda + C) * 2u; voffB[i] = (unsigned)(Rb * g.ldb + C) * 2u; }
    const size_t kstep = (size_t)(BK * 2);
    const size_t hstepA = (size_t)HALF * g.lda * 2, hstepB = (size_t)HALF * g.ldb * 2;
    const size_t tstepA = 2 * hstepA, tstepB = 2 * hstepB;
    const unsigned ldsw = (unsigned)wid * 1024u;
    const int aoff = lds_byte(wr * 64 + fr, fq * 8), boff = lds_byte(wc * 32 + fr, fq * 8);
#define PG8_SA(b, h) (((b) * 2 + (h)) * HTB)
#define PG8_SB(b, h) ((4 + (b) * 2 + (h)) * HTB)
#define PG8_STAGE(bufoff, gbase, voff) do { _Pragma("unroll") for (int _i = 0; _i < 2; ++_i) \
        __builtin_amdgcn_global_load_lds((const unsigned*)((const char*)(gbase) + (voff)[_i]), (PG8_LAS unsigned*)(lds + (bufoff) + ldsw + _i * 8192), 16, 0, 0); } while (0)
#define PG8_LDA(dst, b, h) do { _Pragma("unroll") for (int m = 0; m < 4; ++m) _Pragma("unroll") for (int k = 0; k < 2; ++k) dst[m][k] = *(const PG8_LAS bf16x8*)(lds + PG8_SA(b, h) + aoff + m * 2048 + k * 1024); } while (0)
#define PG8_LDB(dst, b, h) do { _Pragma("unroll") for (int n = 0; n < 2; ++n) _Pragma("unroll") for (int k = 0; k < 2; ++k) dst[n][k] = *(const PG8_LAS bf16x8*)(lds + PG8_SB(b, h) + boff + n * 2048 + k * 1024); } while (0)
#define PG8_MMA(ai, bj, At, Bt) do { __builtin_amdgcn_s_setprio(1); _Pragma("unroll") for (int m = 0; m < 4; ++m) _Pragma("unroll") for (int n = 0; n < 2; ++n) _Pragma("unroll") for (int k = 0; k < 2; ++k) \
        acc[ai][bj][m][n] = __builtin_amdgcn_mfma_f32_16x16x32_bf16(Bt[n][k], At[m][k], acc[ai][bj][m][n], 0, 0, 0); __builtin_amdgcn_s_setprio(0); } while (0)
#define PG8_WAIT_V(n) asm volatile("s_waitcnt vmcnt(" #n ")" ::: "memory")
#define PG8_WAIT_L(n) asm volatile("s_waitcnt lgkmcnt(" #n ")" ::: "memory")
#define PG8_BAR __builtin_amdgcn_s_barrier()
#define PG8_SCHED __builtin_amdgcn_sched_barrier(0)
    Unit cur, nxt; int ui = 0; float pfj = 0.f;
    if (!S.next(0, cur)) return;
    f32x4 acc[2][2][4][2];
#pragma unroll
    for (int a = 0; a < 2; ++a)
#pragma unroll
        for (int b = 0; b < 2; ++b)
#pragma unroll
            for (int m = 0; m < 4; ++m)
#pragma unroll
                for (int n = 0; n < 2; ++n) acc[a][b][m][n] = (f32x4){0.f, 0.f, 0.f, 0.f};
    bf16x8 At[4][2], B0[2][2], B1[2][2];
    const char* cA = (const char*)g.A + (size_t)cur.pm * tstepA + (size_t)cur.koff * 2; const char* cB = (const char*)g.Bt + (size_t)cur.pn * tstepB + (size_t)cur.koff * 2;
    S.a_ready(cur);
    if constexpr (SP2) {
        PG8_STAGE(PG8_SB(0, 0), cB, voffB); PG8_STAGE(PG8_SB(0, 1), cB + hstepB, voffB); PG8_STAGE(PG8_SA(0, 0), cA, voffA); PG8_STAGE(PG8_SA(0, 1), cA + hstepA, voffA);
        if (wr == 1) PG8_BAR;
        PG8_WAIT_V(2); PG8_BAR;
        PG8_STAGE(PG8_SB(1, 0), cB + kstep, voffB); PG8_STAGE(PG8_SA(1, 0), cA + kstep, voffA); PG8_STAGE(PG8_SB(1, 1), cB + hstepB + kstep, voffB);
        PG8_WAIT_V(6); PG8_BAR;
    } else {
        PG8_STAGE(PG8_SB(0, 0), cB, voffB); PG8_STAGE(PG8_SA(0, 0), cA, voffA); PG8_STAGE(PG8_SB(0, 1), cB + hstepB, voffB); PG8_STAGE(PG8_SA(0, 1), cA + hstepA, voffA);
        if (wr == 1) PG8_BAR;
        PG8_WAIT_V(4); PG8_BAR;
        PG8_STAGE(PG8_SB(1, 0), cB + kstep, voffB); PG8_STAGE(PG8_SA(1, 0), cA + kstep, voffA); PG8_STAGE(PG8_SB(1, 1), cB + hstepB + kstep, voffB);
        PG8_WAIT_V(6); PG8_BAR;
    }
    for (;;) {
        const bool has_next = S.next(ui + 1, nxt);
        const char* nA = has_next ? (const char*)g.A + (size_t)nxt.pm * tstepA + (size_t)nxt.koff * 2 : cA; const char* nB = has_next ? (const char*)g.Bt + (size_t)nxt.pn * tstepB + (size_t)nxt.koff * 2 : cB;
        for (int t = 0; t < nt; t += 2) {
            const bool last = (t == nt - 2);
            if constexpr (Epi::PF) E.prefetch(cur, t, nt, tid, pfj);
            if constexpr (Epi::MID) { if (t == (nt >> 1)) E.mid(acc, cur, wr, wc, fr, fq); }
            const char* a1 = cA + (size_t)(t + 1) * kstep;
            const char* a2 = last ? nA : cA + (size_t)(t + 2) * kstep; const char* b2 = last ? nB : cB + (size_t)(t + 2) * kstep;
            const char* a3 = a2 + kstep; const char* b3 = b2 + kstep;
            if (last && has_next) S.a_ready(nxt);
            if constexpr (SP2) {
            PG8_LDB(B0, 0, 0); PG8_LDB(B1, 0, 1); PG8_SCHED; PG8_LDA(At, 0, 0); PG8_STAGE(PG8_SA(1, 1), a1 + hstepA, voffA);
            PG8_WAIT_V(8); PG8_WAIT_L(0); PG8_BAR; PG8_MMA(0, 0, At, B0); PG8_MMA(0, 1, At, B1); PG8_BAR; PG8_SCHED;
            PG8_LDA(At, 0, 1); PG8_STAGE(PG8_SB(0, 0), b2, voffB); PG8_STAGE(PG8_SB(0, 1), b2 + hstepB, voffB); PG8_STAGE(PG8_SA(0, 0), a2, voffA);
            PG8_WAIT_V(8); PG8_WAIT_L(0); PG8_BAR; PG8_MMA(1, 0, At, B0); PG8_MMA(1, 1, At, B1); PG8_BAR; PG8_SCHED;
            PG8_LDB(B0, 1, 0); PG8_LDB(B1, 1, 1); PG8_SCHED; PG8_LDA(At, 1, 0); PG8_STAGE(PG8_SA(0, 1), a2 + hstepA, voffA);
            PG8_WAIT_V(8); PG8_WAIT_L(0); PG8_BAR; PG8_MMA(0, 0, At, B0); PG8_MMA(0, 1, At, B1); PG8_BAR; PG8_SCHED;
            PG8_LDA(At, 1, 1); PG8_STAGE(PG8_SB(1, 0), b3, voffB); PG8_STAGE(PG8_SB(1, 1), b3 + hstepB, voffB); PG8_STAGE(PG8_SA(1, 0), a3, voffA);
            PG8_WAIT_V(8); PG8_WAIT_L(0); PG8_BAR; PG8_MMA(1, 0, At, B0); PG8_MMA(1, 1, At, B1); PG8_BAR; PG8_SCHED;
            } else {
            PG8_LDB(B0, 0, 0); PG8_SCHED; PG8_LDA(At, 0, 0); PG8_STAGE(PG8_SA(1, 1), a1 + hstepA, voffA);
            PG8_WAIT_L(8); PG8_BAR; PG8_WAIT_L(0); PG8_MMA(0, 0, At, B0); PG8_BAR; PG8_SCHED;
            PG8_LDB(B1, 0, 1); PG8_STAGE(PG8_SB(0, 0), b2, voffB);
            PG8_BAR; PG8_WAIT_L(0); PG8_MMA(0, 1, At, B1); PG8_BAR;
            PG8_LDA(At, 0, 1); PG8_STAGE(PG8_SA(0, 0), a2, voffA);
            PG8_BAR; PG8_WAIT_L(0); PG8_MMA(1, 0, At, B0); PG8_BAR; PG8_SCHED;
            PG8_STAGE(PG8_SB(0, 1), b2 + hstepB, voffB);
            PG8_WAIT_V(6); PG8_BAR; PG8_MMA(1, 1, At, B1); PG8_BAR;
            PG8_LDB(B0, 1, 0); PG8_SCHED; PG8_LDA(At, 1, 0); PG8_STAGE(PG8_SA(0, 1), a2 + hstepA, voffA);
            PG8_WAIT_L(8); PG8_BAR; PG8_WAIT_L(0); PG8_MMA(0, 0, At, B0); PG8_BAR; PG8_SCHED;
            PG8_LDB(B1, 1, 1); PG8_STAGE(PG8_SB(1, 0), b3, voffB);
            PG8_BAR; PG8_WAIT_L(0); PG8_MMA(0, 1, At, B1); PG8_BAR;
            PG8_LDA(At, 1, 1); PG8_STAGE(PG8_SA(1, 0), a3, voffA);
            PG8_BAR; PG8_WAIT_L(0); PG8_MMA(1, 0, At, B0); PG8_BAR; PG8_SCHED;
            PG8_STAGE(PG8_SB(1, 1), b3 + hstepB, voffB);
            PG8_WAIT_V(6); PG8_BAR; PG8_MMA(1, 1, At, B1); PG8_BAR;
            }
        }
        if constexpr (ALIGN_EPI) { if (wr == 0) PG8_BAR; }
        if constexpr (!Epi::AFTER_DRAIN) { E(acc, cur, wr, wc, fr, fq); S.done(cur); }
        asm volatile("" :: "v"(pfj));
        if (!has_next) break;
#pragma unroll
        for (int a = 0; a < 2; ++a)
#pragma unroll
            for (int b = 0; b < 2; ++b)
#pragma unroll
                for (int m = 0; m < 4; ++m)
#pragma unroll
                    for (int n = 0; n < 2; ++n) acc[a][b][m][n] = (f32x4){0.f, 0.f, 0.f, 0.f};
        cur = nxt; cA = nA; cB = nB; ++ui;
        if constexpr (ALIGN_EPI) { if (wr == 1) PG8_BAR; }
    }
    PG8_WAIT_V(0);
    if constexpr (!ALIGN_EPI) { if (wr == 0) PG8_BAR; }
    PG8_BAR;
    if constexpr (Epi::AFTER_DRAIN) { E.fused(acc, cur, wr, wc, fr, fq, lds, wid, lane); S.done(cur); }
#undef PG8_SA
#undef PG8_SB
#undef PG8_STAGE
#undef PG8_LDA
#undef PG8_LDB
#undef PG8_MMA
#undef PG8_WAIT_V
#undef PG8_WAIT_L
#undef PG8_BAR
#undef PG8_SCHED
}
}

namespace attn {
constexpr int SLOTB = 8192;
constexpr int NSLOT = 5;
constexpr int LDS_K = 0, LDS_V = NSLOT * SLOTB, LDS_WS = 2 * NSLOT * SLOTB, LDS_OST = LDS_WS + 8 * 256, LDS_CL = LDS_OST + 8 * 4096, LDS_SCAN = LDS_CL + 2064 * 4 + 64, LDS_END = LDS_SCAN + 64;
#define SBAR() __builtin_amdgcn_sched_barrier(0)
__device__ __forceinline__ int crow(int r, int hi) { return (r & 3) + 8 * (r >> 2) + 4 * hi; }
__device__ __forceinline__ void glds16(const void* gsrc, unsigned lds_dst) { unsigned keep;
    asm volatile("s_mov_b32 %0, m0\n\ts_mov_b32 m0, %2\n\ts_nop 0\n\tglobal_load_lds_dwordx4 %1, off\n\ts_mov_b32 m0, %0" : "=&s"(keep) : "v"(gsrc), "s"(lds_dst) : "memory"); }
typedef float f32x2_t __attribute__((ext_vector_type(2))); typedef __bf16 bf16x2_t __attribute__((ext_vector_type(2)));
__device__ __forceinline__ unsigned cvtpk_s(float lo, float hi) { f32x2_t v = {lo, hi}; bf16x2_t b = __builtin_convertvector(v, bf16x2_t); return __builtin_bit_cast(unsigned, b); }
#define MX3(a, b, c) __builtin_fmaxf(__builtin_fmaxf((a), (b)), (c))
__device__ __forceinline__ void qkt(f32x16& p0, f32x16& p1, const char* Kslot, const bf16x8* qr, const f32x16& negm, int r32, int hi) {
    const char* kb = Kslot + hi * 1024 + r32 * 16;
#pragma unroll
    for (int d0 = 0; d0 < 4; ++d0) {
        const bf16x8 b0 = *reinterpret_cast<const bf16x8*>(kb + d0 * 2048);
        const bf16x8 b1 = *reinterpret_cast<const bf16x8*>(kb + d0 * 2048 + 512);
        if (d0 == 0) { p0 = __builtin_amdgcn_mfma_f32_32x32x16_bf16(b0, qr[0], negm, 0, 0, 0); p1 = __builtin_amdgcn_mfma_f32_32x32x16_bf16(b1, qr[0], negm, 0, 0, 0); }
        else { p0 = __builtin_amdgcn_mfma_f32_32x32x16_bf16(b0, qr[d0], p0, 0, 0, 0); p1 = __builtin_amdgcn_mfma_f32_32x32x16_bf16(b1, qr[d0], p1, 0, 0, 0); }
    }
}
__device__ __forceinline__ float rowmax(const f32x16& p0, const f32x16& p1) {
    float a = MX3(p0[0], p0[1], p1[0]), b = MX3(p0[2], p0[3], p1[1]); a = MX3(a, p1[2], p1[3]);
#pragma unroll
    for (int r = 4; r < 16; r += 4) { a = MX3(a, p0[r], p0[r + 1]); b = MX3(b, p0[r + 2], p0[r + 3]); a = MX3(a, p1[r], p1[r + 1]); b = MX3(b, p1[r + 2], p1[r + 3]); }
    const float m = __builtin_fmaxf(a, b);
    auto rr = __builtin_amdgcn_permlane32_swap(__float_as_uint(m), __float_as_uint(m), false, false);
    return __builtin_fmaxf(__uint_as_float(rr[0]), __uint_as_float(rr[1]));
}
__device__ __forceinline__ void pv(f32x16* o, int vb, bf16x8 pa0, bf16x8 pa1, bf16x8 pa2, bf16x8 pa3) {
#pragma unroll
    for (int d0 = 0; d0 < 2; ++d0) { s16x4 lo[4], hi[4];
#pragma unroll
        for (int ks = 0; ks < 4; ++ks) {
            asm volatile("ds_read_b64_tr_b16 %0,%1 offset:%c2" : "=&v"(lo[ks]) : "v"(vb), "i"(d0 * 4096 + ks * 1024) : "memory");
            asm volatile("ds_read_b64_tr_b16 %0,%1 offset:%c2" : "=&v"(hi[ks]) : "v"(vb), "i"(d0 * 4096 + ks * 1024 + 512) : "memory"); }
        asm volatile("s_waitcnt lgkmcnt(0)" ::: "memory"); SBAR();
#define PK(k) (bf16x8){lo[k][0], lo[k][1], lo[k][2], lo[k][3], hi[k][0], hi[k][1], hi[k][2], hi[k][3]}
        o[d0] = __builtin_amdgcn_mfma_f32_32x32x16_bf16(pa0, PK(0), o[d0], 0, 0, 0);
        o[d0] = __builtin_amdgcn_mfma_f32_32x32x16_bf16(pa1, PK(1), o[d0], 0, 0, 0);
        o[d0] = __builtin_amdgcn_mfma_f32_32x32x16_bf16(pa2, PK(2), o[d0], 0, 0, 0);
        o[d0] = __builtin_amdgcn_mfma_f32_32x32x16_bf16(pa3, PK(3), o[d0], 0, 0, 0);
#undef PK
    }
}
#define WAIT_BAR0() asm volatile("s_waitcnt vmcnt(0) lgkmcnt(0)\n\ts_barrier" ::: "memory")

template <int MODE>
__device__ __forceinline__ void unit(const bf16_t* Qw, bf16_t* Ow, const bf16_t* Kh, const bf16_t* Vh, int kp, int NT, int kbase, int qpos0,
                                     float slope2, float sink2, const float* cl, char* shm) {
    const int tid = threadIdx.x, lane = tid & 63, r32 = lane & 31, hi = lane >> 5; const int wid = __builtin_amdgcn_readfirstlane(tid >> 6);
    const unsigned lds0 = (unsigned)(uintptr_t)shm;
    float* wsf = (float*)(shm + LDS_WS) + wid * 64;
    const bf16_t* ksrc = Kh + (size_t)lane * kp + wid * 8;
    const bf16_t* vsrc = Vh + (size_t)(16 * (wid & 3) + (lane >> 2)) * kp + (wid >> 2) * 32 + (lane & 3) * 8;
    const unsigned kdst = lds0 + LDS_K + wid * 1024, vdst = lds0 + LDS_V + wid * 1024;
#define TILE_KR0(t) ((t) == 0 ? 64 : kbase + 64 * ((t) - 1))
#define DMA_KV(t, slot) do { const size_t ro_ = (size_t)TILE_KR0(t) * kp; \
        glds16(ksrc + ro_, (unsigned)__builtin_amdgcn_readfirstlane(kdst + (slot) * SLOTB)); glds16(vsrc + ro_, (unsigned)__builtin_amdgcn_readfirstlane(vdst + (slot) * SLOTB)); } while (0)
    const int vb0 = (int)(lds0 + LDS_V) + ((lane >> 4) & 1) * 32 + (lane & 3) * 8 + (4 * hi + ((lane & 15) >> 2)) * 64;
    DMA_KV(0, 0);
    bf16x8 qr[4];
#pragma unroll
    for (int d0 = 0; d0 < 4; ++d0) qr[d0] = *reinterpret_cast<const bf16x8*>(Qw + (size_t)r32 * DM + d0 * 16 + hi * 8);
    const int qp = qpos0 + r32;
    const float rowterm = (MODE == 0) ? cl[qp - KR_META] : -slope2 * (float)qp;
    float mhat = (MODE == 0) ? 0.f : sink2, l_reg = (MODE == 1 && hi == 0) ? 1.f : 0.f;
    f32x16 o[2]; o[0] = f32x16{}; o[1] = f32x16{};
    for (int t = 0; t < NT; ++t) {
        WAIT_BAR0();
        if (t + 1 < NT) DMA_KV(t + 1, (t + 1) & 1);
        const int slot = t & 1, kr0 = TILE_KR0(t);
        bool empty = false, full = false;
        if (MODE == 1 && t > 0) { empty = (kr0 > qpos0 + 31) || (kr0 + 63 <= qpos0 - 128) || (kr0 + 63 < KR_REAL);
            full = (kr0 >= KR_REAL) && (kr0 + 63 <= qpos0) && (qpos0 + 31 - kr0 < 128); }
        if (empty) continue;
        f32x16 negm; { const float nm = rowterm - mhat;
#pragma unroll
            for (int r = 0; r < 16; ++r) negm[r] = nm; }
        f32x16 p0, p1;
        qkt(p0, p1, shm + LDS_K + slot * SLOTB, qr, negm, r32, hi);
        const bool need_mask = (MODE == 1 && !full) || (MODE == 0 && ((kr0 < KR_META) || (kr0 + 63 > qpos0)));
        if (need_mask) {
#pragma unroll
            for (int r = 0; r < 16; ++r) {
                const int k0 = kr0 + crow(r, hi), k1 = k0 + 32;
                bool ok0, ok1; float c0, c1;
                if (MODE == 0) { ok0 = (k0 >= KR_META) && (k0 <= qp); ok1 = (k1 >= KR_META) && (k1 <= qp);
                    c0 = -cl[k0 >= KR_META ? k0 - KR_META : 0]; c1 = -cl[k1 >= KR_META ? k1 - KR_META : 0]; }
                else { ok0 = (t == 0) ? (k0 >= KR_META) : (k0 >= KR_REAL && k0 <= qp && qp - k0 < 128); ok1 = (t == 0) ? (k1 >= KR_META) : (k1 >= KR_REAL && k1 <= qp && qp - k1 < 128);
                    c0 = slope2 * (float)k0; c1 = slope2 * (float)k1; }
                p0[r] = ok0 ? p0[r] + c0 : -INFINITY; p1[r] = ok1 ? p1[r] + c1 : -INFINITY;
            }
        } else {
#pragma unroll
            for (int r = 0; r < 16; ++r) { const int k0 = kr0 + crow(r, hi);
                if (MODE == 0) { p0[r] -= cl[k0 - KR_META]; p1[r] -= cl[k0 - KR_META + 32]; }
                else { p0[r] += slope2 * (float)k0; p1[r] += slope2 * (float)(k0 + 32); } }
        }
        const float rm = rowmax(p0, p1);
        if (MODE == 0 && t == 0) {
            mhat = rm;
#pragma unroll
            for (int r = 0; r < 16; ++r) { p0[r] -= rm; p1[r] -= rm; }
        } else if (__any(rm > 0.f)) {
            const float dl = __builtin_fmaxf(rm, 0.f); mhat += dl;
#pragma unroll
            for (int r = 0; r < 16; ++r) { p0[r] -= dl; p1[r] -= dl; }
            const float f = __builtin_amdgcn_exp2f(-dl); l_reg *= f;
            if (hi == 0) wsf[r32] = f;
            asm volatile("s_waitcnt lgkmcnt(0)" ::: "memory");
#pragma unroll
            for (int d = 0; d < 2; ++d)
#pragma unroll
                for (int r = 0; r < 16; ++r) o[d][r] *= wsf[crow(r, hi)];
        }
        float sacc = 0.f;
#pragma unroll
        for (int r = 0; r < 16; ++r) { p0[r] = __builtin_amdgcn_exp2f(p0[r]); p1[r] = __builtin_amdgcn_exp2f(p1[r]); sacc += p0[r] + p1[r]; }
        l_reg += sacc;
        u32x4 pw0, pw1, pw2, pw3;
        pw0 = (u32x4){cvtpk_s(p0[0], p0[1]), cvtpk_s(p0[2], p0[3]), cvtpk_s(p0[4], p0[5]), cvtpk_s(p0[6], p0[7])};
        pw1 = (u32x4){cvtpk_s(p0[8], p0[9]), cvtpk_s(p0[10], p0[11]), cvtpk_s(p0[12], p0[13]), cvtpk_s(p0[14], p0[15])};
        pw2 = (u32x4){cvtpk_s(p1[0], p1[1]), cvtpk_s(p1[2], p1[3]), cvtpk_s(p1[4], p1[5]), cvtpk_s(p1[6], p1[7])};
        pw3 = (u32x4){cvtpk_s(p1[8], p1[9]), cvtpk_s(p1[10], p1[11]), cvtpk_s(p1[12], p1[13]), cvtpk_s(p1[14], p1[15])};
        SBAR();
        pv(o, vb0 + slot * SLOTB, __builtin_bit_cast(bf16x8, pw0), __builtin_bit_cast(bf16x8, pw1), __builtin_bit_cast(bf16x8, pw2), __builtin_bit_cast(bf16x8, pw3));
    }
    { auto rr = __builtin_amdgcn_permlane32_swap(__float_as_uint(l_reg), __float_as_uint(l_reg), false, false); l_reg = __uint_as_float(rr[0]) + __uint_as_float(rr[1]); }
    if (hi == 0) wsf[32 + r32] = l_reg;
    asm volatile("s_waitcnt lgkmcnt(0)" ::: "memory");
    float rli[16];
#pragma unroll
    for (int r = 0; r < 16; ++r) rli[r] = 1.0f / wsf[32 + crow(r, hi)];
    { __hip_bfloat16* stg = (__hip_bfloat16*)(shm + LDS_OST) + wid * 2048;
#pragma unroll
        for (int r = 0; r < 16; ++r) { const int orow = crow(r, hi);
#pragma unroll
            for (int d0 = 0; d0 < 2; ++d0) stg[orow * 64 + d0 * 32 + r32] = __float2bfloat16(o[d0][r] * rli[r]); }
        asm volatile("s_waitcnt lgkmcnt(0)" ::: "memory");
#pragma unroll
        for (int i = 0; i < 4; ++i) { const int row = i * 8 + (lane >> 3), ch = lane & 7; const u32x4 v = *(const u32x4*)(stg + row * 64 + ch * 8); *(u32x4*)(Ow + (size_t)row * DM + ch * 8) = v; } }
    asm volatile("s_waitcnt lgkmcnt(0)\n\ts_barrier" ::: "memory");
#undef DMA_KV
#undef TILE_KR0
}

__device__ __forceinline__ void unit_swa(const bf16_t* Qw, bf16_t* Ow, const bf16_t* Kh, const bf16_t* Vh, int kp, int kbase, int qpos0, float slope2, float sink2, char* shm, int dbg_nocompute = 0) {
    const int tid = threadIdx.x; int lane_ = tid & 63; asm volatile("" : "+v"(lane_));
    const int lane = lane_, r32 = lane & 31, hi = lane >> 5; const int wid = __builtin_amdgcn_readfirstlane(tid >> 6);
    const unsigned lds0 = (unsigned)(uintptr_t)shm;
    float* wsf = (float*)(shm + LDS_WS) + wid * 64;
    const bf16_t* ksrc = Kh + (size_t)lane * kp + wid * 8;
    const bf16_t* vsrc = Vh + (size_t)(16 * (wid & 3) + (lane >> 2)) * kp + (wid >> 2) * 32 + (lane & 3) * 8;
    const unsigned kdst = lds0 + LDS_K + wid * 1024, vdst = lds0 + LDS_V + wid * 1024;
#define TILE_KR0(t) ((t) == 0 ? 64 : kbase + 64 * ((t) - 1))
#define DMA_KV(t, slot) do { const size_t ro_ = (size_t)TILE_KR0(t) * kp; \
        glds16(ksrc + ro_, (unsigned)__builtin_amdgcn_readfirstlane(kdst + (slot) * SLOTB)); glds16(vsrc + ro_, (unsigned)__builtin_amdgcn_readfirstlane(vdst + (slot) * SLOTB)); } while (0)
    const int vb0 = (int)(lds0 + LDS_V) + ((lane >> 4) & 1) * 32 + (lane & 3) * 8 + (4 * hi + ((lane & 15) >> 2)) * 64;
#pragma unroll
    for (int t = 0; t < 5; ++t) DMA_KV(t, t);
    bf16x8 qr[4];
#pragma unroll
    for (int d0 = 0; d0 < 4; ++d0) qr[d0] = *reinterpret_cast<const bf16x8*>(Qw + (size_t)r32 * DM + d0 * 16 + hi * 8);
    const int qp = qpos0 + r32;
    const float rowterm = -slope2 * (float)qp;
    float mhat = sink2, l_reg = (hi == 0) ? 1.f : 0.f;
    f32x16 o[2]; o[0] = f32x16{}; o[1] = f32x16{};
#define SWA_RESCALE(RM, SUBS) do { if (__any((RM) > 8.f)) { const float dl = __builtin_fmaxf((RM), 0.f); mhat += dl; SUBS; \
        const float f = __builtin_amdgcn_exp2f(-dl); l_reg *= f; if (hi == 0) wsf[r32] = f; asm volatile("s_waitcnt lgkmcnt(0)" ::: "memory"); \
        _Pragma("unroll") for (int d = 0; d < 2; ++d) _Pragma("unroll") for (int r = 0; r < 16; ++r) o[d][r] *= wsf[crow(r, hi)]; } } while (0)
    WAIT_BAR0();
    for (int t = 0; t < 5; ++t) {
        if (dbg_nocompute) continue;
        const int slot = t, kr0 = TILE_KR0(t);
        const char* Kslot = shm + LDS_K + slot * SLOTB;
        if (t == 0) {
            f32x16 p1; { const float nm = rowterm - mhat;
#pragma unroll
                for (int r = 0; r < 16; ++r) p1[r] = nm; }
            const char* kb = Kslot + hi * 1024 + r32 * 16 + 512;
#pragma unroll
            for (int d0 = 0; d0 < 4; ++d0) p1 = __builtin_amdgcn_mfma_f32_32x32x16_bf16(*reinterpret_cast<const bf16x8*>(kb + d0 * 2048), qr[d0], p1, 0, 0, 0);
            const float base = slope2 * (float)(96 + 4 * hi);
            float x[8];
#pragma unroll
            for (int r = 0; r < 8; ++r) x[r] = p1[8 + r] + __builtin_fmaf(slope2, (float)(((8 + r) & 3) + 8 * ((8 + r) >> 2)), base);
            float rm = MX3(MX3(x[0], x[1], x[2]), MX3(x[3], x[4], x[5]), __builtin_fmaxf(x[6], x[7]));
            { auto rr = __builtin_amdgcn_permlane32_swap(__float_as_uint(rm), __float_as_uint(rm), false, false); rm = __builtin_fmaxf(__uint_as_float(rr[0]), __uint_as_float(rr[1])); }
            SWA_RESCALE(rm, _Pragma("unroll") for (int r = 0; r < 8; ++r) x[r] -= dl);
            float sacc = 0.f;
#pragma unroll
            for (int r = 0; r < 8; ++r) { x[r] = __builtin_amdgcn_exp2f(x[r]); sacc += x[r]; }
            l_reg += sacc;
            const u32x4 pw3 = (u32x4){cvtpk_s(x[0], x[1]), cvtpk_s(x[2], x[3]), cvtpk_s(x[4], x[5]), cvtpk_s(x[6], x[7])};
            const int vb = vb0 + slot * SLOTB;
#pragma unroll
            for (int d0 = 0; d0 < 2; ++d0) { s16x4 lo, hh;
                asm volatile("ds_read_b64_tr_b16 %0,%1 offset:%c2" : "=&v"(lo) : "v"(vb), "i"(d0 * 4096 + 3 * 1024) : "memory");
                asm volatile("ds_read_b64_tr_b16 %0,%1 offset:%c2" : "=&v"(hh) : "v"(vb), "i"(d0 * 4096 + 3 * 1024 + 512) : "memory");
                asm volatile("s_waitcnt lgkmcnt(0)" ::: "memory"); SBAR();
                o[d0] = __builtin_amdgcn_mfma_f32_32x32x16_bf16(__builtin_bit_cast(bf16x8, pw3), (bf16x8){lo[0], lo[1], lo[2], lo[3], hh[0], hh[1], hh[2], hh[3]}, o[d0], 0, 0, 0); }
            continue;
        }
        const int dmin = qpos0 - (kr0 + 63), dmax = qpos0 + 31 - kr0;
        if (dmax < 0 || dmin >= 128 || kr0 + 63 < KR_REAL) continue;
        f32x16 negm; { const float nm = rowterm - mhat;
#pragma unroll
            for (int r = 0; r < 16; ++r) negm[r] = nm; }
        f32x16 p0, p1;
        qkt(p0, p1, Kslot, qr, negm, r32, hi);
        const float base = slope2 * (float)(kr0 + 4 * hi);
        const int lim = qp - kr0 - 4 * hi;
        if (dmin < 0) {
#pragma unroll
            for (int r = 0; r < 16; ++r) { const int cr = (r & 3) + 8 * (r >> 2);
                p0[r] = (cr <= lim) ? p0[r] + __builtin_fmaf(slope2, (float)cr, base) : -INFINITY; p1[r] = (cr + 32 <= lim) ? p1[r] + __builtin_fmaf(slope2, (float)(cr + 32), base) : -INFINITY; }
        } else if (dmax >= 128) {
#pragma unroll
            for (int r = 0; r < 16; ++r) { const int cr = (r & 3) + 8 * (r >> 2);
                p0[r] = (cr > lim - 128) ? p0[r] + __builtin_fmaf(slope2, (float)cr, base) : -INFINITY; p1[r] = (cr + 32 > lim - 128) ? p1[r] + __builtin_fmaf(slope2, (float)(cr + 32), base) : -INFINITY; }
        } else {
#pragma unroll
            for (int r = 0; r < 16; ++r) { const int cr = (r & 3) + 8 * (r >> 2); p0[r] += __builtin_fmaf(slope2, (float)cr, base); p1[r] += __builtin_fmaf(slope2, (float)(cr + 32), base); }
        }
        const float rm = rowmax(p0, p1);
        SWA_RESCALE(rm, _Pragma("unroll") for (int r = 0; r < 16; ++r) { p0[r] -= dl; p1[r] -= dl; });
        float sacc = 0.f;
#pragma unroll
        for (int r = 0; r < 16; ++r) { p0[r] = __builtin_amdgcn_exp2f(p0[r]); p1[r] = __builtin_amdgcn_exp2f(p1[r]); sacc += p0[r] + p1[r]; }
        l_reg += sacc;
        u32x4 pw0, pw1, pw2, pw3;
        pw0 = (u32x4){cvtpk_s(p0[0], p0[1]), cvtpk_s(p0[2], p0[3]), cvtpk_s(p0[4], p0[5]), cvtpk_s(p0[6], p0[7])};
        pw1 = (u32x4){cvtpk_s(p0[8], p0[9]), cvtpk_s(p0[10], p0[11]), cvtpk_s(p0[12], p0[13]), cvtpk_s(p0[14], p0[15])};
        pw2 = (u32x4){cvtpk_s(p1[0], p1[1]), cvtpk_s(p1[2], p1[3]), cvtpk_s(p1[4], p1[5]), cvtpk_s(p1[6], p1[7])};
        pw3 = (u32x4){cvtpk_s(p1[8], p1[9]), cvtpk_s(p1[10], p1[11]), cvtpk_s(p1[12], p1[13]), cvtpk_s(p1[14], p1[15])};
        SBAR();
        pv(o, vb0 + slot * SLOTB, __builtin_bit_cast(bf16x8, pw0), __builtin_bit_cast(bf16x8, pw1), __builtin_bit_cast(bf16x8, pw2), __builtin_bit_cast(bf16x8, pw3));
    }
    { auto rr = __builtin_amdgcn_permlane32_swap(__float_as_uint(l_reg), __float_as_uint(l_reg), false, false); l_reg = __uint_as_float(rr[0]) + __uint_as_float(rr[1]); }
    if (hi == 0) wsf[32 + r32] = l_reg;
    asm volatile("s_waitcnt lgkmcnt(0)" ::: "memory");
    float rli[16];
#pragma unroll
    for (int r = 0; r < 16; ++r) rli[r] = 1.0f / wsf[32 + crow(r, hi)];
    { __hip_bfloat16* stg = (__hip_bfloat16*)(shm + LDS_OST) + wid * 2048;
#pragma unroll
        for (int r = 0; r < 16; ++r) { const int orow = crow(r, hi);
#pragma unroll
            for (int d0 = 0; d0 < 2; ++d0) stg[orow * 64 + d0 * 32 + r32] = __float2bfloat16(o[d0][r] * rli[r]); }
        asm volatile("s_waitcnt lgkmcnt(0)" ::: "memory");
#pragma unroll
        for (int i = 0; i < 4; ++i) { const int row = i * 8 + (lane >> 3), ch = lane & 7; const u32x4 v = *(const u32x4*)(stg + row * 64 + ch * 8); *(u32x4*)(Ow + (size_t)row * DM + ch * 8) = v; } }
    asm volatile("s_waitcnt lgkmcnt(0)\n\ts_barrier" ::: "memory");
#undef SWA_RESCALE
#undef DMA_KV
#undef TILE_KR0
}

__device__ __forceinline__ void unit_swa2(const bf16_t* Qw, bf16_t* Ow, const bf16_t* Kh, const bf16_t* Vh, int kp, int kbase, int qpos0, float slope2, float sink2, char* shm) {
    const int tid = threadIdx.x; int lane_ = tid & 63; asm volatile("" : "+v"(lane_));
    const int lane = lane_, r32 = lane & 31, hi = lane >> 5; const int wid = __builtin_amdgcn_readfirstlane(tid >> 6);
    const unsigned lds0 = (unsigned)(uintptr_t)shm;
    float* wsf = (float*)(shm + LDS_WS) + wid * 64;
    const bf16_t* ksrc = Kh + (size_t)lane * kp + wid * 8;
    const bf16_t* vsrc = Vh + (size_t)(16 * (wid & 3) + (lane >> 2)) * kp + (wid >> 2) * 32 + (lane & 3) * 8;
    const unsigned kdst = lds0 + LDS_K + wid * 1024, vdst = lds0 + LDS_V + wid * 1024;
#define TILE_KR0(t) ((t) == 0 ? 64 : kbase + 64 * ((t) - 1))
#define DMA_KV(t, slot) do { const size_t ro_ = (size_t)TILE_KR0(t) * kp; \
        glds16(ksrc + ro_, (unsigned)__builtin_amdgcn_readfirstlane(kdst + (slot) * SLOTB)); glds16(vsrc + ro_, (unsigned)__builtin_amdgcn_readfirstlane(vdst + (slot) * SLOTB)); } while (0)
    const int vb0 = (int)(lds0 + LDS_V) + ((lane >> 4) & 1) * 32 + (lane & 3) * 8 + (4 * hi + ((lane & 15) >> 2)) * 64;
#pragma unroll
    for (int t = 0; t < 5; ++t) DMA_KV(t, t);
    bf16x8 qr[4];
#pragma unroll
    for (int d0 = 0; d0 < 4; ++d0) qr[d0] = *reinterpret_cast<const bf16x8*>(Qw + (size_t)r32 * DM + d0 * 16 + hi * 8);
    const int qp = qpos0 + r32;
    const float rowterm = -slope2 * (float)qp;
    const int jb0 = ((qpos0 - kbase - 128) >> 5) >= 2 ? 1 : 0;
    const int krW = kbase + 64 * jb0, krF = krW + 64, krC = krW + 128;
    const bool vW = krW >= KR_REAL, vF = krF >= KR_REAL;
    f32x16 initc;
#pragma unroll
    for (int r = 0; r < 16; ++r) initc[r] = rowterm;
    WAIT_BAR0();
    f32x16 pm = initc;
    { const char* kb = shm + LDS_K + hi * 1024 + r32 * 16 + 512;
#pragma unroll
      for (int d0 = 0; d0 < 4; ++d0) pm = __builtin_amdgcn_mfma_f32_32x32x16_bf16(*reinterpret_cast<const bf16x8*>(kb + d0 * 2048), qr[d0], pm, 0, 0, 0); }
    f32x16 w0, w1, f0, f1, c0, c1;
    if (vW) qkt(w0, w1, shm + LDS_K + (1 + jb0) * SLOTB, qr, initc, r32, hi);
    if (vF) qkt(f0, f1, shm + LDS_K + (2 + jb0) * SLOTB, qr, initc, r32, hi);
    qkt(c0, c1, shm + LDS_K + (3 + jb0) * SLOTB, qr, initc, r32, hi);
    float xm[8];
    { const float base = slope2 * (float)(96 + 4 * hi);
#pragma unroll
      for (int r = 0; r < 8; ++r) xm[r] = pm[8 + r] + __builtin_fmaf(slope2, (float)(((8 + r) & 3) + 8 * ((8 + r) >> 2)), base); }
    if (vW) { const float base = slope2 * (float)(krW + 4 * hi); const int lim = qp - krW - 4 * hi;
#pragma unroll
        for (int r = 0; r < 16; ++r) { const int cr = (r & 3) + 8 * (r >> 2);
            w0[r] = (cr > lim - 128) ? w0[r] + __builtin_fmaf(slope2, (float)cr, base) : -INFINITY; w1[r] = (cr + 32 > lim - 128) ? w1[r] + __builtin_fmaf(slope2, (float)(cr + 32), base) : -INFINITY; }
    } else {
#pragma unroll
        for (int r = 0; r < 16; ++r) { w0[r] = -INFINITY; w1[r] = -INFINITY; } }
    if (vF) { const float base = slope2 * (float)(krF + 4 * hi);
#pragma unroll
        for (int r = 0; r < 16; ++r) { const int cr = (r & 3) + 8 * (r >> 2); f0[r] += __builtin_fmaf(slope2, (float)cr, base); f1[r] += __builtin_fmaf(slope2, (float)(cr + 32), base); }
    } else {
#pragma unroll
        for (int r = 0; r < 16; ++r) { f0[r] = -INFINITY; f1[r] = -INFINITY; } }
    { const float base = slope2 * (float)(krC + 4 * hi); const int lim = qp - krC - 4 * hi;
#pragma unroll
      for (int r = 0; r < 16; ++r) { const int cr = (r & 3) + 8 * (r >> 2);
          c0[r] = (cr <= lim) ? c0[r] + __builtin_fmaf(slope2, (float)cr, base) : -INFINITY; c1[r] = (cr + 32 <= lim) ? c1[r] + __builtin_fmaf(slope2, (float)(cr + 32), base) : -INFINITY; } }
    float m = __builtin_fmaxf(__builtin_fmaxf(rowmax(w0, w1), rowmax(f0, f1)), rowmax(c0, c1));
    { float mm = MX3(MX3(xm[0], xm[1], xm[2]), MX3(xm[3], xm[4], xm[5]), __builtin_fmaxf(xm[6], xm[7]));
      auto rr = __builtin_amdgcn_permlane32_swap(__float_as_uint(mm), __float_as_uint(mm), false, false); mm = __builtin_fmaxf(__uint_as_float(rr[0]), __uint_as_float(rr[1]));
      m = __builtin_fmaxf(__builtin_fmaxf(m, mm), sink2); }
    f32x16 o[2]; o[0] = f32x16{}; o[1] = f32x16{};
    float l_reg = (hi == 0) ? __builtin_amdgcn_exp2f(sink2 - m) : 0.f;
    { float sacc = 0.f;
#pragma unroll
      for (int r = 0; r < 8; ++r) { xm[r] = __builtin_amdgcn_exp2f(xm[r] - m); sacc += xm[r]; }
      l_reg += sacc;
      const u32x4 pw3 = (u32x4){cvtpk_s(xm[0], xm[1]), cvtpk_s(xm[2], xm[3]), cvtpk_s(xm[4], xm[5]), cvtpk_s(xm[6], xm[7])};
#pragma unroll
      for (int d0 = 0; d0 < 2; ++d0) { s16x4 lo, hh;
          asm volatile("ds_read_b64_tr_b16 %0,%1 offset:%c2" : "=&v"(lo) : "v"(vb0), "i"(d0 * 4096 + 3 * 1024) : "memory");
          asm volatile("ds_read_b64_tr_b16 %0,%1 offset:%c2" : "=&v"(hh) : "v"(vb0), "i"(d0 * 4096 + 3 * 1024 + 512) : "memory");
          asm volatile("s_waitcnt lgkmcnt(0)" ::: "memory"); SBAR();
          o[d0] = __builtin_amdgcn_mfma_f32_32x32x16_bf16(__builtin_bit_cast(bf16x8, pw3), (bf16x8){lo[0], lo[1], lo[2], lo[3], hh[0], hh[1], hh[2], hh[3]}, o[d0], 0, 0, 0); } }
#define SWA2_TILE(P0, P1, SLOT) do { float sacc = 0.f; \
        _Pragma("unroll") for (int r = 0; r < 16; ++r) { P0[r] = __builtin_amdgcn_exp2f(P0[r] - m); P1[r] = __builtin_amdgcn_exp2f(P1[r] - m); sacc += P0[r] + P1[r]; } \
        l_reg += sacc; \
        const u32x4 q0_ = (u32x4){cvtpk_s(P0[0], P0[1]), cvtpk_s(P0[2], P0[3]), cvtpk_s(P0[4], P0[5]), cvtpk_s(P0[6], P0[7])}; \
        const u32x4 q1_ = (u32x4){cvtpk_s(P0[8], P0[9]), cvtpk_s(P0[10], P0[11]), cvtpk_s(P0[12], P0[13]), cvtpk_s(P0[14], P0[15])}; \
        const u32x4 q2_ = (u32x4){cvtpk_s(P1[0], P1[1]), cvtpk_s(P1[2], P1[3]), cvtpk_s(P1[4], P1[5]), cvtpk_s(P1[6], P1[7])}; \
        const u32x4 q3_ = (u32x4){cvtpk_s(P1[8], P1[9]), cvtpk_s(P1[10], P1[11]), cvtpk_s(P1[12], P1[13]), cvtpk_s(P1[14], P1[15])}; \
        SBAR(); pv(o, vb0 + (SLOT) * SLOTB, __builtin_bit_cast(bf16x8, q0_), __builtin_bit_cast(bf16x8, q1_), __builtin_bit_cast(bf16x8, q2_), __builtin_bit_cast(bf16x8, q3_)); } while (0)
    if (vW) SWA2_TILE(w0, w1, 1 + jb0);
    if (vF) SWA2_TILE(f0, f1, 2 + jb0);
    SWA2_TILE(c0, c1, 3 + jb0);
#undef SWA2_TILE
    { auto rr = __builtin_amdgcn_permlane32_swap(__float_as_uint(l_reg), __float_as_uint(l_reg), false, false); l_reg = __uint_as_float(rr[0]) + __uint_as_float(rr[1]); }
    if (hi == 0) wsf[32 + r32] = l_reg;
    asm volatile("s_waitcnt lgkmcnt(0)" ::: "memory");
    float rli[16];
#pragma unroll
    for (int r = 0; r < 16; ++r) rli[r] = 1.0f / wsf[32 + crow(r, hi)];
    { __hip_bfloat16* stg = (__hip_bfloat16*)(shm + LDS_OST) + wid * 2048;
#pragma unroll
        for (int r = 0; r < 16; ++r) { const int orow = crow(r, hi);
#pragma unroll
            for (int d0 = 0; d0 < 2; ++d0) stg[orow * 64 + d0 * 32 + r32] = __float2bfloat16(o[d0][r] * rli[r]); }
        asm volatile("s_waitcnt lgkmcnt(0)" ::: "memory");
#pragma unroll
        for (int i = 0; i < 4; ++i) { const int row = i * 8 + (lane >> 3), ch = lane & 7; const u32x4 v = *(const u32x4*)(stg + row * 64 + ch * 8); *(u32x4*)(Ow + (size_t)row * DM + ch * 8) = v; } }
    asm volatile("s_waitcnt lgkmcnt(0)\n\ts_barrier" ::: "memory");
#undef DMA_KV
#undef TILE_KR0
}
#undef WAIT_BAR0
#undef SBAR
#undef MX3
}

namespace attn2 {
using bf16=__hip_bfloat16;
__device__ __forceinline__ int crow(int r,int hi){return (r&3)+8*(r>>2)+4*hi;}
#define SBAR() __builtin_amdgcn_sched_barrier(0)
__device__ __forceinline__ void cmask(f32x16&p0,f32x16&p1,int jb,int qrel,int hi){
  const float NEG=-INFINITY; int kb=64*jb+4*hi;
  #pragma unroll
  for(int r=0;r<16;++r){int kv=kb+(r&3)+8*(r>>2); if(kv>qrel)p0[r]=NEG; if(kv+32>qrel)p1[r]=NEG;}
}

constexpr int NSLOT=3, SLOTB=8192;
constexpr int NW=8;
constexpr int LDS_K=0, LDS_V=NSLOT*SLOTB, LDS_WS=2*NSLOT*SLOTB, LDS_OST=LDS_WS+NW*64*4, LDS_CL=LDS_OST+NW*4096, LDS_SCAN=LDS_CL+2064*4+64, LDS_END=LDS_SCAN+192;
__device__ __forceinline__ void glds16(const void*gsrc,unsigned lds_dst){unsigned keep;
  asm volatile("s_mov_b32 %0, m0\n\ts_mov_b32 m0, %2\n\ts_nop 0\n\tglobal_load_lds_dwordx4 %1, off\n\ts_mov_b32 m0, %0":"=&s"(keep):"v"(gsrc),"s"(lds_dst):"memory");}
__device__ __forceinline__ float max3f(float a,float b,float c){float r;asm("v_max3_f32 %0, %1, %2, %3":"=v"(r):"v"(a),"v"(b),"v"(c));return r;}
__device__ __forceinline__ float max2f(float a,float b){float r;asm("v_max_f32_e32 %0, %1, %2":"=v"(r):"v"(a),"v"(b));return r;}
__device__ __forceinline__ float fadd_s(float a,float b){float r;asm("v_add_f32_e32 %0, %1, %2":"=v"(r):"v"(a),"v"(b));return r;}
__device__ __forceinline__ float fsub_s(float a,float b){float r;asm("v_sub_f32_e32 %0, %1, %2":"=v"(r):"v"(a),"v"(b));return r;}
typedef float f32x2_t __attribute__((ext_vector_type(2))); typedef __bf16 bf16x2_t __attribute__((ext_vector_type(2)));
__device__ __forceinline__ unsigned cvtpk_s(float lo,float hi){f32x2_t v={lo,hi};bf16x2_t b=__builtin_convertvector(v,bf16x2_t);return __builtin_bit_cast(unsigned,b);}
#define WAIT_BAR(N) asm volatile("s_waitcnt vmcnt(" #N ") lgkmcnt(0)\n\ts_barrier":::"memory")

__device__ __forceinline__ void qkt(f32x16&p0,f32x16&p1,const char*Kslot,const bf16x8*qr,const f32x16&negm,int r32,int hi){
  const char*kb=Kslot+hi*1024+r32*16;
  #pragma unroll
  for(int d0=0;d0<4;++d0){
    const bf16x8 b0=*reinterpret_cast<const bf16x8*>(kb+d0*2048);
    const bf16x8 b1=*reinterpret_cast<const bf16x8*>(kb+d0*2048+512);
    if(d0==0){p0=__builtin_amdgcn_mfma_f32_32x32x16_bf16(b0,qr[0],negm,0,0,0);p1=__builtin_amdgcn_mfma_f32_32x32x16_bf16(b1,qr[0],negm,0,0,0);}
    else{p0=__builtin_amdgcn_mfma_f32_32x32x16_bf16(b0,qr[d0],p0,0,0,0);p1=__builtin_amdgcn_mfma_f32_32x32x16_bf16(b1,qr[d0],p1,0,0,0);}}
}
typedef __attribute__((address_space(3))) const char* lds_cptr;
typedef short v4i16_t __attribute__((ext_vector_type(4)));
__device__ __forceinline__ void kload8(bf16x8*kf,lds_cptr kp){
  kf[0]=*(const __attribute__((address_space(3))) bf16x8*)(kp);      kf[1]=*(const __attribute__((address_space(3))) bf16x8*)(kp+512);
  kf[2]=*(const __attribute__((address_space(3))) bf16x8*)(kp+2048); kf[3]=*(const __attribute__((address_space(3))) bf16x8*)(kp+2560);
  kf[4]=*(const __attribute__((address_space(3))) bf16x8*)(kp+4096); kf[5]=*(const __attribute__((address_space(3))) bf16x8*)(kp+4608);
  kf[6]=*(const __attribute__((address_space(3))) bf16x8*)(kp+6144); kf[7]=*(const __attribute__((address_space(3))) bf16x8*)(kp+6656);
}
__device__ __forceinline__ void kload2(bf16x8*kf,lds_cptr kp,int j){ kf[2*j]=*(const __attribute__((address_space(3))) bf16x8*)(kp+j*2048); kf[2*j+1]=*(const __attribute__((address_space(3))) bf16x8*)(kp+j*2048+512); }
__device__ __forceinline__ s16x4 vtr(lds_cptr p){ return __builtin_bit_cast(s16x4,__builtin_amdgcn_ds_read_tr16_b64_v4i16((__attribute__((address_space(3))) v4i16_t*)p)); }
__device__ __forceinline__ float rowmax(const f32x16&p0,const f32x16&p1){
  float a=max3f(p0[0],p0[1],p1[0]),b=max3f(p0[2],p0[3],p1[1]);a=max3f(a,p1[2],p1[3]);
  #pragma unroll
  for(int r=4;r<16;r+=4){a=max3f(a,p0[r],p0[r+1]);b=max3f(b,p0[r+2],p0[r+3]);a=max3f(a,p1[r],p1[r+1]);b=max3f(b,p1[r+2],p1[r+3]);}
  const float m=max2f(a,b);
  auto rr=__builtin_amdgcn_permlane32_swap(__float_as_uint(m),__float_as_uint(m),false,false);
  return max2f(__uint_as_float(rr[0]),__uint_as_float(rr[1]));
}
__device__ __forceinline__ void pv(f32x16*o,int vb,bf16x8 pa0,bf16x8 pa1,bf16x8 pa2,bf16x8 pa3){
  #pragma unroll
  for(int d0=0;d0<2;++d0){s16x4 lo[4],hi[4];
    #pragma unroll
    for(int ks=0;ks<4;++ks){
      asm volatile("ds_read_b64_tr_b16 %0,%1 offset:%c2":"=&v"(lo[ks]):"v"(vb),"i"(d0*4096+ks*1024):"memory");
      asm volatile("ds_read_b64_tr_b16 %0,%1 offset:%c2":"=&v"(hi[ks]):"v"(vb),"i"(d0*4096+ks*1024+512):"memory");}
    asm volatile("s_waitcnt lgkmcnt(0)":::"memory");SBAR();
    #define PK(k) (bf16x8){lo[k][0],lo[k][1],lo[k][2],lo[k][3],hi[k][0],hi[k][1],hi[k][2],hi[k][3]}
    o[d0]=__builtin_amdgcn_mfma_f32_32x32x16_bf16(pa0,PK(0),o[d0],0,0,0);
    o[d0]=__builtin_amdgcn_mfma_f32_32x32x16_bf16(pa1,PK(1),o[d0],0,0,0);
    o[d0]=__builtin_amdgcn_mfma_f32_32x32x16_bf16(pa2,PK(2),o[d0],0,0,0);
    o[d0]=__builtin_amdgcn_mfma_f32_32x32x16_bf16(pa3,PK(3),o[d0],0,0,0);
    #undef PK
  }
}


__device__ __forceinline__ void amask(f32x16&p0,f32x16&p1,int kr0,int qp,float slope2,int hi){
  asm volatile("":"+v"(slope2));
  const float base=slope2*(float)(kr0+4*hi); const int d0=qp-kr0-4*hi;
  #pragma unroll
  for(int r=0;r<16;++r){ const int cr=(r&3)+8*(r>>2); const int da=d0-cr, db=da-32;
    const bool ok0=((unsigned)da<128u)&&(qp-da>=KR_REAL), ok1=((unsigned)db<128u)&&(qp-db>=KR_REAL);
    p0[r]=ok0?p0[r]+__builtin_fmaf(slope2,(float)cr,base):-INFINITY; p1[r]=ok1?p1[r]+__builtin_fmaf(slope2,(float)(cr+32),base):-INFINITY; }
}
template<int MODE,int THRL> __device__ __forceinline__ void unit2(const bf16*Qw,bf16*Ow,const bf16*__restrict__ Kh,const bf16*__restrict__ Vh,int kp,int NT,int row0,int kbase,int qpos0,int qrel0,float slope2,float sink2,const float*cl,char*shm){
  const int tid=threadIdx.x; int lane_=tid&63; asm volatile("":"+v"(lane_));
  const int lane=lane_,r32=lane&31,hi=lane>>5; const int wid=__builtin_amdgcn_readfirstlane(tid>>6);
  const unsigned lds0=(unsigned)(uintptr_t)shm;
  float*wsf=(float*)(shm+LDS_WS)+wid*64;
  const bf16*ksrc=Kh+(long)lane*kp+wid*8;
  const bf16*vsrc=Vh+(long)(16*(wid&3)+(lane>>2))*kp+(wid>>2)*32+(lane&3)*8;
  const unsigned kdst=lds0+LDS_K+wid*1024, vdst=lds0+LDS_V+wid*1024;
  #define TROW(t) ((t)==0?row0:kbase+64*((t)-1))
  #define DMA_K(t,slot) glds16(ksrc+(long)TROW(t)*kp,(unsigned)__builtin_amdgcn_readfirstlane(kdst+(slot)))
  #define DMA_V(t,slot) glds16(vsrc+(long)TROW(t)*kp,(unsigned)__builtin_amdgcn_readfirstlane(vdst+(slot)))
  const int vb0=(int)(lds0+LDS_V)+((lane>>4)&1)*32+(lane&3)*8+(4*hi+((lane&15)>>2))*64;
  const char*Kbase=shm+LDS_K; bf16x8 kf[8];
  const lds_cptr shm3=(lds_cptr)shm; const lds_cptr kp0=shm3+LDS_K+hi*1024+r32*16; const lds_cptr vp0=shm3+LDS_V+((lane>>4)&1)*32+(lane&3)*8+(4*hi+((lane&15)>>2))*64;
  DMA_K(0,0);DMA_V(0,0);DMA_K(1,SLOTB);
  bf16x8 qr[4];
  #pragma unroll
  for(int d0=0;d0<4;++d0)qr[d0]=*reinterpret_cast<const bf16x8*>(&Qw[(long)r32*DM+d0*16+hi*8]);
  const int qrel=qrel0+r32, qp=qpos0+r32;
  const float rowterm=(MODE==0)?cl[qp-KR_META]:-slope2*(float)qp;
  float mhat=(MODE==0)?0.f:sink2,l_reg=(MODE==1&&hi==0)?1.f:0.f;f32x16 o[2];o[0]=f32x16{};o[1]=f32x16{};f32x16 negm;
  { const float nm_=rowterm-mhat; _Pragma("unroll") for(int r=0;r<16;++r)negm[r]=nm_; } asm volatile("":"+v"(negm));
  #define POST(C0,C1,t,MK) do{ if(MODE==0){ const float*clt_=cl+(TROW(t)-KR_META)+4*hi; \
      _Pragma("unroll") for(int g_=0;g_<4;++g_){ const f32x4 a_=*(const f32x4*)(clt_+8*g_), b_=*(const f32x4*)(clt_+32+8*g_); \
        _Pragma("unroll") for(int e_=0;e_<4;++e_){ C0[4*g_+e_]-=a_[e_]; C1[4*g_+e_]-=b_[e_]; } SBAR(); } \
      if(MK) cmask(C0,C1,(t)-(NT-4),qrel,hi); } \
    else { amask(C0,C1,TROW(t),qp,slope2,hi); } }while(0)
  #define POST0(P0,P1) do{ _Pragma("unroll") for(int r=0;r<16;++r)P0[r]=-INFINITY; _Pragma("unroll") for(int r=0;r<8;++r)P1[r]=-INFINITY; \
    if(MODE==0){ const f32x4 a_=*(const f32x4*)(cl+4*hi), b_=*(const f32x4*)(cl+8+4*hi); _Pragma("unroll") for(int e_=0;e_<4;++e_){ P1[8+e_]-=a_[e_]; P1[12+e_]-=b_[e_]; } } \
    else { _Pragma("unroll") for(int r=8;r<16;++r)P1[r]+=slope2*(float)(96+crow(r,hi)); } }while(0)
  bool resc=false;
  #define START(P0,P1) do{ const float rm=rowmax(P0,P1); resc=false; \
    { const float dl=(MODE==0)?rm:__builtin_fmaxf(rm,0.f); mhat=fadd_s(mhat,dl); \
      _Pragma("unroll") for(int r=0;r<16;++r){P0[r]=fsub_s(P0[r],dl);P1[r]=fsub_s(P1[r],dl);} \
      { const float nm_=rowterm-mhat; _Pragma("unroll") for(int r=0;r<16;++r)negm[r]=nm_; } asm volatile("":"+v"(negm)); \
      if(MODE==1) l_reg*=__builtin_amdgcn_exp2f(-dl); } \
    _Pragma("unroll") for(int r=0;r<16;++r)P0[r]=__builtin_amdgcn_exp2f(P0[r]); }while(0)
  #define RESC() do{ if(resc){ asm volatile("s_waitcnt lgkmcnt(0)":::"memory"); \
      _Pragma("unroll") for(int d_=0;d_<2;++d_) _Pragma("unroll") for(int r=0;r<16;++r)o[d_][r]*=wsf[crow(r,hi)]; } }while(0)
  f32x16 pA0,pA1,pB0,pB1;
  int sl_prev=0,sl_cur=0,sl_next=SLOTB;
  #define ROT() do{sl_prev=sl_cur;sl_cur=sl_next;sl_next=(sl_next==(NSLOT-1)*SLOTB)?0:sl_next+SLOTB;}while(0)
  DMA_K(2,2*SLOTB);
  WAIT_BAR(3);
  qkt(pA0,pA1,Kbase,qr,negm,r32,hi);asm volatile("s_nop 15\n\ts_nop 7":"+v"(pA0),"+v"(pA1));if(row0==64){POST0(pA0,pA1);}else{POST(pA0,pA1,0,false);}
  START(pA0,pA1);
  _Pragma("unroll") for(int r=0;r<16;++r)pA1[r]=__builtin_amdgcn_exp2f(pA1[r]);
  WAIT_BAR(0);
  DMA_K(3,0);DMA_V(1,SLOTB);
  ROT();
  kload8(kf,kp0+sl_cur);
  WAIT_BAR(2);
  s16x4 vlo[8],vhi[8]; u32x4 pw0,pw1,pw2,pw3;
  #define PKW(P,B) cvtpk_s(P[B],P[B+1])
  #define PAF(k) __builtin_bit_cast(bf16x8,pw##k)
  #define VFR(i) (bf16x8){vlo[i][0],vlo[i][1],vlo[i][2],vlo[i][3],vhi[i][0],vhi[i][1],vhi[i][2],vhi[i][3]}
  #define PIN(x) asm volatile("":"+v"(x))
  #define MX3(a,b,c) __builtin_fmaxf(__builtin_fmaxf((a),(b)),(c))
  #define GAPA(MF,A0,A1,A2,A3,W0,W1,PW) do{ MF; sacc+=A0; sacc+=A1; sacc+=A2; sacc+=A3; PIN(sacc); W0; W1; PIN(PW); SBAR(); }while(0)
  #define EX(v) __builtin_amdgcn_exp2f(v)
  #define GAPB(MF,X,B) do{ MF; X[B]=EX(X[B]); X[B+1]=EX(X[B+1]); X[B+2]=EX(X[B+2]); X[B+3]=EX(X[B+3]); PIN(X); SBAR(); }while(0)
  #define VRD(i) do{ vlo[i]=vtr(vp_+(((i)>>2)*4096+((i)&3)*1024)); vhi[i]=vtr(vp_+(((i)>>2)*4096+((i)&3)*1024+512)); }while(0)
  #define KRD(G,j) do{ if(G){ kload2(kf,kp0+sl_next,j); SBAR(); } }while(0)
  #define STEP(C0,C1,P0,P1,t,GK,GV,GL,MK) do{ SBAR(); \
    const lds_cptr vp_=vp0+sl_prev; \
    VRD(0); SBAR(); float sacc=(P0[0]+P0[1]); \
    GAPA(C0=__builtin_amdgcn_mfma_f32_32x32x16_bf16(kf[0],qr[0],negm,0,0,0), P0[2],P0[3],P0[4],P0[5],     pw0[0]=PKW(P0,0), pw0[1]=PKW(P0,2), pw0); \
    VRD(4); SBAR(); GAPA(C1=__builtin_amdgcn_mfma_f32_32x32x16_bf16(kf[1],qr[0],negm,0,0,0), P0[6],P0[7],P0[8],P0[9],     pw0[2]=PKW(P0,4), pw0[3]=PKW(P0,6), pw0); \
    VRD(1); SBAR(); GAPA(C0=__builtin_amdgcn_mfma_f32_32x32x16_bf16(kf[2],qr[1],C0,0,0,0),   P0[10],P0[11],P0[12],P0[13], pw1[0]=PKW(P0,8), pw1[1]=PKW(P0,10), pw1); \
    VRD(5); SBAR(); GAPA(C1=__builtin_amdgcn_mfma_f32_32x32x16_bf16(kf[3],qr[1],C1,0,0,0),   P0[14],P0[15],P1[0],P1[1],   pw1[2]=PKW(P0,12),pw1[3]=PKW(P0,14), pw1); \
    VRD(2); SBAR(); GAPA(C0=__builtin_amdgcn_mfma_f32_32x32x16_bf16(kf[4],qr[2],C0,0,0,0),   P1[2],P1[3],P1[4],P1[5],     pw2[0]=PKW(P1,0), pw2[1]=PKW(P1,2), pw2); \
    VRD(6); SBAR(); GAPA(C1=__builtin_amdgcn_mfma_f32_32x32x16_bf16(kf[5],qr[2],C1,0,0,0),   P1[6],P1[7],P1[8],P1[9],     pw2[2]=PKW(P1,4), pw2[3]=PKW(P1,6), pw2); \
    VRD(3); SBAR(); GAPA(C0=__builtin_amdgcn_mfma_f32_32x32x16_bf16(kf[6],qr[3],C0,0,0,0),   P1[10],P1[11],P1[12],P1[13], pw3[0]=PKW(P1,8), pw3[1]=PKW(P1,10), pw3); \
    VRD(7); SBAR(); GAPA(C1=__builtin_amdgcn_mfma_f32_32x32x16_bf16(kf[7],qr[3],C1,0,0,0),   P1[14],P1[15],0.f,0.f,       pw3[2]=PKW(P1,12),pw3[3]=PKW(P1,14), pw3); \
    l_reg+=sacc; \
    if(GK){DMA_K((t)+3,sl_cur);} if(GV){DMA_V((t)+1,sl_next);} \
    POST(C0,C1,t,MK); \
    { float a=MX3(C0[0],C0[1],C1[0]),b=MX3(C0[2],C0[3],C1[1]); a=MX3(a,C1[2],C1[3]); \
      _Pragma("unroll") for(int r=4;r<16;r+=4){a=MX3(a,C0[r],C0[r+1]);b=MX3(b,C0[r+2],C0[r+3]);a=MX3(a,C1[r],C1[r+1]);b=MX3(b,C1[r+2],C1[r+3]);} \
      float rm=__builtin_fmaxf(a,b); { auto rr=__builtin_amdgcn_permlane32_swap(__float_as_uint(rm),__float_as_uint(rm),false,false); rm=__builtin_fmaxf(__uint_as_float(rr[0]),__uint_as_float(rr[1])); } \
      resc=false; \
      if(__builtin_expect(__any(rm>(float)THRL),0)){ const float dl=__builtin_fmaxf(rm,0.f); mhat+=dl; \
        _Pragma("unroll") for(int r=0;r<16;++r){C0[r]-=dl;C1[r]-=dl;} \
        { const float nm_=rowterm-mhat; _Pragma("unroll") for(int r=0;r<16;++r)negm[r]=nm_; } asm volatile("":"+v"(negm)); \
        const float f=__builtin_amdgcn_exp2f(-dl); l_reg*=f; if(hi==0)wsf[r32]=f; resc=true; } } \
    SBAR(); \
    GAPB(o[0]=__builtin_amdgcn_mfma_f32_32x32x16_bf16(PAF(0),VFR(0),o[0],0,0,0), C0,0); \
    GAPB(o[1]=__builtin_amdgcn_mfma_f32_32x32x16_bf16(PAF(0),VFR(4),o[1],0,0,0), C0,4); \
    KRD(GL,0); GAPB(o[0]=__builtin_amdgcn_mfma_f32_32x32x16_bf16(PAF(1),VFR(1),o[0],0,0,0), C0,8); \
    KRD(GL,1); GAPB(o[1]=__builtin_amdgcn_mfma_f32_32x32x16_bf16(PAF(1),VFR(5),o[1],0,0,0), C0,12); \
    KRD(GL,2); GAPB(o[0]=__builtin_amdgcn_mfma_f32_32x32x16_bf16(PAF(2),VFR(2),o[0],0,0,0), C1,0); \
    KRD(GL,3); GAPB(o[1]=__builtin_amdgcn_mfma_f32_32x32x16_bf16(PAF(2),VFR(6),o[1],0,0,0), C1,4); \
    GAPB(o[0]=__builtin_amdgcn_mfma_f32_32x32x16_bf16(PAF(3),VFR(3),o[0],0,0,0), C1,8); \
    GAPB(o[1]=__builtin_amdgcn_mfma_f32_32x32x16_bf16(PAF(3),VFR(7),o[1],0,0,0), C1,12); \
    }while(0)
  int t=1;
  for(;t<NT-4;t+=2){
    STEP(pB0,pB1,pA0,pA1,t,true,true,true,false);     WAIT_BAR(2); RESC(); ROT();
    STEP(pA0,pA1,pB0,pB1,t+1,true,true,true,false);   WAIT_BAR(2); RESC(); ROT();
  }
  STEP(pB0,pB1,pA0,pA1,NT-4,true,true,true,true);     WAIT_BAR(2); RESC(); ROT();
  STEP(pA0,pA1,pB0,pB1,NT-3,false,true,true,true);    WAIT_BAR(1); RESC(); ROT();
  STEP(pB0,pB1,pA0,pA1,NT-2,false,true,true,true);    WAIT_BAR(0); RESC(); ROT();
  STEP(pA0,pA1,pB0,pB1,NT-1,false,false,false,true);  RESC();
  { float sacc=pA0[0]+pA0[1]; _Pragma("unroll") for(int r=2;r<16;++r)sacc+=pA0[r]; _Pragma("unroll") for(int r=0;r<16;++r)sacc+=pA1[r]; l_reg+=sacc;
    pw0=(u32x4){PKW(pA0,0),PKW(pA0,2),PKW(pA0,4),PKW(pA0,6)};pw1=(u32x4){PKW(pA0,8),PKW(pA0,10),PKW(pA0,12),PKW(pA0,14)};pw2=(u32x4){PKW(pA1,0),PKW(pA1,2),PKW(pA1,4),PKW(pA1,6)};pw3=(u32x4){PKW(pA1,8),PKW(pA1,10),PKW(pA1,12),PKW(pA1,14)};
    SBAR(); pv(o,vb0+sl_cur,PAF(0),PAF(1),PAF(2),PAF(3)); }
  #undef PKW
  #undef PAF
  #undef VFR
  #undef PIN
  #undef MX3
  #undef GAPA
  #undef GAPB
  #undef EX
  #undef VRD
  #undef KRD
  #undef STEP
  {auto rr=__builtin_amdgcn_permlane32_swap(__float_as_uint(l_reg),__float_as_uint(l_reg),false,false);l_reg=__uint_as_float(rr[0])+__uint_as_float(rr[1]);}
  if(hi==0)wsf[32+r32]=l_reg;asm volatile("s_waitcnt lgkmcnt(0)":::"memory");
  float rli[16];
  #pragma unroll
  for(int r=0;r<16;++r)rli[r]=__builtin_amdgcn_rcpf(wsf[32+crow(r,hi)]);
  { bf16*stg=(bf16*)(shm+LDS_OST)+wid*2048;
    #pragma unroll
    for(int r=0;r<16;++r){const int orow=crow(r,hi);
      #pragma unroll
      for(int d0=0;d0<2;++d0)stg[orow*64+d0*32+r32]=__float2bfloat16(o[d0][r]*rli[r]);}
    asm volatile("s_waitcnt lgkmcnt(0)":::"memory");
    #pragma unroll
    for(int i=0;i<4;++i){const int row=i*8+(lane>>3),ch=lane&7; const u32x4 v=*(const u32x4*)(stg+row*64+ch*8); *(u32x4*)(Ow+(long)row*DM+ch*8)=v;} }
  asm volatile("s_waitcnt lgkmcnt(0)\n\ts_barrier":::"memory");
  #undef DMA_K
  #undef DMA_V
  #undef POST
  #undef POST0
  #undef TROW
  #undef START
  #undef RESC
  #undef ROT
}

#undef SBAR
#undef WAIT_BAR
}

constexpr int NWAVES = 8;
#ifndef MK_N_LAUNCHES
#define MK_N_LAUNCHES 1
#endif
constexpr int N_PHASES = 9;
constexpr int N_LAUNCHES = MK_N_LAUNCHES;

constexpr size_t MiB = 1u << 20;
constexpr size_t WS_CTL = 0, CTL_ZERO_BYTES = 64 * 1024;
constexpr size_t WS_SSQ = 2 * MiB;
constexpr size_t WS_META = 10 * MiB;
constexpr size_t WS_LOGF = 11 * MiB;
constexpr size_t WS_QN2 = 4 * MiB, WS_KN2 = 6 * MiB;
static_assert(WS_QN2 + (size_t)MROWS * 64 <= WS_KN2 && WS_KN2 + (size_t)NKR * 64 <= WS_META, "norm partials map");
constexpr size_t WS_W1 = 16 * MiB, WS_W2 = 27 * MiB, WS_WP = 33 * MiB, WS_WAB = 42 * MiB, WS_WO = 44 * MiB, WS_W3 = 46 * MiB, WS_W4 = 57 * MiB;
constexpr size_t WS_XB = 64 * MiB;
constexpr size_t WS_R = 128 * MiB;
constexpr size_t WS_ACT = WS_R;
constexpr size_t WS_QO = WS_R, WS_KA = WS_R + 64 * MiB, WS_VA = WS_KA + 9 * MiB, WS_KB = WS_VA + 9 * MiB, WS_VB = WS_KB + 34 * MiB,
                 WS_SGA = WS_VB + 34 * MiB, WS_SGB = WS_SGA + 64 * MiB, WS_MIX = WS_SGB + 64 * MiB, WS_END = WS_MIX + 64 * MiB;
static_assert(WS_W1 + (size_t)2 * DFF * DM * 2 <= WS_W2 && WS_W2 + (size_t)DM * DFF * 2 <= WS_WP && WS_WP + (size_t)NPROJ * DM * 2 <= WS_WAB && WS_W3 + (size_t)2 * DFF * DM * 2 <= WS_W4 && WS_W4 + (size_t)DM * DFF * 2 <= WS_XB, "weights map");
static_assert((size_t)NKR * 128 * 2 <= 9 * MiB && (size_t)NKR * 512 * 2 <= 34 * MiB && (size_t)NKR * 8 * 4 <= 2 * MiB && WS_END <= 512 * MiB && WS_ACT + (size_t)MROWS * DFF * 2 <= WS_END, "activation map");
constexpr size_t MT_XB = 0, MT_SSQ0 = 32768, MT_ACT = 65536, MT_H1B = 163840, MT_SSQ1 = 196608, MT_KNM = 204800;
constexpr int CW_BAR = 4096;
constexpr int CW_PANEL = 8192;
static_assert((CW_PANEL + 64 * 128) * 4 <= (int)CTL_ZERO_BYTES, "control words inside the per-call memset");

constexpr int RING_OFF = 0, RING_BYTES = 131072;
constexpr int LDSCTL_OFF = RING_BYTES, MISC_OFF = LDSCTL_OFF + 320;
constexpr int LDS_BYTES = 147456;
static_assert(MISC_OFF + 128 <= LDS_BYTES && attn::LDS_END <= RING_BYTES && attn2::LDS_END <= RING_BYTES, "LDS map");

typedef GAS unsigned gu32;
#define RLX_AGENT __ATOMIC_RELAXED, __HIP_MEMORY_SCOPE_AGENT
#define LDS_WAIT() asm volatile("s_waitcnt lgkmcnt(0)" ::: "memory")
#define VM_WAIT() asm volatile("s_waitcnt vmcnt(0)" ::: "memory")
#define XB_TMO      128
#define XB_XCNT(j)  (256  + 64 * (j))
#define XB_XSUB(j)  (1280 + 64 * (j))
#define XB_XGEN(j)  (2304 + 64 * (j))
#define XB_TOP      3328
#define XB_TOPGEN   3392
#define XB_LSUB(j)  (3456 + 16 * (j))
#define XB_LGEN(j)  (3712 + 16 * (j))
#define XCD_BAR_WORDS 3968
#define XB_SPIN_CAP (1u << 18)

__device__ __forceinline__ unsigned xb_ld(unsigned* p)              { return __hip_atomic_load(p, __ATOMIC_RELAXED, __HIP_MEMORY_SCOPE_AGENT); }
__device__ __forceinline__ unsigned xb_add(unsigned* p, unsigned v) { return __hip_atomic_fetch_add(p, v, __ATOMIC_RELAXED, __HIP_MEMORY_SCOPE_AGENT); }
__device__ __forceinline__ unsigned xb_xcc_id() { return (unsigned)__builtin_amdgcn_s_getreg((3 << 11) | 20) & 0xFu; }
#define XB_SPIN(cond, bar) do { unsigned _sp = 0; while (cond) { __builtin_amdgcn_s_sleep(1); \
    if ((++_sp & 255u) == 0u) { if (xb_ld(&(bar)[XB_TMO])) break; if (_sp > XB_SPIN_CAP) { atomicAdd(&(bar)[XB_TMO], 1u); break; } } } } while (0)

struct XcdBarrier {
    unsigned* bar; unsigned x;
    volatile LAS unsigned* st;
};

__device__ __forceinline__ XcdBarrier xcd_barrier_post(unsigned* bar, volatile LAS unsigned* st) {
    XcdBarrier b; b.bar = bar; b.x = xb_xcc_id(); b.st = st;
    if (threadIdx.x == 0) (void)xb_add(&bar[XB_XCNT(b.x)], 1u + ((b.x == (blockIdx.x & 7u)) ? 0x10000u : 0u));
    return b;
}
__device__ __forceinline__ void xcd_barrier_complete(unsigned* bar, unsigned x, unsigned& nloc, unsigned& nx, unsigned& rr) {
    const unsigned G = gridDim.x * gridDim.y * gridDim.z;
    unsigned sum, cnt, mine, mt, sp = 0u;
    for (;;) {
        sum = 0u; cnt = 0u; mine = 0u; mt = 0u;
#pragma unroll
        for (unsigned j = 0; j < 16; ++j) { const unsigned cw = xb_ld(&bar[XB_XCNT(j)]); const unsigned c = cw & 0xFFFFu; mt += cw >> 16; sum += c; cnt += (c > 0u) ? 1u : 0u; mine = (j == x) ? c : mine; }
        if (sum == G) break;
        __builtin_amdgcn_s_sleep(1);
        if ((++sp & 255u) == 0u) { if (xb_ld(&bar[XB_TMO])) break; if (sp > XB_SPIN_CAP) { atomicAdd(&bar[XB_TMO], 1u); break; } }
    }
    nloc = mine > 0u ? mine : 1u; nx = cnt > 0u ? cnt : 1u;
    rr = (sum == G && mt == G && G == 256u && cnt == 8u) ? 1u : 0u;
}

__device__ __forceinline__ void xcd_barrier(const XcdBarrier& b) {
    asm volatile("s_waitcnt vmcnt(0)" ::: "memory");
    __syncthreads();
    if (threadIdx.x == 0) {
        unsigned* bar = b.bar;
        __builtin_amdgcn_s_waitcnt(0);
        unsigned nloc = b.st[0], nx = b.st[1];
        if (nloc == 0u) { unsigned rr; xcd_barrier_complete(bar, b.x, nloc, nx, rr); b.st[0] = nloc; b.st[1] = nx; b.st[2] = rr; }
        const unsigned old = xb_add(&bar[XB_XSUB(b.x)], 1u);
        const unsigned gen = old / nloc;
        if (old + 1u == (gen + 1u) * nloc) {
            __builtin_amdgcn_fence(__ATOMIC_RELEASE, "agent");
            asm volatile("s_waitcnt vmcnt(0)" ::: "memory");
            const unsigned og = xb_add(&bar[XB_TOP], 1u);
            const unsigned tg = og / nx;
            if (og + 1u == (tg + 1u) * nx) xb_add(&bar[XB_TOPGEN], 1u);
            else XB_SPIN(xb_ld(&bar[XB_TOPGEN]) == tg, bar);
            __builtin_amdgcn_fence(__ATOMIC_ACQUIRE, "agent");
            xb_add(&bar[XB_XGEN(b.x)], 1u);
            asm volatile("s_waitcnt vmcnt(0)" ::: "memory");
        } else {
            asm volatile("buffer_inv sc1" ::: "memory");
            XB_SPIN(xb_ld(&bar[XB_XGEN(b.x)]) == gen, bar);
            asm volatile("s_waitcnt vmcnt(0)" ::: "memory");
        }
    }
    __syncthreads();
}

__device__ __forceinline__ void xcd_barrier_local(const XcdBarrier& b) {
    if (b.st[2] == 0u) { xcd_barrier(b); return; }
    asm volatile("s_waitcnt vmcnt(0)" ::: "memory");
    __syncthreads();
    if (threadIdx.x == 0) {
        unsigned* bar = b.bar;
        __builtin_amdgcn_s_waitcnt(0);
        const unsigned nloc = b.st[0];
        const unsigned old = xb_add(&bar[XB_LSUB(b.x)], 1u);
        const unsigned gen = old / nloc;
        if (old + 1u == (gen + 1u) * nloc) xb_add(&bar[XB_LGEN(b.x)], 1u);
        else XB_SPIN(xb_ld(&bar[XB_LGEN(b.x)]) == gen, bar);
    }
    __syncthreads();
}
#if defined(EXP_SEAM)
__device__ __forceinline__ void xcd_barrier_nf(const XcdBarrier& b) {
    asm volatile("s_waitcnt vmcnt(0)" ::: "memory");
    __syncthreads();
    if (threadIdx.x == 0) {
        unsigned* bar = b.bar;
        __builtin_amdgcn_s_waitcnt(0);
        unsigned nloc = b.st[0], nx = b.st[1];
        if (nloc == 0u) { unsigned rr; xcd_barrier_complete(bar, b.x, nloc, nx, rr); b.st[0] = nloc; b.st[1] = nx; b.st[2] = rr; }
        const unsigned old = xb_add(&bar[XB_XSUB(b.x)], 1u);
        const unsigned gen = old / nloc;
        if (old + 1u == (gen + 1u) * nloc) {
            asm volatile("s_waitcnt vmcnt(0)" ::: "memory");
            const unsigned og = xb_add(&bar[XB_TOP], 1u);
            const unsigned tg = og / nx;
            if (og + 1u == (tg + 1u) * nx) xb_add(&bar[XB_TOPGEN], 1u);
            else XB_SPIN(xb_ld(&bar[XB_TOPGEN]) == tg, bar);
            xb_add(&bar[XB_XGEN(b.x)], 1u);
            asm volatile("s_waitcnt vmcnt(0)" ::: "memory");
        } else {
            XB_SPIN(xb_ld(&bar[XB_XGEN(b.x)]) == gen, bar);
            asm volatile("s_waitcnt vmcnt(0)" ::: "memory");
        }
    }
    __syncthreads();
}
__device__ __forceinline__ void xcd_barrier_norel(const XcdBarrier& b) {
    asm volatile("s_waitcnt vmcnt(0)" ::: "memory");
    __syncthreads();
    if (threadIdx.x == 0) {
        unsigned* bar = b.bar;
        __builtin_amdgcn_s_waitcnt(0);
        unsigned nloc = b.st[0], nx = b.st[1];
        if (nloc == 0u) { unsigned rr; xcd_barrier_complete(bar, b.x, nloc, nx, rr); b.st[0] = nloc; b.st[1] = nx; b.st[2] = rr; }
        const unsigned old = xb_add(&bar[XB_XSUB(b.x)], 1u);
        const unsigned gen = old / nloc;
        if (old + 1u == (gen + 1u) * nloc) {
            asm volatile("s_waitcnt vmcnt(0)" ::: "memory");
            const unsigned og = xb_add(&bar[XB_TOP], 1u);
            const unsigned tg = og / nx;
            if (og + 1u == (tg + 1u) * nx) xb_add(&bar[XB_TOPGEN], 1u);
            else XB_SPIN(xb_ld(&bar[XB_TOPGEN]) == tg, bar);
            __builtin_amdgcn_fence(__ATOMIC_ACQUIRE, "agent");
            xb_add(&bar[XB_XGEN(b.x)], 1u);
            asm volatile("s_waitcnt vmcnt(0)" ::: "memory");
        } else {
            asm volatile("buffer_inv sc1" ::: "memory");
            XB_SPIN(xb_ld(&bar[XB_XGEN(b.x)]) == gen, bar);
            asm volatile("s_waitcnt vmcnt(0)" ::: "memory");
        }
    }
    __syncthreads();
}

__device__ __forceinline__ void xcd_barrier_noacq(const XcdBarrier& b) {
    asm volatile("s_waitcnt vmcnt(0)" ::: "memory");
    __syncthreads();
    if (threadIdx.x == 0) {
        unsigned* bar = b.bar;
        __builtin_amdgcn_s_waitcnt(0);
        unsigned nloc = b.st[0], nx = b.st[1];
        if (nloc == 0u) { unsigned rr; xcd_barrier_complete(bar, b.x, nloc, nx, rr); b.st[0] = nloc; b.st[1] = nx; b.st[2] = rr; }
        const unsigned old = xb_add(&bar[XB_XSUB(b.x)], 1u);
        const unsigned gen = old / nloc;
        if (old + 1u == (gen + 1u) * nloc) {
            __builtin_amdgcn_fence(__ATOMIC_RELEASE, "agent");
            asm volatile("s_waitcnt vmcnt(0)" ::: "memory");
            const unsigned og = xb_add(&bar[XB_TOP], 1u);
            const unsigned tg = og / nx;
            if (og + 1u == (tg + 1u) * nx) xb_add(&bar[XB_TOPGEN], 1u);
            else XB_SPIN(xb_ld(&bar[XB_TOPGEN]) == tg, bar);
            xb_add(&bar[XB_XGEN(b.x)], 1u);
            asm volatile("s_waitcnt vmcnt(0)" ::: "memory");
        } else {
            XB_SPIN(xb_ld(&bar[XB_XGEN(b.x)]) == gen, bar);
            asm volatile("s_waitcnt vmcnt(0)" ::: "memory");
        }
    }
    __syncthreads();
}

#endif

struct Frame {
    LAS unsigned char* lds;
    volatile LAS unsigned* MISC;
    gu32* ctl;
    int tid, lane, wave;
    int vcu, G;
    unsigned char* ws;
    const float* in[16]; float* out;
};
__device__ __forceinline__ float wave_sum(float v) {
#pragma unroll
    for (int o = 1; o < 64; o <<= 1) v += __shfl_xor(v, o);
    return v;
}
__device__ __forceinline__ void tr_item(const float* W, int ldw, int k0, int c0, int ncols, const float* gain, bf16_t* WT, int ldt, int drow0, int dk0, LAS float* scr, int lane) {
    float v[32]; const int col = lane & 31, kh = lane >> 5;
    const float* wp = W + (size_t)(k0 + kh) * ldw + c0 + (col < ncols ? col : 0);
#pragma unroll
    for (int i = 0; i < 32; ++i) v[i] = wp[(size_t)(2 * i) * ldw];
    if (gain) {
#pragma unroll
        for (int i = 0; i < 32; ++i) v[i] *= gain[k0 + 2 * i + kh];
    }
#pragma unroll
    for (int i = 0; i < 32; ++i) scr[(2 * i + kh) * 33 + col] = v[i];
    LDS_WAIT(); asm volatile("" ::: "memory");
    const int c = lane & 7;
#pragma unroll
    for (int j = 0; j < 4; ++j) { const int n = (lane >> 3) + 8 * j; const LAS float* s = scr + (8 * c) * 33 + n;
        u32x4 o; o.x = cvt_pk_bf16(s[0 * 33], s[1 * 33]); o.y = cvt_pk_bf16(s[2 * 33], s[3 * 33]); o.z = cvt_pk_bf16(s[4 * 33], s[5 * 33]); o.w = cvt_pk_bf16(s[6 * 33], s[7 * 33]);
        if (n < ncols) *(GAS u32x4*)(WT + (size_t)(drow0 + n) * ldt + dk0 + k0 + 8 * c) = o; }
    LDS_WAIT(); asm volatile("" ::: "memory");
}
__device__ __forceinline__ int swiglu_row(int c0) { const int up = c0 >= DFF, c = up ? c0 - DFF : c0; return 256 * (c / 128) + (up ? 128 : 0) + (c % 128); }
__device__ __forceinline__ void row_to_bf16(const float* xrow, bf16_t* orow, float* ssq16, int lane) {
    const GAS f32x4* xr = (const GAS f32x4*)xrow + lane;
    f32x4 v[4]; float s = 0.f;
#pragma unroll
    for (int j = 0; j < 4; ++j) { v[j] = xr[64 * j]; s += (v[j].x * v[j].x + v[j].y * v[j].y) + (v[j].z * v[j].z + v[j].w * v[j].w); }
    s = wave_sum(s);
    GAS u32x2* o8 = (GAS u32x2*)orow + lane;
#pragma unroll
    for (int j = 0; j < 4; ++j) { u32x2 w; w.x = cvt_pk_bf16(v[j].x, v[j].y); w.y = cvt_pk_bf16(v[j].z, v[j].w); o8[64 * j] = w; }
    if (ssq16 && lane < 16) ssq16[lane] = lane == 0 ? s : 0.f;
}
__device__ __forceinline__ void zero_bytes(Frame& F, void* p, size_t nbytes) {
    const size_t n16 = nbytes / 16; GAS u32x4* q = (GAS u32x4*)p;
    for (size_t i = (size_t)F.vcu * 512 + F.tid; i < n16; i += (size_t)F.G * 512) q[i] = (u32x4){0u, 0u, 0u, 0u};
}
__device__ __forceinline__ void p0_prologue(Frame& F, int part = 0) {
    LAS float* scr = (LAS float*)(F.lds + RING_OFF + F.wave * 16384);
    const int gw = F.vcu * NWAVES + F.wave, NGW = F.G * NWAVES;
    unsigned char* ws = F.ws;
    bf16_t *W1t = (bf16_t*)(ws + WS_W1), *W2t = (bf16_t*)(ws + WS_W2), *Wpt = (bf16_t*)(ws + WS_WP), *Wabt = (bf16_t*)(ws + WS_WAB), *Wot = (bf16_t*)(ws + WS_WO), *W3t = (bf16_t*)(ws + WS_W3), *W4t = (bf16_t*)(ws + WS_W4);
    constexpr int I0 = 16 * 176, I1 = 44 * 32, I2 = 16 * 72, I3 = 16 * 64, I4 = 16, I5 = 8 * 32, I6 = 8 * 32, I7 = 16 * 32, I8 = I0, I9 = I1;
    constexpr int NITEMS = I0 + I1 + I2 + I3 + I4 + I5 + I6 + I7 + I8 + I9;
    if (part != 2) for (int it = gw; it < NITEMS; it += NGW) {
        int r = it;
        if (r < I0) { const int kb = r / 176, nb = r % 176; tr_item(F.in[3], 2 * DFF, 64 * kb, 32 * nb, 32, F.in[2], W1t, DM, swiglu_row(32 * nb), 0, scr, F.lane); continue; } r -= I0;
        if (r < I1) { const int kb = r / 32, nb = r % 32; tr_item(F.in[4], DM, 64 * kb, 32 * nb, 32, nullptr, W2t, DFF, 32 * nb, 0, scr, F.lane); continue; } r -= I1;
        if (r < I2) { const int kb = r / 72, nb = r % 72; tr_item(F.in[6], 4360, 64 * kb, 32 * nb, 32, F.in[5], Wpt, DM, 32 * nb, 0, scr, F.lane); continue; } r -= I2;
        if (r < I3) { const int kb = r / 64, nb = r % 64, gb = nb >= 32, cb = gb ? nb - 32 : nb;
            tr_item(F.in[6], 4360, 64 * kb, 2312 + 32 * nb, 32, F.in[5], Wpt, DM, 2304 + 256 * (cb / 4) + (gb ? 128 : 0) + 32 * (cb % 4), 0, scr, F.lane); continue; } r -= I3;
        if (r < I4) { tr_item(F.in[6], 4360, 64 * r, 2304, 8, F.in[5], Wpt, DM, 4352, 0, scr, F.lane); continue; } r -= I4;
        if (r < I5) { const int kb = r / 32, nb = r % 32; tr_item(F.in[9], DM, 64 * kb, 32 * nb, 32, nullptr, Wabt, DM, 32 * nb, 0, scr, F.lane); continue; } r -= I5;
        if (r < I6) { const int kb = r / 32, nb = r % 32; tr_item(F.in[10], DM, 64 * kb, 32 * nb, 32, nullptr, Wabt, DM, 32 * nb, 512, scr, F.lane); continue; } r -= I6;
        if (r < I7) { const int kb = r / 32, nb = r % 32; tr_item(F.in[11], DM, 64 * kb, 32 * nb, 32, nullptr, Wot, DM, 32 * nb, 0, scr, F.lane); continue; } r -= I7;
        if (r < I8) { const int kb = r / 176, nb = r % 176; tr_item(F.in[13], 2 * DFF, 64 * kb, 32 * nb, 32, F.in[12], W3t, DM, swiglu_row(32 * nb), 0, scr, F.lane); continue; } r -= I8;
        { const int kb = r / 32, nb = r % 32; tr_item(F.in[14], DM, 64 * kb, 32 * nb, 32, nullptr, W4t, DFF, 32 * nb, 0, scr, F.lane); }
    }
    bf16_t* XB = (bf16_t*)(ws + WS_XB); float* SSQ = (float*)(ws + WS_SSQ);
    if (part != 1) for (int m0 = gw * 4; m0 < MROWS; m0 += NGW * 4) {
        f32x4 v[4][4]; float sq[4];
#pragma unroll
        for (int r = 0; r < 4; ++r)
#pragma unroll
            for (int j = 0; j < 4; ++j) v[r][j] = ((const GAS f32x4*)(F.in[0] + (size_t)(m0 + r) * DM))[64 * j + F.lane];
#pragma unroll
        for (int r = 0; r < 4; ++r) { float s_ = 0.f;
#pragma unroll
            for (int j = 0; j < 4; ++j) s_ += (v[r][j].x * v[r][j].x + v[r][j].y * v[r][j].y) + (v[r][j].z * v[r][j].z + v[r][j].w * v[r][j].w);
            sq[r] = wave_sum(s_); }
#pragma unroll
        for (int r = 0; r < 4; ++r) { GAS u32x2* o8 = (GAS u32x2*)(XB + (size_t)(m0 + r) * DM) + F.lane;
#pragma unroll
            for (int j = 0; j < 4; ++j) { u32x2 w; w.x = cvt_pk_bf16(v[r][j].x, v[r][j].y); w.y = cvt_pk_bf16(v[r][j].z, v[r][j].w); o8[64 * j] = w; } }
        if (F.lane < 16) {
#pragma unroll
            for (int r = 0; r < 4; ++r) SSQ[(size_t)(m0 + r) * 16 + F.lane] = F.lane == 0 ? sq[r] : 0.f; }
    }
    if (gw < NMETA) row_to_bf16(F.in[1] + (size_t)gw * DM, (bf16_t*)(ws + WS_META + MT_XB) + (size_t)gw * DM, (float*)(ws + WS_META + MT_SSQ0) + gw * 16, F.lane);
    zero_bytes(F, Wpt + (size_t)4360 * DM, (size_t)(NPROJ - 4360) * DM * 2);
    for (int b = 0; b < NBATCH; ++b) {
        zero_bytes(F, (bf16_t*)(ws + WS_KA) + (size_t)b * LPOS * 128, (size_t)KR_META * 128 * 2);
        zero_bytes(F, (bf16_t*)(ws + WS_VA) + (size_t)b * LPOS * 128, (size_t)KR_META * 128 * 2);
        zero_bytes(F, (bf16_t*)(ws + WS_KB) + (size_t)b * LPOS * 512, (size_t)KR_META * 512 * 2);
        zero_bytes(F, (bf16_t*)(ws + WS_VB) + (size_t)b * LPOS * 512, (size_t)KR_META * 512 * 2);
    }
}
template <int K> __device__ __forceinline__ f32x4 meta_partial(const bf16_t* Wr, int ldw, const bf16_t* X, int ldx, int wid, int lane) {
    constexpr int NI = K / 32 / NWAVES; static_assert(K % (32 * NWAVES) == 0, "K split over the 8 waves");
    const int i = lane & 15, q = lane >> 4; f32x4 acc = (f32x4){0.f, 0.f, 0.f, 0.f};
    bf16x8 a[NI], b[NI];
#pragma unroll
    for (int t = 0; t < NI; ++t) { const int s = wid + t * NWAVES; a[t] = *(const bf16x8*)(Wr + (size_t)i * ldw + s * 32 + q * 8); b[t] = *(const bf16x8*)(X + (size_t)i * ldx + s * 32 + q * 8); }
#pragma unroll
    for (int t = 0; t < NI; ++t) acc = __builtin_amdgcn_mfma_f32_16x16x32_bf16(a[t], b[t], acc, 0, 0, 0);
    return acc;
}
__device__ __forceinline__ f32x4 meta_reduce(Frame& F, f32x4 part, int blk) {
    LAS f32x4* scr = (LAS f32x4*)(F.lds + RING_OFF + blk * 8192);
    scr[F.wave * 64 + F.lane] = part;
    __syncthreads();
    f32x4 s = scr[F.lane];
#pragma unroll
    for (int w = 1; w < NWAVES; ++w) s += scr[w * 64 + F.lane];
    __syncthreads();
    return s;
}
__device__ __forceinline__ void meta_up(Frame& F) {
    if (F.vcu >= DFF / 16) return;
    unsigned char* ws = F.ws; const int c = F.vcu, j = F.lane & 15, q = F.lane >> 4;
    const bf16_t* W1t = (const bf16_t*)(ws + WS_W1); const bf16_t* X = (const bf16_t*)(ws + WS_META + MT_XB);
    const int grow = 256 * (c / 8) + 16 * (c % 8);
    f32x4 g = meta_partial<DM>(W1t + (size_t)grow * DM, DM, X, DM, F.wave, F.lane);
    f32x4 u = meta_partial<DM>(W1t + (size_t)(grow + 128) * DM, DM, X, DM, F.wave, F.lane);
    g = meta_reduce(F, g, 0); u = meta_reduce(F, u, 1);
    if (F.wave == 0) {
        const float rs = 1.0f / sqrtf(((const float*)(ws + WS_META + MT_SSQ0))[j * 16] * (1.0f / 1024.0f) + EPS);
        float o[4];
#pragma unroll
        for (int e = 0; e < 4; ++e) { const float gg = g[e] * rs, uu = u[e] * rs; o[e] = gg * pg8::fast_sigmoid(gg) * uu; }
        u32x2 w; w.x = cvt_pk_bf16(o[0], o[1]); w.y = cvt_pk_bf16(o[2], o[3]);
        *(u32x2*)((bf16_t*)(ws + WS_META + MT_ACT) + (size_t)j * DFF + 16 * c + 4 * q) = w;
    }
}
__device__ __forceinline__ void meta_down(Frame& F) {
    if (F.vcu >= DM / 16) return;
    unsigned char* ws = F.ws; const int c = F.vcu, j = F.lane & 15, q = F.lane >> 4;
    const bf16_t* W2t = (const bf16_t*)(ws + WS_W2); const bf16_t* X = (const bf16_t*)(ws + WS_META + MT_ACT);
    f32x4 d = meta_partial<DFF>(W2t + (size_t)(16 * c) * DFF, DFF, X, DFF, F.wave, F.lane);
    d = meta_reduce(F, d, 0);
    if (F.wave == 0) {
        const f32x4 base = *(const f32x4*)(F.in[1] + (size_t)j * DM + 16 * c + 4 * q);
        const f32x4 v = base + d * 0.5f;
        u32x2 w; w.x = cvt_pk_bf16(v[0], v[1]); w.y = cvt_pk_bf16(v[2], v[3]);
        *(u32x2*)((bf16_t*)(ws + WS_META + MT_H1B) + (size_t)j * DM + 16 * c + 4 * q) = w;
        float sq = (v[0] * v[0] + v[1] * v[1]) + (v[2] * v[2] + v[3] * v[3]);
        sq += __shfl_xor(sq, 16); sq += __shfl_xor(sq, 32);
        if (q == 0) ((float*)(ws + WS_META + MT_SSQ1))[j * 64 + c] = sq;
    }
}
__device__ __forceinline__ void meta_proj(Frame& F) {
    if (F.vcu >= 81) return;
    unsigned char* ws = F.ws; const int g = F.vcu, j = F.lane & 15, q = F.lane >> 4;
    const bf16_t* Wpt = (const bf16_t*)(ws + WS_WP); const bf16_t* X = (const bf16_t*)(ws + WS_META + MT_H1B);
    int prow; bf16_t* dst; int pitch, col;
    if (g < 8)       { prow = 512 + 16 * g;         dst = (bf16_t*)(ws + WS_KA); pitch = 128; col = 16 * g; }
    else if (g < 16) { prow = 640 + 16 * (g - 8);   dst = (bf16_t*)(ws + WS_VA); pitch = 128; col = 16 * (g - 8); }
    else if (g < 48) { prow = 1280 + 16 * (g - 16); dst = (bf16_t*)(ws + WS_KB); pitch = 512; col = 16 * (g - 16); }
    else if (g < 80) { prow = 1792 + 16 * (g - 48); dst = (bf16_t*)(ws + WS_VB); pitch = 512; col = 16 * (g - 48); }
    else             { prow = 4352;                 dst = nullptr; pitch = 0; col = 0; }
    f32x4 d = meta_partial<DM>(Wpt + (size_t)prow * DM, DM, X, DM, F.wave, F.lane);
    d = meta_reduce(F, d, 0);
    if (F.wave == 0) {
        const float* s1 = (const float*)(ws + WS_META + MT_SSQ1) + j * 64 + 16 * q;
        const f32x4 a0 = *(const f32x4*)s1, a1 = *(const f32x4*)(s1 + 4), a2 = *(const f32x4*)(s1 + 8), a3 = *(const f32x4*)(s1 + 12);
        float s = ((a0[0] + a0[1]) + (a0[2] + a0[3])) + ((a1[0] + a1[1]) + (a1[2] + a1[3])) + ((a2[0] + a2[1]) + (a2[2] + a2[3])) + ((a3[0] + a3[1]) + (a3[2] + a3[3]));
        s += __shfl_xor(s, 16); s += __shfl_xor(s, 32);
        const float rs = 1.0f / sqrtf(s * (1.0f / 1024.0f) + EPS);
        const f32x4 v = d * rs;
        if (dst) {
            u32x2 w; w.x = cvt_pk_bf16(v[0], v[1]); w.y = cvt_pk_bf16(v[2], v[3]);
            for (int b = 0; b < NBATCH; ++b) *(u32x2*)(dst + (size_t)(b * LPOS + KR_META + j) * pitch + col + 4 * q) = w;
            if (g >= 16 && g < 48) {
                float s2 = (v[0] * v[0] + v[1] * v[1]) + (v[2] * v[2] + v[3] * v[3]);
                s2 += __shfl_xor(s2, 16); s2 += __shfl_xor(s2, 32);
                if (q == 0) ((float*)(ws + WS_META + MT_KNM))[(j * 8 + ((g - 16) >> 2)) * 4 + ((g - 16) & 3)] = s2;
            }
        } else if (q < 2) {
            const f32x4 bb = *(const f32x4*)(F.in[7] + 4 * q); f32x4 lf;
#pragma unroll
            for (int e = 0; e < 4; ++e) { const float x = v[e] + bb[e]; lf[e] = fminf(x, 0.f) - log1pf(expf(-fabsf(x))); }
            float* L = (float*)(ws + WS_LOGF);
            for (int b = 0; b < NBATCH; ++b) *(f32x4*)(L + (size_t)(b * LPOS + KR_META + j) * 8 + 4 * q) = lf;
        }
    }
}
__device__ __forceinline__ void attn_phase(Frame& F, char* shm, bf16_t* OB, int only) {
    unsigned char* ws = F.ws;
    bf16_t* QO = (bf16_t*)(ws + WS_QO);
    const bf16_t *KA = (const bf16_t*)(ws + WS_KA), *VA = (const bf16_t*)(ws + WS_VA), *KB = (const bf16_t*)(ws + WS_KB), *VB = (const bf16_t*)(ws + WS_VB);
    const float* LOGF = (const float*)(ws + WS_LOGF); const float* QN2 = (const float*)(ws + WS_QN2); const float* KN2 = (const float*)(ws + WS_KN2);
    float* cl = (float*)(shm + attn2::LDS_CL); float* wtot = (float*)(shm + attn2::LDS_SCAN);
    if (only != 2 && only != 4) for (int s = F.vcu; s < NBATCH * 8 * 2; s += F.G) {
        const int bh = s >> 1, half = s & 1, b = bh >> 3, h = bh & 7; float kmax2 = 0.f;
        { float v[5]; float run = 0.f; int ln = F.lane; asm volatile("" : "+v"(ln));
#pragma unroll
          for (int k = 0; k < 5; ++k) { const int e = F.tid * 5 + k; const float x = (e < 2064) ? LOGF[(size_t)(b * LPOS + KR_META + e) * 8 + h] : 0.f; run += x; v[k] = run; }
          float inc = run;
#pragma unroll
          for (int o = 1; o < 64; o <<= 1) { const float y = __shfl_up(inc, o); if (ln >= o) inc += y; }
          float km = 0.f;
#pragma unroll
          for (int k = 0; k < 5; ++k) { const int e = F.tid * 5 + k;
              if (e >= NMETA && e < 2064) { const float* kp2 = KN2 + (size_t)(b * LPOS + KR_META + e) * 16 + 2 * h; km = fmaxf(km, kp2[0] + kp2[1]); }
              else if (e < NMETA) { const float* kq = (const float*)(ws + WS_META + MT_KNM) + (e * 8 + h) * 4; km = fmaxf(km, (kq[0] + kq[1]) + (kq[2] + kq[3])); } }
#pragma unroll
          for (int o = 1; o < 64; o <<= 1) km = fmaxf(km, __shfl_xor(km, o));
          float qm4[4];
#pragma unroll
          for (int i = 0; i < 4; ++i) { const int jq = half == 0 ? (i == 0 ? 0 : i == 1 ? 7 : i == 2 ? 3 : 4) : (i == 0 ? 1 : i == 1 ? 6 : i == 2 ? 2 : 5);
              if (F.tid < 256) { const float* qp2 = QN2 + (size_t)(b * SEQ + 256 * jq + F.tid) * 16 + 2 * h; qm4[i] = qp2[0] + qp2[1]; } else qm4[i] = 0.f; }
#pragma unroll
          for (int i = 0; i < 4; ++i) {
#pragma unroll
              for (int o = 1; o < 64; o <<= 1) qm4[i] = fmaxf(qm4[i], __shfl_xor(qm4[i], o)); }
          if (ln == 63) { wtot[F.wave] = inc; wtot[8 + F.wave] = km;
#pragma unroll
              for (int i = 0; i < 4; ++i) wtot[16 + i * 8 + F.wave] = qm4[i]; }
          __syncthreads();
          kmax2 = wtot[8];
          for (int w = 1; w < NWAVES; ++w) kmax2 = fmaxf(kmax2, wtot[8 + w]);
          float woff = 0.f;
          for (int w = 0; w < F.wave; ++w) woff += wtot[w];
          const float ex = inc - run + woff;
#pragma unroll
          for (int k = 0; k < 5; ++k) { const int e = F.tid * 5 + k; if (e < 2064) cl[e] = (v[k] + ex) * LOG2E; }
          __syncthreads(); }
        for (int i = 0; i < 4; ++i) {
            const int jj = half == 0 ? (i == 0 ? 0 : i == 1 ? 7 : i == 2 ? 3 : 4) : (i == 0 ? 1 : i == 1 ? 6 : i == 2 ? 2 : 5);
            const int t0 = 256 * jj + 32 * F.wave;
            int fskip = 0;
            { float qmax2 = wtot[16 + i * 8];
              for (int w = 1; w < 4; ++w) qmax2 = fmaxf(qmax2, wtot[16 + i * 8 + w]);
              const float bound = 2.05f * sqrtf(qmax2 * kmax2) + cl[16 + 256 * jj];
              for (int T = 1; T <= 4 * jj; ++T) { if (bound - cl[79 + 64 * (T - 1)] < -152.f) fskip = T + 1; else break; }
              fskip &= ~1; }
            const int row0 = fskip ? KR_REAL + 64 * (fskip - 1) : 64, kb2 = KR_REAL + 64 * fskip, nt2 = 4 * jj + 5 - fskip;
#if defined(DBG_SKIP)
            if (blockIdx.x == 0 && F.tid == 0 && jj == 7) ((float*)(ws + WS_META + 262144))[0] = (float)fskip;
#endif
            bf16_t* qw = QO + (size_t)(b * SEQ + t0) * DM + 512 + h * 64;
            attn2::unit2<0, 8>((const attn2::bf16*)qw, (attn2::bf16*)(OB + (qw - QO)), (const attn2::bf16*)(KB + (size_t)b * LPOS * 512 + h * 64), (const attn2::bf16*)(VB + (size_t)b * LPOS * 512 + h * 64), 512, nt2, row0, kb2, KR_REAL + t0, 32 * F.wave, 0.f, 0.f, cl, shm);
        }
        __syncthreads();
    }
    if (only != 1) for (int s = F.vcu; s < 256; s += F.G) {
        for (int i = 0; i < 4; ++i) {
            const int a = s * 4 + i, b = a >> 6, rem = a & 63, n = rem >> 2, kvh = (rem >> 1) & 1, pair = rem & 1;
            const int head = kvh * 4 + pair * 2 + (F.wave >> 2), t0 = 128 * n + 32 * (F.wave & 3);
            bf16_t* qw = QO + (size_t)(b * SEQ + t0) * DM + head * 64;
            const float slope2 = exp2f(-(float)(head + 1)) * LOG2E, sink2 = F.in[8][head] * LOG2E;
            attn::unit_swa2(qw, OB + (qw - QO), KA + (size_t)b * LPOS * 128 + kvh * 64, VA + (size_t)b * LPOS * 128 + kvh * 64, 128, 128 * n, KR_REAL + t0, slope2, sink2, shm);
        }
    }
}
__device__ __forceinline__ void final_norm(Frame& F) {
    const int gw = F.vcu * NWAVES + F.wave, NGW = F.G * NWAVES;
    const float* SSQ = (const float*)(F.ws + WS_SSQ);
    f32x4 gf[4];
#pragma unroll
    for (int j = 0; j < 4; ++j) gf[j] = ((const f32x4*)F.in[15])[64 * j + F.lane];
    for (int m = gw; m < MROWS; m += NGW) {
        const f32x4 p = *(const f32x4*)(SSQ + (size_t)m * 16 + 4 * (F.lane & 3));
        float s = (p[0] + p[1]) + (p[2] + p[3]); s += __shfl_xor(s, 1); s += __shfl_xor(s, 2);
        const float rs = 1.0f / sqrtf(s * (1.0f / 1024.0f) + EPS);
        GAS f32x4* xr = (GAS f32x4*)(F.out + (size_t)m * DM) + F.lane;
#pragma unroll
        for (int j = 0; j < 4; ++j) { const f32x4 v = xr[64 * j]; xr[64 * j] = v * rs * gf[j]; }
    }
}

#ifndef EXP_ATTN_ONLY
#define EXP_ATTN_ONLY 0
#endif
#ifndef EXP_P0_PART
#define EXP_P0_PART 0
#endif
struct Args { const float* in[16]; float* out; unsigned char* ws; int ph_lo, ph_hi, alt, pad; };
__global__ void __launch_bounds__(NWAVES * 64, 2) fwd_kernel(Args args) {
    extern __shared__ __attribute__((aligned(16))) unsigned char lds[];
    Frame F;
    F.lds = (LAS unsigned char*)lds;
    F.MISC = (volatile LAS unsigned*)(F.lds + MISC_OFF);
    F.tid = threadIdx.x; F.lane = F.tid & 63; F.wave = __builtin_amdgcn_readfirstlane(F.tid >> 6);
    F.G = gridDim.x; { const int bx = blockIdx.x; F.vcu = (F.G % 8 == 0) ? (bx % 8) * (F.G / 8) + bx / 8 : bx; }
    F.ws = args.ws; F.out = args.out;
#pragma unroll
    for (int i = 0; i < 16; ++i) F.in[i] = args.in[i];
    F.ctl = (gu32*)(F.ws + WS_CTL);
    for (int u = F.tid; u < (LDS_BYTES - LDSCTL_OFF) / 4; u += NWAVES * 64) ((LAS unsigned*)(F.lds + LDSCTL_OFF))[u] = 0u;
    __syncthreads();
    XcdBarrier bar; bar.bar = (unsigned*)(F.ctl + CW_BAR); bar.x = 0; bar.st = nullptr;
    if (N_LAUNCHES == 1) bar = xcd_barrier_post((unsigned*)(F.ctl + CW_BAR), F.MISC + 8);
#if defined(DBG_BAR2)
#define GRID_BAR() do { if (N_LAUNCHES == 1) { xcd_barrier(bar); xcd_barrier(bar); } } while (0)
#else
#define GRID_BAR() do { if (N_LAUNCHES == 1) xcd_barrier(bar); } while (0)
#endif
    const int lo = args.ph_lo, hi = args.ph_hi;
#define IN(k) (lo <= (k) && (k) < hi)
#define BOTH(k) (IN(k) && IN((k) + 1))
#define ENDBAR(k) do { if (BOTH(k)) GRID_BAR(); } while (0)
#define ENDBAR_L(k) do { if (BOTH(k)) { if (N_LAUNCHES == 1) xcd_barrier_local(bar); } } while (0)
    unsigned char* ws = F.ws;
    bf16_t* XB = (bf16_t*)(ws + WS_XB); bf16_t* ACT = (bf16_t*)(ws + WS_ACT); float* SSQ = (float*)(ws + WS_SSQ);
    const int bx = (int)blockIdx.x;
    LAS float* rsc = (LAS float*)(F.lds + LDSCTL_OFF + 4096);
#define RSC_RESET() do { if (F.tid < 8) ((LAS int*)(rsc + 1024))[F.tid] = 0; __syncthreads(); } while (0)
#if defined(DBG_PH)
    unsigned long long ph_c0 = 0, ph_r0 = 0, ph_c1 = 0, ph_r1 = 0;
#define STAMP0(k) do { if ((k) == DBG_PH) { ph_c0 = __builtin_amdgcn_s_memtime(); ph_r0 = __builtin_amdgcn_s_memrealtime(); asm volatile("s_waitcnt lgkmcnt(0)" ::: "memory"); } } while (0)
#define STAMP1(k) do { if ((k) == DBG_PH) { ph_c1 = __builtin_amdgcn_s_memtime(); ph_r1 = __builtin_amdgcn_s_memrealtime(); asm volatile("s_waitcnt lgkmcnt(0)" ::: "memory"); } } while (0)
#else
#define STAMP0(k) do {} while (0)
#define STAMP1(k) do {} while (0)
#endif

    if (IN(0)) { STAMP0(0); p0_prologue(F, args.alt ? EXP_P0_PART : 0); STAMP1(0); ENDBAR(0); }

#if defined(DBG_CLOCK)
    unsigned long long dbg_c0 = 0, dbg_r0 = 0, dbg_c1 = 0, dbg_r1 = 0;
#endif
    if (IN(1)) { STAMP0(1);
        meta_up(F);
        pg8::Gemm g{XB, (const bf16_t*)(ws + WS_W1), DM, DM, DM}; pg8::StaticOrder S; S.init(MROWS, 2 * DFF, F.G, bx);
        pg8::EpiSwiGLU E{ACT, SSQ, rsc}; RSC_RESET();
#if defined(EXP_STAGGER)
        if (args.alt) { const unsigned long long t0 = __builtin_amdgcn_s_memrealtime(); const unsigned long long dly = (unsigned long long)((F.vcu % EXP_STAGGER_G) * EXP_STAGGER);
            while (__builtin_amdgcn_s_memrealtime() - t0 < dly) __builtin_amdgcn_s_sleep(8); }
#endif
#if defined(DBG_CLOCK)
        dbg_c0 = __builtin_amdgcn_s_memtime(); dbg_r0 = __builtin_amdgcn_s_memrealtime(); asm volatile("s_waitcnt lgkmcnt(0)" ::: "memory");
#endif
#if defined(EXP_NULL_EPI)
        if (args.alt) { pg8::EpiNull EN; pg8::gemm_phase<pg8::EpiNull, pg8::StaticOrder, true, true>(F.lds + RING_OFF, g, S, EN); } else
#endif
#if defined(EXP_SEAM)
        { pg8::RangeOrder R0{S, 0, 6}, R1{S, 6, 1 << 20};
          pg8::gemm_phase<pg8::EpiSwiGLU, pg8::RangeOrder, true, true>(F.lds + RING_OFF, g, R0, E);
#if EXP_SEAM == 1
          GRID_BAR();
#elif EXP_SEAM == 2
          xcd_barrier_nf(bar);
#elif EXP_SEAM == 3
          xcd_barrier_norel(bar);
#elif EXP_SEAM == 4
          xcd_barrier_noacq(bar);
#endif
          pg8::gemm_phase<pg8::EpiSwiGLU, pg8::RangeOrder, true, true>(F.lds + RING_OFF, g, R1, E); }
#else
        pg8::gemm_phase<pg8::EpiSwiGLU, pg8::StaticOrder, true, true>(F.lds + RING_OFF, g, S, E);
#endif
#if defined(DBG_CLOCK)
        dbg_c1 = __builtin_amdgcn_s_memtime(); dbg_r1 = __builtin_amdgcn_s_memrealtime(); asm volatile("s_waitcnt lgkmcnt(0)" ::: "memory");
#endif
        STAMP1(1); ENDBAR(1);
    }
    if (IN(2)) { STAMP0(2);
        meta_down(F);
        pg8::Gemm g{ACT, (const bf16_t*)(ws + WS_W2), DFF, DFF, DFF}; pg8::StaticOrder S; S.init(MROWS, DM, F.G, bx, 8);
        pg8::EpiResB<false> E{XB, XB, SSQ, 0.5f};
#if defined(EXP_NULL_EPI)
        if (args.alt) { pg8::EpiNull EN; pg8::gemm_phase<pg8::EpiNull, pg8::StaticOrder, true, true>(F.lds + RING_OFF, g, S, EN); } else
#endif
        pg8::gemm_phase<pg8::EpiResB<false>, pg8::StaticOrder, true, true>(F.lds + RING_OFF, g, S, E);
        STAMP1(2); ENDBAR(2);
    }
    if (IN(3)) { STAMP0(3);
        meta_proj(F);
        pg8::Gemm g{XB, (const bf16_t*)(ws + WS_WP), DM, DM, DM}; pg8::StaticOrder S; S.init(MROWS, NPROJ, F.G, bx);
        pg8::EpiProj E{SSQ, (bf16_t*)(ws + WS_QO), (bf16_t*)(ws + WS_KA), (bf16_t*)(ws + WS_VA), (bf16_t*)(ws + WS_KB), (bf16_t*)(ws + WS_VB), (bf16_t*)(ws + WS_SGA), (bf16_t*)(ws + WS_SGB), (float*)(ws + WS_LOGF), F.in[7], (float*)(ws + WS_QN2), (float*)(ws + WS_KN2), rsc}; RSC_RESET();
#if defined(EXP_NULL_EPI)
        if (args.alt) { pg8::EpiNull EN; pg8::gemm_phase<pg8::EpiNull, pg8::StaticOrder, true, true>(F.lds + RING_OFF, g, S, EN); } else
#elif defined(EXP_PROJX)
        if (args.alt) { pg8::EpiProjX<EXP_PROJX> EX{SSQ, (bf16_t*)(ws + WS_QO)}; pg8::gemm_phase<pg8::EpiProjX<EXP_PROJX>, pg8::StaticOrder, true, true>(F.lds + RING_OFF, g, S, EX); } else
#endif
        pg8::gemm_phase<pg8::EpiProj, pg8::StaticOrder, true, true>(F.lds + RING_OFF, g, S, E);
        STAMP1(3); ENDBAR(3);
    }
    if (IN(4)) { STAMP0(4); attn_phase(F, (char*)lds + RING_OFF, args.alt ? (bf16_t*)(ws + WS_MIX) : (bf16_t*)(ws + WS_QO), args.alt ? EXP_ATTN_ONLY : 0); STAMP1(4); ENDBAR_L(4); }

    if (IN(5)) { STAMP0(5);
        pg8::Gemm g{(const bf16_t*)(ws + WS_QO), (const bf16_t*)(ws + WS_WAB), DM, DM, DM}; pg8::StaticOrder S; S.init(MROWS, DM, F.G, bx);
        pg8::EpiMix E{(const bf16_t*)(ws + WS_SGA), (const bf16_t*)(ws + WS_SGB), (bf16_t*)(ws + WS_MIX)};
        pg8::gemm_phase<pg8::EpiMix, pg8::StaticOrder, true, true>(F.lds + RING_OFF, g, S, E);
        STAMP1(5); ENDBAR_L(5);
    }
    if (IN(6)) { STAMP0(6);
        pg8::Gemm g{(const bf16_t*)(ws + WS_MIX), (const bf16_t*)(ws + WS_WO), DM, DM, DM}; pg8::StaticOrder S; S.init(MROWS, DM, F.G, bx);
        pg8::EpiResB<false> E{XB, XB, SSQ, 1.0f};
        pg8::gemm_phase<pg8::EpiResB<false>, pg8::StaticOrder, true, true>(F.lds + RING_OFF, g, S, E);
        STAMP1(6); ENDBAR(6);
    }
    if (IN(7)) { STAMP0(7);
        pg8::Gemm g{XB, (const bf16_t*)(ws + WS_W3), DM, DM, DM}; pg8::StaticOrder S; S.init(MROWS, 2 * DFF, F.G, bx);
        pg8::EpiSwiGLU E{ACT, SSQ, rsc}; RSC_RESET();
        pg8::gemm_phase<pg8::EpiSwiGLU, pg8::StaticOrder, true, true>(F.lds + RING_OFF, g, S, E);
        STAMP1(7); ENDBAR_L(7);
    }
    if (IN(8)) { STAMP0(8);
        pg8::Gemm g{ACT, (const bf16_t*)(ws + WS_W4), DFF, DFF, DFF}; pg8::StaticOrder S; S.init(MROWS, DM, F.G, bx, 8);
        pg8::EpiFinal E{XB, F.out, F.in[15], SSQ, (unsigned*)(F.ctl + CW_PANEL), 0.5f};
        pg8::gemm_phase<pg8::EpiFinal, pg8::StaticOrder, true, true>(F.lds + RING_OFF, g, S, E);
        STAMP1(8);
    }
#if defined(DBG_PH)
    GRID_BAR();
    if (bx == 0 && F.tid == 0) {
        const float dc = (float)(ph_c1 - ph_c0), dr = (float)(ph_r1 - ph_r0);
#if DBG_WHAT == 2
        F.out[0] = 400.f * floorf(dc / dr * 100.f / 400.f + 0.5f);
#elif DBG_WHAT == 0
        F.out[0] = 100.f * floorf(dc / dr + 0.5f);
#else
        F.out[0] = 1000.f + 20.f * floorf(dr * 0.01f / 20.f + 0.5f);
#endif
    }
#endif
#if defined(DBG_SKIP)
    GRID_BAR();
    if (bx == 0 && F.tid == 0) F.out[0] = 1000.f + 100.f * ((float*)(ws + WS_META + 262144))[0];
#endif
#if defined(DBG_CLOCK)
    GRID_BAR();
    if (bx == 0 && F.tid == 0) {
        const float dc = (float)(dbg_c1 - dbg_c0), dr = (float)(dbg_r1 - dbg_r0);
        float v;
        if (DBG_CLOCK == 0) v = dc / dr * 100.f;
        else if (DBG_CLOCK == 1) v = dr * 0.01f * 10.f;
        else v = dc / 176.f;
        F.out[0] = v;
    }
#endif
#undef IN
#undef BOTH
#undef GRID_BAR
}

extern "C" void kernel_launch(void* const* d_in, const int* in_sizes, int n_in, void* d_out, int out_size, void* d_ws, size_t ws_size, hipStream_t stream) {
    static int grid = 0;
    if (grid == 0) {
        if (n_in != 16 || in_sizes[0] != MROWS * DM || out_size != MROWS * DM || ws_size < WS_END) {
            fprintf(stderr, "kernel_launch: built for 16 inputs, x/out of %d floats, >= %zu bytes of workspace; got n_in %d, in0 %d, out %d, ws %zu; nothing launched\n", MROWS * DM, (size_t)WS_END, n_in, n_in > 0 ? in_sizes[0] : -1, out_size, ws_size); grid = -1; return; }
        int dev = 0, cus = 0, per_cu = 0;
        if (hipGetDevice(&dev) != hipSuccess || hipDeviceGetAttribute(&cus, hipDeviceAttributeMultiprocessorCount, dev) != hipSuccess) { fprintf(stderr, "kernel_launch: device query failed\n"); grid = -1; return; }
        if (hipFuncSetAttribute((const void*)fwd_kernel, hipFuncAttributeMaxDynamicSharedMemorySize, LDS_BYTES) != hipSuccess) { fprintf(stderr, "kernel_launch: hipFuncSetAttribute failed\n"); grid = -1; return; }
        if (hipOccupancyMaxActiveBlocksPerMultiprocessor(&per_cu, (const void*)fwd_kernel, NWAVES * 64, LDS_BYTES) != hipSuccess || per_cu < 1) { fprintf(stderr, "kernel_launch: occupancy query reports %d workgroups per CU\n", per_cu); per_cu = 1; }
        (void)hipGetLastError();
        grid = cus * (per_cu < 1 ? 1 : 1);
    }
    if (grid < 0) return;
    if (hipMemsetAsync((char*)d_ws + WS_CTL, 0, CTL_ZERO_BYTES, stream) != hipSuccess) { fprintf(stderr, "kernel_launch: hipMemsetAsync failed\n"); return; }
    Args a{};
    for (int i = 0; i < 16; ++i) a.in[i] = (const float*)d_in[i];
    a.out = (float*)d_out; a.ws = (unsigned char*)d_ws;
#ifndef EXP_REP
#define EXP_REP -1
#endif
    for (int li = 0; li < N_LAUNCHES; ++li) {
        if (N_LAUNCHES == 1) { a.ph_lo = 0; a.ph_hi = N_PHASES; } else { a.ph_lo = li; a.ph_hi = li + 1; }
        if (N_LAUNCHES != 1 && li == EXP_REP) { a.alt = 1; hipLaunchKernelGGL(fwd_kernel, dim3(grid), dim3(NWAVES * 64), LDS_BYTES, stream, a); a.alt = 0; }
        hipLaunchKernelGGL(fwd_kernel, dim3(grid), dim3(NWAVES * 64), LDS_BYTES, stream, a);
        const hipError_t le = hipPeekAtLastError();
        if (le != hipSuccess) { fprintf(stderr, "kernel_launch: launch %d failed: %s\n", li, hipGetErrorName(le)); break; }
    }
}
```

```cpp
#include <hip/hip_runtime.h>
#include <hip/hip_bf16.h>
#include <cstdio>
#include <cstdint>

#define LAS __attribute__((address_space(3)))
#define GAS __attribute__((address_space(1)))
typedef unsigned short bf16_t;
typedef short bf16x8 __attribute__((ext_vector_type(8)));
typedef float f32x4 __attribute__((ext_vector_type(4)));
typedef float f32x16 __attribute__((ext_vector_type(16)));
typedef unsigned u32x4 __attribute__((ext_vector_type(4)));
typedef unsigned u32x2 __attribute__((ext_vector_type(2)));
typedef short s16x4 __attribute__((ext_vector_type(4)));

constexpr int DM = 1024, NBATCH = 16, SEQ = 2048, MROWS = NBATCH * SEQ;
constexpr int DFF = 2816, NPROJ = 4608;
constexpr int LPOS = 2176, NKR = NBATCH * LPOS;
constexpr int NMETA = 16, KR_META = 112, KR_REAL = 128;
constexpr float EPS = 1e-6f, LOG2E = 1.4426950408889634f, QSCALE = 0.125f * 1.4426950408889634f;

__device__ __forceinline__ unsigned cvt_pk_bf16(float lo, float hi) { unsigned r; asm volatile("v_cvt_pk_bf16_f32 %0, %1, %2" : "=v"(r) : "v"(lo), "v"(hi)); return r; }
__device__ __forceinline__ void st16_wt(void* p, u32x4 v) { asm volatile("global_store_dwordx4 %0, %1, off sc1\n\ts_nop 1" :: "v"(p), "v"(v) : "memory"); }
__device__ __forceinline__ float log_sigmoid_hw(float x) {
    const float t = __builtin_amdgcn_exp2f(-fabsf(x) * LOG2E);
    const float l1p = t < 9.765625e-4f ? t * (1.0f - 0.5f * t) : 0.6931471805599453f * __builtin_amdgcn_logf(1.0f + t);
    return fminf(x, 0.f) - l1p;
}
__device__ __forceinline__ float xsum16(float v) { auto r = __builtin_amdgcn_permlane16_swap(__float_as_uint(v), __float_as_uint(v), false, false); return __uint_as_float(r[0]) + __uint_as_float(r[1]); }
__device__ __forceinline__ float xsum32(float v) { auto r = __builtin_amdgcn_permlane32_swap(__float_as_uint(v), __float_as_uint(v), false, false); return __uint_as_float(r[0]) + __uint_as_float(r[1]); }
__device__ __forceinline__ float xmax16(float v) { auto r = __builtin_amdgcn_permlane16_swap(__float_as_uint(v), __float_as_uint(v), false, false); return fmaxf(__uint_as_float(r[0]), __uint_as_float(r[1])); }
__device__ __forceinline__ float xmax32(float v) { auto r = __builtin_amdgcn_permlane32_swap(__float_as_uint(v), __float_as_uint(v), false, false); return fmaxf(__uint_as_float(r[0]), __uint_as_float(r[1])); }
#define DPP_F(v, ctrl) __int_as_float(__builtin_amdgcn_update_dpp(0, __float_as_int(v), (ctrl), 0xF, 0xF, true))
__device__ __forceinline__ float row_sum16(float v) { v += DPP_F(v, 0xB1); v += DPP_F(v, 0x4E); v += DPP_F(v, 0x141); v += DPP_F(v, 0x140); return v; }
__device__ __forceinline__ float row_max16(float v) { v = fmaxf(v, DPP_F(v, 0xB1)); v = fmaxf(v, DPP_F(v, 0x4E)); v = fmaxf(v, DPP_F(v, 0x141)); v = fmaxf(v, DPP_F(v, 0x140)); return v; }
__device__ __forceinline__ float wave_sum64(float v) { return xsum32(xsum16(row_sum16(v))); }
__device__ __forceinline__ float wave_max64(float v) { return xmax32(xmax16(row_max16(v))); }
__device__ __forceinline__ float bf_lo(unsigned w) { return __uint_as_float(w << 16); }
__device__ __forceinline__ float bf_hi(unsigned w) { return __uint_as_float(w & 0xffff0000u); }

namespace pg8 {
#define PG8_LAS __attribute__((address_space(3)))
constexpr int BM = 256, BK = 64, HALF = 128, HTB = HALF * BK * 2  , STAGE_BYTES = 8 * HTB, NXCD = 8, WGM = 8;

__host__ __device__ __forceinline__ int lds_byte(int r, int c) { const int st = (r >> 4) * 2 + (c >> 5), rr = r & 15, cc = c & 31, ob = rr * 64 + cc * 2; return st * 1024 + (ob ^ (((ob >> 9) & 1) << 5)); }
__host__ __device__ __forceinline__ void stage_rc(int b, int& R, int& C) { const int st = b / 1024, sb = b % 1024, swz = sb ^ (((sb >> 9) & 1) << 5); R = (st >> 1) * 16 + swz / 64; C = (st & 1) * 32 + (swz % 64) / 2; }
__host__ __device__ __forceinline__ int perm32(int rho) { const int n = rho >> 4, i = rho & 15; return 8 * (i >> 2) + 4 * n + (i & 3); }

struct Unit { int pm, pn, koff, br; };
struct Gemm { const bf16_t* A; const bf16_t* Bt; int lda, ldb, K; const char* arel = nullptr; };
constexpr size_t ACT_OFF_SGA = (size_t)278 << 20, ACT_OFF_QO = (size_t)128 << 20, ACT_PANEL_BYTES = (size_t)256 * 2816 * 2;
__host__ __device__ __forceinline__ size_t act_panel_off(int pm) { const int x = pm >> 4, sl = pm & 15, reg = sl / 5, idx = sl - 5 * reg;
    return (reg < 3 ? ACT_OFF_SGA + ((size_t)reg << 26) : ACT_OFF_QO) + ((size_t)x << 23) + (size_t)idx * ACT_PANEL_BYTES; }

struct StaticOrder {
    int nM, nN, nwg, G, c, flip;
    __host__ __device__ void init(int M, int N, int G_, int c_, int flip_ = 0) { nM = M / BM; nN = N / BM; nwg = nM * nN; G = G_; c = c_; flip = flip_; }
    __host__ __device__ bool next(int i, Unit& u) const {
        const long L = (long)i * G + c; if (L >= nwg) return false;
        int wgid = (int)L; { const int q = nwg / NXCD, r = nwg % NXCD, xcd = wgid % NXCD, off = wgid / NXCD; wgid = (xcd < r ? xcd * (q + 1) : r * (q + 1) + (xcd - r) * q) + off; }
        const int nig = WGM * nN, gid = wgid / nig, fm = gid * WGM, gsz = (nM - fm) < WGM ? (nM - fm) : WGM;
        u.pm = (fm + ((wgid % nig) % gsz)) ^ flip; u.pn = (wgid % nig) / gsz; u.koff = 0; u.br = 0; return true;
    }
    __device__ __forceinline__ void a_ready(const Unit&) const {}
    __device__ __forceinline__ void done(const Unit&) const {}
};
struct MapOrder {
    StaticOrder S; int base, special;
    __host__ __device__ bool next(int i, Unit& u) const { if (!S.next(i, u)) return false; u.pn = (special >= 0 && u.pn == S.nN - 1) ? special : base + u.pn; return true; }
    __device__ __forceinline__ void a_ready(const Unit&) const {}
    __device__ __forceinline__ void done(const Unit&) const {}
};
struct RangeOrder {
    StaticOrder S; int i0, i1;
    __host__ __device__ bool next(int i, Unit& u) const { if (i0 + i >= i1) return false; return S.next(i0 + i, u); }
    __device__ __forceinline__ void a_ready(const Unit&) const {}
    __device__ __forceinline__ void done(const Unit&) const {}
};
struct DualOrder {
    StaticOrder S;
    __host__ __device__ bool next(int i, Unit& u) const { if (!S.next(i >> 1, u)) return false; u.br = i & 1; u.koff = 512 * (i & 1); return true; }
    __device__ __forceinline__ void a_ready(const Unit&) const {}
    __device__ __forceinline__ void done(const Unit&) const {}
};

__device__ __forceinline__ float row_rs(const float* ssq, int row, int fq) {
    const f32x4 p = *(const f32x4*)(ssq + (size_t)row * 16 + 4 * fq);
    float s = (p[0] + p[1]) + (p[2] + p[3]);
    s = xsum32(xsum16(s));
    return __builtin_amdgcn_rsqf(s * (1.0f / 1024.0f) + EPS);
}
typedef float f32x2 __attribute__((ext_vector_type(2)));
__device__ __forceinline__ void row_rs8(const float* ssq, int row0, int fq, float (&rs)[8]) {
    f32x4 p[8];
#pragma unroll
    for (int i = 0; i < 8; ++i) p[i] = *(const f32x4*)(ssq + (size_t)(row0 + (i >> 2) * HALF + (i & 3) * 16) * 16 + 4 * fq);
#pragma unroll
    for (int i = 0; i < 8; ++i) { float s = (p[i][0] + p[i][1]) + (p[i][2] + p[i][3]); s = xsum32(xsum16(s)); rs[i] = __builtin_amdgcn_rsqf(s * (1.0f / 1024.0f) + EPS); }
}
__device__ __forceinline__ float fast_sigmoid(float x) { return __builtin_amdgcn_rcpf(1.0f + __builtin_amdgcn_exp2f(-x * LOG2E)); }
__device__ __forceinline__ u32x4 pack8(const f32x4 a, const f32x4 b) { u32x4 w; w.x = cvt_pk_bf16(a[0], a[1]); w.y = cvt_pk_bf16(a[2], a[3]); w.z = cvt_pk_bf16(b[0], b[1]); w.w = cvt_pk_bf16(b[2], b[3]); return w; }

__device__ __forceinline__ void pf_tile(const void* base, int esz, const Unit& u, int part, int nparts, int tid, float& junk) {
    const int lpr = esz * 2, per = 256 * lpr / nparts, L = part * per + tid;
    if (tid < per) { const char* p = (const char*)base + ((size_t)(u.pm * BM + L / lpr) * DM + (size_t)u.pn * BM) * esz + (L % lpr) * 128;
        asm volatile("global_load_dword %0, %1, off" : "+v"(junk) : "v"(p) : "memory"); }
}
__device__ __forceinline__ void row_rs8_cached(const float* ssq, int pm, int row0, int fr, int fq, PG8_LAS float* rc, float (&rs)[8]) {
    const int wid = __builtin_amdgcn_readfirstlane((int)threadIdx.x >> 6);
    PG8_LAS float* mine = rc + wid * 128; PG8_LAS int* tag = (PG8_LAS int*)(rc + 1024) + wid;
    const int have = __builtin_amdgcn_readfirstlane(*tag);
    if (have != pm + 1) {
        row_rs8(ssq, row0, fq, rs);
        if (fq == 0) { *(PG8_LAS f32x4*)(mine + fr * 8) = (f32x4){rs[0], rs[1], rs[2], rs[3]}; *(PG8_LAS f32x4*)(mine + fr * 8 + 4) = (f32x4){rs[4], rs[5], rs[6], rs[7]}; }
        if ((threadIdx.x & 63) == 0) *tag = pm + 1;
    } else {
        const f32x4 a = *(const PG8_LAS f32x4*)(mine + fr * 8), b = *(const PG8_LAS f32x4*)(mine + fr * 8 + 4);
        rs[0] = a[0]; rs[1] = a[1]; rs[2] = a[2]; rs[3] = a[3]; rs[4] = b[0]; rs[5] = b[1]; rs[6] = b[2]; rs[7] = b[3];
    }
}
struct EpiSwiGLU {
    static constexpr bool PERM = true, AFTER_DRAIN = false, MID = false, PF = false;
    char* wsb; const float* ssq; PG8_LAS float* rsc;
    __device__ __forceinline__ void operator()(const f32x4 (&acc)[2][2][4][2], const Unit& u, int wr, int wc, int fr, int fq) const {
        const int row0 = u.pm * BM + wr * 64 + fr, col0 = u.pn * HALF + wc * 32 + 8 * fq;
        bf16_t* O = (bf16_t*)(wsb + act_panel_off(u.pm)) + (size_t)(wr * 64 + fr) * DFF + col0;
        float rsv[8]; row_rs8_cached(ssq, u.pm, row0, fr, fq, rsc, rsv);
#pragma unroll
        for (int ai = 0; ai < 2; ++ai)
#pragma unroll
            for (int m = 0; m < 4; ++m) {
                const int row = row0 + ai * HALF + m * 16; const float rs = rsv[ai * 4 + m];
                f32x4 o[2]; const float c1 = -LOG2E * rs, irs2 = __builtin_amdgcn_rcpf(rs * rs);
#pragma unroll
                for (int n = 0; n < 2; ++n)
#pragma unroll
                    for (int e = 0; e < 4; e += 2) {
                        const f32x2 g = (f32x2){acc[ai][0][m][n][e], acc[ai][0][m][n][e + 1]}, uu = (f32x2){acc[ai][1][m][n][e], acc[ai][1][m][n][e + 1]};
                        const f32x2 t = g * c1; f32x2 d; d.x = __builtin_amdgcn_exp2f(t.x); d.y = __builtin_amdgcn_exp2f(t.y); d = d * irs2 + irs2;
                        f32x2 r; r.x = __builtin_amdgcn_rcpf(d.x); r.y = __builtin_amdgcn_rcpf(d.y);
                        const f32x2 w = (g * uu) * r; o[n][e] = w.x; o[n][e + 1] = w.y;
                    }
                *(u32x4*)(O + (size_t)(ai * HALF + m * 16) * DFF) = pack8(o[0], o[1]);
            }
    }
};
template <bool BASE_F32> struct EpiResB {
    static constexpr bool PERM = true, AFTER_DRAIN = false, MID = false, PF = false;
    const void* base; bf16_t* xb; float* ssq; float scale;
    __device__ __forceinline__ void prefetch(const Unit& u, int t, int nt, int tid, float& junk) const { const int q = t - (nt - 8); if (q >= 0) pf_tile(base, BASE_F32 ? 4 : 2, u, q >> 1, 4, tid, junk); }
    __device__ __forceinline__ void operator()(const f32x4 (&acc)[2][2][4][2], const Unit& u, int wr, int wc, int fr, int fq) const {
        const int row0 = u.pm * BM + wr * 64 + fr, col0 = u.pn * BM + wc * 32 + 8 * fq;
        u32x4 wv[2][4][2];
        if (!BASE_F32) {
#pragma unroll
            for (int ai = 0; ai < 2; ++ai)
#pragma unroll
                for (int m = 0; m < 4; ++m)
#pragma unroll
                    for (int bj = 0; bj < 2; ++bj) wv[ai][m][bj] = *(const u32x4*)((const bf16_t*)base + (size_t)(row0 + ai * HALF + m * 16) * DM + col0 + bj * HALF);
        }
#pragma unroll
        for (int ai = 0; ai < 2; ++ai) {
            f32x4 fv[4][2][2];
            if (BASE_F32) {
#pragma unroll
                for (int m = 0; m < 4; ++m)
#pragma unroll
                    for (int bj = 0; bj < 2; ++bj) { const float* bp = (const float*)base + (size_t)(row0 + ai * HALF + m * 16) * DM + col0 + bj * HALF; fv[m][bj][0] = *(const f32x4*)bp; fv[m][bj][1] = *(const f32x4*)(bp + 4); }
            }
#pragma unroll
            for (int m = 0; m < 4; ++m) {
                const int row = row0 + ai * HALF + m * 16; const size_t off = (size_t)row * DM + col0; float sq = 0.f;
#pragma unroll
                for (int bj = 0; bj < 2; ++bj) {
                    const size_t c = off + bj * HALF; f32x4 b0, b1;
                    if (BASE_F32) { b0 = fv[m][bj][0]; b1 = fv[m][bj][1]; }
                    else { const u32x4 w = wv[ai][m][bj]; b0 = (f32x4){bf_lo(w.x), bf_hi(w.x), bf_lo(w.y), bf_hi(w.y)}; b1 = (f32x4){bf_lo(w.z), bf_hi(w.z), bf_lo(w.w), bf_hi(w.w)}; }
                    const f32x4 v0 = b0 + acc[ai][bj][m][0] * scale, v1 = b1 + acc[ai][bj][m][1] * scale;
                    *(u32x4*)(xb + c) = pack8(v0, v1);
                    sq += (v0[0] * v0[0] + v0[1] * v0[1]) + (v0[2] * v0[2] + v0[3] * v0[3]) + (v1[0] * v1[0] + v1[1] * v1[1]) + (v1[2] * v1[2] + v1[3] * v1[3]);
                }
                sq = xsum32(xsum16(sq));
                if (fq == 0) ssq[(size_t)row * 16 + u.pn * 4 + wc] = sq;
            }
            if (BASE_F32) asm volatile("" ::: "memory");
        }
    }
};
struct EpiFinal {
    static constexpr bool PERM = true, AFTER_DRAIN = false, MID = false, PF = false;
    const bf16_t* base; float* out; const float* gf; float* part; unsigned* cnt; float scale;
    __device__ __forceinline__ void prefetch(const Unit& u, int t, int nt, int tid, float& junk) const { const int q = t - (nt - 8); if (q >= 0) pf_tile(base, 2, u, q >> 1, 4, tid, junk); }
    __device__ __forceinline__ void operator()(f32x4 (&acc)[2][2][4][2], const Unit& u, int wr, int wc, int fr, int fq) const {
        const int row0 = u.pm * BM + wr * 64 + fr, col0 = u.pn * BM + wc * 32 + 8 * fq;
        u32x4 wv[2][4][2];
#pragma unroll
        for (int ai = 0; ai < 2; ++ai)
#pragma unroll
            for (int m = 0; m < 4; ++m)
#pragma unroll
                for (int bj = 0; bj < 2; ++bj) wv[ai][m][bj] = *(const u32x4*)(base + (size_t)(row0 + ai * HALF + m * 16) * DM + col0 + bj * HALF);
#pragma unroll
        for (int ai = 0; ai < 2; ++ai)
#pragma unroll
            for (int m = 0; m < 4; ++m) {
                const int row = row0 + ai * HALF + m * 16; float sq = 0.f;
#pragma unroll
                for (int bj = 0; bj < 2; ++bj) {
                    const u32x4 w = wv[ai][m][bj];
                    const f32x4 b0 = (f32x4){bf_lo(w.x), bf_hi(w.x), bf_lo(w.y), bf_hi(w.y)}, b1 = (f32x4){bf_lo(w.z), bf_hi(w.z), bf_lo(w.w), bf_hi(w.w)};
                    const f32x4 v0 = b0 + acc[ai][bj][m][0] * scale, v1 = b1 + acc[ai][bj][m][1] * scale;
                    acc[ai][bj][m][0] = v0; acc[ai][bj][m][1] = v1;
                    sq += (v0[0] * v0[0] + v0[1] * v0[1]) + (v0[2] * v0[2] + v0[3] * v0[3]) + (v1[0] * v1[0] + v1[1] * v1[1]) + (v1[2] * v1[2] + v1[3] * v1[3]);
                }
                sq = xsum32(xsum16(sq));
                if (fq == 0) __hip_atomic_store(part + (size_t)row * 16 + u.pn * 4 + wc, sq, __ATOMIC_RELAXED, __HIP_MEMORY_SCOPE_AGENT);
            }
        asm volatile("s_waitcnt vmcnt(0)" ::: "memory");
        unsigned* pc = cnt + 64 * u.pm;
        if ((threadIdx.x & 63) == 0) __hip_atomic_fetch_add(pc, 1u, __ATOMIC_RELAXED, __HIP_MEMORY_SCOPE_AGENT);
        for (unsigned spins = 0; spins < (1u << 22); ++spins) {
            if ((unsigned)__builtin_amdgcn_readfirstlane(__hip_atomic_load(pc, __ATOMIC_RELAXED, __HIP_MEMORY_SCOPE_AGENT)) >= 32u) break;
            __builtin_amdgcn_s_sleep(2);
        }
        asm volatile("" ::: "memory");
        const int gc0 = u.pn * BM + wc * 32 + 8 * fq;
        unsigned long long qq[8][2];
#pragma unroll
        for (int i = 0; i < 8; ++i) { const unsigned long long* pp = (const unsigned long long*)(part + (size_t)(row0 + (i >> 2) * HALF + (i & 3) * 16) * 16 + 4 * fq);
            qq[i][0] = __hip_atomic_load(pp, __ATOMIC_RELAXED, __HIP_MEMORY_SCOPE_AGENT); qq[i][1] = __hip_atomic_load(pp + 1, __ATOMIC_RELAXED, __HIP_MEMORY_SCOPE_AGENT); }
#pragma unroll
        for (int ai = 0; ai < 2; ++ai)
#pragma unroll
            for (int m = 0; m < 4; ++m) {
                const int row = row0 + ai * HALF + m * 16; const size_t off = (size_t)row * DM + col0;
                const unsigned long long q0 = qq[ai * 4 + m][0], q1 = qq[ai * 4 + m][1];
                float s = (__uint_as_float((unsigned)q0) + __uint_as_float((unsigned)(q0 >> 32))) + (__uint_as_float((unsigned)q1) + __uint_as_float((unsigned)(q1 >> 32)));
                s = xsum32(xsum16(s));
                const float rs = __builtin_amdgcn_rsqf(s * (1.0f / 1024.0f) + EPS);
#pragma unroll
                for (int bj = 0; bj < 2; ++bj) {
                    const f32x4 g0 = *(const f32x4*)(gf + gc0 + bj * HALF), g1 = *(const f32x4*)(gf + gc0 + bj * HALF + 4);
                    *(f32x4*)(out + off + bj * HALF) = acc[ai][bj][m][0] * rs * g0; *(f32x4*)(out + off + bj * HALF + 4) = acc[ai][bj][m][1] * rs * g1;
                }
            }
    }
};
struct EpiProj {
    static constexpr bool PERM = true, AFTER_DRAIN = false, MID = false, PF = false;
    const float* ssq; bf16_t *QO, *KA, *VA, *KB, *VB, *RAB, *SGB; float* LOGF; const float* bfg; float *QN2, *KN2; PG8_LAS float* rsc;
    __device__ __forceinline__ void operator()(const f32x4 (&acc)[2][2][4][2], const Unit& u, int wr, int wc, int fr, int fq) const {
        const int pn = u.pn, row0 = u.pm * BM + wr * 64 + fr, kadd = KR_REAL * (u.pm / 8 + 1);
        float rsv[8]; row_rs8_cached(ssq, u.pm, row0, fr, fq, rsc, rsv);
        if (pn == 17) {
            f32x4 bb0 = *(const f32x4*)(bfg), bb1 = *(const f32x4*)(bfg + 4);
#pragma unroll
            for (int ai = 0; ai < 2; ++ai)
#pragma unroll
                for (int m = 0; m < 4; ++m) {
                    const int row = row0 + ai * HALF + m * 16; const float rs = rsv[ai * 4 + m];
                    if (wc == 0 && fq == 0) {
                        f32x4 lf[2];
#pragma unroll
                        for (int n = 0; n < 2; ++n)
#pragma unroll
                            for (int e = 0; e < 4; ++e) { const float x = acc[ai][0][m][n][e] * rs + (n ? bb1[e] : bb0[e]); lf[n][e] = log_sigmoid_hw(x); }
                        float* d = LOGF + (size_t)(row + kadd) * 8; *(f32x4*)d = lf[0]; *(f32x4*)(d + 4) = lf[1];
                    }
                }
            return;
        }
        if (pn >= 9) {
            const int cg = (pn - 9) * HALF + wc * 32 + 8 * fq;
#pragma unroll
            for (int ai = 0; ai < 2; ++ai)
#pragma unroll
                for (int m = 0; m < 4; ++m) {
                    const int row = row0 + ai * HALF + m * 16; const float rs = rsv[ai * 4 + m]; f32x4 r[2], sb[2];
                    const float c1 = -LOG2E * rs;
#pragma unroll
                    for (int n = 0; n < 2; ++n)
#pragma unroll
                        for (int e = 0; e < 4; e += 2) {
                            f32x2 ta = (f32x2){acc[ai][0][m][n][e], acc[ai][0][m][n][e + 1]} * c1, tb = (f32x2){acc[ai][1][m][n][e], acc[ai][1][m][n][e + 1]} * c1;
                            tb.x = __builtin_amdgcn_fmed3f(tb.x, -115.4f, 115.4f); tb.y = __builtin_amdgcn_fmed3f(tb.y, -115.4f, 115.4f);
                            f32x2 da, db; da.x = __builtin_amdgcn_exp2f(ta.x); da.y = __builtin_amdgcn_exp2f(ta.y); db.x = __builtin_amdgcn_exp2f(tb.x); db.y = __builtin_amdgcn_exp2f(tb.y);
                            da = da + 1.0f; db = db + 1.0f;
                            f32x2 ra, rb; ra.x = __builtin_amdgcn_rcpf(da.x); ra.y = __builtin_amdgcn_rcpf(da.y); rb.x = __builtin_amdgcn_rcpf(db.x); rb.y = __builtin_amdgcn_rcpf(db.y);
                            const f32x2 q = db * ra; r[n][e] = q.x; r[n][e + 1] = q.y; sb[n][e] = rb.x; sb[n][e + 1] = rb.y;
                        }
                    *(u32x4*)(RAB + (size_t)row * DM + cg) = pack8(r[0], r[1]); *(u32x4*)(SGB + (size_t)row * DM + cg) = pack8(sb[0], sb[1]);
                }
            return;
        }
        bf16_t* d0; bf16_t* d1; int pitch, radd = 0; float mul = 1.f;
        if (pn < 2)       { d0 = QO + pn * 256; d1 = d0 + HALF; pitch = DM; mul = QSCALE; }
        else if (pn == 2) { d0 = KA; d1 = VA; pitch = 128; radd = kadd; }
        else if (pn < 5)  { d0 = QO + 512 + (pn - 3) * 256; d1 = d0 + HALF; pitch = DM; mul = QSCALE; }
        else if (pn < 7)  { d0 = KB + (pn - 5) * 256; d1 = d0 + HALF; pitch = 512; radd = kadd; }
        else              { d0 = VB + (pn - 7) * 256; d1 = d0 + HALF; pitch = 512; radd = kadd; }
        const int cw = wc * 32 + 8 * fq;
#pragma unroll
        for (int ai = 0; ai < 2; ++ai)
#pragma unroll
            for (int m = 0; m < 4; ++m) {
                const int row = row0 + ai * HALF + m * 16; const float rs = rsv[ai * 4 + m] * mul; const size_t ro = (size_t)(row + radd) * pitch + cw;
#pragma unroll
                for (int bj = 0; bj < 2; ++bj) {
                    const f32x4 v0 = acc[ai][bj][m][0] * rs, v1 = acc[ai][bj][m][1] * rs;
                    *(u32x4*)((bj ? d1 : d0) + ro) = pack8(v0, v1);
                    if (pn >= 3 && pn < 7) {
                        float s2 = (v0[0] * v0[0] + v0[1] * v0[1]) + (v0[2] * v0[2] + v0[3] * v0[3]) + (v1[0] * v1[0] + v1[1] * v1[1]) + (v1[2] * v1[2] + v1[3] * v1[3]);
                        s2 = xsum32(xsum16(s2));
                        if (fq == 0) ((pn < 5 ? QN2 : KN2) + (size_t)(row + radd) * 16)[2 * (4 * ((pn - 3) & 1) + 2 * bj + (wc >> 1)) + (wc & 1)] = s2;
                    }
                }
            }
    }
};
struct EpiMix {
    static constexpr bool PERM = true, AFTER_DRAIN = false, MID = true, PF = false;
    const bf16_t *RAB, *SGB; bf16_t* MIX;
    __device__ __forceinline__ void prefetch(const Unit& u, int t, int nt, int tid, float& junk) const { const int h = nt >> 1; if (t < h) pf_tile(RAB, 2, u, t >> 1, h >> 1, tid, junk); else pf_tile(SGB, 2, u, (t - h) >> 1, h >> 1, tid, junk); }
    __device__ __forceinline__ void mid(f32x4 (&acc)[2][2][4][2], const Unit& u, int wr, int wc, int fr, int fq) const {
        int row0 = u.pm * BM + wr * 64 + fr; const int col0 = u.pn * BM + wc * 32 + 8 * fq;
        asm volatile("" : "+v"(row0));
        u32x4 gv[2][4][2];
#pragma unroll
        for (int ai = 0; ai < 2; ++ai)
#pragma unroll
            for (int m = 0; m < 4; ++m)
#pragma unroll
                for (int bj = 0; bj < 2; ++bj) gv[ai][m][bj] = *(const u32x4*)(RAB + (size_t)(row0 + ai * HALF + m * 16) * DM + col0 + bj * HALF);
#pragma unroll
        for (int ai = 0; ai < 2; ++ai)
#pragma unroll
            for (int m = 0; m < 4; ++m) {
#pragma unroll
                for (int bj = 0; bj < 2; ++bj) {
                    const u32x4 gw = gv[ai][m][bj];
                    acc[ai][bj][m][0] *= (f32x4){bf_lo(gw.x), bf_hi(gw.x), bf_lo(gw.y), bf_hi(gw.y)}; acc[ai][bj][m][1] *= (f32x4){bf_lo(gw.z), bf_hi(gw.z), bf_lo(gw.w), bf_hi(gw.w)};
                }
            }
    }
    __device__ __forceinline__ void operator()(const f32x4 (&acc)[2][2][4][2], const Unit& u, int wr, int wc, int fr, int fq) const {
        int row0 = u.pm * BM + wr * 64 + fr; const int col0 = u.pn * BM + wc * 32 + 8 * fq;
        asm volatile("" : "+v"(row0));
        u32x4 gv[2][4][2];
#pragma unroll
        for (int ai = 0; ai < 2; ++ai)
#pragma unroll
            for (int m = 0; m < 4; ++m)
#pragma unroll
                for (int bj = 0; bj < 2; ++bj) gv[ai][m][bj] = *(const u32x4*)(SGB + (size_t)(row0 + ai * HALF + m * 16) * DM + col0 + bj * HALF);
#pragma unroll
        for (int ai = 0; ai < 2; ++ai)
#pragma unroll
            for (int m = 0; m < 4; ++m) {
                const int row = row0 + ai * HALF + m * 16;
#pragma unroll
                for (int bj = 0; bj < 2; ++bj) {
                    const size_t c = (size_t)row * DM + col0 + bj * HALF;
                    const u32x4 gw = gv[ai][m][bj];
                    const f32x4 v0 = acc[ai][bj][m][0] * (f32x4){bf_lo(gw.x), bf_hi(gw.x), bf_lo(gw.y), bf_hi(gw.y)}, v1 = acc[ai][bj][m][1] * (f32x4){bf_lo(gw.z), bf_hi(gw.z), bf_lo(gw.w), bf_hi(gw.w)};
                    *(u32x4*)(MIX + c) = pack8(v0, v1);
                }
            }
    }
};
struct EpiNull {
    static constexpr bool PERM = true, AFTER_DRAIN = false, MID = false, PF = false;
    __device__ __forceinline__ void operator()(const f32x4 (&acc)[2][2][4][2], const Unit& u, int wr, int wc, int fr, int fq) const {
#pragma unroll
        for (int ai = 0; ai < 2; ++ai)
#pragma unroll
            for (int bj = 0; bj < 2; ++bj)
#pragma unroll
                for (int m = 0; m < 4; ++m)
#pragma unroll
                    for (int n = 0; n < 2; ++n) asm volatile("" :: "v"(acc[ai][bj][m][n]));
    }
};

template <int MODE> struct EpiProjX {
    static constexpr bool PERM = true, AFTER_DRAIN = false, MID = false, PF = false;
    const float* ssq; bf16_t* D;
    __device__ __forceinline__ void operator()(const f32x4 (&acc)[2][2][4][2], const Unit& u, int wr, int wc, int fr, int fq) const {
        int row0 = u.pm * BM + wr * 64 + fr; const int cw = (u.pn % 4) * 256 + wc * 32 + 8 * fq;
        asm volatile("" : "+v"(row0));
#pragma unroll
        for (int ai = 0; ai < 2; ++ai)
#pragma unroll
            for (int m = 0; m < 4; ++m) {
                const int row = row0 + ai * HALF + m * 16;
                if (MODE == 0) {
                    const float rs = row_rs(ssq, row, fq); f32x4 r[2], sb[2];
#pragma unroll
                    for (int n = 0; n < 2; ++n)
#pragma unroll
                        for (int e = 0; e < 4; ++e) {
                            const float ga = __builtin_amdgcn_fmed3f(acc[ai][0][m][n][e] * rs, -80.f, 80.f), gb = __builtin_amdgcn_fmed3f(acc[ai][1][m][n][e] * rs, -80.f, 80.f);
                            const float ea = __builtin_amdgcn_exp2f(-ga * LOG2E), eb = __builtin_amdgcn_exp2f(-gb * LOG2E);
                            r[n][e] = (1.0f + eb) * __builtin_amdgcn_rcpf(1.0f + ea); sb[n][e] = __builtin_amdgcn_rcpf(1.0f + eb);
                        }
                    u32x4 a = pack8(r[0], r[1]), b = pack8(sb[0], sb[1]); asm volatile("" :: "v"(a), "v"(b));
                } else if (MODE == 1) {
#pragma unroll
                    for (int bj = 0; bj < 2; ++bj) *(u32x4*)(D + (size_t)row * DM + cw + bj * HALF) = pack8(acc[ai][bj][m][0], acc[ai][bj][m][1]);
                } else {
                    const int lrow = (int)blockIdx.x * BM + (row & 255); const int cw2 = wc * 32 + 8 * fq;
#pragma unroll
                    for (int bj = 0; bj < 2; ++bj) *(u32x4*)(D + (size_t)lrow * DM + cw2 + bj * HALF) = pack8(acc[ai][bj][m][0], acc[ai][bj][m][1]);
                }
            }
    }
};
template <class Epi, class Sched, bool ALIGN_EPI = false, bool SP2 = false>
__device__ __forceinline__ void gemm_phase(PG8_LAS unsigned char* lds, const Gemm g, const Sched& S, const Epi& E) {
    const int tid = threadIdx.x, wid = __builtin_amdgcn_readfirstlane(tid >> 6), lane = tid & 63, wr = wid >> 2, wc = wid & 3, fr = lane & 15, fq = lane >> 4;
    const int K = g.K, nt = K / BK;
    unsigned voffA[2], voffB[2];
#pragma unroll
    for (int i = 0; i < 2; ++i) { int R, C; stage_rc(tid * 16 + i * 8192, R, C); const int Rb = Epi::PERM ? ((R & ~31) + perm32(R & 31)) : R;
        voffA[i] = (unsigned)(R * g.lda + C) * 2u; voffB[i] = (unsigned)(Rb * g.ldb + C) * 2u; }
    const size_t kstep = (size_t)(BK * 2);
    const size_t hstepA = (size_t)HALF * g.lda * 2, hstepB = (size_t)HALF * g.ldb * 2;
    const size_t tstepA = 2 * hstepA, tstepB = 2 * hstepB;
    const unsigned ldsw = (unsigned)wid * 1024u;
    const int aoff = lds_byte(wr * 64 + fr, fq * 8), boff = lds_byte(wc * 32 + fr, fq * 8);
#define PG8_SA(b, h) (((b) * 2 + (h)) * HTB)
#define PG8_SB(b, h) ((4 + (b) * 2 + (h)) * HTB)
#define PG8_STAGE(bufoff, gbase, voff) do { _Pragma("unroll") for (int _i = 0; _i < 2; ++_i) \
        __builtin_amdgcn_global_load_lds((const unsigned*)((const char*)(gbase) + (voff)[_i]), (PG8_LAS unsigned*)(lds + (bufoff) + ldsw + _i * 8192), 16, 0, 0); } while (0)
#define PG8_LDA(dst, b, h) do { _Pragma("unroll") for (int m = 0; m < 4; ++m) _Pragma("unroll") for (int k = 0; k < 2; ++k) dst[m][k] = *(const PG8_LAS bf16x8*)(lds + PG8_SA(b, h) + aoff + m * 2048 + k * 1024); } while (0)
#define PG8_LDB(dst, b, h) do { _Pragma("unroll") for (int n = 0; n < 2; ++n) _Pragma("unroll") for (int k = 0; k < 2; ++k) dst[n][k] = *(const PG8_LAS bf16x8*)(lds + PG8_SB(b, h) + boff + n * 2048 + k * 1024); } while (0)
#define PG8_MMA(ai, bj, At, Bt) do { __builtin_amdgcn_s_setprio(1); _Pragma("unroll") for (int m = 0; m < 4; ++m) _Pragma("unroll") for (int n = 0; n < 2; ++n) _Pragma("unroll") for (int k = 0; k < 2; ++k) \
        acc[ai][bj][m][n] = __builtin_amdgcn_mfma_f32_16x16x32_bf16(Bt[n][k], At[m][k], acc[ai][bj][m][n], 0, 0, 0); __builtin_amdgcn_s_setprio(0); } while (0)
#define PG8_WAIT_V(n) asm volatile("s_waitcnt vmcnt(" #n ")" ::: "memory")
#define PG8_WAIT_L(n) asm volatile("s_waitcnt lgkmcnt(" #n ")" ::: "memory")
#define PG8_BAR __builtin_amdgcn_s_barrier()
#define PG8_SCHED __builtin_amdgcn_sched_barrier(0)
    Unit cur, nxt; int ui = 0; float pfj = 0.f;
    if (!S.next(0, cur)) return;
    f32x4 acc[2][2][4][2];
#pragma unroll
    for (int a = 0; a < 2; ++a)
#pragma unroll
        for (int b = 0; b < 2; ++b)
#pragma unroll
            for (int m = 0; m < 4; ++m)
#pragma unroll
                for (int n = 0; n < 2; ++n) acc[a][b][m][n] = (f32x4){0.f, 0.f, 0.f, 0.f};
    bf16x8 At[4][2], B0[2][2], B1[2][2];
    const char* cA = g.arel ? g.arel + act_panel_off(cur.pm) : (const char*)g.A + (size_t)cur.pm * tstepA + (size_t)cur.koff * 2; const char* cB = (const char*)g.Bt + (size_t)cur.pn * tstepB + (size_t)cur.koff * 2;
    S.a_ready(cur);
    if constexpr (SP2) {
        PG8_STAGE(PG8_SB(0, 0), cB, voffB); PG8_STAGE(PG8_SB(0, 1), cB + hstepB, voffB); PG8_STAGE(PG8_SA(0, 0), cA, voffA); PG8_STAGE(PG8_SA(0, 1), cA + hstepA, voffA);
        if (wr == 1) PG8_BAR;
        PG8_WAIT_V(2); PG8_BAR;
        PG8_STAGE(PG8_SB(1, 0), cB + kstep, voffB); PG8_STAGE(PG8_SA(1, 0), cA + kstep, voffA); PG8_STAGE(PG8_SB(1, 1), cB + hstepB + kstep, voffB);
        PG8_WAIT_V(6); PG8_BAR;
    } else {
        PG8_STAGE(PG8_SB(0, 0), cB, voffB); PG8_STAGE(PG8_SA(0, 0), cA, voffA); PG8_STAGE(PG8_SB(0, 1), cB + hstepB, voffB); PG8_STAGE(PG8_SA(0, 1), cA + hstepA, voffA);
        if (wr == 1) PG8_BAR;
        PG8_WAIT_V(4); PG8_BAR;
        PG8_STAGE(PG8_SB(1, 0), cB + kstep, voffB); PG8_STAGE(PG8_SA(1, 0), cA + kstep, voffA); PG8_STAGE(PG8_SB(1, 1), cB + hstepB + kstep, voffB);
        PG8_WAIT_V(6); PG8_BAR;
    }
    for (;;) {
        const bool has_next = S.next(ui + 1, nxt);
        const char* nA = has_next ? (g.arel ? g.arel + act_panel_off(nxt.pm) : (const char*)g.A + (size_t)nxt.pm * tstepA + (size_t)nxt.koff * 2) : cA; const char* nB = has_next ? (const char*)g.Bt + (size_t)nxt.pn * tstepB + (size_t)nxt.koff * 2 : cB;
        for (int t = 0; t < nt; t += 2) {
            const bool last = (t == nt - 2);
            if constexpr (Epi::PF) E.prefetch(cur, t, nt, tid, pfj);
            if constexpr (Epi::MID) { if (t == (nt >> 1)) E.mid(acc, cur, wr, wc, fr, fq); }
            const char* a1 = cA + (size_t)(t + 1) * kstep;
            const char* a2 = last ? nA : cA + (size_t)(t + 2) * kstep; const char* b2 = last ? nB : cB + (size_t)(t + 2) * kstep;
            const char* a3 = a2 + kstep; const char* b3 = b2 + kstep;
            if (last && has_next) S.a_ready(nxt);
            if constexpr (SP2) {
            PG8_LDB(B0, 0, 0); PG8_LDB(B1, 0, 1); PG8_SCHED; PG8_LDA(At, 0, 0); PG8_STAGE(PG8_SA(1, 1), a1 + hstepA, voffA);
            PG8_WAIT_V(8); PG8_WAIT_L(0); PG8_BAR; PG8_MMA(0, 0, At, B0); PG8_MMA(0, 1, At, B1); PG8_BAR; PG8_SCHED;
            PG8_LDA(At, 0, 1); PG8_STAGE(PG8_SB(0, 0), b2, voffB); PG8_STAGE(PG8_SB(0, 1), b2 + hstepB, voffB); PG8_STAGE(PG8_SA(0, 0), a2, voffA);
            PG8_WAIT_V(8); PG8_WAIT_L(0); PG8_BAR; PG8_MMA(1, 0, At, B0); PG8_MMA(1, 1, At, B1); PG8_BAR; PG8_SCHED;
            PG8_LDB(B0, 1, 0); PG8_LDB(B1, 1, 1); PG8_SCHED; PG8_LDA(At, 1, 0); PG8_STAGE(PG8_SA(0, 1), a2 + hstepA, voffA);
            PG8_WAIT_V(8); PG8_WAIT_L(0); PG8_BAR; PG8_MMA(0, 0, At, B0); PG8_MMA(0, 1, At, B1); PG8_BAR; PG8_SCHED;
            PG8_LDA(At, 1, 1); PG8_STAGE(PG8_SB(1, 0), b3, voffB); PG8_STAGE(PG8_SB(1, 1), b3 + hstepB, voffB); PG8_STAGE(PG8_SA(1, 0), a3, voffA);
            PG8_WAIT_V(8); PG8_WAIT_L(0); PG8_BAR; PG8_MMA(1, 0, At, B0); PG8_MMA(1, 1, At, B1); PG8_BAR; PG8_SCHED;
            } else {
            PG8_LDB(B0, 0, 0); PG8_SCHED; PG8_LDA(At, 0, 0); PG8_STAGE(PG8_SA(1, 1), a1 + hstepA, voffA);
            PG8_WAIT_L(8); PG8_BAR; PG8_WAIT_L(0); PG8_MMA(0, 0, At, B0); PG8_BAR; PG8_SCHED;
            PG8_LDB(B1, 0, 1); PG8_STAGE(PG8_SB(0, 0), b2, voffB);
            PG8_BAR; PG8_WAIT_L(0); PG8_MMA(0, 1, At, B1); PG8_BAR;
            PG8_LDA(At, 0, 1); PG8_STAGE(PG8_SA(0, 0), a2, voffA);
            PG8_BAR; PG8_WAIT_L(0); PG8_MMA(1, 0, At, B0); PG8_BAR; PG8_SCHED;
            PG8_STAGE(PG8_SB(0, 1), b2 + hstepB, voffB);
            PG8_WAIT_V(6); PG8_BAR; PG8_MMA(1, 1, At, B1); PG8_BAR;
            PG8_LDB(B0, 1, 0); PG8_SCHED; PG8_LDA(At, 1, 0); PG8_STAGE(PG8_SA(0, 1), a2 + hstepA, voffA);
            PG8_WAIT_L(8); PG8_BAR; PG8_WAIT_L(0); PG8_MMA(0, 0, At, B0); PG8_BAR; PG8_SCHED;
            PG8_LDB(B1, 1, 1); PG8_STAGE(PG8_SB(1, 0), b3, voffB);
            PG8_BAR; PG8_WAIT_L(0); PG8_MMA(0, 1, At, B1); PG8_BAR;
            PG8_LDA(At, 1, 1); PG8_STAGE(PG8_SA(1, 0), a3, voffA);
            PG8_BAR; PG8_WAIT_L(0); PG8_MMA(1, 0, At, B0); PG8_BAR; PG8_SCHED;
            PG8_STAGE(PG8_SB(1, 1), b3 + hstepB, voffB);
            PG8_WAIT_V(6); PG8_BAR; PG8_MMA(1, 1, At, B1); PG8_BAR;
            }
        }
        if constexpr (ALIGN_EPI) { if (wr == 0) PG8_BAR; }
        if constexpr (!Epi::AFTER_DRAIN) { E(acc, cur, wr, wc, fr, fq); S.done(cur); }
        asm volatile("" :: "v"(pfj));
        if (!has_next) break;
#pragma unroll
        for (int a = 0; a < 2; ++a)
#pragma unroll
            for (int b = 0; b < 2; ++b)
#pragma unroll
                for (int m = 0; m < 4; ++m)
#pragma unroll
                    for (int n = 0; n < 2; ++n) acc[a][b][m][n] = (f32x4){0.f, 0.f, 0.f, 0.f};
        cur = nxt; cA = nA; cB = nB; ++ui;
        if constexpr (ALIGN_EPI) { if (wr == 1) PG8_BAR; }
    }
    PG8_WAIT_V(0);
    if constexpr (!ALIGN_EPI) { if (wr == 0) PG8_BAR; }
    PG8_BAR;
    if constexpr (Epi::AFTER_DRAIN) { E.fused(acc, cur, wr, wc, fr, fq, lds, wid, lane); S.done(cur); }
#undef PG8_SA
#undef PG8_SB
#undef PG8_STAGE
#undef PG8_LDA
#undef PG8_LDB
#undef PG8_MMA
#undef PG8_WAIT_V
#undef PG8_WAIT_L
#undef PG8_BAR
#undef PG8_SCHED
}
}

namespace attn {
constexpr int SLOTB = 8192;
constexpr int NSLOT = 5;
constexpr int LDS_K = 0, LDS_V = NSLOT * SLOTB, LDS_WS = 2 * NSLOT * SLOTB, LDS_OST = LDS_WS + 8 * 256, LDS_CL = LDS_OST + 8 * 4096, LDS_SCAN = LDS_CL + 2064 * 4 + 64, LDS_END = LDS_SCAN + 64;
#define SBAR() __builtin_amdgcn_sched_barrier(0)
__device__ __forceinline__ int crow(int r, int hi) { return (r & 3) + 8 * (r >> 2) + 4 * hi; }
__device__ __forceinline__ void glds16(const void* gsrc, unsigned lds_dst) { unsigned keep;
    asm volatile("s_mov_b32 %0, m0\n\ts_mov_b32 m0, %2\n\ts_nop 0\n\tglobal_load_lds_dwordx4 %1, off\n\ts_mov_b32 m0, %0" : "=&s"(keep) : "v"(gsrc), "s"(lds_dst) : "memory"); }
typedef float f32x2_t __attribute__((ext_vector_type(2))); typedef __bf16 bf16x2_t __attribute__((ext_vector_type(2)));
__device__ __forceinline__ unsigned cvtpk_s(float lo, float hi) { f32x2_t v = {lo, hi}; bf16x2_t b = __builtin_convertvector(v, bf16x2_t); return __builtin_bit_cast(unsigned, b); }
#define MX3(a, b, c) __builtin_fmaxf(__builtin_fmaxf((a), (b)), (c))
__device__ __forceinline__ void qkt(f32x16& p0, f32x16& p1, const char* Kslot, const bf16x8* qr, const f32x16& negm, int r32, int hi) {
    const char* kb = Kslot + hi * 1024 + r32 * 16;
#pragma unroll
    for (int d0 = 0; d0 < 4; ++d0) {
        const bf16x8 b0 = *reinterpret_cast<const bf16x8*>(kb + d0 * 2048);
        const bf16x8 b1 = *reinterpret_cast<const bf16x8*>(kb + d0 * 2048 + 512);
        if (d0 == 0) { p0 = __builtin_amdgcn_mfma_f32_32x32x16_bf16(b0, qr[0], negm, 0, 0, 0); p1 = __builtin_amdgcn_mfma_f32_32x32x16_bf16(b1, qr[0], negm, 0, 0, 0); }
        else { p0 = __builtin_amdgcn_mfma_f32_32x32x16_bf16(b0, qr[d0], p0, 0, 0, 0); p1 = __builtin_amdgcn_mfma_f32_32x32x16_bf16(b1, qr[d0], p1, 0, 0, 0); }
    }
}
__device__ __forceinline__ float rowmax(const f32x16& p0, const f32x16& p1) {
    float a = MX3(p0[0], p0[1], p1[0]), b = MX3(p0[2], p0[3], p1[1]); a = MX3(a, p1[2], p1[3]);
#pragma unroll
    for (int r = 4; r < 16; r += 4) { a = MX3(a, p0[r], p0[r + 1]); b = MX3(b, p0[r + 2], p0[r + 3]); a = MX3(a, p1[r], p1[r + 1]); b = MX3(b, p1[r + 2], p1[r + 3]); }
    const float m = __builtin_fmaxf(a, b);
    auto rr = __builtin_amdgcn_permlane32_swap(__float_as_uint(m), __float_as_uint(m), false, false);
    return __builtin_fmaxf(__uint_as_float(rr[0]), __uint_as_float(rr[1]));
}
__device__ __forceinline__ void pv(f32x16* o, int vb, bf16x8 pa0, bf16x8 pa1, bf16x8 pa2, bf16x8 pa3) {
#pragma unroll
    for (int d0 = 0; d0 < 2; ++d0) { s16x4 lo[4], hi[4];
#pragma unroll
        for (int ks = 0; ks < 4; ++ks) {
            asm volatile("ds_read_b64_tr_b16 %0,%1 offset:%c2" : "=&v"(lo[ks]) : "v"(vb), "i"(d0 * 4096 + ks * 1024) : "memory");
            asm volatile("ds_read_b64_tr_b16 %0,%1 offset:%c2" : "=&v"(hi[ks]) : "v"(vb), "i"(d0 * 4096 + ks * 1024 + 512) : "memory"); }
        asm volatile("s_waitcnt lgkmcnt(0)" ::: "memory"); SBAR();
#define PK(k) (bf16x8){lo[k][0], lo[k][1], lo[k][2], lo[k][3], hi[k][0], hi[k][1], hi[k][2], hi[k][3]}
        o[d0] = __builtin_amdgcn_mfma_f32_32x32x16_bf16(pa0, PK(0), o[d0], 0, 0, 0);
        o[d0] = __builtin_amdgcn_mfma_f32_32x32x16_bf16(pa1, PK(1), o[d0], 0, 0, 0);
        o[d0] = __builtin_amdgcn_mfma_f32_32x32x16_bf16(pa2, PK(2), o[d0], 0, 0, 0);
        o[d0] = __builtin_amdgcn_mfma_f32_32x32x16_bf16(pa3, PK(3), o[d0], 0, 0, 0);
#undef PK
    }
}
#define WAIT_BAR0() asm volatile("s_waitcnt vmcnt(0) lgkmcnt(0)\n\ts_barrier" ::: "memory")

template <int MODE>
__device__ __forceinline__ void unit(const bf16_t* Qw, bf16_t* Ow, const bf16_t* Kh, const bf16_t* Vh, int kp, int NT, int kbase, int qpos0,
                                     float slope2, float sink2, const float* cl, char* shm) {
    const int tid = threadIdx.x, lane = tid & 63, r32 = lane & 31, hi = lane >> 5; const int wid = __builtin_amdgcn_readfirstlane(tid >> 6);
    const unsigned lds0 = (unsigned)(uintptr_t)shm;
    float* wsf = (float*)(shm + LDS_WS) + wid * 64;
    const bf16_t* ksrc = Kh + (size_t)lane * kp + wid * 8;
    const bf16_t* vsrc = Vh + (size_t)(16 * (wid & 3) + (lane >> 2)) * kp + (wid >> 2) * 32 + (lane & 3) * 8;
    const unsigned kdst = lds0 + LDS_K + wid * 1024, vdst = lds0 + LDS_V + wid * 1024;
#define TILE_KR0(t) ((t) == 0 ? 64 : kbase + 64 * ((t) - 1))
#define DMA_KV(t, slot) do { const size_t ro_ = (size_t)TILE_KR0(t) * kp; \
        glds16(ksrc + ro_, (unsigned)__builtin_amdgcn_readfirstlane(kdst + (slot) * SLOTB)); glds16(vsrc + ro_, (unsigned)__builtin_amdgcn_readfirstlane(vdst + (slot) * SLOTB)); } while (0)
    const int vb0 = (int)(lds0 + LDS_V) + ((lane >> 4) & 1) * 32 + (lane & 3) * 8 + (4 * hi + ((lane & 15) >> 2)) * 64;
    DMA_KV(0, 0);
    bf16x8 qr[4];
#pragma unroll
    for (int d0 = 0; d0 < 4; ++d0) qr[d0] = *reinterpret_cast<const bf16x8*>(Qw + (size_t)r32 * DM + d0 * 16 + hi * 8);
    const int qp = qpos0 + r32;
    const float rowterm = (MODE == 0) ? cl[qp - KR_META] : -slope2 * (float)qp;
    float mhat = (MODE == 0) ? 0.f : sink2, l_reg = (MODE == 1 && hi == 0) ? 1.f : 0.f;
    f32x16 o[2]; o[0] = f32x16{}; o[1] = f32x16{};
    for (int t = 0; t < NT; ++t) {
        WAIT_BAR0();
        if (t + 1 < NT) DMA_KV(t + 1, (t + 1) & 1);
        const int slot = t & 1, kr0 = TILE_KR0(t);
        bool empty = false, full = false;
        if (MODE == 1 && t > 0) { empty = (kr0 > qpos0 + 31) || (kr0 + 63 <= qpos0 - 128) || (kr0 + 63 < KR_REAL);
            full = (kr0 >= KR_REAL) && (kr0 + 63 <= qpos0) && (qpos0 + 31 - kr0 < 128); }
        if (empty) continue;
        f32x16 negm; { const float nm = rowterm - mhat;
#pragma unroll
            for (int r = 0; r < 16; ++r) negm[r] = nm; }
        f32x16 p0, p1;
        qkt(p0, p1, shm + LDS_K + slot * SLOTB, qr, negm, r32, hi);
        const bool need_mask = (MODE == 1 && !full) || (MODE == 0 && ((kr0 < KR_META) || (kr0 + 63 > qpos0)));
        if (need_mask) {
#pragma unroll
            for (int r = 0; r < 16; ++r) {
                const int k0 = kr0 + crow(r, hi), k1 = k0 + 32;
                bool ok0, ok1; float c0, c1;
                if (MODE == 0) { ok0 = (k0 >= KR_META) && (k0 <= qp); ok1 = (k1 >= KR_META) && (k1 <= qp);
                    c0 = -cl[k0 >= KR_META ? k0 - KR_META : 0]; c1 = -cl[k1 >= KR_META ? k1 - KR_META : 0]; }
                else { ok0 = (t == 0) ? (k0 >= KR_META) : (k0 >= KR_REAL && k0 <= qp && qp - k0 < 128); ok1 = (t == 0) ? (k1 >= KR_META) : (k1 >= KR_REAL && k1 <= qp && qp - k1 < 128);
                    c0 = slope2 * (float)k0; c1 = slope2 * (float)k1; }
                p0[r] = ok0 ? p0[r] + c0 : -INFINITY; p1[r] = ok1 ? p1[r] + c1 : -INFINITY;
            }
        } else {
#pragma unroll
            for (int r = 0; r < 16; ++r) { const int k0 = kr0 + crow(r, hi);
                if (MODE == 0) { p0[r] -= cl[k0 - KR_META]; p1[r] -= cl[k0 - KR_META + 32]; }
                else { p0[r] += slope2 * (float)k0; p1[r] += slope2 * (float)(k0 + 32); } }
        }
        const float rm = rowmax(p0, p1);
        if (MODE == 0 && t == 0) {
            mhat = rm;
#pragma unroll
            for (int r = 0; r < 16; ++r) { p0[r] -= rm; p1[r] -= rm; }
        } else if (__any(rm > 0.f)) {
            const float dl = __builtin_fmaxf(rm, 0.f); mhat += dl;
#pragma unroll
            for (int r = 0; r < 16; ++r) { p0[r] -= dl; p1[r] -= dl; }
            const float f = __builtin_amdgcn_exp2f(-dl); l_reg *= f;
            if (hi == 0) wsf[r32] = f;
            asm volatile("s_waitcnt lgkmcnt(0)" ::: "memory");
#pragma unroll
            for (int d = 0; d < 2; ++d)
#pragma unroll
                for (int r = 0; r < 16; ++r) o[d][r] *= wsf[crow(r, hi)];
        }
        float sacc = 0.f;
#pragma unroll
        for (int r = 0; r < 16; ++r) { p0[r] = __builtin_amdgcn_exp2f(p0[r]); p1[r] = __builtin_amdgcn_exp2f(p1[r]); sacc += p0[r] + p1[r]; }
        l_reg += sacc;
        u32x4 pw0, pw1, pw2, pw3;
        pw0 = (u32x4){cvtpk_s(p0[0], p0[1]), cvtpk_s(p0[2], p0[3]), cvtpk_s(p0[4], p0[5]), cvtpk_s(p0[6], p0[7])};
        pw1 = (u32x4){cvtpk_s(p0[8], p0[9]), cvtpk_s(p0[10], p0[11]), cvtpk_s(p0[12], p0[13]), cvtpk_s(p0[14], p0[15])};
        pw2 = (u32x4){cvtpk_s(p1[0], p1[1]), cvtpk_s(p1[2], p1[3]), cvtpk_s(p1[4], p1[5]), cvtpk_s(p1[6], p1[7])};
        pw3 = (u32x4){cvtpk_s(p1[8], p1[9]), cvtpk_s(p1[10], p1[11]), cvtpk_s(p1[12], p1[13]), cvtpk_s(p1[14], p1[15])};
        SBAR();
        pv(o, vb0 + slot * SLOTB, __builtin_bit_cast(bf16x8, pw0), __builtin_bit_cast(bf16x8, pw1), __builtin_bit_cast(bf16x8, pw2), __builtin_bit_cast(bf16x8, pw3));
    }
    { auto rr = __builtin_amdgcn_permlane32_swap(__float_as_uint(l_reg), __float_as_uint(l_reg), false, false); l_reg = __uint_as_float(rr[0]) + __uint_as_float(rr[1]); }
    if (hi == 0) wsf[32 + r32] = l_reg;
    asm volatile("s_waitcnt lgkmcnt(0)" ::: "memory");
    float rli[16];
#pragma unroll
    for (int r = 0; r < 16; ++r) rli[r] = 1.0f / wsf[32 + crow(r, hi)];
    { __hip_bfloat16* stg = (__hip_bfloat16*)(shm + LDS_OST) + wid * 2048;
#pragma unroll
        for (int r = 0; r < 16; ++r) { const int orow = crow(r, hi);
#pragma unroll
            for (int d0 = 0; d0 < 2; ++d0) stg[orow * 64 + d0 * 32 + r32] = __float2bfloat16(o[d0][r] * rli[r]); }
        asm volatile("s_waitcnt lgkmcnt(0)" ::: "memory");
#pragma unroll
        for (int i = 0; i < 4; ++i) { const int row = i * 8 + (lane >> 3), ch = lane & 7; const u32x4 v = *(const u32x4*)(stg + row * 64 + ch * 8); *(u32x4*)(Ow + (size_t)row * DM + ch * 8) = v; } }
    asm volatile("s_waitcnt lgkmcnt(0)\n\ts_barrier" ::: "memory");
#undef DMA_KV
#undef TILE_KR0
}

__device__ __forceinline__ void unit_swa(const bf16_t* Qw, bf16_t* Ow, const bf16_t* Kh, const bf16_t* Vh, int kp, int kbase, int qpos0, float slope2, float sink2, char* shm, int dbg_nocompute = 0) {
    const int tid = threadIdx.x; int lane_ = tid & 63; asm volatile("" : "+v"(lane_));
    const int lane = lane_, r32 = lane & 31, hi = lane >> 5; const int wid = __builtin_amdgcn_readfirstlane(tid >> 6);
    const unsigned lds0 = (unsigned)(uintptr_t)shm;
    float* wsf = (float*)(shm + LDS_WS) + wid * 64;
    const bf16_t* ksrc = Kh + (size_t)lane * kp + wid * 8;
    const bf16_t* vsrc = Vh + (size_t)(16 * (wid & 3) + (lane >> 2)) * kp + (wid >> 2) * 32 + (lane & 3) * 8;
    const unsigned kdst = lds0 + LDS_K + wid * 1024, vdst = lds0 + LDS_V + wid * 1024;
#define TILE_KR0(t) ((t) == 0 ? 64 : kbase + 64 * ((t) - 1))
#define DMA_KV(t, slot) do { const size_t ro_ = (size_t)TILE_KR0(t) * kp; \
        glds16(ksrc + ro_, (unsigned)__builtin_amdgcn_readfirstlane(kdst + (slot) * SLOTB)); glds16(vsrc + ro_, (unsigned)__builtin_amdgcn_readfirstlane(vdst + (slot) * SLOTB)); } while (0)
    const int vb0 = (int)(lds0 + LDS_V) + ((lane >> 4) & 1) * 32 + (lane & 3) * 8 + (4 * hi + ((lane & 15) >> 2)) * 64;
#pragma unroll
    for (int t = 0; t < 5; ++t) DMA_KV(t, t);
    bf16x8 qr[4];
#pragma unroll
    for (int d0 = 0; d0 < 4; ++d0) qr[d0] = *reinterpret_cast<const bf16x8*>(Qw + (size_t)r32 * DM + d0 * 16 + hi * 8);
    const int qp = qpos0 + r32;
    const float rowterm = -slope2 * (float)qp;
    float mhat = sink2, l_reg = (hi == 0) ? 1.f : 0.f;
    f32x16 o[2]; o[0] = f32x16{}; o[1] = f32x16{};
#define SWA_RESCALE(RM, SUBS) do { if (__any((RM) > 8.f)) { const float dl = __builtin_fmaxf((RM), 0.f); mhat += dl; SUBS; \
        const float f = __builtin_amdgcn_exp2f(-dl); l_reg *= f; if (hi == 0) wsf[r32] = f; asm volatile("s_waitcnt lgkmcnt(0)" ::: "memory"); \
        _Pragma("unroll") for (int d = 0; d < 2; ++d) _Pragma("unroll") for (int r = 0; r < 16; ++r) o[d][r] *= wsf[crow(r, hi)]; } } while (0)
    WAIT_BAR0();
    for (int t = 0; t < 5; ++t) {
        if (dbg_nocompute) continue;
        const int slot = t, kr0 = TILE_KR0(t);
        const char* Kslot = shm + LDS_K + slot * SLOTB;
        if (t == 0) {
            f32x16 p1; { const float nm = rowterm - mhat;
#pragma unroll
                for (int r = 0; r < 16; ++r) p1[r] = nm; }
            const char* kb = Kslot + hi * 1024 + r32 * 16 + 512;
#pragma unroll
            for (int d0 = 0; d0 < 4; ++d0) p1 = __builtin_amdgcn_mfma_f32_32x32x16_bf16(*reinterpret_cast<const bf16x8*>(kb + d0 * 2048), qr[d0], p1, 0, 0, 0);
            const float base = slope2 * (float)(96 + 4 * hi);
            float x[8];
#pragma unroll
            for (int r = 0; r < 8; ++r) x[r] = p1[8 + r] + __builtin_fmaf(slope2, (float)(((8 + r) & 3) + 8 * ((8 + r) >> 2)), base);
            float rm = MX3(MX3(x[0], x[1], x[2]), MX3(x[3], x[4], x[5]), __builtin_fmaxf(x[6], x[7]));
            { auto rr = __builtin_amdgcn_permlane32_swap(__float_as_uint(rm), __float_as_uint(rm), false, false); rm = __builtin_fmaxf(__uint_as_float(rr[0]), __uint_as_float(rr[1])); }
            SWA_RESCALE(rm, _Pragma("unroll") for (int r = 0; r < 8; ++r) x[r] -= dl);
            float sacc = 0.f;
#pragma unroll
            for (int r = 0; r < 8; ++r) { x[r] = __builtin_amdgcn_exp2f(x[r]); sacc += x[r]; }
            l_reg += sacc;
            const u32x4 pw3 = (u32x4){cvtpk_s(x[0], x[1]), cvtpk_s(x[2], x[3]), cvtpk_s(x[4], x[5]), cvtpk_s(x[6], x[7])};
            const int vb = vb0 + slot * SLOTB;
#pragma unroll
            for (int d0 = 0; d0 < 2; ++d0) { s16x4 lo, hh;
                asm volatile("ds_read_b64_tr_b16 %0,%1 offset:%c2" : "=&v"(lo) : "v"(vb), "i"(d0 * 4096 + 3 * 1024) : "memory");
                asm volatile("ds_read_b64_tr_b16 %0,%1 offset:%c2" : "=&v"(hh) : "v"(vb), "i"(d0 * 4096 + 3 * 1024 + 512) : "memory");
                asm volatile("s_waitcnt lgkmcnt(0)" ::: "memory"); SBAR();
                o[d0] = __builtin_amdgcn_mfma_f32_32x32x16_bf16(__builtin_bit_cast(bf16x8, pw3), (bf16x8){lo[0], lo[1], lo[2], lo[3], hh[0], hh[1], hh[2], hh[3]}, o[d0], 0, 0, 0); }
            continue;
        }
        const int dmin = qpos0 - (kr0 + 63), dmax = qpos0 + 31 - kr0;
        if (dmax < 0 || dmin >= 128 || kr0 + 63 < KR_REAL) continue;
        f32x16 negm; { const float nm = rowterm - mhat;
#pragma unroll
            for (int r = 0; r < 16; ++r) negm[r] = nm; }
        f32x16 p0, p1;
        qkt(p0, p1, Kslot, qr, negm, r32, hi);
        const float base = slope2 * (float)(kr0 + 4 * hi);
        const int lim = qp - kr0 - 4 * hi;
        if (dmin < 0) {
#pragma unroll
            for (int r = 0; r < 16; ++r) { const int cr = (r & 3) + 8 * (r >> 2);
                p0[r] = (cr <= lim) ? p0[r] + __builtin_fmaf(slope2, (float)cr, base) : -INFINITY; p1[r] = (cr + 32 <= lim) ? p1[r] + __builtin_fmaf(slope2, (float)(cr + 32), base) : -INFINITY; }
        } else if (dmax >= 128) {
#pragma unroll
            for (int r = 0; r < 16; ++r) { const int cr = (r & 3) + 8 * (r >> 2);
                p0[r] = (cr > lim - 128) ? p0[r] + __builtin_fmaf(slope2, (float)cr, base) : -INFINITY; p1[r] = (cr + 32 > lim - 128) ? p1[r] + __builtin_fmaf(slope2, (float)(cr + 32), base) : -INFINITY; }
        } else {
#pragma unroll
            for (int r = 0; r < 16; ++r) { const int cr = (r & 3) + 8 * (r >> 2); p0[r] += __builtin_fmaf(slope2, (float)cr, base); p1[r] += __builtin_fmaf(slope2, (float)(cr + 32), base); }
        }
        const float rm = rowmax(p0, p1);
        SWA_RESCALE(rm, _Pragma("unroll") for (int r = 0; r < 16; ++r) { p0[r] -= dl; p1[r] -= dl; });
        float sacc = 0.f;
#pragma unroll
        for (int r = 0; r < 16; ++r) { p0[r] = __builtin_amdgcn_exp2f(p0[r]); p1[r] = __builtin_amdgcn_exp2f(p1[r]); sacc += p0[r] + p1[r]; }
        l_reg += sacc;
        u32x4 pw0, pw1, pw2, pw3;
        pw0 = (u32x4){cvtpk_s(p0[0], p0[1]), cvtpk_s(p0[2], p0[3]), cvtpk_s(p0[4], p0[5]), cvtpk_s(p0[6], p0[7])};
        pw1 = (u32x4){cvtpk_s(p0[8], p0[9]), cvtpk_s(p0[10], p0[11]), cvtpk_s(p0[12], p0[13]), cvtpk_s(p0[14], p0[15])};
        pw2 = (u32x4){cvtpk_s(p1[0], p1[1]), cvtpk_s(p1[2], p1[3]), cvtpk_s(p1[4], p1[5]), cvtpk_s(p1[6], p1[7])};
        pw3 = (u32x4){cvtpk_s(p1[8], p1[9]), cvtpk_s(p1[10], p1[11]), cvtpk_s(p1[12], p1[13]), cvtpk_s(p1[14], p1[15])};
        SBAR();
        pv(o, vb0 + slot * SLOTB, __builtin_bit_cast(bf16x8, pw0), __builtin_bit_cast(bf16x8, pw1), __builtin_bit_cast(bf16x8, pw2), __builtin_bit_cast(bf16x8, pw3));
    }
    { auto rr = __builtin_amdgcn_permlane32_swap(__float_as_uint(l_reg), __float_as_uint(l_reg), false, false); l_reg = __uint_as_float(rr[0]) + __uint_as_float(rr[1]); }
    if (hi == 0) wsf[32 + r32] = l_reg;
    asm volatile("s_waitcnt lgkmcnt(0)" ::: "memory");
    float rli[16];
#pragma unroll
    for (int r = 0; r < 16; ++r) rli[r] = 1.0f / wsf[32 + crow(r, hi)];
    { __hip_bfloat16* stg = (__hip_bfloat16*)(shm + LDS_OST) + wid * 2048;
#pragma unroll
        for (int r = 0; r < 16; ++r) { const int orow = crow(r, hi);
#pragma unroll
            for (int d0 = 0; d0 < 2; ++d0) stg[orow * 64 + d0 * 32 + r32] = __float2bfloat16(o[d0][r] * rli[r]); }
        asm volatile("s_waitcnt lgkmcnt(0)" ::: "memory");
#pragma unroll
        for (int i = 0; i < 4; ++i) { const int row = i * 8 + (lane >> 3), ch = lane & 7; const u32x4 v = *(const u32x4*)(stg + row * 64 + ch * 8); *(u32x4*)(Ow + (size_t)row * DM + ch * 8) = v; } }
    asm volatile("s_waitcnt lgkmcnt(0)\n\ts_barrier" ::: "memory");
#undef SWA_RESCALE
#undef DMA_KV
#undef TILE_KR0
}

template <bool REUSE> __device__ __forceinline__ void unit_swa2(const bf16_t* Qw, bf16_t* Ow, const bf16_t* Kh, const bf16_t* Vh, int kp, int kbase, int qpos0, float slope2, float sink2, char* shm) {
    const int tid = threadIdx.x; int lane_ = tid & 63; asm volatile("" : "+v"(lane_));
    const int lane = lane_, r32 = lane & 31, hi = lane >> 5; const int wid = __builtin_amdgcn_readfirstlane(tid >> 6);
    const unsigned lds0 = (unsigned)(uintptr_t)shm;
    float* wsf = (float*)(shm + LDS_WS) + wid * 64;
    const bf16_t* ksrc = Kh + (size_t)lane * kp + wid * 8;
    const bf16_t* vsrc = Vh + (size_t)(16 * (wid & 3) + (lane >> 2)) * kp + (wid >> 2) * 32 + (lane & 3) * 8;
    const unsigned kdst = lds0 + LDS_K + wid * 1024, vdst = lds0 + LDS_V + wid * 1024;
#define TILE_KR0(t) ((t) == 0 ? 64 : kbase + 64 * ((t) - 1))
#define DMA_KV(t, slot) do { const size_t ro_ = (size_t)TILE_KR0(t) * kp; \
        glds16(ksrc + ro_, (unsigned)__builtin_amdgcn_readfirstlane(kdst + (slot) * SLOTB)); glds16(vsrc + ro_, (unsigned)__builtin_amdgcn_readfirstlane(vdst + (slot) * SLOTB)); } while (0)
    const int vb0 = (int)(lds0 + LDS_V) + ((lane >> 4) & 1) * 32 + (lane & 3) * 8 + (4 * hi + ((lane & 15) >> 2)) * 64;
    if (!REUSE) {
#pragma unroll
        for (int t = 0; t < 5; ++t) DMA_KV(t, t);
    }
    bf16x8 qr[4];
#pragma unroll
    for (int d0 = 0; d0 < 4; ++d0) qr[d0] = *reinterpret_cast<const bf16x8*>(Qw + (size_t)r32 * DM + d0 * 16 + hi * 8);
    const int qp = qpos0 + r32;
    const float rowterm = -slope2 * (float)qp;
    const int jb0 = ((qpos0 - kbase - 128) >> 5) >= 2 ? 1 : 0;
    const int krW = kbase + 64 * jb0, krF = krW + 64, krC = krW + 128;
    const bool vW = krW >= KR_REAL, vF = krF >= KR_REAL;
    f32x16 initc;
#pragma unroll
    for (int r = 0; r < 16; ++r) initc[r] = rowterm;
    if (!REUSE) WAIT_BAR0();
    f32x16 pm = initc;
    { const char* kb = shm + LDS_K + hi * 1024 + r32 * 16 + 512;
#pragma unroll
      for (int d0 = 0; d0 < 4; ++d0) pm = __builtin_amdgcn_mfma_f32_32x32x16_bf16(*reinterpret_cast<const bf16x8*>(kb + d0 * 2048), qr[d0], pm, 0, 0, 0); }
    f32x16 w0, w1, f0, f1, c0, c1;
    if (vW) qkt(w0, w1, shm + LDS_K + (1 + jb0) * SLOTB, qr, initc, r32, hi);
    if (vF) qkt(f0, f1, shm + LDS_K + (2 + jb0) * SLOTB, qr, initc, r32, hi);
    qkt(c0, c1, shm + LDS_K + (3 + jb0) * SLOTB, qr, initc, r32, hi);
    float xm[8];
    { const float base = slope2 * (float)(96 + 4 * hi);
#pragma unroll
      for (int r = 0; r < 8; ++r) xm[r] = pm[8 + r] + __builtin_fmaf(slope2, (float)(((8 + r) & 3) + 8 * ((8 + r) >> 2)), base); }
    if (vW) { const float base = slope2 * (float)(krW + 4 * hi); const int lim = qp - krW - 4 * hi;
#pragma unroll
        for (int r = 0; r < 16; ++r) { const int cr = (r & 3) + 8 * (r >> 2);
            w0[r] = (cr > lim - 128) ? w0[r] + __builtin_fmaf(slope2, (float)cr, base) : -INFINITY; w1[r] = (cr + 32 > lim - 128) ? w1[r] + __builtin_fmaf(slope2, (float)(cr + 32), base) : -INFINITY; }
    } else {
#pragma unroll
        for (int r = 0; r < 16; ++r) { w0[r] = -INFINITY; w1[r] = -INFINITY; } }
    if (vF) { const float base = slope2 * (float)(krF + 4 * hi);
#pragma unroll
        for (int r = 0; r < 16; ++r) { const int cr = (r & 3) + 8 * (r >> 2); f0[r] += __builtin_fmaf(slope2, (float)cr, base); f1[r] += __builtin_fmaf(slope2, (float)(cr + 32), base); }
    } else {
#pragma unroll
        for (int r = 0; r < 16; ++r) { f0[r] = -INFINITY; f1[r] = -INFINITY; } }
    { const float base = slope2 * (float)(krC + 4 * hi); const int lim = qp - krC - 4 * hi;
#pragma unroll
      for (int r = 0; r < 16; ++r) { const int cr = (r & 3) + 8 * (r >> 2);
          c0[r] = (cr <= lim) ? c0[r] + __builtin_fmaf(slope2, (float)cr, base) : -INFINITY; c1[r] = (cr + 32 <= lim) ? c1[r] + __builtin_fmaf(slope2, (float)(cr + 32), base) : -INFINITY; } }
    float m = __builtin_fmaxf(__builtin_fmaxf(rowmax(w0, w1), rowmax(f0, f1)), rowmax(c0, c1));
    { float mm = MX3(MX3(xm[0], xm[1], xm[2]), MX3(xm[3], xm[4], xm[5]), __builtin_fmaxf(xm[6], xm[7]));
      auto rr = __builtin_amdgcn_permlane32_swap(__float_as_uint(mm), __float_as_uint(mm), false, false); mm = __builtin_fmaxf(__uint_as_float(rr[0]), __uint_as_float(rr[1]));
      m = __builtin_fmaxf(__builtin_fmaxf(m, mm), sink2); }
    f32x16 o[2]; o[0] = f32x16{}; o[1] = f32x16{};
    float l_reg = (hi == 0) ? __builtin_amdgcn_exp2f(sink2 - m) : 0.f;
    { float sacc = 0.f;
#pragma unroll
      for (int r = 0; r < 8; ++r) { xm[r] = __builtin_amdgcn_exp2f(xm[r] - m); sacc += xm[r]; }
      l_reg += sacc;
      const u32x4 pw3 = (u32x4){cvtpk_s(xm[0], xm[1]), cvtpk_s(xm[2], xm[3]), cvtpk_s(xm[4], xm[5]), cvtpk_s(xm[6], xm[7])};
#pragma unroll
      for (int d0 = 0; d0 < 2; ++d0) { s16x4 lo, hh;
          asm volatile("ds_read_b64_tr_b16 %0,%1 offset:%c2" : "=&v"(lo) : "v"(vb0), "i"(d0 * 4096 + 3 * 1024) : "memory");
          asm volatile("ds_read_b64_tr_b16 %0,%1 offset:%c2" : "=&v"(hh) : "v"(vb0), "i"(d0 * 4096 + 3 * 1024 + 512) : "memory");
          asm volatile("s_waitcnt lgkmcnt(0)" ::: "memory"); SBAR();
          o[d0] = __builtin_amdgcn_mfma_f32_32x32x16_bf16(__builtin_bit_cast(bf16x8, pw3), (bf16x8){lo[0], lo[1], lo[2], lo[3], hh[0], hh[1], hh[2], hh[3]}, o[d0], 0, 0, 0); } }
#define SWA2_TILE(P0, P1, SLOT) do { float sacc = 0.f; \
        _Pragma("unroll") for (int r = 0; r < 16; ++r) { P0[r] = __builtin_amdgcn_exp2f(P0[r] - m); P1[r] = __builtin_amdgcn_exp2f(P1[r] - m); sacc += P0[r] + P1[r]; } \
        l_reg += sacc; \
        const u32x4 q0_ = (u32x4){cvtpk_s(P0[0], P0[1]), cvtpk_s(P0[2], P0[3]), cvtpk_s(P0[4], P0[5]), cvtpk_s(P0[6], P0[7])}; \
        const u32x4 q1_ = (u32x4){cvtpk_s(P0[8], P0[9]), cvtpk_s(P0[10], P0[11]), cvtpk_s(P0[12], P0[13]), cvtpk_s(P0[14], P0[15])}; \
        const u32x4 q2_ = (u32x4){cvtpk_s(P1[0], P1[1]), cvtpk_s(P1[2], P1[3]), cvtpk_s(P1[4], P1[5]), cvtpk_s(P1[6], P1[7])}; \
        const u32x4 q3_ = (u32x4){cvtpk_s(P1[8], P1[9]), cvtpk_s(P1[10], P1[11]), cvtpk_s(P1[12], P1[13]), cvtpk_s(P1[14], P1[15])}; \
        SBAR(); pv(o, vb0 + (SLOT) * SLOTB, __builtin_bit_cast(bf16x8, q0_), __builtin_bit_cast(bf16x8, q1_), __builtin_bit_cast(bf16x8, q2_), __builtin_bit_cast(bf16x8, q3_)); } while (0)
    if (vW) SWA2_TILE(w0, w1, 1 + jb0);
    if (vF) SWA2_TILE(f0, f1, 2 + jb0);
    SWA2_TILE(c0, c1, 3 + jb0);
#undef SWA2_TILE
    { auto rr = __builtin_amdgcn_permlane32_swap(__float_as_uint(l_reg), __float_as_uint(l_reg), false, false); l_reg = __uint_as_float(rr[0]) + __uint_as_float(rr[1]); }
    if (hi == 0) wsf[32 + r32] = l_reg;
    asm volatile("s_waitcnt lgkmcnt(0)" ::: "memory");
    float rli[16];
#pragma unroll
    for (int r = 0; r < 16; ++r) rli[r] = __builtin_amdgcn_rcpf(wsf[32 + crow(r, hi)]);
    { __hip_bfloat16* stg = (__hip_bfloat16*)(shm + LDS_OST) + wid * 2048;
#pragma unroll
        for (int r = 0; r < 16; ++r) { const int orow = crow(r, hi);
#pragma unroll
            for (int d0 = 0; d0 < 2; ++d0) stg[orow * 64 + d0 * 32 + r32] = __float2bfloat16(o[d0][r] * rli[r]); }
        asm volatile("s_waitcnt lgkmcnt(0)" ::: "memory");
#pragma unroll
        for (int i = 0; i < 4; ++i) { const int row = i * 8 + (lane >> 3), ch = lane & 7; const u32x4 v = *(const u32x4*)(stg + row * 64 + ch * 8); *(u32x4*)(Ow + (size_t)row * DM + ch * 8) = v; } }
    asm volatile("s_waitcnt lgkmcnt(0)\n\ts_barrier" ::: "memory");
#undef DMA_KV
#undef TILE_KR0
}
#undef WAIT_BAR0
#undef SBAR
#undef MX3
}

namespace attn2 {
using bf16=__hip_bfloat16;
__device__ __forceinline__ int crow(int r,int hi){return (r&3)+8*(r>>2)+4*hi;}
#define SBAR() __builtin_amdgcn_sched_barrier(0)
__device__ __forceinline__ void cmask(f32x16&p0,f32x16&p1,int jb,int qrel,int hi){
  const float NEG=-INFINITY; int kb=64*jb+4*hi;
  #pragma unroll
  for(int r=0;r<16;++r){int kv=kb+(r&3)+8*(r>>2); if(kv>qrel)p0[r]=NEG; if(kv+32>qrel)p1[r]=NEG;}
}

constexpr int NSLOT=3, SLOTB=8192;
constexpr int NW=8;
constexpr int LDS_K=0, LDS_V=NSLOT*SLOTB, LDS_WS=2*NSLOT*SLOTB, LDS_OST=LDS_WS+NW*64*4, LDS_CL=LDS_OST+NW*4096, LDS_SCAN=LDS_CL+2064*4+64, LDS_END=LDS_SCAN+192;
__device__ __forceinline__ void glds16(const void*gsrc,unsigned lds_dst){unsigned keep;
  asm volatile("s_mov_b32 %0, m0\n\ts_mov_b32 m0, %2\n\ts_nop 0\n\tglobal_load_lds_dwordx4 %1, off\n\ts_mov_b32 m0, %0":"=&s"(keep):"v"(gsrc),"s"(lds_dst):"memory");}
__device__ __forceinline__ float max3f(float a,float b,float c){float r;asm("v_max3_f32 %0, %1, %2, %3":"=v"(r):"v"(a),"v"(b),"v"(c));return r;}
__device__ __forceinline__ float max2f(float a,float b){float r;asm("v_max_f32_e32 %0, %1, %2":"=v"(r):"v"(a),"v"(b));return r;}
__device__ __forceinline__ float fadd_s(float a,float b){float r;asm("v_add_f32_e32 %0, %1, %2":"=v"(r):"v"(a),"v"(b));return r;}
__device__ __forceinline__ float fsub_s(float a,float b){float r;asm("v_sub_f32_e32 %0, %1, %2":"=v"(r):"v"(a),"v"(b));return r;}
typedef float f32x2_t __attribute__((ext_vector_type(2))); typedef __bf16 bf16x2_t __attribute__((ext_vector_type(2)));
__device__ __forceinline__ unsigned cvtpk_s(float lo,float hi){f32x2_t v={lo,hi};bf16x2_t b=__builtin_convertvector(v,bf16x2_t);return __builtin_bit_cast(unsigned,b);}
#define WAIT_BAR(N) asm volatile("s_waitcnt vmcnt(" #N ") lgkmcnt(0)\n\ts_barrier":::"memory")

__device__ __forceinline__ void qkt(f32x16&p0,f32x16&p1,const char*Kslot,const bf16x8*qr,const f32x16&negm,int r32,int hi){
  const char*kb=Kslot+hi*1024+r32*16;
  #pragma unroll
  for(int d0=0;d0<4;++d0){
    const bf16x8 b0=*reinterpret_cast<const bf16x8*>(kb+d0*2048);
    const bf16x8 b1=*reinterpret_cast<const bf16x8*>(kb+d0*2048+512);
    if(d0==0){p0=__builtin_amdgcn_mfma_f32_32x32x16_bf16(b0,qr[0],negm,0,0,0);p1=__builtin_amdgcn_mfma_f32_32x32x16_bf16(b1,qr[0],negm,0,0,0);}
    else{p0=__builtin_amdgcn_mfma_f32_32x32x16_bf16(b0,qr[d0],p0,0,0,0);p1=__builtin_amdgcn_mfma_f32_32x32x16_bf16(b1,qr[d0],p1,0,0,0);}}
}
typedef __attribute__((address_space(3))) const char* lds_cptr;
typedef short v4i16_t __attribute__((ext_vector_type(4)));
__device__ __forceinline__ void kload8(bf16x8*kf,lds_cptr kp){
  kf[0]=*(const __attribute__((address_space(3))) bf16x8*)(kp);      kf[1]=*(const __attribute__((address_space(3))) bf16x8*)(kp+512);
  kf[2]=*(const __attribute__((address_space(3))) bf16x8*)(kp+2048); kf[3]=*(const __attribute__((address_space(3))) bf16x8*)(kp+2560);
  kf[4]=*(const __attribute__((address_space(3))) bf16x8*)(kp+4096); kf[5]=*(const __attribute__((address_space(3))) bf16x8*)(kp+4608);
  kf[6]=*(const __attribute__((address_space(3))) bf16x8*)(kp+6144); kf[7]=*(const __attribute__((address_space(3))) bf16x8*)(kp+6656);
}
__device__ __forceinline__ void kload2(bf16x8*kf,lds_cptr kp,int j){ kf[2*j]=*(const __attribute__((address_space(3))) bf16x8*)(kp+j*2048); kf[2*j+1]=*(const __attribute__((address_space(3))) bf16x8*)(kp+j*2048+512); }
__device__ __forceinline__ s16x4 vtr(lds_cptr p){ return __builtin_bit_cast(s16x4,__builtin_amdgcn_ds_read_tr16_b64_v4i16((__attribute__((address_space(3))) v4i16_t*)p)); }
__device__ __forceinline__ float rowmax(const f32x16&p0,const f32x16&p1){
  float a=max3f(p0[0],p0[1],p1[0]),b=max3f(p0[2],p0[3],p1[1]);a=max3f(a,p1[2],p1[3]);
  #pragma unroll
  for(int r=4;r<16;r+=4){a=max3f(a,p0[r],p0[r+1]);b=max3f(b,p0[r+2],p0[r+3]);a=max3f(a,p1[r],p1[r+1]);b=max3f(b,p1[r+2],p1[r+3]);}
  const float m=max2f(a,b);
  auto rr=__builtin_amdgcn_permlane32_swap(__float_as_uint(m),__float_as_uint(m),false,false);
  return max2f(__uint_as_float(rr[0]),__uint_as_float(rr[1]));
}
__device__ __forceinline__ void pv(f32x16*o,int vb,bf16x8 pa0,bf16x8 pa1,bf16x8 pa2,bf16x8 pa3){
  #pragma unroll
  for(int d0=0;d0<2;++d0){s16x4 lo[4],hi[4];
    #pragma unroll
    for(int ks=0;ks<4;++ks){
      asm volatile("ds_read_b64_tr_b16 %0,%1 offset:%c2":"=&v"(lo[ks]):"v"(vb),"i"(d0*4096+ks*1024):"memory");
      asm volatile("ds_read_b64_tr_b16 %0,%1 offset:%c2":"=&v"(hi[ks]):"v"(vb),"i"(d0*4096+ks*1024+512):"memory");}
    asm volatile("s_waitcnt lgkmcnt(0)":::"memory");SBAR();
    #define PK(k) (bf16x8){lo[k][0],lo[k][1],lo[k][2],lo[k][3],hi[k][0],hi[k][1],hi[k][2],hi[k][3]}
    o[d0]=__builtin_amdgcn_mfma_f32_32x32x16_bf16(pa0,PK(0),o[d0],0,0,0);
    o[d0]=__builtin_amdgcn_mfma_f32_32x32x16_bf16(pa1,PK(1),o[d0],0,0,0);
    o[d0]=__builtin_amdgcn_mfma_f32_32x32x16_bf16(pa2,PK(2),o[d0],0,0,0);
    o[d0]=__builtin_amdgcn_mfma_f32_32x32x16_bf16(pa3,PK(3),o[d0],0,0,0);
    #undef PK
  }
}


__device__ __forceinline__ void amask(f32x16&p0,f32x16&p1,int kr0,int qp,float slope2,int hi){
  asm volatile("":"+v"(slope2));
  const float base=slope2*(float)(kr0+4*hi); const int d0=qp-kr0-4*hi;
  #pragma unroll
  for(int r=0;r<16;++r){ const int cr=(r&3)+8*(r>>2); const int da=d0-cr, db=da-32;
    const bool ok0=((unsigned)da<128u)&&(qp-da>=KR_REAL), ok1=((unsigned)db<128u)&&(qp-db>=KR_REAL);
    p0[r]=ok0?p0[r]+__builtin_fmaf(slope2,(float)cr,base):-INFINITY; p1[r]=ok1?p1[r]+__builtin_fmaf(slope2,(float)(cr+32),base):-INFINITY; }
}
template<int MODE,int THRL> __device__ __forceinline__ void unit2(const bf16*Qw,bf16*Ow,const bf16*__restrict__ Kh,const bf16*__restrict__ Vh,int kp,int NT,int row0,int kbase,int qpos0,int qrel0,float slope2,float sink2,const float*cl,char*shm){
  const int tid=threadIdx.x; int lane_=tid&63; asm volatile("":"+v"(lane_));
  const int lane=lane_,r32=lane&31,hi=lane>>5; const int wid=__builtin_amdgcn_readfirstlane(tid>>6);
  const unsigned lds0=(unsigned)(uintptr_t)shm;
  float*wsf=(float*)(shm+LDS_WS)+wid*64;
  const bf16*ksrc=Kh+(long)lane*kp+wid*8;
  const bf16*vsrc=Vh+(long)(16*(wid&3)+(lane>>2))*kp+(wid>>2)*32+(lane&3)*8;
  const unsigned kdst=lds0+LDS_K+wid*1024, vdst=lds0+LDS_V+wid*1024;
  #define TROW(t) ((t)==0?row0:kbase+64*((t)-1))
  #define DMA_K(t,slot) glds16(ksrc+(long)TROW(t)*kp,(unsigned)__builtin_amdgcn_readfirstlane(kdst+(slot)))
  #define DMA_V(t,slot) glds16(vsrc+(long)TROW(t)*kp,(unsigned)__builtin_amdgcn_readfirstlane(vdst+(slot)))
  const int vb0=(int)(lds0+LDS_V)+((lane>>4)&1)*32+(lane&3)*8+(4*hi+((lane&15)>>2))*64;
  const char*Kbase=shm+LDS_K; bf16x8 kf[8];
  const lds_cptr shm3=(lds_cptr)shm; const lds_cptr kp0=shm3+LDS_K+hi*1024+r32*16; const lds_cptr vp0=shm3+LDS_V+((lane>>4)&1)*32+(lane&3)*8+(4*hi+((lane&15)>>2))*64;
  DMA_K(0,0);DMA_V(0,0);DMA_K(1,SLOTB);
  bf16x8 qr[4];
  #pragma unroll
  for(int d0=0;d0<4;++d0)qr[d0]=*reinterpret_cast<const bf16x8*>(&Qw[(long)r32*DM+d0*16+hi*8]);
  const int qrel=qrel0+r32, qp=qpos0+r32;
  const float rowterm=(MODE==0)?cl[qp-KR_META]:-slope2*(float)qp;
  float mhat=(MODE==0)?0.f:sink2,l_reg=(MODE==1&&hi==0)?1.f:0.f;f32x16 o[2];o[0]=f32x16{};o[1]=f32x16{};f32x16 negm;
  { const float nm_=rowterm-mhat; _Pragma("unroll") for(int r=0;r<16;++r)negm[r]=nm_; } asm volatile("":"+v"(negm));
  #define POST(C0,C1,t,MK) do{ if(MODE==0){ const float*clt_=cl+(TROW(t)-KR_META)+4*hi; \
      _Pragma("unroll") for(int g_=0;g_<4;++g_){ const f32x4 a_=*(const f32x4*)(clt_+8*g_), b_=*(const f32x4*)(clt_+32+8*g_); \
        _Pragma("unroll") for(int e_=0;e_<4;++e_){ C0[4*g_+e_]-=a_[e_]; C1[4*g_+e_]-=b_[e_]; } SBAR(); } \
      if(MK) cmask(C0,C1,(t)-(NT-4),qrel,hi); } \
    else { amask(C0,C1,TROW(t),qp,slope2,hi); } }while(0)
  #define POST0(P0,P1) do{ _Pragma("unroll") for(int r=0;r<16;++r)P0[r]=-INFINITY; _Pragma("unroll") for(int r=0;r<8;++r)P1[r]=-INFINITY; \
    if(MODE==0){ const f32x4 a_=*(const f32x4*)(cl+4*hi), b_=*(const f32x4*)(cl+8+4*hi); _Pragma("unroll") for(int e_=0;e_<4;++e_){ P1[8+e_]-=a_[e_]; P1[12+e_]-=b_[e_]; } } \
    else { _Pragma("unroll") for(int r=8;r<16;++r)P1[r]+=slope2*(float)(96+crow(r,hi)); } }while(0)
  bool resc=false;
  #define START(P0,P1) do{ const float rm=rowmax(P0,P1); resc=false; \
    { const float dl=(MODE==0)?rm:__builtin_fmaxf(rm,0.f); mhat=fadd_s(mhat,dl); \
      _Pragma("unroll") for(int r=0;r<16;++r){P0[r]=fsub_s(P0[r],dl);P1[r]=fsub_s(P1[r],dl);} \
      { const float nm_=rowterm-mhat; _Pragma("unroll") for(int r=0;r<16;++r)negm[r]=nm_; } asm volatile("":"+v"(negm)); \
      if(MODE==1) l_reg*=__builtin_amdgcn_exp2f(-dl); } \
    _Pragma("unroll") for(int r=0;r<16;++r)P0[r]=__builtin_amdgcn_exp2f(P0[r]); }while(0)
  #define RESC() do{ if(resc){ asm volatile("s_waitcnt lgkmcnt(0)":::"memory"); \
      _Pragma("unroll") for(int d_=0;d_<2;++d_) _Pragma("unroll") for(int r=0;r<16;++r)o[d_][r]*=wsf[crow(r,hi)]; } }while(0)
  f32x16 pA0,pA1,pB0,pB1;
  int sl_prev=0,sl_cur=0,sl_next=SLOTB;
  #define ROT() do{sl_prev=sl_cur;sl_cur=sl_next;sl_next=(sl_next==(NSLOT-1)*SLOTB)?0:sl_next+SLOTB;}while(0)
  DMA_K(2,2*SLOTB);
  WAIT_BAR(3);
  qkt(pA0,pA1,Kbase,qr,negm,r32,hi);asm volatile("s_nop 15\n\ts_nop 7":"+v"(pA0),"+v"(pA1));if(row0==64){POST0(pA0,pA1);}else{POST(pA0,pA1,0,false);}
  START(pA0,pA1);
  _Pragma("unroll") for(int r=0;r<16;++r)pA1[r]=__builtin_amdgcn_exp2f(pA1[r]);
  WAIT_BAR(0);
  DMA_K(3,0);DMA_V(1,SLOTB);
  ROT();
  kload8(kf,kp0+sl_cur);
  WAIT_BAR(2);
  s16x4 vlo[8],vhi[8]; u32x4 pw0,pw1,pw2,pw3;
  #define PKW(P,B) cvtpk_s(P[B],P[B+1])
  #define PAF(k) __builtin_bit_cast(bf16x8,pw##k)
  #define VFR(i) (bf16x8){vlo[i][0],vlo[i][1],vlo[i][2],vlo[i][3],vhi[i][0],vhi[i][1],vhi[i][2],vhi[i][3]}
  #define PIN(x) asm volatile("":"+v"(x))
  #define MX3(a,b,c) __builtin_fmaxf(__builtin_fmaxf((a),(b)),(c))
  #define GAPA(MF,A0,A1,A2,A3,W0,W1,PW) do{ MF; sacc+=A0; sacc+=A1; sacc+=A2; sacc+=A3; PIN(sacc); W0; W1; PIN(PW); SBAR(); }while(0)
  #define EX(v) __builtin_amdgcn_exp2f(v)
  #define GAPB(MF,X,B) do{ MF; X[B]=EX(X[B]); X[B+1]=EX(X[B+1]); X[B+2]=EX(X[B+2]); X[B+3]=EX(X[B+3]); PIN(X); SBAR(); }while(0)
  #define VRD(i) do{ vlo[i]=vtr(vp_+(((i)>>2)*4096+((i)&3)*1024)); vhi[i]=vtr(vp_+(((i)>>2)*4096+((i)&3)*1024+512)); }while(0)
  #define KRD(G,j) do{ if(G){ kload2(kf,kp0+sl_next,j); SBAR(); } }while(0)
  #define STEP(C0,C1,P0,P1,t,GK,GV,GL,MK) do{ SBAR(); \
    const lds_cptr vp_=vp0+sl_prev; \
    VRD(0); SBAR(); float sacc=(P0[0]+P0[1]); \
    GAPA(C0=__builtin_amdgcn_mfma_f32_32x32x16_bf16(kf[0],qr[0],negm,0,0,0), P0[2],P0[3],P0[4],P0[5],     pw0[0]=PKW(P0,0), pw0[1]=PKW(P0,2), pw0); \
    VRD(4); SBAR(); GAPA(C1=__builtin_amdgcn_mfma_f32_32x32x16_bf16(kf[1],qr[0],negm,0,0,0), P0[6],P0[7],P0[8],P0[9],     pw0[2]=PKW(P0,4), pw0[3]=PKW(P0,6), pw0); \
    VRD(1); SBAR(); GAPA(C0=__builtin_amdgcn_mfma_f32_32x32x16_bf16(kf[2],qr[1],C0,0,0,0),   P0[10],P0[11],P0[12],P0[13], pw1[0]=PKW(P0,8), pw1[1]=PKW(P0,10), pw1); \
    VRD(5); SBAR(); GAPA(C1=__builtin_amdgcn_mfma_f32_32x32x16_bf16(kf[3],qr[1],C1,0,0,0),   P0[14],P0[15],P1[0],P1[1],   pw1[2]=PKW(P0,12),pw1[3]=PKW(P0,14), pw1); \
    VRD(2); SBAR(); GAPA(C0=__builtin_amdgcn_mfma_f32_32x32x16_bf16(kf[4],qr[2],C0,0,0,0),   P1[2],P1[3],P1[4],P1[5],     pw2[0]=PKW(P1,0), pw2[1]=PKW(P1,2), pw2); \
    VRD(6); SBAR(); GAPA(C1=__builtin_amdgcn_mfma_f32_32x32x16_bf16(kf[5],qr[2],C1,0,0,0),   P1[6],P1[7],P1[8],P1[9],     pw2[2]=PKW(P1,4), pw2[3]=PKW(P1,6), pw2); \
    VRD(3); SBAR(); GAPA(C0=__builtin_amdgcn_mfma_f32_32x32x16_bf16(kf[6],qr[3],C0,0,0,0),   P1[10],P1[11],P1[12],P1[13], pw3[0]=PKW(P1,8), pw3[1]=PKW(P1,10), pw3); \
    VRD(7); SBAR(); GAPA(C1=__builtin_amdgcn_mfma_f32_32x32x16_bf16(kf[7],qr[3],C1,0,0,0),   P1[14],P1[15],0.f,0.f,       pw3[2]=PKW(P1,12),pw3[3]=PKW(P1,14), pw3); \
    l_reg+=sacc; \
    if(GK){DMA_K((t)+3,sl_cur);} if(GV){DMA_V((t)+1,sl_next);} \
    POST(C0,C1,t,MK); \
    { float a=MX3(C0[0],C0[1],C1[0]),b=MX3(C0[2],C0[3],C1[1]); a=MX3(a,C1[2],C1[3]); \
      _Pragma("unroll") for(int r=4;r<16;r+=4){a=MX3(a,C0[r],C0[r+1]);b=MX3(b,C0[r+2],C0[r+3]);a=MX3(a,C1[r],C1[r+1]);b=MX3(b,C1[r+2],C1[r+3]);} \
      float rm=__builtin_fmaxf(a,b); { auto rr=__builtin_amdgcn_permlane32_swap(__float_as_uint(rm),__float_as_uint(rm),false,false); rm=__builtin_fmaxf(__uint_as_float(rr[0]),__uint_as_float(rr[1])); } \
      resc=false; \
      if(__builtin_expect(__any(rm>(float)THRL),0)){ const float dl=__builtin_fmaxf(rm,0.f); mhat+=dl; \
        _Pragma("unroll") for(int r=0;r<16;++r){C0[r]-=dl;C1[r]-=dl;} \
        { const float nm_=rowterm-mhat; _Pragma("unroll") for(int r=0;r<16;++r)negm[r]=nm_; } asm volatile("":"+v"(negm)); \
        const float f=__builtin_amdgcn_exp2f(-dl); l_reg*=f; if(hi==0)wsf[r32]=f; resc=true; } } \
    SBAR(); \
    GAPB(o[0]=__builtin_amdgcn_mfma_f32_32x32x16_bf16(PAF(0),VFR(0),o[0],0,0,0), C0,0); \
    GAPB(o[1]=__builtin_amdgcn_mfma_f32_32x32x16_bf16(PAF(0),VFR(4),o[1],0,0,0), C0,4); \
    KRD(GL,0); GAPB(o[0]=__builtin_amdgcn_mfma_f32_32x32x16_bf16(PAF(1),VFR(1),o[0],0,0,0), C0,8); \
    KRD(GL,1); GAPB(o[1]=__builtin_amdgcn_mfma_f32_32x32x16_bf16(PAF(1),VFR(5),o[1],0,0,0), C0,12); \
    KRD(GL,2); GAPB(o[0]=__builtin_amdgcn_mfma_f32_32x32x16_bf16(PAF(2),VFR(2),o[0],0,0,0), C1,0); \
    KRD(GL,3); GAPB(o[1]=__builtin_amdgcn_mfma_f32_32x32x16_bf16(PAF(2),VFR(6),o[1],0,0,0), C1,4); \
    GAPB(o[0]=__builtin_amdgcn_mfma_f32_32x32x16_bf16(PAF(3),VFR(3),o[0],0,0,0), C1,8); \
    GAPB(o[1]=__builtin_amdgcn_mfma_f32_32x32x16_bf16(PAF(3),VFR(7),o[1],0,0,0), C1,12); \
    }while(0)
  int t=1;
  for(;t<NT-4;t+=2){
    STEP(pB0,pB1,pA0,pA1,t,true,true,true,false);     WAIT_BAR(2); RESC(); ROT();
    STEP(pA0,pA1,pB0,pB1,t+1,true,true,true,false);   WAIT_BAR(2); RESC(); ROT();
  }
  STEP(pB0,pB1,pA0,pA1,NT-4,true,true,true,true);     WAIT_BAR(2); RESC(); ROT();
  STEP(pA0,pA1,pB0,pB1,NT-3,false,true,true,true);    WAIT_BAR(1); RESC(); ROT();
  STEP(pB0,pB1,pA0,pA1,NT-2,false,true,true,true);    WAIT_BAR(0); RESC(); ROT();
  STEP(pA0,pA1,pB0,pB1,NT-1,false,false,false,true);  RESC();
  { float sacc=pA0[0]+pA0[1]; _Pragma("unroll") for(int r=2;r<16;++r)sacc+=pA0[r]; _Pragma("unroll") for(int r=0;r<16;++r)sacc+=pA1[r]; l_reg+=sacc;
    pw0=(u32x4){PKW(pA0,0),PKW(pA0,2),PKW(pA0,4),PKW(pA0,6)};pw1=(u32x4){PKW(pA0,8),PKW(pA0,10),PKW(pA0,12),PKW(pA0,14)};pw2=(u32x4){PKW(pA1,0),PKW(pA1,2),PKW(pA1,4),PKW(pA1,6)};pw3=(u32x4){PKW(pA1,8),PKW(pA1,10),PKW(pA1,12),PKW(pA1,14)};
    SBAR(); pv(o,vb0+sl_cur,PAF(0),PAF(1),PAF(2),PAF(3)); }
  #undef PKW
  #undef PAF
  #undef VFR
  #undef PIN
  #undef MX3
  #undef GAPA
  #undef GAPB
  #undef EX
  #undef VRD
  #undef KRD
  #undef STEP
  {auto rr=__builtin_amdgcn_permlane32_swap(__float_as_uint(l_reg),__float_as_uint(l_reg),false,false);l_reg=__uint_as_float(rr[0])+__uint_as_float(rr[1]);}
  if(hi==0)wsf[32+r32]=l_reg;asm volatile("s_waitcnt lgkmcnt(0)":::"memory");
  float rli[16];
  #pragma unroll
  for(int r=0;r<16;++r)rli[r]=__builtin_amdgcn_rcpf(wsf[32+crow(r,hi)]);
  { bf16*stg=(bf16*)(shm+LDS_OST)+wid*2048;
    #pragma unroll
    for(int r=0;r<16;++r){const int orow=crow(r,hi);
      #pragma unroll
      for(int d0=0;d0<2;++d0)stg[orow*64+d0*32+r32]=__float2bfloat16(o[d0][r]*rli[r]);}
    asm volatile("s_waitcnt lgkmcnt(0)":::"memory");
    #pragma unroll
    for(int i=0;i<4;++i){const int row=i*8+(lane>>3),ch=lane&7; const u32x4 v=*(const u32x4*)(stg+row*64+ch*8); *(u32x4*)(Ow+(long)row*DM+ch*8)=v;} }
  asm volatile("s_waitcnt lgkmcnt(0)\n\ts_barrier":::"memory");
  #undef DMA_K
  #undef DMA_V
  #undef POST
  #undef POST0
  #undef TROW
  #undef START
  #undef RESC
  #undef ROT
}

#undef SBAR
#undef WAIT_BAR
}

constexpr int NWAVES = 8;
#ifndef MK_N_LAUNCHES
#define MK_N_LAUNCHES 1
#endif
constexpr int N_PHASES = 9;
constexpr int N_LAUNCHES = MK_N_LAUNCHES;

constexpr size_t MiB = 1u << 20;
constexpr size_t WS_CTL = 0, CTL_ZERO_BYTES = 64 * 1024;
constexpr size_t WS_SSQ = 2 * MiB;
constexpr size_t WS_META = 10 * MiB;
constexpr size_t WS_LOGF = 11 * MiB;
constexpr size_t WS_QN2 = 4 * MiB, WS_KN2 = 6 * MiB;
static_assert(WS_QN2 + (size_t)MROWS * 64 <= WS_KN2 && WS_KN2 + (size_t)NKR * 64 <= WS_META, "norm partials map");
constexpr size_t WS_W1 = 16 * MiB, WS_W2 = 27 * MiB, WS_WP = 33 * MiB, WS_WAB = 42 * MiB, WS_WO = 44 * MiB, WS_W3 = 46 * MiB, WS_W4 = 57 * MiB;
constexpr size_t WS_XB = 64 * MiB;
constexpr size_t WS_R = 128 * MiB;
constexpr size_t WS_ACT = WS_R;
constexpr size_t WS_QO = WS_R, WS_KA = WS_R + 64 * MiB, WS_VA = WS_KA + 9 * MiB, WS_KB = WS_VA + 9 * MiB, WS_VB = WS_KB + 34 * MiB,
                 WS_SGA = WS_VB + 34 * MiB, WS_SGB = WS_SGA + 64 * MiB, WS_MIX = WS_SGB + 64 * MiB, WS_END = WS_MIX + 64 * MiB;
static_assert(WS_W1 + (size_t)2 * DFF * DM * 2 <= WS_W2 && WS_W2 + (size_t)DM * DFF * 2 <= WS_WP && WS_WP + (size_t)NPROJ * DM * 2 <= WS_WAB && WS_W3 + (size_t)2 * DFF * DM * 2 <= WS_W4 && WS_W4 + (size_t)DM * DFF * 2 <= WS_XB, "weights map");
static_assert((size_t)NKR * 128 * 2 <= 9 * MiB && (size_t)NKR * 512 * 2 <= 34 * MiB && (size_t)NKR * 8 * 4 <= 2 * MiB && WS_END <= 512 * MiB && WS_ACT + (size_t)MROWS * DFF * 2 <= WS_END, "activation map");
static_assert(pg8::ACT_OFF_SGA == WS_SGA && pg8::ACT_OFF_QO == WS_QO && WS_SGB == WS_SGA + 64 * MiB && WS_MIX == WS_SGB + 64 * MiB && 5 * pg8::ACT_PANEL_BYTES <= 8 * MiB, "relocated FFN activation panels");
constexpr size_t MT_XB = 0, MT_SSQ0 = 32768, MT_ACT = 65536, MT_H1B = 163840, MT_SSQ1 = 196608, MT_KNM = 204800;
constexpr int CW_BAR = 4096;
constexpr int CW_META1 = 1024, CW_META3 = 1088, CW_META2 = 1152;
constexpr int CW_PANEL = 8192;
static_assert((CW_PANEL + 64 * 128) * 4 <= (int)CTL_ZERO_BYTES, "control words inside the per-call memset");

constexpr int RING_OFF = 0, RING_BYTES = 131072;
constexpr int LDSCTL_OFF = RING_BYTES, MISC_OFF = LDSCTL_OFF + 320;
constexpr int LDS_BYTES = 147456;
static_assert(MISC_OFF + 128 <= LDS_BYTES && attn::LDS_END <= RING_BYTES && attn2::LDS_END <= RING_BYTES, "LDS map");

typedef GAS unsigned gu32;
#define RLX_AGENT __ATOMIC_RELAXED, __HIP_MEMORY_SCOPE_AGENT
#define LDS_WAIT() asm volatile("s_waitcnt lgkmcnt(0)" ::: "memory")
#define VM_WAIT() asm volatile("s_waitcnt vmcnt(0)" ::: "memory")
#define XB_TMO      128
#define XB_XCNT(j)  (256  + 64 * (j))
#define XB_XSUB(j)  (1280 + 64 * (j))
#define XB_XGEN(j)  (2304 + 64 * (j))
#define XB_TOP      3328
#define XB_TOPGEN   3392
#define XB_LSUB(j)  (3456 + 16 * (j))
#define XB_LGEN(j)  (3712 + 16 * (j))
#define XCD_BAR_WORDS 3968
#define XB_SPIN_CAP (1u << 18)

__device__ __forceinline__ unsigned xb_ld(unsigned* p)              { return __hip_atomic_load(p, __ATOMIC_RELAXED, __HIP_MEMORY_SCOPE_AGENT); }
__device__ __forceinline__ unsigned xb_add(unsigned* p, unsigned v) { return __hip_atomic_fetch_add(p, v, __ATOMIC_RELAXED, __HIP_MEMORY_SCOPE_AGENT); }
__device__ __forceinline__ unsigned xb_xcc_id() { return (unsigned)__builtin_amdgcn_s_getreg((3 << 11) | 20) & 0xFu; }
#define XB_SPIN(cond, bar) do { unsigned _sp = 0; while (cond) { __builtin_amdgcn_s_sleep(1); \
    if ((++_sp & 255u) == 0u) { if (xb_ld(&(bar)[XB_TMO])) break; if (_sp > XB_SPIN_CAP) { atomicAdd(&(bar)[XB_TMO], 1u); break; } } } } while (0)

struct XcdBarrier {
    unsigned* bar; unsigned x;
    volatile LAS unsigned* st;
};

__device__ __forceinline__ XcdBarrier xcd_barrier_post(unsigned* bar, volatile LAS unsigned* st) {
    XcdBarrier b; b.bar = bar; b.x = xb_xcc_id(); b.st = st;
    if (threadIdx.x == 0) (void)xb_add(&bar[XB_XCNT(b.x)], 1u + ((b.x == (blockIdx.x & 7u)) ? 0x10000u : 0u));
    return b;
}
__device__ __forceinline__ void xcd_barrier_complete(unsigned* bar, unsigned x, unsigned& nloc, unsigned& nx, unsigned& rr) {
    const unsigned G = gridDim.x * gridDim.y * gridDim.z;
    unsigned sum, cnt, mine, mt, sp = 0u;
    for (;;) {
        sum = 0u; cnt = 0u; mine = 0u; mt = 0u;
#pragma unroll
        for (unsigned j = 0; j < 16; ++j) { const unsigned cw = xb_ld(&bar[XB_XCNT(j)]); const unsigned c = cw & 0xFFFFu; mt += cw >> 16; sum += c; cnt += (c > 0u) ? 1u : 0u; mine = (j == x) ? c : mine; }
        if (sum == G) break;
        __builtin_amdgcn_s_sleep(1);
        if ((++sp & 255u) == 0u) { if (xb_ld(&bar[XB_TMO])) break; if (sp > XB_SPIN_CAP) { atomicAdd(&bar[XB_TMO], 1u); break; } }
    }
    nloc = mine > 0u ? mine : 1u; nx = cnt > 0u ? cnt : 1u;
    rr = (sum == G && mt == G && G == 256u && cnt == 8u) ? 1u : 0u;
}

__device__ __forceinline__ void xcd_barrier(const XcdBarrier& b) {
    asm volatile("s_waitcnt vmcnt(0)" ::: "memory");
    __syncthreads();
    if (threadIdx.x == 0) {
        unsigned* bar = b.bar;
        __builtin_amdgcn_s_waitcnt(0);
        unsigned nloc = b.st[0], nx = b.st[1];
        if (nloc == 0u) { unsigned rr; xcd_barrier_complete(bar, b.x, nloc, nx, rr); b.st[0] = nloc; b.st[1] = nx; b.st[2] = rr; }
        const unsigned old = xb_add(&bar[XB_XSUB(b.x)], 1u);
        const unsigned gen = old / nloc;
        if (old + 1u == (gen + 1u) * nloc) {
            __builtin_amdgcn_fence(__ATOMIC_RELEASE, "agent");
            asm volatile("s_waitcnt vmcnt(0)" ::: "memory");
            const unsigned og = xb_add(&bar[XB_TOP], 1u);
            const unsigned tg = og / nx;
            if (og + 1u == (tg + 1u) * nx) xb_add(&bar[XB_TOPGEN], 1u);
            else XB_SPIN(xb_ld(&bar[XB_TOPGEN]) == tg, bar);
            __builtin_amdgcn_fence(__ATOMIC_ACQUIRE, "agent");
            xb_add(&bar[XB_XGEN(b.x)], 1u);
            asm volatile("s_waitcnt vmcnt(0)" ::: "memory");
        } else {
            asm volatile("buffer_inv sc1" ::: "memory");
            XB_SPIN(xb_ld(&bar[XB_XGEN(b.x)]) == gen, bar);
            asm volatile("s_waitcnt vmcnt(0)" ::: "memory");
        }
    }
    __syncthreads();
}

__device__ __forceinline__ void xcd_barrier_local(const XcdBarrier& b) {
    if (b.st[2] == 0u) { xcd_barrier(b); return; }
    asm volatile("s_waitcnt vmcnt(0)" ::: "memory");
    __syncthreads();
    if (threadIdx.x == 0) {
        unsigned* bar = b.bar;
        __builtin_amdgcn_s_waitcnt(0);
        const unsigned nloc = b.st[0];
        const unsigned old = xb_add(&bar[XB_LSUB(b.x)], 1u);
        const unsigned gen = old / nloc;
        if (old + 1u == (gen + 1u) * nloc) xb_add(&bar[XB_LGEN(b.x)], 1u);
        else XB_SPIN(xb_ld(&bar[XB_LGEN(b.x)]) == gen, bar);
    }
    __syncthreads();
}
__device__ __forceinline__ void xcd_barrier_local_inv(const XcdBarrier& b) {
    if (b.st[2] == 0u) { xcd_barrier(b); return; }
    asm volatile("s_waitcnt vmcnt(0)" ::: "memory");
    __syncthreads();
    if (threadIdx.x == 0) {
        unsigned* bar = b.bar;
        __builtin_amdgcn_s_waitcnt(0);
        const unsigned nloc = b.st[0];
        const unsigned old = xb_add(&bar[XB_LSUB(b.x)], 1u);
        const unsigned gen = old / nloc;
        asm volatile("buffer_inv sc1" ::: "memory");
        if (old + 1u == (gen + 1u) * nloc) xb_add(&bar[XB_LGEN(b.x)], 1u);
        else XB_SPIN(xb_ld(&bar[XB_LGEN(b.x)]) == gen, bar);
        asm volatile("s_waitcnt vmcnt(0)" ::: "memory");
    }
    __syncthreads();
}
#if defined(EXP_SEAM)
__device__ __forceinline__ void xcd_barrier_nf(const XcdBarrier& b) {
    asm volatile("s_waitcnt vmcnt(0)" ::: "memory");
    __syncthreads();
    if (threadIdx.x == 0) {
        unsigned* bar = b.bar;
        __builtin_amdgcn_s_waitcnt(0);
        unsigned nloc = b.st[0], nx = b.st[1];
        if (nloc == 0u) { unsigned rr; xcd_barrier_complete(bar, b.x, nloc, nx, rr); b.st[0] = nloc; b.st[1] = nx; b.st[2] = rr; }
        const unsigned old = xb_add(&bar[XB_XSUB(b.x)], 1u);
        const unsigned gen = old / nloc;
        if (old + 1u == (gen + 1u) * nloc) {
            asm volatile("s_waitcnt vmcnt(0)" ::: "memory");
            const unsigned og = xb_add(&bar[XB_TOP], 1u);
            const unsigned tg = og / nx;
            if (og + 1u == (tg + 1u) * nx) xb_add(&bar[XB_TOPGEN], 1u);
            else XB_SPIN(xb_ld(&bar[XB_TOPGEN]) == tg, bar);
            xb_add(&bar[XB_XGEN(b.x)], 1u);
            asm volatile("s_waitcnt vmcnt(0)" ::: "memory");
        } else {
            XB_SPIN(xb_ld(&bar[XB_XGEN(b.x)]) == gen, bar);
            asm volatile("s_waitcnt vmcnt(0)" ::: "memory");
        }
    }
    __syncthreads();
}
__device__ __forceinline__ void xcd_barrier_norel(const XcdBarrier& b) {
    asm volatile("s_waitcnt vmcnt(0)" ::: "memory");
    __syncthreads();
    if (threadIdx.x == 0) {
        unsigned* bar = b.bar;
        __builtin_amdgcn_s_waitcnt(0);
        unsigned nloc = b.st[0], nx = b.st[1];
        if (nloc == 0u) { unsigned rr; xcd_barrier_complete(bar, b.x, nloc, nx, rr); b.st[0] = nloc; b.st[1] = nx; b.st[2] = rr; }
        const unsigned old = xb_add(&bar[XB_XSUB(b.x)], 1u);
        const unsigned gen = old / nloc;
        if (old + 1u == (gen + 1u) * nloc) {
            asm volatile("s_waitcnt vmcnt(0)" ::: "memory");
            const unsigned og = xb_add(&bar[XB_TOP], 1u);
            const unsigned tg = og / nx;
            if (og + 1u == (tg + 1u) * nx) xb_add(&bar[XB_TOPGEN], 1u);
            else XB_SPIN(xb_ld(&bar[XB_TOPGEN]) == tg, bar);
            __builtin_amdgcn_fence(__ATOMIC_ACQUIRE, "agent");
            xb_add(&bar[XB_XGEN(b.x)], 1u);
            asm volatile("s_waitcnt vmcnt(0)" ::: "memory");
        } else {
            asm volatile("buffer_inv sc1" ::: "memory");
            XB_SPIN(xb_ld(&bar[XB_XGEN(b.x)]) == gen, bar);
            asm volatile("s_waitcnt vmcnt(0)" ::: "memory");
        }
    }
    __syncthreads();
}

__device__ __forceinline__ void xcd_barrier_noacq(const XcdBarrier& b) {
    asm volatile("s_waitcnt vmcnt(0)" ::: "memory");
    __syncthreads();
    if (threadIdx.x == 0) {
        unsigned* bar = b.bar;
        __builtin_amdgcn_s_waitcnt(0);
        unsigned nloc = b.st[0], nx = b.st[1];
        if (nloc == 0u) { unsigned rr; xcd_barrier_complete(bar, b.x, nloc, nx, rr); b.st[0] = nloc; b.st[1] = nx; b.st[2] = rr; }
        const unsigned old = xb_add(&bar[XB_XSUB(b.x)], 1u);
        const unsigned gen = old / nloc;
        if (old + 1u == (gen + 1u) * nloc) {
            __builtin_amdgcn_fence(__ATOMIC_RELEASE, "agent");
            asm volatile("s_waitcnt vmcnt(0)" ::: "memory");
            const unsigned og = xb_add(&bar[XB_TOP], 1u);
            const unsigned tg = og / nx;
            if (og + 1u == (tg + 1u) * nx) xb_add(&bar[XB_TOPGEN], 1u);
            else XB_SPIN(xb_ld(&bar[XB_TOPGEN]) == tg, bar);
            xb_add(&bar[XB_XGEN(b.x)], 1u);
            asm volatile("s_waitcnt vmcnt(0)" ::: "memory");
        } else {
            XB_SPIN(xb_ld(&bar[XB_XGEN(b.x)]) == gen, bar);
            asm volatile("s_waitcnt vmcnt(0)" ::: "memory");
        }
    }
    __syncthreads();
}

#endif

struct Frame {
    LAS unsigned char* lds;
    volatile LAS unsigned* MISC;
    gu32* ctl;
    int tid, lane, wave;
    int vcu, G;
    unsigned char* ws;
    const float* in[16]; float* out;
};
__device__ __forceinline__ float wave_sum(float v) {
    return wave_sum64(v);
}
__device__ __forceinline__ void tr_item(const float* W, int ldw, int k0, int c0, int ncols, const float* gain, bf16_t* WT, int ldt, int drow0, int dk0, LAS float* scr, int lane) {
    float v[32]; const int col = lane & 31, kh = lane >> 5;
    const float* wp = W + (size_t)(k0 + kh) * ldw + c0 + (col < ncols ? col : 0);
#pragma unroll
    for (int i = 0; i < 32; ++i) v[i] = wp[(size_t)(2 * i) * ldw];
    if (gain) {
#pragma unroll
        for (int i = 0; i < 32; ++i) v[i] *= gain[k0 + 2 * i + kh];
    }
#pragma unroll
    for (int i = 0; i < 32; ++i) scr[(2 * i + kh) * 33 + col] = v[i];
    LDS_WAIT(); asm volatile("" ::: "memory");
    const int c = lane & 7;
#pragma unroll
    for (int j = 0; j < 4; ++j) { const int n = (lane >> 3) + 8 * j; const LAS float* s = scr + (8 * c) * 33 + n;
        u32x4 o; o.x = cvt_pk_bf16(s[0 * 33], s[1 * 33]); o.y = cvt_pk_bf16(s[2 * 33], s[3 * 33]); o.z = cvt_pk_bf16(s[4 * 33], s[5 * 33]); o.w = cvt_pk_bf16(s[6 * 33], s[7 * 33]);
        if (n < ncols) *(GAS u32x4*)(WT + (size_t)(drow0 + n) * ldt + dk0 + k0 + 8 * c) = o; }
    LDS_WAIT(); asm volatile("" ::: "memory");
}
__device__ __forceinline__ int swiglu_row(int c0) { const int up = c0 >= DFF, c = up ? c0 - DFF : c0; return 256 * (c / 128) + (up ? 128 : 0) + (c % 128); }
__device__ __forceinline__ void row_to_bf16(const float* xrow, bf16_t* orow, float* ssq16, int lane) {
    const GAS f32x4* xr = (const GAS f32x4*)xrow + lane;
    f32x4 v[4]; float s = 0.f;
#pragma unroll
    for (int j = 0; j < 4; ++j) { v[j] = xr[64 * j]; s += (v[j].x * v[j].x + v[j].y * v[j].y) + (v[j].z * v[j].z + v[j].w * v[j].w); }
    s = wave_sum(s);
    GAS u32x2* o8 = (GAS u32x2*)orow + lane;
#pragma unroll
    for (int j = 0; j < 4; ++j) { u32x2 w; w.x = cvt_pk_bf16(v[j].x, v[j].y); w.y = cvt_pk_bf16(v[j].z, v[j].w); o8[64 * j] = w; }
    if (ssq16 && lane < 16) ssq16[lane] = lane == 0 ? s : 0.f;
}
__device__ __forceinline__ void zero_bytes(Frame& F, void* p, size_t nbytes) {
    const size_t n16 = nbytes / 16; GAS u32x4* q = (GAS u32x4*)p;
    for (size_t i = (size_t)F.vcu * 512 + F.tid; i < n16; i += (size_t)F.G * 512) q[i] = (u32x4){0u, 0u, 0u, 0u};
}
__device__ __forceinline__ void p0_prologue(Frame& F, int part = 0) {
    LAS float* scr = (LAS float*)(F.lds + RING_OFF + F.wave * 16384);
    const int gw = F.vcu * NWAVES + F.wave, NGW = F.G * NWAVES;
    unsigned char* ws = F.ws;
    bf16_t *W1t = (bf16_t*)(ws + WS_W1), *W2t = (bf16_t*)(ws + WS_W2), *Wpt = (bf16_t*)(ws + WS_WP), *Wabt = (bf16_t*)(ws + WS_WAB), *Wot = (bf16_t*)(ws + WS_WO), *W3t = (bf16_t*)(ws + WS_W3), *W4t = (bf16_t*)(ws + WS_W4);
    constexpr int I0 = 16 * 176, I1 = 44 * 32, I2 = 16 * 72, I3 = 16 * 64, I4 = 16, I5 = 8 * 32, I6 = 8 * 32, I7 = 16 * 32, I8 = I0, I9 = I1;
    constexpr int NITEMS = I0 + I1 + I2 + I3 + I4 + I5 + I6 + I7 + I8 + I9;
    if (part != 2) for (int it = gw; it < NITEMS; it += NGW) {
        int r = it;
        if (r < I0) { const int kb = r / 176, nb = r % 176; tr_item(F.in[3], 2 * DFF, 64 * kb, 32 * nb, 32, F.in[2], W1t, DM, swiglu_row(32 * nb), 0, scr, F.lane); continue; } r -= I0;
        if (r < I1) { const int kb = r / 32, nb = r % 32; tr_item(F.in[4], DM, 64 * kb, 32 * nb, 32, nullptr, W2t, DFF, 32 * nb, 0, scr, F.lane); continue; } r -= I1;
        if (r < I2) { const int kb = r / 72, nb = r % 72; tr_item(F.in[6], 4360, 64 * kb, 32 * nb, 32, F.in[5], Wpt, DM, 32 * nb, 0, scr, F.lane); continue; } r -= I2;
        if (r < I3) { const int kb = r / 64, nb = r % 64, gb = nb >= 32, cb = gb ? nb - 32 : nb;
            tr_item(F.in[6], 4360, 64 * kb, 2312 + 32 * nb, 32, F.in[5], Wpt, DM, 2304 + 256 * (cb / 4) + (gb ? 128 : 0) + 32 * (cb % 4), 0, scr, F.lane); continue; } r -= I3;
        if (r < I4) { tr_item(F.in[6], 4360, 64 * r, 2304, 8, F.in[5], Wpt, DM, 4352, 0, scr, F.lane); continue; } r -= I4;
        if (r < I5) { const int kb = r / 32, nb = r % 32; tr_item(F.in[9], DM, 64 * kb, 32 * nb, 32, nullptr, Wabt, DM, 32 * nb, 0, scr, F.lane); continue; } r -= I5;
        if (r < I6) { const int kb = r / 32, nb = r % 32; tr_item(F.in[10], DM, 64 * kb, 32 * nb, 32, nullptr, Wabt, DM, 32 * nb, 512, scr, F.lane); continue; } r -= I6;
        if (r < I7) { const int kb = r / 32, nb = r % 32; tr_item(F.in[11], DM, 64 * kb, 32 * nb, 32, nullptr, Wot, DM, 32 * nb, 0, scr, F.lane); continue; } r -= I7;
        if (r < I8) { const int kb = r / 176, nb = r % 176; tr_item(F.in[13], 2 * DFF, 64 * kb, 32 * nb, 32, F.in[12], W3t, DM, swiglu_row(32 * nb), 0, scr, F.lane); continue; } r -= I8;
        { const int kb = r / 32, nb = r % 32; tr_item(F.in[14], DM, 64 * kb, 32 * nb, 32, nullptr, W4t, DFF, 32 * nb, 0, scr, F.lane); }
    }
    bf16_t* XB = (bf16_t*)(ws + WS_XB); float* SSQ = (float*)(ws + WS_SSQ);
#define P0_LOAD(V, M) do { _Pragma("unroll") for (int r = 0; r < 4; ++r) _Pragma("unroll") for (int j = 0; j < 4; ++j) V[r][j] = ((const GAS f32x4*)(F.in[0] + (size_t)((M) + r) * DM))[128 * (j >> 1) + 2 * F.lane + (j & 1)]; } while (0)
#define P0_PROC(V, M) do { float sq[4]; \
        _Pragma("unroll") for (int r = 0; r < 4; ++r) { float s_ = 0.f; \
            _Pragma("unroll") for (int j = 0; j < 4; ++j) s_ += (V[r][j].x * V[r][j].x + V[r][j].y * V[r][j].y) + (V[r][j].z * V[r][j].z + V[r][j].w * V[r][j].w); \
            sq[r] = wave_sum(s_); } \
        _Pragma("unroll") for (int r = 0; r < 4; ++r) { GAS u32x4* o16 = (GAS u32x4*)(XB + (size_t)((M) + r) * DM) + F.lane; \
            _Pragma("unroll") for (int c = 0; c < 2; ++c) { u32x4 w; w.x = cvt_pk_bf16(V[r][2 * c].x, V[r][2 * c].y); w.y = cvt_pk_bf16(V[r][2 * c].z, V[r][2 * c].w); \
                w.z = cvt_pk_bf16(V[r][2 * c + 1].x, V[r][2 * c + 1].y); w.w = cvt_pk_bf16(V[r][2 * c + 1].z, V[r][2 * c + 1].w); o16[64 * c] = w; } } \
        if (F.lane < 16) { _Pragma("unroll") for (int r = 0; r < 4; ++r) SSQ[(size_t)((M) + r) * 16 + F.lane] = F.lane == 0 ? sq[r] : 0.f; } } while (0)
    if (part != 1) {
        const int step = NGW * 4; int m = gw * 4;
        f32x4 va[4][4], vb[4][4];
        if (m < MROWS) P0_LOAD(va, m);
        while (m < MROWS) {
            int mn = m + step;
            if (mn < MROWS) P0_LOAD(vb, mn);
            P0_PROC(va, m);
            m = mn; if (m >= MROWS) break;
            mn = m + step;
            if (mn < MROWS) P0_LOAD(va, mn);
            P0_PROC(vb, m);
            m = mn;
        }
    }
#undef P0_LOAD
#undef P0_PROC
    if (gw < NMETA) row_to_bf16(F.in[1] + (size_t)gw * DM, (bf16_t*)(ws + WS_META + MT_XB) + (size_t)gw * DM, (float*)(ws + WS_META + MT_SSQ0) + gw * 16, F.lane);
    { constexpr size_t NW_ = (size_t)(NPROJ - 4360) * DM * 2 / 16, NKA_ = (size_t)KR_META * 128 * 2 / 16, NKB_ = (size_t)KR_META * 512 * 2 / 16, NB_ = 2 * NKA_ + 2 * NKB_, NT_ = NW_ + NBATCH * NB_;
      for (size_t i = (size_t)F.vcu * 512 + F.tid; i < NT_; i += (size_t)F.G * 512) {
          GAS u32x4* q;
          if (i < NW_) q = (GAS u32x4*)(Wpt + (size_t)4360 * DM) + i;
          else { const size_t jj = i - NW_; const int b = (int)(jj / NB_); const size_t r = jj % NB_;
              if (r < NKA_)                q = (GAS u32x4*)((bf16_t*)(ws + WS_KA) + (size_t)b * LPOS * 128) + r;
              else if (r < 2 * NKA_)       q = (GAS u32x4*)((bf16_t*)(ws + WS_VA) + (size_t)b * LPOS * 128) + (r - NKA_);
              else if (r < 2 * NKA_ + NKB_) q = (GAS u32x4*)((bf16_t*)(ws + WS_KB) + (size_t)b * LPOS * 512) + (r - 2 * NKA_);
              else                         q = (GAS u32x4*)((bf16_t*)(ws + WS_VB) + (size_t)b * LPOS * 512) + (r - 2 * NKA_ - NKB_); }
          *q = (u32x4){0u, 0u, 0u, 0u}; } }
}
__device__ __forceinline__ void st8_wt(void* p, u32x2 w) { __hip_atomic_store((GAS unsigned long long*)p, (unsigned long long)w.x | ((unsigned long long)w.y << 32), RLX_AGENT); }
__device__ __forceinline__ void meta_arrive(Frame& F, int word) {
    asm volatile("s_waitcnt vmcnt(0)" ::: "memory");
    if (F.lane == 0) __hip_atomic_fetch_add(F.ctl + word, 1u, RLX_AGENT);
}
__device__ __forceinline__ void meta_wait(Frame& F, int word, unsigned want) {
    if (F.tid == 0) { for (unsigned sp = 0; sp < (1u << 22); ++sp) { if (__hip_atomic_load(F.ctl + word, RLX_AGENT) >= want) break; __builtin_amdgcn_s_sleep(2); } }
    __syncthreads();
}
template <int K> __device__ __forceinline__ f32x4 meta_partial(const bf16_t* Wr, int ldw, const bf16_t* X, int ldx, int wid, int lane) {
    constexpr int NI = K / 32 / NWAVES; static_assert(K % (32 * NWAVES) == 0, "K split over the 8 waves");
    const int i = lane & 15, q = lane >> 4; f32x4 acc = (f32x4){0.f, 0.f, 0.f, 0.f};
    bf16x8 a[NI], b[NI];
#pragma unroll
    for (int t = 0; t < NI; ++t) { const int s = wid + t * NWAVES; a[t] = *(const bf16x8*)(Wr + (size_t)i * ldw + s * 32 + q * 8); b[t] = *(const bf16x8*)(X + (size_t)i * ldx + s * 32 + q * 8); }
#pragma unroll
    for (int t = 0; t < NI; ++t) acc = __builtin_amdgcn_mfma_f32_16x16x32_bf16(a[t], b[t], acc, 0, 0, 0);
    return acc;
}
__device__ __forceinline__ f32x4 meta_reduce(Frame& F, f32x4 part, int blk) {
    LAS f32x4* scr = (LAS f32x4*)(F.lds + RING_OFF + blk * 8192);
    scr[F.wave * 64 + F.lane] = part;
    __syncthreads();
    f32x4 s = scr[F.lane];
#pragma unroll
    for (int w = 1; w < NWAVES; ++w) s += scr[w * 64 + F.lane];
    __syncthreads();
    return s;
}
__device__ __forceinline__ void meta_up(Frame& F) {
    if (F.vcu >= DFF / 16) return;
    unsigned char* ws = F.ws; const int c = F.vcu, j = F.lane & 15, q = F.lane >> 4;
    const bf16_t* W1t = (const bf16_t*)(ws + WS_W1); const bf16_t* X = (const bf16_t*)(ws + WS_META + MT_XB);
    const int grow = 256 * (c / 8) + 16 * (c % 8);
    const float ssq0 = ((const float*)(ws + WS_META + MT_SSQ0))[j * 16];
    f32x4 g = meta_partial<DM>(W1t + (size_t)grow * DM, DM, X, DM, F.wave, F.lane);
    f32x4 u = meta_partial<DM>(W1t + (size_t)(grow + 128) * DM, DM, X, DM, F.wave, F.lane);
    g = meta_reduce(F, g, 0); u = meta_reduce(F, u, 1);
    if (F.wave == 0) {
        const float rs = __builtin_amdgcn_rsqf(ssq0 * (1.0f / 1024.0f) + EPS);
        float o[4];
#pragma unroll
        for (int e = 0; e < 4; ++e) { const float gg = g[e] * rs, uu = u[e] * rs; o[e] = gg * pg8::fast_sigmoid(gg) * uu; }
        u32x2 w; w.x = cvt_pk_bf16(o[0], o[1]); w.y = cvt_pk_bf16(o[2], o[3]);
        st8_wt((bf16_t*)(ws + WS_META + MT_ACT) + (size_t)j * DFF + 16 * c + 4 * q, w);
        meta_arrive(F, CW_META1);
    }
}
__device__ __forceinline__ void meta_down(Frame& F) {
    if (F.vcu >= DM / 16) return;
    meta_wait(F, CW_META1, DFF / 16);
    unsigned char* ws = F.ws; const int c = F.vcu, j = F.lane & 15, q = F.lane >> 4;
    const bf16_t* W2t = (const bf16_t*)(ws + WS_W2); const bf16_t* X = (const bf16_t*)(ws + WS_META + MT_ACT);
    const f32x4 base = *(const f32x4*)(F.in[1] + (size_t)j * DM + 16 * c + 4 * q);
    f32x4 d = meta_partial<DFF>(W2t + (size_t)(16 * c) * DFF, DFF, X, DFF, F.wave, F.lane);
    d = meta_reduce(F, d, 0);
    if (F.wave == 0) {
        const f32x4 v = base + d * 0.5f;
        u32x2 w; w.x = cvt_pk_bf16(v[0], v[1]); w.y = cvt_pk_bf16(v[2], v[3]);
        st8_wt((bf16_t*)(ws + WS_META + MT_H1B) + (size_t)j * DM + 16 * c + 4 * q, w);
        float sq = (v[0] * v[0] + v[1] * v[1]) + (v[2] * v[2] + v[3] * v[3]);
        sq = xsum32(xsum16(sq));
        if (q == 0) __hip_atomic_store((GAS float*)(ws + WS_META + MT_SSQ1) + j * 64 + c, sq, RLX_AGENT);
        meta_arrive(F, CW_META2);
    }
}
__device__ __forceinline__ void meta_proj(Frame& F) {
    if (F.vcu >= 81) return;
    meta_wait(F, CW_META2, DM / 16);
    unsigned char* ws = F.ws; const int g = F.vcu, j = F.lane & 15, q = F.lane >> 4;
    const bf16_t* Wpt = (const bf16_t*)(ws + WS_WP); const bf16_t* X = (const bf16_t*)(ws + WS_META + MT_H1B);
    int prow; bf16_t* dst; int pitch, col;
    if (g < 8)       { prow = 512 + 16 * g;         dst = (bf16_t*)(ws + WS_KA); pitch = 128; col = 16 * g; }
    else if (g < 16) { prow = 640 + 16 * (g - 8);   dst = (bf16_t*)(ws + WS_VA); pitch = 128; col = 16 * (g - 8); }
    else if (g < 48) { prow = 1280 + 16 * (g - 16); dst = (bf16_t*)(ws + WS_KB); pitch = 512; col = 16 * (g - 16); }
    else if (g < 80) { prow = 1792 + 16 * (g - 48); dst = (bf16_t*)(ws + WS_VB); pitch = 512; col = 16 * (g - 48); }
    else             { prow = 4352;                 dst = nullptr; pitch = 0; col = 0; }
    const float* s1 = (const float*)(ws + WS_META + MT_SSQ1) + j * 64 + 16 * q;
    const f32x4 a0 = *(const f32x4*)s1, a1 = *(const f32x4*)(s1 + 4), a2 = *(const f32x4*)(s1 + 8), a3 = *(const f32x4*)(s1 + 12);
    const f32x4 bb = *(const f32x4*)(F.in[7] + 4 * (q & 1));
    f32x4 d = meta_partial<DM>(Wpt + (size_t)prow * DM, DM, X, DM, F.wave, F.lane);
    d = meta_reduce(F, d, 0);
    if (F.wave == 0) {
        float s = ((a0[0] + a0[1]) + (a0[2] + a0[3])) + ((a1[0] + a1[1]) + (a1[2] + a1[3])) + ((a2[0] + a2[1]) + (a2[2] + a2[3])) + ((a3[0] + a3[1]) + (a3[2] + a3[3]));
        s = xsum32(xsum16(s));
        const float rs = __builtin_amdgcn_rsqf(s * (1.0f / 1024.0f) + EPS);
        const f32x4 v = d * rs;
        if (dst) {
            u32x2 w; w.x = cvt_pk_bf16(v[0], v[1]); w.y = cvt_pk_bf16(v[2], v[3]);
            for (int b = 0; b < NBATCH; ++b) st8_wt(dst + (size_t)(b * LPOS + KR_META + j) * pitch + col + 4 * q, w);
            if (g >= 16 && g < 48) {
                float s2 = (v[0] * v[0] + v[1] * v[1]) + (v[2] * v[2] + v[3] * v[3]);
                s2 = xsum32(xsum16(s2));
                if (q == 0) __hip_atomic_store((GAS float*)(ws + WS_META + MT_KNM) + (j * 8 + ((g - 16) >> 2)) * 4 + ((g - 16) & 3), s2, RLX_AGENT);
            }
        } else if (q < 2) {
            f32x4 lf;
#pragma unroll
            for (int e = 0; e < 4; ++e) { const float x = v[e] + bb[e]; lf[e] = log_sigmoid_hw(x); }
            float* L = (float*)(ws + WS_LOGF);
            u32x2 l0, l1; l0.x = __float_as_uint(lf[0]); l0.y = __float_as_uint(lf[1]); l1.x = __float_as_uint(lf[2]); l1.y = __float_as_uint(lf[3]);
            for (int b = 0; b < NBATCH; ++b) { float* d = L + (size_t)(b * LPOS + KR_META + j) * 8 + 4 * q; st8_wt(d, l0); st8_wt(d + 2, l1); }
        }
        meta_arrive(F, CW_META3);
    }
}
__device__ __forceinline__ void attn_phase(Frame& F, char* shm, bf16_t* OB, int only) {
    unsigned char* ws = F.ws;
    bf16_t* QO = (bf16_t*)(ws + WS_QO);
    const bf16_t *KA = (const bf16_t*)(ws + WS_KA), *VA = (const bf16_t*)(ws + WS_VA), *KB = (const bf16_t*)(ws + WS_KB), *VB = (const bf16_t*)(ws + WS_VB);
    const float* LOGF = (const float*)(ws + WS_LOGF); const float* QN2 = (const float*)(ws + WS_QN2); const float* KN2 = (const float*)(ws + WS_KN2);
    float* cl = (float*)(shm + attn2::LDS_CL); float* wtot = (float*)(shm + attn2::LDS_SCAN);
    meta_wait(F, CW_META3, 81);
    if (F.wave >= 4) __builtin_amdgcn_s_setprio(1);
    if (only != 2 && only != 4) for (int s = F.vcu; s < NBATCH * 8 * 2; s += F.G) {
        const int bh = s >> 1, half = s & 1, b = bh >> 3, h = bh & 7; float kmax2 = 0.f;
        { float v[5]; float run = 0.f; int ln = F.lane; asm volatile("" : "+v"(ln));
          float xs[5], kn[5];
#pragma unroll
          for (int k = 0; k < 5; ++k) { const int e = F.tid * 5 + k; xs[k] = (e < 2064) ? LOGF[(size_t)(b * LPOS + KR_META + e) * 8 + h] : 0.f;
              if (e >= NMETA && e < 2064) { const float* kp2 = KN2 + (size_t)(b * LPOS + KR_META + e) * 16 + 2 * h; kn[k] = kp2[0] + kp2[1]; }
              else if (e < NMETA) { const float* kq = (const float*)(ws + WS_META + MT_KNM) + (e * 8 + h) * 4; kn[k] = (kq[0] + kq[1]) + (kq[2] + kq[3]); }
              else kn[k] = 0.f; }
          float qm4[4];
#pragma unroll
          for (int i = 0; i < 4; ++i) { const int jq = half == 0 ? (i == 0 ? 0 : i == 1 ? 7 : i == 2 ? 3 : 4) : (i == 0 ? 1 : i == 1 ? 6 : i == 2 ? 2 : 5);
              if (F.tid < 256) { const float* qp2 = QN2 + (size_t)(b * SEQ + 256 * jq + F.tid) * 16 + 2 * h; qm4[i] = qp2[0] + qp2[1]; } else qm4[i] = 0.f; }
#pragma unroll
          for (int k = 0; k < 5; ++k) { run += xs[k]; v[k] = run; }
          float inc = run;
#pragma unroll
          for (int o = 1; o < 64; o <<= 1) { const float y = __shfl_up(inc, o); if (ln >= o) inc += y; }
          float km = fmaxf(fmaxf(fmaxf(kn[0], kn[1]), fmaxf(kn[2], kn[3])), kn[4]);
          km = wave_max64(km);
#pragma unroll
          for (int i = 0; i < 4; ++i) qm4[i] = wave_max64(qm4[i]);
          if (ln == 63) { wtot[F.wave] = inc; wtot[8 + F.wave] = km;
#pragma unroll
              for (int i = 0; i < 4; ++i) wtot[16 + i * 8 + F.wave] = qm4[i]; }
          __syncthreads();
          kmax2 = wtot[8];
          for (int w = 1; w < NWAVES; ++w) kmax2 = fmaxf(kmax2, wtot[8 + w]);
          float woff = 0.f;
          for (int w = 0; w < F.wave; ++w) woff += wtot[w];
          const float ex = inc - run + woff;
#pragma unroll
          for (int k = 0; k < 5; ++k) { const int e = F.tid * 5 + k; if (e < 2064) cl[e] = (v[k] + ex) * LOG2E; }
          __syncthreads(); }
        for (int i = 0; i < 4; ++i) {
            const int jj = half == 0 ? (i == 0 ? 0 : i == 1 ? 7 : i == 2 ? 3 : 4) : (i == 0 ? 1 : i == 1 ? 6 : i == 2 ? 2 : 5);
            const int t0 = 256 * jj + 32 * F.wave;
            int fskip = 0;
            { float qmax2 = wtot[16 + i * 8];
              for (int w = 1; w < 4; ++w) qmax2 = fmaxf(qmax2, wtot[16 + i * 8 + w]);
              const float bound = 2.05f * sqrtf(qmax2 * kmax2) + cl[16 + 256 * jj];
              const int T = F.lane + 1; const bool sk = (T <= 4 * jj) && (bound - cl[79 + 64 * ((T <= 4 * jj ? T : 1) - 1)] < -152.f);
              const unsigned long long mk = __ballot(sk); const int nsk = (int)__builtin_ctzll(~mk);
              fskip = nsk ? nsk + 1 : 0;
              fskip &= ~1; }
            const int row0 = fskip ? KR_REAL + 64 * (fskip - 1) : 64, kb2 = KR_REAL + 64 * fskip, nt2 = 4 * jj + 5 - fskip;
#if defined(DBG_SKIP)
            if (blockIdx.x == 0 && F.tid == 0 && jj == 7) ((float*)(ws + WS_META + 262144))[0] = (float)fskip;
#endif
            bf16_t* qw = QO + (size_t)(b * SEQ + t0) * DM + 512 + h * 64;
            attn2::unit2<0, 8>((const attn2::bf16*)qw, (attn2::bf16*)(OB + (qw - QO)), (const attn2::bf16*)(KB + (size_t)b * LPOS * 512 + h * 64), (const attn2::bf16*)(VB + (size_t)b * LPOS * 512 + h * 64), 512, nt2, row0, kb2, KR_REAL + t0, 32 * F.wave, 0.f, 0.f, cl, shm);
        }
        __syncthreads();
    }
    if (only != 1) for (int s = F.vcu; s < 256; s += F.G) {
        for (int i = 0; i < 4; ++i) {
            const int a = s * 4 + i, b = a >> 6, rem = a & 63, n = rem >> 2, kvh = (rem >> 1) & 1, pair = rem & 1;
            const int head = kvh * 4 + pair * 2 + (F.wave >> 2), t0 = 128 * n + 32 * (F.wave & 3);
            bf16_t* qw = QO + (size_t)(b * SEQ + t0) * DM + head * 64;
            const float slope2 = exp2f(-(float)(head + 1)) * LOG2E, sink2 = F.in[8][head] * LOG2E;
            if (i & 1) attn::unit_swa2<true>(qw, OB + (qw - QO), KA + (size_t)b * LPOS * 128 + kvh * 64, VA + (size_t)b * LPOS * 128 + kvh * 64, 128, 128 * n, KR_REAL + t0, slope2, sink2, shm);
            else attn::unit_swa2<false>(qw, OB + (qw - QO), KA + (size_t)b * LPOS * 128 + kvh * 64, VA + (size_t)b * LPOS * 128 + kvh * 64, 128, 128 * n, KR_REAL + t0, slope2, sink2, shm);
        }
    }
    __builtin_amdgcn_s_setprio(0);
}
__device__ __forceinline__ void final_norm(Frame& F) {
    const int gw = F.vcu * NWAVES + F.wave, NGW = F.G * NWAVES;
    const float* SSQ = (const float*)(F.ws + WS_SSQ);
    f32x4 gf[4];
#pragma unroll
    for (int j = 0; j < 4; ++j) gf[j] = ((const f32x4*)F.in[15])[64 * j + F.lane];
    for (int m = gw; m < MROWS; m += NGW) {
        const f32x4 p = *(const f32x4*)(SSQ + (size_t)m * 16 + 4 * (F.lane & 3));
        float s = (p[0] + p[1]) + (p[2] + p[3]); s += __shfl_xor(s, 1); s += __shfl_xor(s, 2);
        const float rs = 1.0f / sqrtf(s * (1.0f / 1024.0f) + EPS);
        GAS f32x4* xr = (GAS f32x4*)(F.out + (size_t)m * DM) + F.lane;
#pragma unroll
        for (int j = 0; j < 4; ++j) { const f32x4 v = xr[64 * j]; xr[64 * j] = v * rs * gf[j]; }
    }
}

#ifndef EXP_ATTN_ONLY
#define EXP_ATTN_ONLY 0
#endif
#ifndef EXP_P0_PART
#define EXP_P0_PART 0
#endif
struct Args { const float* in[16]; float* out; unsigned char* ws; int ph_lo, ph_hi, alt, pad; };
__global__ void __launch_bounds__(NWAVES * 64, 2) fwd_kernel(Args args) {
    extern __shared__ __attribute__((aligned(16))) unsigned char lds[];
    Frame F;
    F.lds = (LAS unsigned char*)lds;
    F.MISC = (volatile LAS unsigned*)(F.lds + MISC_OFF);
    F.tid = threadIdx.x; F.lane = F.tid & 63; F.wave = __builtin_amdgcn_readfirstlane(F.tid >> 6);
    F.G = gridDim.x; { const int bx = blockIdx.x; F.vcu = (F.G % 8 == 0) ? (bx % 8) * (F.G / 8) + bx / 8 : bx; }
    F.ws = args.ws; F.out = args.out;
#pragma unroll
    for (int i = 0; i < 16; ++i) F.in[i] = args.in[i];
    F.ctl = (gu32*)(F.ws + WS_CTL);
    for (int u = F.tid; u < (LDS_BYTES - LDSCTL_OFF) / 4; u += NWAVES * 64) ((LAS unsigned*)(F.lds + LDSCTL_OFF))[u] = 0u;
    __syncthreads();
    XcdBarrier bar; bar.bar = (unsigned*)(F.ctl + CW_BAR); bar.x = 0; bar.st = nullptr;
    if (N_LAUNCHES == 1) bar = xcd_barrier_post((unsigned*)(F.ctl + CW_BAR), F.MISC + 8);
#if defined(DBG_BAR2)
#define GRID_BAR() do { if (N_LAUNCHES == 1) { xcd_barrier(bar); xcd_barrier(bar); } } while (0)
#else
#define GRID_BAR() do { if (N_LAUNCHES == 1) xcd_barrier(bar); } while (0)
#endif
    const int lo = args.ph_lo, hi = args.ph_hi;
#define IN(k) (lo <= (k) && (k) < hi)
#define BOTH(k) (IN(k) && IN((k) + 1))
#define ENDBAR(k) do { if (BOTH(k)) GRID_BAR(); } while (0)
#define ENDBAR_L(k) do { if (BOTH(k)) { if (N_LAUNCHES == 1) xcd_barrier_local(bar); } } while (0)
#define ENDBAR_LI(k) do { if (BOTH(k)) { if (N_LAUNCHES == 1) xcd_barrier_local_inv(bar); } } while (0)
    unsigned char* ws = F.ws;
    bf16_t* XB = (bf16_t*)(ws + WS_XB); bf16_t* ACT = (bf16_t*)(ws + WS_ACT); float* SSQ = (float*)(ws + WS_SSQ);
    const int bx = (int)blockIdx.x;
    LAS float* rsc = (LAS float*)(F.lds + LDSCTL_OFF + 4096);
#define RSC_RESET() do { if (F.tid < 8) ((LAS int*)(rsc + 1024))[F.tid] = 0; __syncthreads(); } while (0)
#if defined(DBG_PH)
    unsigned long long ph_c0 = 0, ph_r0 = 0, ph_c1 = 0, ph_r1 = 0;
#define STAMP0(k) do { if ((k) == DBG_PH) { ph_c0 = __builtin_amdgcn_s_memtime(); ph_r0 = __builtin_amdgcn_s_memrealtime(); asm volatile("s_waitcnt lgkmcnt(0)" ::: "memory"); } } while (0)
#define STAMP1(k) do { if ((k) == DBG_PH) { ph_c1 = __builtin_amdgcn_s_memtime(); ph_r1 = __builtin_amdgcn_s_memrealtime(); asm volatile("s_waitcnt lgkmcnt(0)" ::: "memory"); } } while (0)
#else
#define STAMP0(k) do {} while (0)
#define STAMP1(k) do {} while (0)
#endif

    if (IN(0)) { STAMP0(0); p0_prologue(F, args.alt ? EXP_P0_PART : 0); STAMP1(0); ENDBAR(0); }

#if defined(DBG_CLOCK)
    unsigned long long dbg_c0 = 0, dbg_r0 = 0, dbg_c1 = 0, dbg_r1 = 0;
#endif
    if (IN(1)) { STAMP0(1);
        meta_up(F);
        pg8::Gemm g{XB, (const bf16_t*)(ws + WS_W1), DM, DM, DM}; pg8::StaticOrder S; S.init(MROWS, 2 * DFF, F.G, bx);
        pg8::EpiSwiGLU E{(char*)ws, SSQ, rsc}; RSC_RESET();
#if defined(EXP_STAGGER)
        if (args.alt) { const unsigned long long t0 = __builtin_amdgcn_s_memrealtime(); const unsigned long long dly = (unsigned long long)((F.vcu % EXP_STAGGER_G) * EXP_STAGGER);
            while (__builtin_amdgcn_s_memrealtime() - t0 < dly) __builtin_amdgcn_s_sleep(8); }
#endif
#if defined(DBG_CLOCK)
        dbg_c0 = __builtin_amdgcn_s_memtime(); dbg_r0 = __builtin_amdgcn_s_memrealtime(); asm volatile("s_waitcnt lgkmcnt(0)" ::: "memory");
#endif
#if defined(EXP_NULL_EPI)
        if (args.alt) { pg8::EpiNull EN; pg8::gemm_phase<pg8::EpiNull, pg8::StaticOrder, true, true>(F.lds + RING_OFF, g, S, EN); } else
#endif
#if defined(EXP_SEAM)
        { pg8::RangeOrder R0{S, 0, 6}, R1{S, 6, 1 << 20};
          pg8::gemm_phase<pg8::EpiSwiGLU, pg8::RangeOrder, true, true>(F.lds + RING_OFF, g, R0, E);
#if EXP_SEAM == 1
          GRID_BAR();
#elif EXP_SEAM == 2
          xcd_barrier_nf(bar);
#elif EXP_SEAM == 3
          xcd_barrier_norel(bar);
#elif EXP_SEAM == 4
          xcd_barrier_noacq(bar);
#endif
          pg8::gemm_phase<pg8::EpiSwiGLU, pg8::RangeOrder, true, true>(F.lds + RING_OFF, g, R1, E); }
#else
        pg8::gemm_phase<pg8::EpiSwiGLU, pg8::StaticOrder, true, true>(F.lds + RING_OFF, g, S, E);
#endif
#if defined(DBG_CLOCK)
        dbg_c1 = __builtin_amdgcn_s_memtime(); dbg_r1 = __builtin_amdgcn_s_memrealtime(); asm volatile("s_waitcnt lgkmcnt(0)" ::: "memory");
#endif
        STAMP1(1); ENDBAR_L(1);
    }
    if (IN(2)) { STAMP0(2);
        meta_down(F);
        pg8::Gemm g{ACT, (const bf16_t*)(ws + WS_W2), DFF, DFF, DFF, (const char*)ws}; pg8::StaticOrder S; S.init(MROWS, DM, F.G, bx, 8);
        pg8::EpiResB<false> E{XB, XB, SSQ, 0.5f};
#if defined(EXP_NULL_EPI)
        if (args.alt) { pg8::EpiNull EN; pg8::gemm_phase<pg8::EpiNull, pg8::StaticOrder, true, true>(F.lds + RING_OFF, g, S, EN); } else
#endif
        pg8::gemm_phase<pg8::EpiResB<false>, pg8::StaticOrder, true, true>(F.lds + RING_OFF, g, S, E);
        STAMP1(2); ENDBAR_LI(2);
    }
    if (IN(3)) { STAMP0(3);
        meta_proj(F);
        pg8::Gemm g{XB, (const bf16_t*)(ws + WS_WP), DM, DM, DM}; pg8::MapOrder S; S.S.init(MROWS, 10 * 256, F.G, bx); S.base = 0; S.special = 17;
        pg8::EpiProj E{SSQ, (bf16_t*)(ws + WS_QO), (bf16_t*)(ws + WS_KA), (bf16_t*)(ws + WS_VA), (bf16_t*)(ws + WS_KB), (bf16_t*)(ws + WS_VB), (bf16_t*)(ws + WS_SGA), (bf16_t*)(ws + WS_SGB), (float*)(ws + WS_LOGF), F.in[7], (float*)(ws + WS_QN2), (float*)(ws + WS_KN2), rsc}; RSC_RESET();
#if defined(EXP_NULL_EPI)
        if (args.alt) { pg8::EpiNull EN; pg8::gemm_phase<pg8::EpiNull, pg8::MapOrder, true, true>(F.lds + RING_OFF, g, S, EN); } else
#elif defined(EXP_PROJX)
        if (args.alt) { pg8::EpiProjX<EXP_PROJX> EX{SSQ, (bf16_t*)(ws + WS_QO)}; pg8::gemm_phase<pg8::EpiProjX<EXP_PROJX>, pg8::MapOrder, true, true>(F.lds + RING_OFF, g, S, EX); } else
#endif
        pg8::gemm_phase<pg8::EpiProj, pg8::MapOrder, true, true>(F.lds + RING_OFF, g, S, E);
        STAMP1(3); ENDBAR_L(3);
    }
    if (IN(4)) { STAMP0(4); attn_phase(F, (char*)lds + RING_OFF, args.alt ? (bf16_t*)(ws + WS_MIX) : (bf16_t*)(ws + WS_QO), args.alt ? EXP_ATTN_ONLY : 0);
        {
            __syncthreads();
            pg8::Gemm g{XB, (const bf16_t*)(ws + WS_WP), DM, DM, DM}; pg8::MapOrder S; S.S.init(MROWS, 8 * 256, F.G, bx); S.base = 9; S.special = -1;
            pg8::EpiProj E{SSQ, (bf16_t*)(ws + WS_QO), (bf16_t*)(ws + WS_KA), (bf16_t*)(ws + WS_VA), (bf16_t*)(ws + WS_KB), (bf16_t*)(ws + WS_VB), (bf16_t*)(ws + WS_SGA), (bf16_t*)(ws + WS_SGB), (float*)(ws + WS_LOGF), F.in[7], (float*)(ws + WS_QN2), (float*)(ws + WS_KN2), rsc}; RSC_RESET();
            pg8::gemm_phase<pg8::EpiProj, pg8::MapOrder, true, true>(F.lds + RING_OFF, g, S, E); }
        STAMP1(4); ENDBAR_L(4); }

    if (IN(5)) { STAMP0(5);
        pg8::Gemm g{(const bf16_t*)(ws + WS_QO), (const bf16_t*)(ws + WS_WAB), DM, DM, DM}; pg8::StaticOrder S; S.init(MROWS, DM, F.G, bx);
        pg8::EpiMix E{(const bf16_t*)(ws + WS_SGA), (const bf16_t*)(ws + WS_SGB), (bf16_t*)(ws + WS_MIX)};
        pg8::gemm_phase<pg8::EpiMix, pg8::StaticOrder, true, true>(F.lds + RING_OFF, g, S, E);
        STAMP1(5); ENDBAR_L(5);
    }
    if (IN(6)) { STAMP0(6);
        pg8::Gemm g{(const bf16_t*)(ws + WS_MIX), (const bf16_t*)(ws + WS_WO), DM, DM, DM}; pg8::StaticOrder S; S.init(MROWS, DM, F.G, bx);
        pg8::EpiResB<false> E{XB, XB, SSQ, 1.0f};
        pg8::gemm_phase<pg8::EpiResB<false>, pg8::StaticOrder, true, true>(F.lds + RING_OFF, g, S, E);
        STAMP1(6); ENDBAR_LI(6);
    }
    if (IN(7)) { STAMP0(7);
        pg8::Gemm g{XB, (const bf16_t*)(ws + WS_W3), DM, DM, DM}; pg8::StaticOrder S; S.init(MROWS, 2 * DFF, F.G, bx);
        pg8::EpiSwiGLU E{(char*)ws, SSQ, rsc}; RSC_RESET();
        pg8::gemm_phase<pg8::EpiSwiGLU, pg8::StaticOrder, true, true>(F.lds + RING_OFF, g, S, E);
        STAMP1(7); ENDBAR_L(7);
    }
    if (IN(8)) { STAMP0(8);
        pg8::Gemm g{ACT, (const bf16_t*)(ws + WS_W4), DFF, DFF, DFF, (const char*)ws}; pg8::StaticOrder S; S.init(MROWS, DM, F.G, bx, 8);
        pg8::EpiFinal E{XB, F.out, F.in[15], SSQ, (unsigned*)(F.ctl + CW_PANEL), 0.5f};
        pg8::gemm_phase<pg8::EpiFinal, pg8::StaticOrder, true, true>(F.lds + RING_OFF, g, S, E);
        STAMP1(8);
    }
#if defined(DBG_PH)
    GRID_BAR();
    if (bx == 0 && F.tid == 0) {
        const float dc = (float)(ph_c1 - ph_c0), dr = (float)(ph_r1 - ph_r0);
#if DBG_WHAT == 2
        F.out[0] = 400.f * floorf(dc / dr * 100.f / 400.f + 0.5f);
#elif DBG_WHAT == 0
        F.out[0] = 100.f * floorf(dc / dr + 0.5f);
#else
        F.out[0] = 1000.f + 20.f * floorf(dr * 0.01f / 20.f + 0.5f);
#endif
    }
#endif
#if defined(DBG_SKIP)
    GRID_BAR();
    if (bx == 0 && F.tid == 0) F.out[0] = 1000.f + 100.f * ((float*)(ws + WS_META + 262144))[0];
#endif
#if defined(DBG_CLOCK)
    GRID_BAR();
    if (bx == 0 && F.tid == 0) {
        const float dc = (float)(dbg_c1 - dbg_c0), dr = (float)(dbg_r1 - dbg_r0);
        float v;
        if (DBG_CLOCK == 0) v = dc / dr * 100.f;
        else if (DBG_CLOCK == 1) v = dr * 0.01f * 10.f;
        else v = dc / 176.f;
        F.out[0] = v;
    }
#endif
#undef IN
#undef BOTH
#undef GRID_BAR
}

extern "C" void kernel_launch(void* const* d_in, const int* in_sizes, int n_in, void* d_out, int out_size, void* d_ws, size_t ws_size, hipStream_t stream) {
    static int grid = 0;
    if (grid == 0) {
        if (n_in != 16 || in_sizes[0] != MROWS * DM || out_size != MROWS * DM || ws_size < WS_END) {
            fprintf(stderr, "kernel_launch: built for 16 inputs, x/out of %d floats, >= %zu bytes of workspace; got n_in %d, in0 %d, out %d, ws %zu; nothing launched\n", MROWS * DM, (size_t)WS_END, n_in, n_in > 0 ? in_sizes[0] : -1, out_size, ws_size); grid = -1; return; }
        int dev = 0, cus = 0, per_cu = 0;
        if (hipGetDevice(&dev) != hipSuccess || hipDeviceGetAttribute(&cus, hipDeviceAttributeMultiprocessorCount, dev) != hipSuccess) { fprintf(stderr, "kernel_launch: device query failed\n"); grid = -1; return; }
        if (hipFuncSetAttribute((const void*)fwd_kernel, hipFuncAttributeMaxDynamicSharedMemorySize, LDS_BYTES) != hipSuccess) { fprintf(stderr, "kernel_launch: hipFuncSetAttribute failed\n"); grid = -1; return; }
        if (hipOccupancyMaxActiveBlocksPerMultiprocessor(&per_cu, (const void*)fwd_kernel, NWAVES * 64, LDS_BYTES) != hipSuccess || per_cu < 1) { fprintf(stderr, "kernel_launch: occupancy query reports %d workgroups per CU\n", per_cu); per_cu = 1; }
        (void)hipGetLastError();
        grid = cus * (per_cu < 1 ? 1 : 1);
    }
    if (grid < 0) return;
    if (hipMemsetAsync((char*)d_ws + WS_CTL, 0, CTL_ZERO_BYTES, stream) != hipSuccess) { fprintf(stderr, "kernel_launch: hipMemsetAsync failed\n"); return; }
    Args a{};
    for (int i = 0; i < 16; ++i) a.in[i] = (const float*)d_in[i];
    a.out = (float*)d_out; a.ws = (unsigned char*)d_ws;
#ifndef EXP_REP
#define EXP_REP -1
#endif
    for (int li = 0; li < N_LAUNCHES; ++li) {
        if (N_LAUNCHES == 1) { a.ph_lo = 0; a.ph_hi = N_PHASES; } else { a.ph_lo = li; a.ph_hi = li + 1; }
        if (N_LAUNCHES != 1 && li == EXP_REP) { a.alt = 1; hipLaunchKernelGGL(fwd_kernel, dim3(grid), dim3(NWAVES * 64), LDS_BYTES, stream, a); a.alt = 0; }
        hipLaunchKernelGGL(fwd_kernel, dim3(grid), dim3(NWAVES * 64), LDS_BYTES, stream, a);
        const hipError_t le = hipPeekAtLastError();
        if (le != hipSuccess) { fprintf(stderr, "kernel_launch: launch %d failed: %s\n", li, hipGetErrorName(le)); break; }
    }
}
```
